# Optimizing an MI355X kernel written in HIP

```python
import math
import jax
import jax.numpy as jnp
from jax import lax
import numpy as np

D_MODEL = 1024
BATCH = 8
SEQ = 4096
DEPTH = 2

CTX_LEN = 256
GRID_W = 64

HEAD_DIM = 64
N_MIXERS = 4
GROUP_WIDTH = D_MODEL // N_MIXERS
MIX_WIDTH = N_MIXERS * GROUP_WIDTH
N_MOD = 9
D_FF = 2816

SWA_HEADS = GROUP_WIDTH // HEAD_DIM
SWA_KV_HEADS = 2
SWA_WINDOW = 128
SWA_BLOCK = 128
SSD_HEADS = GROUP_WIDTH // HEAD_DIM
SSD_HEAD_DIM = HEAD_DIM
SSD_INNER = SSD_HEADS * SSD_HEAD_DIM
SSD_STATE = 128
SSD_BC_GROUPS = 2
SSD_CONV = 5
SSD_CHUNK = 128
SSD_CONV_CH = SSD_INNER + 2 * SSD_BC_GROUPS * SSD_STATE
DT_MIN = 0.001
DT_MAX = 0.1
GQA_HEADS = GROUP_WIDTH // HEAD_DIM
GQA_KV_HEADS = 2
GQA_BLOCK = 128
NA_HEADS = GROUP_WIDTH // HEAD_DIM
NA_ROWS = 8
NA_COLS = 16

ROPE_BASE = 10000.0
EPS = 1e-5
ALPHA = (2 * DEPTH) ** 0.25
BETA = (8 * DEPTH) ** -0.25

IN_SPLITS = (SWA_HEADS * HEAD_DIM, SWA_KV_HEADS * HEAD_DIM, SWA_KV_HEADS * HEAD_DIM,
             SSD_INNER, SSD_CONV_CH, 2 * SSD_HEADS,
             GQA_HEADS * HEAD_DIM, GQA_KV_HEADS * HEAD_DIM, GQA_KV_HEADS * HEAD_DIM,
             NA_HEADS * HEAD_DIM, NA_HEADS * HEAD_DIM, NA_HEADS * HEAD_DIM)
IN_WIDTH = sum(IN_SPLITS)

kernel_name = 'hybrid_parallel_group_diffusion_block'


def _heads(t):
    return t.reshape(t.shape[:-1] + (t.shape[-1] // HEAD_DIM, HEAD_DIM))


def _flip(t):
    return jnp.flip(t, axis=1)


def layer_norm(x, g, b):
    xf = x.astype(jnp.float32)
    mu = jnp.mean(xf, -1, keepdims=True)
    var = jnp.mean(jnp.square(xf - mu), -1, keepdims=True)
    return ((xf - mu) * lax.rsqrt(var + EPS) * g.astype(jnp.float32) + b.astype(jnp.float32)).astype(x.dtype)


def rms_norm(x, g):
    xf = x.astype(jnp.float32)
    return (xf * lax.rsqrt(jnp.mean(xf * xf, -1, keepdims=True) + EPS) * g.astype(jnp.float32)).astype(x.dtype)


def modulate(x, shift, scale):
    return x * (1 + scale) + shift


def post_norm(x, f, g, b):
    return layer_norm(ALPHA * x + f, g, b)


def swiglu(h, w_in, w_out):
    a, u = jnp.split(h @ w_in, 2, axis=-1)
    return (jax.nn.silu(a) * u) @ w_out


def rope_tables(S, dtype):
    t = jnp.arange(S)
    pos = jnp.stack([t // GRID_W, t % GRID_W], -1).astype(jnp.float32)
    quarter = HEAD_DIM // 4
    inv = ROPE_BASE ** (-jnp.arange(quarter, dtype=jnp.float32) / quarter)
    ang = pos[:, None, :, None] * inv
    return jnp.cos(ang).astype(dtype), jnp.sin(ang).astype(dtype)


def rope2d(x, cos, sin):
    xr = x.reshape(x.shape[:-1] + (2, 2, HEAD_DIM // 4))
    x1, x2 = xr[..., 0, :], xr[..., 1, :]
    out = jnp.stack([x1 * cos - x2 * sin, x1 * sin + x2 * cos], -2)
    return out.reshape(x.shape)


def dense_attn(q, k, v, sink=None):
    Bq, L, Hq, dh = q.shape
    g = k.shape[2]
    r = Hq // g
    qg = q.reshape(Bq, L, g, r, dh)
    s = jnp.einsum('blgrd,bmgd->bgrlm', qg, k).astype(jnp.float32) * (dh ** -0.5)
    if sink is not None:
        sk = jnp.broadcast_to(sink.astype(jnp.float32).reshape(1, g, r, 1, 1), s.shape[:-1] + (1,))
        p = jax.nn.softmax(jnp.concatenate([s, sk], -1), -1)[..., :-1]
    else:
        p = jax.nn.softmax(s, -1)
    o = jnp.einsum('bgrlm,bmgd->blgrd', p.astype(v.dtype), v)
    return o.reshape(Bq, L, Hq * dh)


def swa_latent(q, k, v, k_ctx, v_ctx, sink):
    Bq, S, Hq, dh = q.shape
    g = k.shape[2]
    r = Hq // g
    Q = SWA_BLOCK
    nb = S // Q
    M = k_ctx.shape[1]
    qb = q.reshape(Bq, nb, Q, g, r, dh)

    def band(t):
        tp = jnp.pad(t, ((0, 0), (Q, Q), (0, 0), (0, 0))).reshape(Bq, nb + 2, Q, g, dh)
        return jnp.concatenate([tp[:, :-2], tp[:, 1:-1], tp[:, 2:]], axis=2)

    kb, vb = band(k), band(v)
    qpos = jnp.arange(nb)[:, None] * Q + jnp.arange(Q)[None]
    kpos = (jnp.arange(nb)[:, None] - 1) * Q + jnp.arange(3 * Q)[None]
    off = kpos[:, None, :] - qpos[:, :, None]
    valid = (jnp.abs(off) <= SWA_WINDOW) & (kpos[:, None, :] >= 0) & (kpos[:, None, :] < S)
    scale = dh ** -0.5
    s_loc = jnp.einsum('bnqgrd,bnkgd->bngrqk', qb, kb).astype(jnp.float32) * scale
    s_loc = jnp.where(valid[None, :, None, None], s_loc, -jnp.inf)
    s_ctx = jnp.einsum('bnqgrd,bmgd->bngrqm', qb, k_ctx).astype(jnp.float32) * scale
    sk = jnp.broadcast_to(sink.astype(jnp.float32).reshape(1, 1, g, r, 1, 1), s_ctx.shape[:-1] + (1,))
    p = jax.nn.softmax(jnp.concatenate([s_loc, s_ctx, sk], -1), -1).astype(v.dtype)
    o = (jnp.einsum('bngrqk,bnkgd->bnqgrd', p[..., :3 * Q], vb)
         + jnp.einsum('bngrqm,bmgd->bnqgrd', p[..., 3 * Q:3 * Q + M], v_ctx))
    return o.reshape(Bq, S, Hq * dh)


def gqa_latent(q, k, v, k_ctx, v_ctx):
    Bq, S, Hq, dh = q.shape
    nb = S // GQA_BLOCK
    k_all = jnp.concatenate([k, k_ctx], axis=1)
    v_all = jnp.concatenate([v, v_ctx], axis=1)
    qb = jnp.moveaxis(q.reshape(Bq, nb, GQA_BLOCK, Hq, dh), 1, 0)
    o = lax.map(lambda qblk: dense_attn(qblk, k_all, v_all), qb)
    return jnp.moveaxis(o, 0, 1).reshape(Bq, S, Hq * dh)


def na_latent(q, k, v, k_ctx, v_ctx, rpb):
    Bq, S, H, dh = q.shape
    W = GRID_W
    rows = S // W
    KH = min(NA_ROWS, rows)
    KW = NA_COLS
    qg = q.reshape(Bq, rows, W, H, dh)
    kg = k.reshape(Bq, rows, W, H, dh)
    vg = v.reshape(Bq, rows, W, H, dh)
    cidx = jnp.arange(W)
    col_idx = jnp.clip(cidx - KW // 2, 0, W - KW)[:, None] + jnp.arange(KW)[None]
    dc = col_idx - cidx[:, None] + NA_COLS - 1
    rpb_c = rpb.astype(jnp.float32)[:, :, dc]
    scale = dh ** -0.5

    def one_row(args):
        r, q_row = args
        rs = jnp.clip(r - KH // 2, 0, rows - KH)
        k_nb = lax.dynamic_slice_in_dim(kg, rs, KH, axis=1)[:, :, col_idx]
        v_nb = lax.dynamic_slice_in_dim(vg, rs, KH, axis=1)[:, :, col_idx]
        dr = rs + jnp.arange(KH) - r + NA_ROWS - 1
        bias = jnp.transpose(jnp.take(rpb_c, dr, axis=1), (0, 2, 1, 3))
        s_nb = jnp.einsum('bwhd,bawkhd->bhwak', q_row, k_nb).astype(jnp.float32) * scale + bias
        s_ctx = jnp.einsum('bwhd,bmhd->bhwm', q_row, k_ctx).astype(jnp.float32) * scale
        p = jax.nn.softmax(jnp.concatenate([s_nb.reshape(Bq, H, W, KH * KW), s_ctx], -1), -1)
        p = p.astype(v.dtype)
        p_nb = p[..., :KH * KW].reshape(Bq, H, W, KH, KW)
        return (jnp.einsum('bhwak,bawkhd->bwhd', p_nb, v_nb)
                + jnp.einsum('bhwm,bmhd->bwhd', p[..., KH * KW:], v_ctx))

    o = lax.map(one_row, (jnp.arange(rows), jnp.moveaxis(qg, 1, 0)))
    return jnp.moveaxis(o, 0, 1).reshape(Bq, S, H * dh)


def dwconv(u, w, b):
    out = lax.conv_general_dilated(u, w.astype(u.dtype), window_strides=(1,), padding='SAME',
                                   dimension_numbers=('NWC', 'WIO', 'NWC'),
                                   feature_group_count=u.shape[-1])
    return jax.nn.silu(out + b)


def ssd_prep(xbc, dt_raw, conv_w, conv_b, dt_bias):
    u = dwconv(xbc, conv_w, conv_b)
    xs, Bm, Cm = jnp.split(u, [SSD_INNER, SSD_INNER + SSD_BC_GROUPS * SSD_STATE], axis=-1)
    lead = u.shape[:-1]
    rep = SSD_HEADS // SSD_BC_GROUPS
    xs = xs.reshape(lead + (SSD_HEADS, SSD_HEAD_DIM))
    Bh = jnp.repeat(Bm.reshape(lead + (SSD_BC_GROUPS, SSD_STATE)), rep, axis=-2)
    Ch = jnp.repeat(Cm.reshape(lead + (SSD_BC_GROUPS, SSD_STATE)), rep, axis=-2)
    dt = jax.nn.softplus(dt_raw.astype(jnp.float32).reshape(lead + (2, SSD_HEADS))
                         + dt_bias.astype(jnp.float32))
    return xs, Bh, Ch, dt


def ssd_chunked(x, dt, A, Bh, Ch, h0):
    Bsz, L, H, P = x.shape
    N = Bh.shape[-1]
    Q = SSD_CHUNK
    nc = L // Q
    xc = x.reshape(Bsz, nc, Q, H, P)
    Bc = Bh.reshape(Bsz, nc, Q, H, N)
    Cc = Ch.reshape(Bsz, nc, Q, H, N)
    dtc = dt.reshape(Bsz, nc, Q, H)
    cum = jnp.cumsum(dtc * A, axis=2)
    seg = cum[:, :, :, None, :] - cum[:, :, None, :, :]
    tril = jnp.tril(jnp.ones((Q, Q), bool))[None, None, :, :, None]
    lmat = jnp.exp(jnp.where(tril, seg, -jnp.inf))
    att = jnp.einsum('bcihn,bcjhn->bcijh', Cc, Bc) * lmat * dtc[:, :, None]
    y = jnp.einsum('bcijh,bcjhp->bcihp', att, xc)
    w_end = jnp.exp(cum[:, :, -1:] - cum) * dtc
    states = jnp.einsum('bcjhn,bcjh,bcjhp->bchpn', Bc, w_end, xc)
    chunk_decay = jnp.exp(cum[:, :, -1])

    def step(h, inp):
        st, dec = inp
        return h * dec[:, :, None, None] + st, h

    h_last, h_start = lax.scan(step, h0, (jnp.moveaxis(states, 1, 0), jnp.moveaxis(chunk_decay, 1, 0)))
    y = y + jnp.einsum('bcihn,bchpn,bcih->bcihp', Cc, jnp.moveaxis(h_start, 0, 1), jnp.exp(cum))
    return y.reshape(Bsz, L, H, P), h_last


def ssd_final_state(x, dt, A, Bh):
    cum = jnp.cumsum(dt * A, axis=1)
    w_end = jnp.exp(cum[:, -1:] - cum) * dt
    return jnp.einsum('blhn,blh,blhp->bhpn', Bh, w_end, x)


def ssd_bidir(xs, dt, A, Bh, Ch, h0f, h0b):
    yf, hf = ssd_chunked(xs, dt[..., 0, :], A[0], Bh, Ch, h0f)
    yb, hb = ssd_chunked(_flip(xs), _flip(dt[..., 1, :]), A[1], _flip(Bh), _flip(Ch), h0b)
    return yf + _flip(yb), hf, hb


def ssd_out(y, xs, z, d_skip):
    y = y + d_skip.astype(jnp.float32)[:, None] * xs
    return (y.reshape(z.shape) * jax.nn.silu(z)).astype(z.dtype)


def merge_groups(outs, g, w_out):
    y = jnp.concatenate(outs, -1)
    yf = y.astype(jnp.float32).reshape(y.shape[:-1] + (N_MIXERS, GROUP_WIDTH))
    yf = yf * lax.rsqrt(jnp.mean(yf * yf, -1, keepdims=True) + EPS)
    yf = yf * g.astype(jnp.float32).reshape(N_MIXERS, GROUP_WIDTH)
    return yf.reshape(y.shape).astype(y.dtype) @ w_out


def project(h, w_in):
    idx = np.cumsum(IN_SPLITS)[:-1].tolist()
    return jnp.split(h @ w_in, idx, axis=-1)


def hybrid_mixer(h, hc, cos, sin, w_in, w_out, norm_g, sink, conv_w, conv_b, dt_bias, a_log,
                 d_skip, q_norm, k_norm, rpb, last):
    aq, ak, av, bz, bxbc, bdt, cq, ck, cv, dq, dk, dv = project(h, w_in)
    aq_c, ak_c, av_c, bz_c, bxbc_c, bdt_c, cq_c, ck_c, cv_c, dq_c, dk_c, dv_c = project(hc, w_in)
    A = -jnp.exp(a_log.astype(jnp.float32))
    ka_c, va_c = _heads(ak_c), _heads(av_c)
    kc_c, vc_c = rms_norm(_heads(ck_c), k_norm), _heads(cv_c)
    kd_c, vd_c = _heads(dk_c), _heads(dv_c)
    xs_c, bh_c, ch_c, dt_c = ssd_prep(bxbc_c, bdt_c, conv_w, conv_b, dt_bias)
    if last:
        hf_c = ssd_final_state(xs_c, dt_c[..., 0, :], A[0], bh_c)
        hb_c = ssd_final_state(_flip(xs_c), _flip(dt_c[..., 1, :]), A[1], _flip(bh_c))
    else:
        zeros = jnp.zeros((xs_c.shape[0], SSD_HEADS, SSD_HEAD_DIM, SSD_STATE), jnp.float32)
        y_c, hf_c, hb_c = ssd_bidir(xs_c, dt_c, A, bh_c, ch_c, zeros, zeros)
    oa = swa_latent(rope2d(_heads(aq), cos, sin), rope2d(_heads(ak), cos, sin), _heads(av), ka_c, va_c, sink)
    xs, bh, ch, dt = ssd_prep(bxbc, bdt, conv_w, conv_b, dt_bias)
    y, _, _ = ssd_bidir(xs, dt, A, bh, ch, hf_c, hb_c)
    ob = ssd_out(y, xs, bz, d_skip)
    oc = gqa_latent(rope2d(rms_norm(_heads(cq), q_norm), cos, sin),
                    rope2d(rms_norm(_heads(ck), k_norm), cos, sin), _heads(cv), kc_c, vc_c)
    od = na_latent(_heads(dq), _heads(dk), _heads(dv), kd_c, vd_c, rpb)
    mix_x = merge_groups([oa, ob, oc, od], norm_g, w_out)
    if last:
        return mix_x, None
    oa_c = dense_attn(_heads(aq_c), ka_c, va_c, sink)
    ob_c = ssd_out(y_c, xs_c, bz_c, d_skip)
    oc_c = dense_attn(rms_norm(_heads(cq_c), q_norm), kc_c, vc_c)
    od_c = dense_attn(_heads(dq_c), kd_c, vd_c)
    return mix_x, merge_groups([oa_c, ob_c, oc_c, od_c], norm_g, w_out)


def setup_inputs(seed: int = 0) -> dict:
    key = jax.random.key(seed)
    ks = jax.random.split(key, 24)
    f32 = jnp.float32
    D = D_MODEL
    L = DEPTH

    def nrm(k, shape, std):
        return jax.random.normal(k, shape, f32) * std

    dt0 = jnp.exp(jax.random.uniform(ks[16], (L, 2, SSD_HEADS), f32)
                  * (math.log(DT_MAX) - math.log(DT_MIN)) + math.log(DT_MIN))
    return {
        'x': nrm(ks[0], (BATCH, SEQ, D), 1.0),
        'c': nrm(ks[1], (BATCH, D), 1.0),
        'ctx': nrm(ks[2], (BATCH, CTX_LEN, D), 1.0),
        'c_ctx': nrm(ks[3], (D,), 1.0),
        'ada_w': nrm(ks[4], (L, D, N_MOD * D), 0.5 * D ** -0.5),
        'ada_b': nrm(ks[5], (L, N_MOD * D), 0.01),
        'ln_g': 1.0 + nrm(ks[6], (L, 3, D), 0.05),
        'ln_b': nrm(ks[7], (L, 3, D), 0.01),
        'ffn1_w_in': nrm(ks[8], (L, D, 2 * D_FF), D ** -0.5),
        'ffn1_w_out': nrm(ks[9], (L, D_FF, D), BETA * D_FF ** -0.5),
        'mix_w_in': nrm(ks[10], (L, D, IN_WIDTH), D ** -0.5),
        'mix_w_out': nrm(ks[11], (L, MIX_WIDTH, D), BETA * MIX_WIDTH ** -0.5),
        'mix_norm_g': 1.0 + nrm(ks[12], (L, MIX_WIDTH), 0.05),
        'swa_sink': nrm(ks[13], (L, SWA_HEADS), 1.0),
        'ssd_conv_w': nrm(ks[14], (L, SSD_CONV, 1, SSD_CONV_CH), SSD_CONV ** -0.5),
        'ssd_conv_b': nrm(ks[15], (L, SSD_CONV_CH), 0.01),
        'ssd_dt_bias': dt0 + jnp.log(-jnp.expm1(-dt0)),
        'ssd_A_log': jnp.log(jax.random.uniform(ks[17], (L, 2, SSD_HEADS), f32, 1.0, 16.0)),
        'ssd_D': 1.0 + nrm(ks[18], (L, SSD_HEADS), 0.1),
        'gqa_q_norm': 1.0 + nrm(ks[19], (L, HEAD_DIM), 0.05),
        'gqa_k_norm': 1.0 + nrm(ks[20], (L, HEAD_DIM), 0.05),
        'na_rpb': nrm(ks[21], (L, NA_HEADS, 2 * NA_ROWS - 1, 2 * NA_COLS - 1), 0.2),
        'ffn2_w_in': nrm(ks[22], (L, D, 2 * D_FF), D ** -0.5),
        'ffn2_w_out': nrm(ks[23], (L, D_FF, D), BETA * D_FF ** -0.5),
    }


def reference(x, c, ctx, c_ctx, ada_w, ada_b, ln_g, ln_b, ffn1_w_in, ffn1_w_out, mix_w_in, mix_w_out,
              mix_norm_g, swa_sink, ssd_conv_w, ssd_conv_b, ssd_dt_bias, ssd_A_log, ssd_D,
              gqa_q_norm, gqa_k_norm, na_rpb, ffn2_w_in, ffn2_w_out):
    Bsz, S, _ = x.shape
    cos, sin = rope_tables(S, x.dtype)
    for l in range(DEPTH):
        last = l == DEPTH - 1
        m = (jax.nn.silu(c) @ ada_w[l] + ada_b[l]).reshape(Bsz, N_MOD, 1, D_MODEL)
        mc = (jax.nn.silu(c_ctx) @ ada_w[l] + ada_b[l]).reshape(N_MOD, 1, D_MODEL)
        x = post_norm(x, 0.5 * m[:, 2] * swiglu(modulate(x, m[:, 0], m[:, 1]), ffn1_w_in[l], ffn1_w_out[l]),
                      ln_g[l, 0], ln_b[l, 0])
        ctx = post_norm(ctx, 0.5 * mc[2] * swiglu(modulate(ctx, mc[0], mc[1]), ffn1_w_in[l], ffn1_w_out[l]),
                        ln_g[l, 0], ln_b[l, 0])
        mix_x, mix_c = hybrid_mixer(modulate(x, m[:, 3], m[:, 4]), modulate(ctx, mc[3], mc[4]), cos, sin,
                                    mix_w_in[l], mix_w_out[l], mix_norm_g[l], swa_sink[l],
                                    ssd_conv_w[l], ssd_conv_b[l], ssd_dt_bias[l], ssd_A_log[l], ssd_D[l],
                                    gqa_q_norm[l], gqa_k_norm[l], na_rpb[l], last)
        x = post_norm(x, m[:, 5] * mix_x, ln_g[l, 1], ln_b[l, 1])
        x = post_norm(x, 0.5 * m[:, 8] * swiglu(modulate(x, m[:, 6], m[:, 7]), ffn2_w_in[l], ffn2_w_out[l]),
                      ln_g[l, 2], ln_b[l, 2])
        if not last:
            ctx = post_norm(ctx, mc[5] * mix_c, ln_g[l, 1], ln_b[l, 1])
            ctx = post_norm(ctx, 0.5 * mc[8] * swiglu(modulate(ctx, mc[6], mc[7]), ffn2_w_in[l], ffn2_w_out[l]),
                            ln_g[l, 2], ln_b[l, 2])
    return x
```

```cpp
#include <hip/hip_runtime.h>
#include <hip/hip_cooperative_groups.h>
#include <cstdio>
#include <cstdint>
namespace cg = cooperative_groups;
namespace pg8 {
#define PG8_LAS __attribute__((address_space(3)))
typedef unsigned short bf16_t;
typedef short bf16x8 __attribute__((ext_vector_type(8)));
typedef float f32x4 __attribute__((ext_vector_type(4)));
typedef unsigned u32x4 __attribute__((ext_vector_type(4)));
constexpr int BM = 256, BK = 64, HALF = 128, HTB = HALF * BK * 2  , STAGE_BYTES = 8 * HTB, NXCD = 8, WGM = 8;

__host__ __device__ __forceinline__ int lds_byte(int r, int c) { const int st = (r >> 4) * 2 + (c >> 5), rr = r & 15, cc = c & 31, ob = rr * 64 + cc * 2; return st * 1024 + (ob ^ (((ob >> 9) & 1) << 5)); }
__host__ __device__ __forceinline__ void stage_rc(int b, int& R, int& C) { const int st = b / 1024, sb = b % 1024, swz = sb ^ (((sb >> 9) & 1) << 5); R = (st >> 1) * 16 + swz / 64; C = (st & 1) * 32 + (swz % 64) / 2; }
__host__ __device__ __forceinline__ int perm32(int rho) { const int n = rho >> 4, i = rho & 15; return 8 * (i >> 2) + 4 * n + (i & 3); }

struct Unit { int pm, pn; };
struct Gemm { const bf16_t* A; const bf16_t* Bt; int M, N, K; };

struct StaticOrder {
    int nM, nN, nwg, G, c;
    __host__ __device__ void init(int M, int N, int G_, int c_) { nM = M / BM; nN = N / BM; nwg = nM * nN; G = G_; c = c_; }
    __host__ __device__ bool next(int i, Unit& u) const {
        const long L = (long)i * G + c; if (L >= nwg) return false;
        int wgid = (int)L; { const int q = nwg / NXCD, r = nwg % NXCD, xcd = wgid % NXCD, off = wgid / NXCD; wgid = (xcd < r ? xcd * (q + 1) : r * (q + 1) + (xcd - r) * q) + off; }
        const int nig = WGM * nN, gid = wgid / nig, fm = gid * WGM, gsz = (nM - fm) < WGM ? (nM - fm) : WGM;
        u.pm = fm + ((wgid % nig) % gsz); u.pn = (wgid % nig) / gsz; return true;
    }
    __device__ __forceinline__ void a_ready(const Unit&) const {}
    __device__ __forceinline__ void done(const Unit&) const {}
};

__device__ __forceinline__ unsigned cvt_pk_bf16(float lo, float hi) { unsigned r; asm volatile("v_cvt_pk_bf16_f32 %0, %1, %2" : "=v"(r) : "v"(lo), "v"(hi)); return r; }
struct EpiBf16 {
    static constexpr bool PERM = true, AFTER_DRAIN = false;
    bf16_t* O; int ldc;
    __device__ __forceinline__ void operator()(const f32x4 (&acc)[2][2][4][2], const Unit& u, int wr, int wc, int fr, int fq) const {
        const int row0 = u.pm * BM + wr * 64 + fr; const int col0 = u.pn * BM + wc * 32 + 8 * fq;
#pragma unroll
        for (int ai = 0; ai < 2; ++ai)
#pragma unroll
            for (int m = 0; m < 4; ++m) { bf16_t* rowp = O + (size_t)(row0 + ai * HALF + m * 16) * ldc + col0;
#pragma unroll
                for (int bj = 0; bj < 2; ++bj) { const f32x4 v0 = acc[ai][bj][m][0], v1 = acc[ai][bj][m][1];
                    u32x4 w; w.x = cvt_pk_bf16(v0[0], v0[1]); w.y = cvt_pk_bf16(v0[2], v0[3]); w.z = cvt_pk_bf16(v1[0], v1[1]); w.w = cvt_pk_bf16(v1[2], v1[3]);
                    *(u32x4*)(rowp + bj * HALF) = w; } }
    }
};
__device__ __forceinline__ float silu_f(float x) { return x * __builtin_amdgcn_rcpf(1.0f + __expf(-x)); }
struct EpiSwiGLU {
    static constexpr bool PERM = true, AFTER_DRAIN = false;
    bf16_t* O; int ldc;
    __device__ __forceinline__ void operator()(const f32x4 (&acc)[2][2][4][2], const Unit& u, int wr, int wc, int fr, int fq) const {
        const int row0 = u.pm * BM + wr * 64 + fr; const int col0 = u.pn * HALF + wc * 32 + 8 * fq;
#pragma unroll
        for (int ai = 0; ai < 2; ++ai)
#pragma unroll
            for (int m = 0; m < 4; ++m) { bf16_t* rowp = O + (size_t)(row0 + ai * HALF + m * 16) * ldc + col0;
                const f32x4 a0 = acc[ai][0][m][0], a1 = acc[ai][0][m][1], u0 = acc[ai][1][m][0], u1 = acc[ai][1][m][1];
                u32x4 w;
                w.x = cvt_pk_bf16(silu_f(a0[0]) * u0[0], silu_f(a0[1]) * u0[1]); w.y = cvt_pk_bf16(silu_f(a0[2]) * u0[2], silu_f(a0[3]) * u0[3]);
                w.z = cvt_pk_bf16(silu_f(a1[0]) * u1[0], silu_f(a1[1]) * u1[1]); w.w = cvt_pk_bf16(silu_f(a1[2]) * u1[2], silu_f(a1[3]) * u1[3]);
                *(u32x4*)rowp = w; }
    }
};
template <class Epi, class Sched, bool ALIGN_EPI = false, bool SP2 = false>
__device__ __forceinline__ void gemm_phase(PG8_LAS unsigned char* lds, const Gemm g, const Sched& S, const Epi& E) {
    const int tid = threadIdx.x, wid = __builtin_amdgcn_readfirstlane(tid >> 6), lane = tid & 63, wr = wid >> 2, wc = wid & 3, fr = lane & 15, fq = lane >> 4;
    const int K = g.K, nt = K / BK;
    unsigned voffA[2], voffB[2];
#pragma unroll
    for (int i = 0; i < 2; ++i) { int R, C; stage_rc(tid * 16 + i * 8192, R, C); const int Rb = Epi::PERM ? ((R & ~31) + perm32(R & 31)) : R;
        voffA[i] = (unsigned)(R * K + C) * 2u; voffB[i] = (unsigned)(Rb * K + C) * 2u; }
    const size_t kstep = (size_t)(BK * 2);
    const size_t hstep = (size_t)HALF * K * 2;
    const size_t tstep = 2 * hstep;
    const unsigned ldsw = (unsigned)wid * 1024u;
    const int aoff = lds_byte(wr * 64 + fr, fq * 8), boff = lds_byte(wc * 32 + fr, fq * 8);
#define PG8_SA(b, h) (((b) * 2 + (h)) * HTB)
#define PG8_SB(b, h) ((4 + (b) * 2 + (h)) * HTB)
#define PG8_STAGE(bufoff, gbase, voff) do { _Pragma("unroll") for (int _i = 0; _i < 2; ++_i) \
        __builtin_amdgcn_global_load_lds((const unsigned*)((const char*)(gbase) + (voff)[_i]), (PG8_LAS unsigned*)(lds + (bufoff) + ldsw + _i * 8192), 16, 0, 0); } while (0)
#define PG8_LDA(dst, b, h) do { _Pragma("unroll") for (int m = 0; m < 4; ++m) _Pragma("unroll") for (int k = 0; k < 2; ++k) dst[m][k] = *(const PG8_LAS bf16x8*)(lds + PG8_SA(b, h) + aoff + m * 2048 + k * 1024); } while (0)
#define PG8_LDB(dst, b, h) do { _Pragma("unroll") for (int n = 0; n < 2; ++n) _Pragma("unroll") for (int k = 0; k < 2; ++k) dst[n][k] = *(const PG8_LAS bf16x8*)(lds + PG8_SB(b, h) + boff + n * 2048 + k * 1024); } while (0)
#define PG8_MMA(ai, bj, At, Bt) do { __builtin_amdgcn_s_setprio(1); _Pragma("unroll") for (int m = 0; m < 4; ++m) _Pragma("unroll") for (int n = 0; n < 2; ++n) _Pragma("unroll") for (int k = 0; k < 2; ++k) \
        acc[ai][bj][m][n] = __builtin_amdgcn_mfma_f32_16x16x32_bf16(Bt[n][k], At[m][k], acc[ai][bj][m][n], 0, 0, 0); __builtin_amdgcn_s_setprio(0); } while (0)
#define PG8_WAIT_V(n) asm volatile("s_waitcnt vmcnt(" #n ")" ::: "memory")
#define PG8_WAIT_L(n) asm volatile("s_waitcnt lgkmcnt(" #n ")" ::: "memory")
#define PG8_BAR __builtin_amdgcn_s_barrier()
#define PG8_SCHED __builtin_amdgcn_sched_barrier(0)
    Unit cur, nxt; int ui = 0;
    if (!S.next(0, cur)) return;
    f32x4 acc[2][2][4][2];
#pragma unroll
    for (int a = 0; a < 2; ++a)
#pragma unroll
        for (int b = 0; b < 2; ++b)
#pragma unroll
            for (int m = 0; m < 4; ++m)
#pragma unroll
                for (int n = 0; n < 2; ++n) acc[a][b][m][n] = (f32x4){0.f, 0.f, 0.f, 0.f};
    bf16x8 At[4][2], B0[2][2], B1[2][2];
    const char* cA = (const char*)g.A + (size_t)cur.pm * tstep; const char* cB = (const char*)g.Bt + (size_t)cur.pn * tstep;
    S.a_ready(cur);
    if constexpr (SP2) {
        PG8_STAGE(PG8_SB(0, 0), cB, voffB); PG8_STAGE(PG8_SB(0, 1), cB + hstep, voffB); PG8_STAGE(PG8_SA(0, 0), cA, voffA); PG8_STAGE(PG8_SA(0, 1), cA + hstep, voffA);
        if (wr == 1) PG8_BAR;
        PG8_WAIT_V(2); PG8_BAR;
        PG8_STAGE(PG8_SB(1, 0), cB + kstep, voffB); PG8_STAGE(PG8_SA(1, 0), cA + kstep, voffA); PG8_STAGE(PG8_SB(1, 1), cB + hstep + kstep, voffB);
        PG8_WAIT_V(6); PG8_BAR;
    } else {
        PG8_STAGE(PG8_SB(0, 0), cB, voffB); PG8_STAGE(PG8_SA(0, 0), cA, voffA); PG8_STAGE(PG8_SB(0, 1), cB + hstep, voffB); PG8_STAGE(PG8_SA(0, 1), cA + hstep, voffA);
        if (wr == 1) PG8_BAR;
        PG8_WAIT_V(4); PG8_BAR;
        PG8_STAGE(PG8_SB(1, 0), cB + kstep, voffB); PG8_STAGE(PG8_SA(1, 0), cA + kstep, voffA); PG8_STAGE(PG8_SB(1, 1), cB + hstep + kstep, voffB);
        PG8_WAIT_V(6); PG8_BAR;
    }
    for (;;) {
        const bool has_next = S.next(ui + 1, nxt);
        const char* nA = has_next ? (const char*)g.A + (size_t)nxt.pm * tstep : cA; const char* nB = has_next ? (const char*)g.Bt + (size_t)nxt.pn * tstep : cB;
        for (int t = 0; t < nt; t += 2) {
            const bool last = (t == nt - 2);
            const char* a1 = cA + (size_t)(t + 1) * kstep;
            const char* a2 = last ? nA : cA + (size_t)(t + 2) * kstep; const char* b2 = last ? nB : cB + (size_t)(t + 2) * kstep;
            const char* a3 = a2 + kstep; const char* b3 = b2 + kstep;
            if (last && has_next) S.a_ready(nxt);
            if constexpr (SP2) {
            PG8_LDB(B0, 0, 0); PG8_LDB(B1, 0, 1); PG8_SCHED; PG8_LDA(At, 0, 0); PG8_STAGE(PG8_SA(1, 1), a1 + hstep, voffA);
            PG8_WAIT_V(8); PG8_WAIT_L(0); PG8_BAR; PG8_MMA(0, 0, At, B0); PG8_MMA(0, 1, At, B1); PG8_BAR; PG8_SCHED;
            PG8_LDA(At, 0, 1); PG8_STAGE(PG8_SB(0, 0), b2, voffB); PG8_STAGE(PG8_SB(0, 1), b2 + hstep, voffB); PG8_STAGE(PG8_SA(0, 0), a2, voffA);
            PG8_WAIT_V(8); PG8_WAIT_L(0); PG8_BAR; PG8_MMA(1, 0, At, B0); PG8_MMA(1, 1, At, B1); PG8_BAR; PG8_SCHED;
            PG8_LDB(B0, 1, 0); PG8_LDB(B1, 1, 1); PG8_SCHED; PG8_LDA(At, 1, 0); PG8_STAGE(PG8_SA(0, 1), a2 + hstep, voffA);
            PG8_WAIT_V(8); PG8_WAIT_L(0); PG8_BAR; PG8_MMA(0, 0, At, B0); PG8_MMA(0, 1, At, B1); PG8_BAR; PG8_SCHED;
            PG8_LDA(At, 1, 1); PG8_STAGE(PG8_SB(1, 0), b3, voffB); PG8_STAGE(PG8_SB(1, 1), b3 + hstep, voffB); PG8_STAGE(PG8_SA(1, 0), a3, voffA);
            PG8_WAIT_V(8); PG8_WAIT_L(0); PG8_BAR; PG8_MMA(1, 0, At, B0); PG8_MMA(1, 1, At, B1); PG8_BAR; PG8_SCHED;
            } else {
            PG8_LDB(B0, 0, 0); PG8_SCHED; PG8_LDA(At, 0, 0); PG8_STAGE(PG8_SA(1, 1), a1 + hstep, voffA);
            PG8_WAIT_L(8); PG8_BAR; PG8_WAIT_L(0); PG8_MMA(0, 0, At, B0); PG8_BAR; PG8_SCHED;
            PG8_LDB(B1, 0, 1); PG8_STAGE(PG8_SB(0, 0), b2, voffB);
            PG8_BAR; PG8_WAIT_L(0); PG8_MMA(0, 1, At, B1); PG8_BAR;
            PG8_LDA(At, 0, 1); PG8_STAGE(PG8_SA(0, 0), a2, voffA);
            PG8_BAR; PG8_WAIT_L(0); PG8_MMA(1, 0, At, B0); PG8_BAR; PG8_SCHED;
            PG8_STAGE(PG8_SB(0, 1), b2 + hstep, voffB);
            PG8_WAIT_V(6); PG8_BAR; PG8_MMA(1, 1, At, B1); PG8_BAR;
            PG8_LDB(B0, 1, 0); PG8_SCHED; PG8_LDA(At, 1, 0); PG8_STAGE(PG8_SA(0, 1), a2 + hstep, voffA);
            PG8_WAIT_L(8); PG8_BAR; PG8_WAIT_L(0); PG8_MMA(0, 0, At, B0); PG8_BAR; PG8_SCHED;
            PG8_LDB(B1, 1, 1); PG8_STAGE(PG8_SB(1, 0), b3, voffB);
            PG8_BAR; PG8_WAIT_L(0); PG8_MMA(0, 1, At, B1); PG8_BAR;
            PG8_LDA(At, 1, 1); PG8_STAGE(PG8_SA(1, 0), a3, voffA);
            PG8_BAR; PG8_WAIT_L(0); PG8_MMA(1, 0, At, B0); PG8_BAR; PG8_SCHED;
            PG8_STAGE(PG8_SB(1, 1), b3 + hstep, voffB);
            PG8_WAIT_V(6); PG8_BAR; PG8_MMA(1, 1, At, B1); PG8_BAR;
            }
        }
        if constexpr (ALIGN_EPI) { if (wr == 0) PG8_BAR; }
        if constexpr (!Epi::AFTER_DRAIN) { E(acc, cur, wr, wc, fr, fq); S.done(cur); }
        if (!has_next) break;
#pragma unroll
        for (int a = 0; a < 2; ++a)
#pragma unroll
            for (int b = 0; b < 2; ++b)
#pragma unroll
                for (int m = 0; m < 4; ++m)
#pragma unroll
                    for (int n = 0; n < 2; ++n) acc[a][b][m][n] = (f32x4){0.f, 0.f, 0.f, 0.f};
        cur = nxt; cA = nA; cB = nB; ++ui;
        if constexpr (ALIGN_EPI) { if (wr == 1) PG8_BAR; }
    }
    PG8_WAIT_V(0);
    if constexpr (!ALIGN_EPI) { if (wr == 0) PG8_BAR; }
    PG8_BAR;
    if constexpr (Epi::AFTER_DRAIN) { E.fused(acc, cur, wr, wc, fr, fq, lds, wid, lane); S.done(cur); }
#undef PG8_SA
#undef PG8_SB
#undef PG8_STAGE
#undef PG8_LDA
#undef PG8_LDB
#undef PG8_MMA
#undef PG8_WAIT_V
#undef PG8_WAIT_L
#undef PG8_BAR
#undef PG8_SCHED
}
}

constexpr int NB = 8, SEQ = 4096, DM = 1024, NL = 2, CTXL = 256;
constexpr int NLAT = NB * SEQ, NCTX = NB * CTXL, NROW = NLAT + NCTX;
constexpr int DFF = 2816, NPJ = 2816, INW = 2824, NMODW = 9 * DM;
constexpr float LN_EPS = 1e-5f, ALPHA = 1.41421356237f;
constexpr int C_AQ = 0, C_AK = 256, C_AV = 384, C_BZ = 512, C_BX = 768, C_CQ = 1536, C_CK = 1792, C_CV = 1920, C_DQ = 2048, C_DK = 2304, C_DV = 2560;
constexpr int C_DTSRC = 1536;
constexpr size_t MiB = 1u << 20;
constexpr size_t WS_MOD = 0;
constexpr size_t WS_DT = 1 * MiB;
constexpr size_t WS_W = 4 * MiB, WS_WL = 41 * MiB;
constexpr size_t WO_W1A = 0, WO_W2A = 11 * MiB, WO_WIN = 16 * MiB + MiB / 2, WO_WOUT = 22 * MiB, WO_W1B = 24 * MiB, WO_W2B = 35 * MiB;
constexpr size_t WS_A = 86 * MiB;
constexpr size_t WS_ACT = 154 * MiB;
constexpr size_t WS_U = 341 * MiB;
constexpr size_t WS_O = 392 * MiB;
constexpr size_t WS_XC = 460 * MiB;
constexpr size_t WS_Y = 468 * MiB;
constexpr size_t WS_END = 512 * MiB;
constexpr int RING_BYTES = 131072, ROPE_OFF = RING_BYTES, LDS_BYTES = 147456;
constexpr int NWAVES = 8;

#define LAS __attribute__((address_space(3)))
#define DI __device__ __forceinline__
typedef unsigned short bf16;
typedef unsigned v4u __attribute__((ext_vector_type(4)));
typedef unsigned v2u __attribute__((ext_vector_type(2)));
typedef float f32x4 __attribute__((ext_vector_type(4)));

DI float bf2f(unsigned b) { return __uint_as_float(b << 16); }
DI float bflo(unsigned w) { return __uint_as_float(w << 16); }
DI float bfhi(unsigned w) { return __uint_as_float(w & 0xffff0000u); }
DI unsigned f2bf(float f) { unsigned u = __float_as_uint(f); return (u + 0x7fffu + ((u >> 16) & 1u)) >> 16; }
DI unsigned pk2(float lo, float hi) { return f2bf(lo) | (f2bf(hi) << 16); }
DI float wave_sum(float v) {
#pragma unroll
    for (int o = 1; o < 64; o <<= 1) v += __shfl_xor(v, o);
    return v;
}
DI float silu(float x) { return x / (1.0f + __expf(-x)); }

struct Args { const float* in[24]; float* out; unsigned char* ws; };
typedef const __attribute__((address_space(4))) Args* KArgs;
DI KArgs kargs() { KArgs p = (KArgs)__builtin_amdgcn_kernarg_segment_ptr(); asm volatile("" : "+s"(p)); return p; }

struct Frame {
    LAS unsigned char* lds;
    int tid, lane, wave, G, gw, ngw;
};
DI Frame mkframe() { Frame F; extern __shared__ __attribute__((aligned(16))) unsigned char lds_base[]; F.lds = (LAS unsigned char*)lds_base;
    int t = threadIdx.x; asm volatile("" : "+v"(t)); F.tid = t; F.lane = t & 63; F.wave = __builtin_amdgcn_readfirstlane(t >> 6);
    F.G = gridDim.x; F.gw = blockIdx.x * NWAVES + F.wave; F.ngw = F.G * NWAVES; return F; }
DI bf16* wbuf(KArgs KA, int l, size_t off) { return (bf16*)((KA->ws) + WS_W + (size_t)l * WS_WL + off); }

DI void transpose_item(const float* W, int ldw, int k0, int n0, bf16* WT, int ldt, int drow0, LAS float* scr, int lane) {
#pragma unroll 8
    for (int i = 0; i < 32; ++i) { const int kk = 2 * i + (lane >> 5); scr[kk * 33 + (lane & 31)] = W[(size_t)(k0 + kk) * ldw + n0 + (lane & 31)]; }
    asm volatile("s_waitcnt lgkmcnt(0)" ::: "memory");
    const int c = lane & 7;
#pragma unroll
    for (int j = 0; j < 4; ++j) { const int n = (lane >> 3) + 8 * j; const LAS float* s = scr + (8 * c) * 33 + n;
        v4u o; o.x = pk2(s[0 * 33], s[1 * 33]); o.y = pk2(s[2 * 33], s[3 * 33]); o.z = pk2(s[4 * 33], s[5 * 33]); o.w = pk2(s[6 * 33], s[7 * 33]);
        *(v4u*)(WT + (size_t)(drow0 + n) * ldt + k0 + 8 * c) = o; }
    asm volatile("s_waitcnt lgkmcnt(0)" ::: "memory");
}
DI void p0a() {
    KArgs KA = kargs(); Frame F = mkframe();
    {
        LAS float* sv = (LAS float*)F.lds;
        for (int it = blockIdx.x; it < NL * 16 * 9; it += F.G) {
            const int l = it / 144, kc = (it % 144) / 9, cb = it % 9;
            __syncthreads();
            for (int i = F.tid; i < 576; i += 512) { const int r = i >> 6, kk = i & 63; const float v = r < 8 ? KA->in[1][r * DM + kc * 64 + kk] : KA->in[3][kc * 64 + kk]; sv[i] = silu(v); }
            __syncthreads();
            const int cg4 = F.tid & 255, kh = F.tid >> 8, col = cb * 1024 + 4 * cg4;
            f32x4 acc[9];
#pragma unroll
            for (int r = 0; r < 9; ++r) acc[r] = (f32x4){0.f, 0.f, 0.f, 0.f};
            const float* wp = KA->in[4] + ((size_t)l * DM + kc * 64 + kh * 32) * NMODW + col;
#pragma unroll 4
            for (int kk = 0; kk < 32; ++kk) { const f32x4 w = *(const f32x4*)(wp + (size_t)kk * NMODW);
#pragma unroll
                for (int r = 0; r < 9; ++r) acc[r] += w * sv[r * 64 + kh * 32 + kk]; }
#pragma unroll
            for (int r = 0; r < 9; ++r) *(f32x4*)(((float*)(KA->ws + WS_ACT)) + ((size_t)(l * 32 + kc * 2 + kh) * 9 + r) * NMODW + col) = acc[r];
        }
        __syncthreads();
    }
    LAS float* scr = (LAS float*)(F.lds + F.wave * 16384);
    constexpr int I1 = 16 * 176, I2 = 44 * 32, I3 = 16 * 88, I4 = 16 * 32, IL = 2 * I1 + 2 * I2 + I3 + I4;
    for (int it = F.gw; it < NL * IL; it += F.ngw) {
        const int l = it / IL; int r = it % IL;
        if (r < I1 || (r >= I1 + I2 + I3 + I4 && r < 2 * I1 + I2 + I3 + I4)) {
            const bool second = r >= I1; if (second) r -= I1 + I2 + I3 + I4;
            const int kb = r / 176, nb = r % 176, n0 = nb * 32;
            const int drow = n0 < DFF ? 256 * (n0 >> 7) + (n0 & 127) : 256 * ((n0 - DFF) >> 7) + 128 + ((n0 - DFF) & 127);
            transpose_item((second ? KA->in[22] : KA->in[8]) + (size_t)l * DM * 2 * DFF, 2 * DFF, kb * 64, n0, wbuf(KA, l, second ? WO_W1B : WO_W1A), DM, drow, scr, F.lane);
            continue; }
        r -= I1;
        if (r < I2) { const int kb = r / 32, nb = r % 32; transpose_item(KA->in[9] + (size_t)l * DFF * DM, DM, kb * 64, nb * 32, wbuf(KA, l, WO_W2A), DFF, nb * 32, scr, F.lane); continue; }
        r -= I2;
        if (r < I3) { const int kb = r / 88, nb = r % 88; const int n0 = nb < 48 ? nb * 32 : 1544 + (nb - 48) * 32;
            transpose_item(KA->in[10] + (size_t)l * DM * INW, INW, kb * 64, n0, wbuf(KA, l, WO_WIN), DM, nb * 32, scr, F.lane); continue; }
        r -= I3;
        if (r < I4) { const int kb = r / 32, nb = r % 32; transpose_item(KA->in[11] + (size_t)l * DM * DM, DM, kb * 64, nb * 32, wbuf(KA, l, WO_WOUT), DM, nb * 32, scr, F.lane); continue; }
        r -= I4 + I1;
        { const int kb = r / 32, nb = r % 32; transpose_item(KA->in[23] + (size_t)l * DFF * DM, DM, kb * 64, nb * 32, wbuf(KA, l, WO_W2B), DFF, nb * 32, scr, F.lane); }
    }
}
DI void p0b() {
    KArgs KA = kargs(); Frame F = mkframe();
    for (int i = blockIdx.x * 512 + F.tid; i < NL * 9 * NMODW; i += F.G * 512) {
        const int l = i / (9 * NMODW), rr = (i / NMODW) % 9, n = i % NMODW;
        float s = KA->in[5][l * NMODW + n];
        for (int p = 0; p < 32; ++p) s += ((float*)(KA->ws + WS_ACT))[((size_t)(l * 32 + p) * 9 + rr) * NMODW + n];
        ((float*)(KA->ws + WS_MOD))[i] = s;
    }
}
DI const float* modp(KArgs KA, int l, int mb, int idx) { return ((float*)(KA->ws + WS_MOD)) + ((size_t)(l * 9 + mb) * 9 + idx) * DM; }
DI void p0c() {
    KArgs KA = kargs(); Frame F = mkframe();
    for (int row = F.gw; row < NROW; row += F.ngw) {
        const int mb = row < NLAT ? (row >> 12) : 8;
        const float* src = row < NLAT ? KA->in[0] + (size_t)row * DM : KA->in[2] + (size_t)(row - NLAT) * DM;
        float* dst = row < NLAT ? (KA->out) + (size_t)row * DM : ((float*)(KA->ws + WS_XC)) + (size_t)(row - NLAT) * DM;
        const float* sh = modp(KA, 0, mb, 0); const float* sc = modp(KA, 0, mb, 1);
#pragma unroll
        for (int j = 0; j < 4; ++j) { const int n = 4 * F.lane + 256 * j; const f32x4 v = *(const f32x4*)(src + n); *(f32x4*)(dst + n) = v;
            const f32x4 a = v * (1.0f + *(const f32x4*)(sc + n)) + *(const f32x4*)(sh + n);
            v2u w; w.x = pk2(a.x, a.y); w.y = pk2(a.z, a.w); *(v2u*)(((bf16*)(KA->ws + WS_A)) + (size_t)row * DM + n) = w; }
    }
}
template <bool DTP>
DI void ln_pass(int l, int gidx, float gmul, int lnidx, int nl, int nsh, int nrows) {
    KArgs KA = kargs(); Frame F = mkframe();
    LAS float* wdt = (LAS float*)F.lds;
    if (DTP) { __syncthreads(); for (int i = F.tid; i < 8192; i += 512) wdt[i] = KA->in[10][((size_t)l * DM + (i >> 3)) * INW + C_DTSRC + (i & 7)]; __syncthreads(); }
    const float* g = KA->in[6] + (l * 3 + lnidx) * DM; const float* bb = KA->in[7] + (l * 3 + lnidx) * DM;
    for (int row = F.gw; row < nrows; row += F.ngw) {
        const int mb = row < NLAT ? (row >> 12) : 8;
        float* xrow = row < NLAT ? (KA->out) + (size_t)row * DM : ((float*)(KA->ws + WS_XC)) + (size_t)(row - NLAT) * DM;
        const bf16* frow = ((bf16*)(KA->ws + WS_O)) + (size_t)row * DM;
        const float* gate = modp(KA, l, mb, gidx);
        f32x4 v[4]; float s = 0.f;
#pragma unroll
        for (int j = 0; j < 4; ++j) { const int n = 4 * F.lane + 256 * j; const f32x4 xv = *(const f32x4*)(xrow + n); const v2u fw = *(const v2u*)(frow + n); const f32x4 gt = *(const f32x4*)(gate + n);
            const f32x4 fv = (f32x4){bflo(fw.x), bfhi(fw.x), bflo(fw.y), bfhi(fw.y)};
            v[j] = xv * ALPHA + gt * fv * gmul; s += (v[j].x + v[j].y) + (v[j].z + v[j].w); }
        const float mean = wave_sum(s) * (1.f / DM); float s2 = 0.f;
#pragma unroll
        for (int j = 0; j < 4; ++j) { v[j] = v[j] - mean; s2 += (v[j].x * v[j].x + v[j].y * v[j].y) + (v[j].z * v[j].z + v[j].w * v[j].w); }
        const float rstd = 1.f / sqrtf(wave_sum(s2) * (1.f / DM) + LN_EPS);
        float dt[8];
#pragma unroll
        for (int q = 0; q < 8; ++q) dt[q] = 0.f;
#pragma unroll
        for (int j = 0; j < 4; ++j) { const int n = 4 * F.lane + 256 * j;
            const f32x4 y = v[j] * rstd * *(const f32x4*)(g + n) + *(const f32x4*)(bb + n);
            *(f32x4*)(xrow + n) = y;
            if (nsh >= 0) { const f32x4 a = y * (1.0f + *(const f32x4*)(modp(KA, nl, mb, nsh + 1) + n)) + *(const f32x4*)(modp(KA, nl, mb, nsh) + n);
                v2u w; w.x = pk2(a.x, a.y); w.y = pk2(a.z, a.w); *(v2u*)(((bf16*)(KA->ws + WS_A)) + (size_t)row * DM + n) = w;
                if (DTP) {
#pragma unroll
                    for (int e = 0; e < 4; ++e) { const f32x4 w0 = *(const LAS f32x4*)(wdt + (n + e) * 8), w1 = *(const LAS f32x4*)(wdt + (n + e) * 8 + 4); const float ae = a[e];
                        dt[0] += ae * w0.x; dt[1] += ae * w0.y; dt[2] += ae * w0.z; dt[3] += ae * w0.w; dt[4] += ae * w1.x; dt[5] += ae * w1.y; dt[6] += ae * w1.z; dt[7] += ae * w1.w; } } }
        }
        if (DTP) {
#pragma unroll
            for (int q = 0; q < 8; ++q) dt[q] = wave_sum(dt[q]);
            if (F.lane == 0) { *(f32x4*)(((float*)(KA->ws + WS_DT)) + (size_t)row * 8) = (f32x4){dt[0], dt[1], dt[2], dt[3]}; *(f32x4*)(((float*)(KA->ws + WS_DT)) + (size_t)row * 8 + 4) = (f32x4){dt[4], dt[5], dt[6], dt[7]}; }
        }
    }
}
DI void prep_pass(int l) {
    KArgs KA = kargs(); Frame F = mkframe();
    const LAS float* rc = (const LAS float*)(F.lds + ROPE_OFF); const LAS float* rs = rc + 1024;
    bf16* P = ((bf16*)(KA->ws + WS_ACT));
    const int hf = F.lane >> 5, li = F.lane & 31, ra = li >> 4, ri = li & 15, d1 = ra * 32 + ri, d2 = d1 + 16;
    for (int row = F.gw; row < NROW; row += F.ngw) {
        const bool lat = row < NLAT; const int t = row & 4095;
        const int pos = ra == 0 ? (t >> 6) : (t & 63);
        const float cs = rc[pos * 16 + ri], sn = rs[pos * 16 + ri];
        bf16* pr = P + (size_t)row * NPJ;
#pragma unroll
        for (int it = 0; it < 6; ++it) {
            const int hh = 2 * it + hf;
            const bool isc = hh >= 6; const int h6 = isc ? hh - 6 : hh;
            const int col = (isc ? (h6 < 4 ? C_CQ + h6 * 64 : C_CK + (h6 - 4) * 64) : (h6 < 4 ? C_AQ + h6 * 64 : C_AK + (h6 - 4) * 64));
            float x1 = bf2f(pr[col + d1]), x2 = bf2f(pr[col + d2]);
            float ss = x1 * x1 + x2 * x2;
#pragma unroll
            for (int o = 1; o < 32; o <<= 1) ss += __shfl_xor(ss, o);
            if (isc) { const float r = 1.f / sqrtf(ss * (1.f / 64.f) + LN_EPS); const float* gn = (h6 < 4 ? KA->in[19] : KA->in[20]) + l * 64; x1 = x1 * r * gn[d1]; x2 = x2 * r * gn[d2]; }
            if (lat) { const float y1 = x1 * cs - x2 * sn, y2 = x1 * sn + x2 * cs; x1 = y1; x2 = y2; }
            if (isc || lat) { pr[col + d1] = (bf16)f2bf(x1); pr[col + d2] = (bf16)f2bf(x2); }
        }
        const int Ls = lat ? SEQ : CTXL; const int tt = lat ? t : (row - NLAT) & 255;
#pragma unroll
        for (int j = 0; j < 3; ++j) { const int ch = 4 * F.lane + 256 * j;
            f32x4 acc = *(const f32x4*)(KA->in[15] + l * 768 + ch);
#pragma unroll
            for (int k = 0; k < 5; ++k) { const int t2 = tt + k - 2;
                if (t2 >= 0 && t2 < Ls) { const v2u w = *(const v2u*)(P + (size_t)(row + k - 2) * NPJ + C_BX + ch); const f32x4 cw = *(const f32x4*)(KA->in[14] + (l * 5 + k) * 768 + ch);
                    acc += cw * (f32x4){bflo(w.x), bfhi(w.x), bflo(w.y), bfhi(w.y)}; } }
            v2u o; o.x = pk2(silu(acc.x), silu(acc.y)); o.y = pk2(silu(acc.z), silu(acc.w)); *(v2u*)(((bf16*)(KA->ws + WS_U)) + (size_t)row * 768 + ch) = o; }
        if (F.lane < 8) { const float v = ((float*)(KA->ws + WS_DT))[(size_t)row * 8 + F.lane] + KA->in[16][l * 8 + F.lane]; ((float*)(KA->ws + WS_DT))[(size_t)row * 8 + F.lane] = fmaxf(v, 0.f) + log1pf(__expf(-fabsf(v))); }
    }
}
DI void nkey(const float (&q)[64], float (&o)[64], float& m, float& l, const bf16* kr, const bf16* vr, float bias) {
    float s = bias;
#pragma unroll
    for (int c = 0; c < 8; ++c) { const v4u w = *(const v4u*)(kr + 8 * c);
        s += q[8 * c] * bflo(w.x) + q[8 * c + 1] * bfhi(w.x) + q[8 * c + 2] * bflo(w.y) + q[8 * c + 3] * bfhi(w.y) + q[8 * c + 4] * bflo(w.z) + q[8 * c + 5] * bfhi(w.z) + q[8 * c + 6] * bflo(w.w) + q[8 * c + 7] * bfhi(w.w); }
    const float mn = fmaxf(m, s), cf = __expf(m - mn), p = __expf(s - mn);
    l = l * cf + p; m = mn;
#pragma unroll
    for (int c = 0; c < 8; ++c) { const v4u w = *(const v4u*)(vr + 8 * c);
        o[8 * c] = o[8 * c] * cf + p * bflo(w.x); o[8 * c + 1] = o[8 * c + 1] * cf + p * bfhi(w.x); o[8 * c + 2] = o[8 * c + 2] * cf + p * bflo(w.y); o[8 * c + 3] = o[8 * c + 3] * cf + p * bfhi(w.y);
        o[8 * c + 4] = o[8 * c + 4] * cf + p * bflo(w.z); o[8 * c + 5] = o[8 * c + 5] * cf + p * bfhi(w.z); o[8 * c + 6] = o[8 * c + 6] * cf + p * bflo(w.w); o[8 * c + 7] = o[8 * c + 7] * cf + p * bfhi(w.w); }
}
template <int TYPE>
DI void naive_attn(int l, int row, int h, bool ctxq) {
    KArgs KA = kargs(); Frame F = mkframe();
    const bf16* P = ((bf16*)(KA->ws + WS_ACT));
    const int qcol = (TYPE == 0 ? C_AQ : TYPE == 1 ? C_CQ : C_DQ) + h * 64;
    const int kvh = TYPE == 2 ? h : (h >> 1);
    const int kcol = (TYPE == 0 ? C_AK : TYPE == 1 ? C_CK : C_DK) + kvh * 64, vcol = (TYPE == 0 ? C_AV : TYPE == 1 ? C_CV : C_DV) + kvh * 64;
    float q[64], o[64]; float m = -1e30f, ls = 0.f;
#pragma unroll
    for (int c = 0; c < 8; ++c) { const v4u w = *(const v4u*)(P + (size_t)row * NPJ + qcol + 8 * c);
        q[8 * c] = 0.125f * bflo(w.x); q[8 * c + 1] = 0.125f * bfhi(w.x); q[8 * c + 2] = 0.125f * bflo(w.y); q[8 * c + 3] = 0.125f * bfhi(w.y);
        q[8 * c + 4] = 0.125f * bflo(w.z); q[8 * c + 5] = 0.125f * bfhi(w.z); q[8 * c + 6] = 0.125f * bflo(w.w); q[8 * c + 7] = 0.125f * bfhi(w.w); }
#pragma unroll
    for (int d = 0; d < 64; ++d) o[d] = 0.f;
    int b;
    if (!ctxq) {
        b = row >> 12; const int t = row & 4095;
        if (TYPE == 0) { const int k0 = max(t - 128, 0), k1 = min(t + 128, SEQ - 1);
            for (int k = k0; k <= k1; ++k) { const bf16* kp = P + (size_t)(b * SEQ + k) * NPJ; nkey(q, o, m, ls, kp + kcol, kp + vcol, 0.f); } }
        else if (TYPE == 1) { for (int k = 0; k < SEQ; ++k) { const bf16* kp = P + (size_t)(b * SEQ + k) * NPJ; nkey(q, o, m, ls, kp + kcol, kp + vcol, 0.f); } }
        else { const int r = t >> 6, c = t & 63; const int rs = min(max(r - 4, 0), 56), cs = min(max(c - 8, 0), 48);
            for (int a = 0; a < 8; ++a) { const float* bp = KA->in[21] + ((size_t)(l * 4 + h) * 15 + (rs + a - r + 7)) * 31 + (cs - c + 15);
                for (int k = 0; k < 16; ++k) { const bf16* kp = P + (size_t)(b * SEQ + (rs + a) * 64 + cs + k) * NPJ; nkey(q, o, m, ls, kp + kcol, kp + vcol, bp[k]); } } }
    } else b = (row - NLAT) >> 8;
    for (int k = 0; k < CTXL; ++k) { const bf16* kp = P + (size_t)(NLAT + b * CTXL + k) * NPJ; nkey(q, o, m, ls, kp + kcol, kp + vcol, 0.f); }
    if (TYPE == 0) { const float sk = KA->in[13][l * 4 + h]; const float mn = fmaxf(m, sk), cf = __expf(m - mn); ls = ls * cf + __expf(sk - mn);
#pragma unroll
        for (int d = 0; d < 64; ++d) o[d] *= cf; }
    const float inv = 1.f / ls;
    bf16* op = ((bf16*)(KA->ws + WS_O)) + (size_t)row * DM + (TYPE == 0 ? 0 : TYPE == 1 ? 512 : 768) + h * 64;
#pragma unroll
    for (int c = 0; c < 8; ++c) { v4u w; w.x = pk2(o[8 * c] * inv, o[8 * c + 1] * inv); w.y = pk2(o[8 * c + 2] * inv, o[8 * c + 3] * inv); w.z = pk2(o[8 * c + 4] * inv, o[8 * c + 5] * inv); w.w = pk2(o[8 * c + 6] * inv, o[8 * c + 7] * inv);
        *(v4u*)(op + 8 * c) = w; }
}
DI void naive_ssd(int l, int item) {
    KArgs KA = kargs(); Frame F = mkframe();
    const int b = item >> 3, dir = (item >> 2) & 1, h = item & 3, g = h >> 1;
    const int p = F.tid >> 3, ng = F.tid & 7;
    const float A = -__expf(KA->in[17][l * 8 + dir * 4 + h]);
    bf16* Y = dir ? (((bf16*)(KA->ws + WS_Y) + (size_t)NROW * 256)) : ((bf16*)(KA->ws + WS_Y));
    float hs[16];
#pragma unroll
    for (int i = 0; i < 16; ++i) hs[i] = 0.f;
    for (int ph = 0; ph < 2; ++ph) {
        const int ns = ph ? SEQ : CTXL, base = ph ? b * SEQ : NLAT + b * CTXL;
#pragma unroll 4
        for (int s = 0; s < ns; ++s) {
            const int row = base + (dir ? ns - 1 - s : s);
            const float dt = ((float*)(KA->ws + WS_DT))[(size_t)row * 8 + dir * 4 + h];
            const bf16* ur = ((bf16*)(KA->ws + WS_U)) + (size_t)row * 768;
            const float xv = bf2f(ur[h * 64 + p]);
            const v4u b0 = *(const v4u*)(ur + 256 + g * 128 + ng * 16), b1 = *(const v4u*)(ur + 256 + g * 128 + ng * 16 + 8);
            const v4u c0 = *(const v4u*)(ur + 512 + g * 128 + ng * 16), c1 = *(const v4u*)(ur + 512 + g * 128 + ng * 16 + 8);
            const float dA = __expf(dt * A), dx = dt * xv;
            const unsigned bw[8] = {b0.x, b0.y, b0.z, b0.w, b1.x, b1.y, b1.z, b1.w}, cw[8] = {c0.x, c0.y, c0.z, c0.w, c1.x, c1.y, c1.z, c1.w};
            float y = 0.f;
#pragma unroll
            for (int i = 0; i < 8; ++i) { hs[2 * i] = hs[2 * i] * dA + dx * bflo(bw[i]); hs[2 * i + 1] = hs[2 * i + 1] * dA + dx * bfhi(bw[i]); y += bflo(cw[i]) * hs[2 * i] + bfhi(cw[i]) * hs[2 * i + 1]; }
            y += __shfl_xor(y, 1); y += __shfl_xor(y, 2); y += __shfl_xor(y, 4);
            if (ng == 0) Y[(size_t)row * 256 + h * 64 + p] = (bf16)f2bf(y);
        }
    }
}
DI void mixers_naive(int l, bool last) {
    Frame F = mkframe();
    const int nAttL = 64 * 12, nAttC = last ? 0 : 4 * 12, nItems = 64 + nAttL + nAttC;
    for (int it = blockIdx.x; it < nItems; it += F.G) {
        if (it < 64) { naive_ssd(l, it); continue; }
        int r = it - 64; bool cq = false; int rowbase;
        if (r >= nAttL) { r -= nAttL; cq = true; }
        const int rb = r / 12, ty = (r % 12) >> 2, h = r & 3;
        rowbase = cq ? NLAT + rb * 512 : rb * 512;
        const int row = rowbase + F.tid;
        if (ty == 0) naive_attn<0>(l, row, h, cq); else if (ty == 1) naive_attn<1>(l, row, h, cq); else naive_attn<2>(l, row, h, cq);
    }
}
DI void merge_pass(int l, int nrows) {
    KArgs KA = kargs(); Frame F = mkframe();
    const bf16* P = ((bf16*)(KA->ws + WS_ACT));
    const int hh = F.lane >> 4;
    const float dsk = KA->in[18][l * 4 + hh];
    for (int row = F.gw; row < nrows; row += F.ngw) {
        f32x4 v[4];
#pragma unroll
        for (int j = 0; j < 4; ++j) { const int n = 4 * F.lane + 256 * j;
            if (j == 1) { const int cn = 4 * F.lane; const v2u yfw = *(const v2u*)(((bf16*)(KA->ws + WS_Y)) + (size_t)row * 256 + cn), ybw = *(const v2u*)((((bf16*)(KA->ws + WS_Y) + (size_t)NROW * 256)) + (size_t)row * 256 + cn);
                const f32x4 yf = (f32x4){bflo(yfw.x), bfhi(yfw.x), bflo(yfw.y), bfhi(yfw.y)}, yb = (f32x4){bflo(ybw.x), bfhi(ybw.x), bflo(ybw.y), bfhi(ybw.y)};
                const v2u xw = *(const v2u*)(((bf16*)(KA->ws + WS_U)) + (size_t)row * 768 + cn), zw = *(const v2u*)(P + (size_t)row * NPJ + C_BZ + cn);
                const f32x4 xs = (f32x4){bflo(xw.x), bfhi(xw.x), bflo(xw.y), bfhi(xw.y)}, z = (f32x4){bflo(zw.x), bfhi(zw.x), bflo(zw.y), bfhi(zw.y)};
                const f32x4 y = yf + yb + xs * dsk;
                v[j] = (f32x4){y.x * silu(z.x), y.y * silu(z.y), y.z * silu(z.z), y.w * silu(z.w)}; }
            else { const v2u w = *(const v2u*)(((bf16*)(KA->ws + WS_O)) + (size_t)row * DM + n); v[j] = (f32x4){bflo(w.x), bfhi(w.x), bflo(w.y), bfhi(w.y)}; } }
#pragma unroll
        for (int j = 0; j < 4; ++j) { const int n = 4 * F.lane + 256 * j;
            const float ss = wave_sum((v[j].x * v[j].x + v[j].y * v[j].y) + (v[j].z * v[j].z + v[j].w * v[j].w));
            const float r = 1.f / sqrtf(ss * (1.f / 256.f) + LN_EPS);
            const f32x4 a = v[j] * r * *(const f32x4*)(KA->in[12] + l * DM + n);
            v2u w; w.x = pk2(a.x, a.y); w.y = pk2(a.z, a.w); *(v2u*)(((bf16*)(KA->ws + WS_A)) + (size_t)row * DM + n) = w; }
    }
}
__global__ void __launch_bounds__(NWAVES * 64, 2) mega_fwd(Args args) {
    extern __shared__ __attribute__((aligned(16))) unsigned char lds[];
    cg::grid_group grid = cg::this_grid();
    { LAS float* rc = (LAS float*)((LAS unsigned char*)lds + ROPE_OFF);
      for (int i = threadIdx.x; i < 1024; i += 512) { const int pos = i >> 4, fi = i & 15; const float inv = exp2f(-(float)fi * (13.287712379549449f / 16.f)); const float ang = (float)pos * inv; rc[i] = cosf(ang); rc[1024 + i] = sinf(ang); } }
    __syncthreads();

    p0a(); grid.sync();
    p0b(); grid.sync();
    p0c(); grid.sync();
    for (int l = 0; l < NL; ++l) {
        const bool last = (l == NL - 1); const int mrows = last ? NLAT : NROW;
        { KArgs KA = kargs(); pg8::Gemm g{((bf16*)(KA->ws + WS_A)), wbuf(KA, l, WO_W1A), NROW, 2 * DFF, DM}; pg8::StaticOrder S; S.init(NROW, 2 * DFF, (int)gridDim.x, (int)blockIdx.x); pg8::EpiSwiGLU E{((bf16*)(KA->ws + WS_ACT)), DFF};
          pg8::gemm_phase<pg8::EpiSwiGLU, pg8::StaticOrder, true, true>((LAS unsigned char*)lds, g, S, E); }
        grid.sync();
        { KArgs KA = kargs(); pg8::Gemm g{((bf16*)(KA->ws + WS_ACT)), wbuf(KA, l, WO_W2A), NROW, DM, DFF}; pg8::StaticOrder S; S.init(NROW, DM, (int)gridDim.x, (int)blockIdx.x); pg8::EpiBf16 E{((bf16*)(KA->ws + WS_O)), DM};
          pg8::gemm_phase<pg8::EpiBf16, pg8::StaticOrder, true, true>((LAS unsigned char*)lds, g, S, E); }
        grid.sync();
        ln_pass<true>(l, 2, 0.5f, 0, l, 3, NROW); grid.sync();
        { KArgs KA = kargs(); pg8::Gemm g{((bf16*)(KA->ws + WS_A)), wbuf(KA, l, WO_WIN), NROW, NPJ, DM}; pg8::StaticOrder S; S.init(NROW, NPJ, (int)gridDim.x, (int)blockIdx.x); pg8::EpiBf16 E{((bf16*)(KA->ws + WS_ACT)), NPJ};
          pg8::gemm_phase<pg8::EpiBf16, pg8::StaticOrder, true, true>((LAS unsigned char*)lds, g, S, E); }
        grid.sync();
        prep_pass(l); grid.sync();
        mixers_naive(l, last); grid.sync();
        merge_pass(l, mrows); grid.sync();
        { KArgs KA = kargs(); pg8::Gemm g{((bf16*)(KA->ws + WS_A)), wbuf(KA, l, WO_WOUT), mrows, DM, DM}; pg8::StaticOrder S; S.init(mrows, DM, (int)gridDim.x, (int)blockIdx.x); pg8::EpiBf16 E{((bf16*)(KA->ws + WS_O)), DM};
          pg8::gemm_phase<pg8::EpiBf16, pg8::StaticOrder, true, true>((LAS unsigned char*)lds, g, S, E); }
        grid.sync();
        ln_pass<false>(l, 5, 1.0f, 1, l, 6, mrows); grid.sync();
        { KArgs KA = kargs(); pg8::Gemm g{((bf16*)(KA->ws + WS_A)), wbuf(KA, l, WO_W1B), mrows, 2 * DFF, DM}; pg8::StaticOrder S; S.init(mrows, 2 * DFF, (int)gridDim.x, (int)blockIdx.x); pg8::EpiSwiGLU E{((bf16*)(KA->ws + WS_ACT)), DFF};
          pg8::gemm_phase<pg8::EpiSwiGLU, pg8::StaticOrder, true, true>((LAS unsigned char*)lds, g, S, E); }
        grid.sync();
        { KArgs KA = kargs(); pg8::Gemm g{((bf16*)(KA->ws + WS_ACT)), wbuf(KA, l, WO_W2B), mrows, DM, DFF}; pg8::StaticOrder S; S.init(mrows, DM, (int)gridDim.x, (int)blockIdx.x); pg8::EpiBf16 E{((bf16*)(KA->ws + WS_O)), DM};
          pg8::gemm_phase<pg8::EpiBf16, pg8::StaticOrder, true, true>((LAS unsigned char*)lds, g, S, E); }
        grid.sync();
        ln_pass<false>(l, 8, 0.5f, 2, l + 1, last ? -1 : 0, mrows);
        if (!last) grid.sync();
    }
}

extern "C" void kernel_launch(void* const* d_in, const int* in_sizes, int n_in, void* d_out, int out_size, void* d_ws, size_t ws_size, hipStream_t stream) {
    static int grid = 0;
    if (grid == 0) {
        if (n_in != 24 || out_size != NLAT * DM || ws_size < WS_END) { fprintf(stderr, "kernel_launch: unexpected shapes: n_in %d out %d ws %zu\n", n_in, out_size, ws_size); grid = -1; return; }
        int dev = 0, cus = 0, per_cu = 0;
        hipGetDevice(&dev); hipDeviceGetAttribute(&cus, hipDeviceAttributeMultiprocessorCount, dev);
        if (hipFuncSetAttribute((const void*)mega_fwd, hipFuncAttributeMaxDynamicSharedMemorySize, LDS_BYTES) != hipSuccess) { fprintf(stderr, "kernel_launch: hipFuncSetAttribute failed\n"); grid = -1; return; }
        if (hipOccupancyMaxActiveBlocksPerMultiprocessor(&per_cu, (const void*)mega_fwd, NWAVES * 64, LDS_BYTES) != hipSuccess || per_cu < 1) { fprintf(stderr, "kernel_launch: occupancy query says %d\n", per_cu); per_cu = 1; }
        (void)hipGetLastError();
        grid = cus;
    }
    if (grid < 0) return;
    Args a{};
    for (int i = 0; i < 24; ++i) a.in[i] = (const float*)d_in[i];
    a.out = (float*)d_out; a.ws = (unsigned char*)d_ws;
    void* kargs[] = {&a};
    hipError_t e = hipLaunchCooperativeKernel((const void*)mega_fwd, dim3(grid), dim3(NWAVES * 64), kargs, LDS_BYTES, stream);
    if (e != hipSuccess) fprintf(stderr, "kernel_launch: cooperative launch failed: %s (grid %d)\n", hipGetErrorString(e), grid);
}
```

```cpp
#include <hip/hip_runtime.h>
#include <hip/hip_cooperative_groups.h>
#include <cstdio>
#include <cstdint>
namespace cg = cooperative_groups;
namespace pg8 {
#define PG8_LAS __attribute__((address_space(3)))
typedef unsigned short bf16_t;
typedef short bf16x8 __attribute__((ext_vector_type(8)));
typedef float f32x4 __attribute__((ext_vector_type(4)));
typedef unsigned u32x4 __attribute__((ext_vector_type(4)));
constexpr int BM = 256, BK = 64, HALF = 128, HTB = HALF * BK * 2  , STAGE_BYTES = 8 * HTB, NXCD = 8, WGM = 8;

__host__ __device__ __forceinline__ int lds_byte(int r, int c) { const int st = (r >> 4) * 2 + (c >> 5), rr = r & 15, cc = c & 31, ob = rr * 64 + cc * 2; return st * 1024 + (ob ^ (((ob >> 9) & 1) << 5)); }
__host__ __device__ __forceinline__ void stage_rc(int b, int& R, int& C) { const int st = b / 1024, sb = b % 1024, swz = sb ^ (((sb >> 9) & 1) << 5); R = (st >> 1) * 16 + swz / 64; C = (st & 1) * 32 + (swz % 64) / 2; }
__host__ __device__ __forceinline__ int perm32(int rho) { const int n = rho >> 4, i = rho & 15; return 8 * (i >> 2) + 4 * n + (i & 3); }

struct Unit { int pm, pn; };
struct Gemm { const bf16_t* A; const bf16_t* Bt; int M, N, K; };

struct StaticOrder {
    int nM, nN, nwg, G, c;
    __host__ __device__ void init(int M, int N, int G_, int c_) { nM = M / BM; nN = N / BM; nwg = nM * nN; G = G_; c = c_; }
    __host__ __device__ bool next(int i, Unit& u) const {
        const long L = (long)i * G + c; if (L >= nwg) return false;
        int wgid = (int)L; { const int q = nwg / NXCD, r = nwg % NXCD, xcd = wgid % NXCD, off = wgid / NXCD; wgid = (xcd < r ? xcd * (q + 1) : r * (q + 1) + (xcd - r) * q) + off; }
        const int nig = WGM * nN, gid = wgid / nig, fm = gid * WGM, gsz = (nM - fm) < WGM ? (nM - fm) : WGM;
        u.pm = fm + ((wgid % nig) % gsz); u.pn = (wgid % nig) / gsz; return true;
    }
    __device__ __forceinline__ void a_ready(const Unit&) const {}
    __device__ __forceinline__ void done(const Unit&) const {}
};

__device__ __forceinline__ unsigned cvt_pk_bf16(float lo, float hi) { unsigned r; asm volatile("v_cvt_pk_bf16_f32 %0, %1, %2" : "=v"(r) : "v"(lo), "v"(hi)); return r; }
struct EpiBf16 {
    static constexpr bool PERM = true, AFTER_DRAIN = false;
    bf16_t* O; int ldc;
    __device__ __forceinline__ void operator()(const f32x4 (&acc)[2][2][4][2], const Unit& u, int wr, int wc, int fr, int fq) const {
        const int row0 = u.pm * BM + wr * 64 + fr; const int col0 = u.pn * BM + wc * 32 + 8 * fq;
#pragma unroll
        for (int ai = 0; ai < 2; ++ai)
#pragma unroll
            for (int m = 0; m < 4; ++m) { bf16_t* rowp = O + (size_t)(row0 + ai * HALF + m * 16) * ldc + col0;
#pragma unroll
                for (int bj = 0; bj < 2; ++bj) { const f32x4 v0 = acc[ai][bj][m][0], v1 = acc[ai][bj][m][1];
                    u32x4 w; w.x = cvt_pk_bf16(v0[0], v0[1]); w.y = cvt_pk_bf16(v0[2], v0[3]); w.z = cvt_pk_bf16(v1[0], v1[1]); w.w = cvt_pk_bf16(v1[2], v1[3]);
                    *(u32x4*)(rowp + bj * HALF) = w; } }
    }
};
__device__ __forceinline__ float silu_f(float x) { return x * __builtin_amdgcn_rcpf(1.0f + __expf(-x)); }
struct EpiSwiGLU {
    static constexpr bool PERM = true, AFTER_DRAIN = false;
    bf16_t* O; int ldc;
    __device__ __forceinline__ void operator()(const f32x4 (&acc)[2][2][4][2], const Unit& u, int wr, int wc, int fr, int fq) const {
        const int row0 = u.pm * BM + wr * 64 + fr; const int col0 = u.pn * HALF + wc * 32 + 8 * fq;
#pragma unroll
        for (int ai = 0; ai < 2; ++ai)
#pragma unroll
            for (int m = 0; m < 4; ++m) { bf16_t* rowp = O + (size_t)(row0 + ai * HALF + m * 16) * ldc + col0;
                const f32x4 a0 = acc[ai][0][m][0], a1 = acc[ai][0][m][1], u0 = acc[ai][1][m][0], u1 = acc[ai][1][m][1];
                u32x4 w;
                w.x = cvt_pk_bf16(silu_f(a0[0]) * u0[0], silu_f(a0[1]) * u0[1]); w.y = cvt_pk_bf16(silu_f(a0[2]) * u0[2], silu_f(a0[3]) * u0[3]);
                w.z = cvt_pk_bf16(silu_f(a1[0]) * u1[0], silu_f(a1[1]) * u1[1]); w.w = cvt_pk_bf16(silu_f(a1[2]) * u1[2], silu_f(a1[3]) * u1[3]);
                *(u32x4*)rowp = w; }
    }
};
template <class Epi, class Sched, bool ALIGN_EPI = false, bool SP2 = false>
__device__ __forceinline__ void gemm_phase(PG8_LAS unsigned char* lds, const Gemm g, const Sched& S, const Epi& E) {
    const int tid = threadIdx.x, wid = __builtin_amdgcn_readfirstlane(tid >> 6), lane = tid & 63, wr = wid >> 2, wc = wid & 3, fr = lane & 15, fq = lane >> 4;
    const int K = g.K, nt = K / BK;
    unsigned voffA[2], voffB[2];
#pragma unroll
    for (int i = 0; i < 2; ++i) { int R, C; stage_rc(tid * 16 + i * 8192, R, C); const int Rb = Epi::PERM ? ((R & ~31) + perm32(R & 31)) : R;
        voffA[i] = (unsigned)(R * K + C) * 2u; voffB[i] = (unsigned)(Rb * K + C) * 2u; }
    const size_t kstep = (size_t)(BK * 2);
    const size_t hstep = (size_t)HALF * K * 2;
    const size_t tstep = 2 * hstep;
    const unsigned ldsw = (unsigned)wid * 1024u;
    const int aoff = lds_byte(wr * 64 + fr, fq * 8), boff = lds_byte(wc * 32 + fr, fq * 8);
#define PG8_SA(b, h) (((b) * 2 + (h)) * HTB)
#define PG8_SB(b, h) ((4 + (b) * 2 + (h)) * HTB)
#define PG8_STAGE(bufoff, gbase, voff) do { _Pragma("unroll") for (int _i = 0; _i < 2; ++_i) \
        __builtin_amdgcn_global_load_lds((const unsigned*)((const char*)(gbase) + (voff)[_i]), (PG8_LAS unsigned*)(lds + (bufoff) + ldsw + _i * 8192), 16, 0, 0); } while (0)
#define PG8_LDA(dst, b, h) do { _Pragma("unroll") for (int m = 0; m < 4; ++m) _Pragma("unroll") for (int k = 0; k < 2; ++k) dst[m][k] = *(const PG8_LAS bf16x8*)(lds + PG8_SA(b, h) + aoff + m * 2048 + k * 1024); } while (0)
#define PG8_LDB(dst, b, h) do { _Pragma("unroll") for (int n = 0; n < 2; ++n) _Pragma("unroll") for (int k = 0; k < 2; ++k) dst[n][k] = *(const PG8_LAS bf16x8*)(lds + PG8_SB(b, h) + boff + n * 2048 + k * 1024); } while (0)
#define PG8_MMA(ai, bj, At, Bt) do { __builtin_amdgcn_s_setprio(1); _Pragma("unroll") for (int m = 0; m < 4; ++m) _Pragma("unroll") for (int n = 0; n < 2; ++n) _Pragma("unroll") for (int k = 0; k < 2; ++k) \
        acc[ai][bj][m][n] = __builtin_amdgcn_mfma_f32_16x16x32_bf16(Bt[n][k], At[m][k], acc[ai][bj][m][n], 0, 0, 0); __builtin_amdgcn_s_setprio(0); } while (0)
#define PG8_WAIT_V(n) asm volatile("s_waitcnt vmcnt(" #n ")" ::: "memory")
#define PG8_WAIT_L(n) asm volatile("s_waitcnt lgkmcnt(" #n ")" ::: "memory")
#define PG8_BAR __builtin_amdgcn_s_barrier()
#define PG8_SCHED __builtin_amdgcn_sched_barrier(0)
    Unit cur, nxt; int ui = 0;
    if (!S.next(0, cur)) return;
    f32x4 acc[2][2][4][2];
#pragma unroll
    for (int a = 0; a < 2; ++a)
#pragma unroll
        for (int b = 0; b < 2; ++b)
#pragma unroll
            for (int m = 0; m < 4; ++m)
#pragma unroll
                for (int n = 0; n < 2; ++n) acc[a][b][m][n] = (f32x4){0.f, 0.f, 0.f, 0.f};
    bf16x8 At[4][2], B0[2][2], B1[2][2];
    const char* cA = (const char*)g.A + (size_t)cur.pm * tstep; const char* cB = (const char*)g.Bt + (size_t)cur.pn * tstep;
    S.a_ready(cur);
    if constexpr (SP2) {
        PG8_STAGE(PG8_SB(0, 0), cB, voffB); PG8_STAGE(PG8_SB(0, 1), cB + hstep, voffB); PG8_STAGE(PG8_SA(0, 0), cA, voffA); PG8_STAGE(PG8_SA(0, 1), cA + hstep, voffA);
        if (wr == 1) PG8_BAR;
        PG8_WAIT_V(2); PG8_BAR;
        PG8_STAGE(PG8_SB(1, 0), cB + kstep, voffB); PG8_STAGE(PG8_SA(1, 0), cA + kstep, voffA); PG8_STAGE(PG8_SB(1, 1), cB + hstep + kstep, voffB);
        PG8_WAIT_V(6); PG8_BAR;
    } else {
        PG8_STAGE(PG8_SB(0, 0), cB, voffB); PG8_STAGE(PG8_SA(0, 0), cA, voffA); PG8_STAGE(PG8_SB(0, 1), cB + hstep, voffB); PG8_STAGE(PG8_SA(0, 1), cA + hstep, voffA);
        if (wr == 1) PG8_BAR;
        PG8_WAIT_V(4); PG8_BAR;
        PG8_STAGE(PG8_SB(1, 0), cB + kstep, voffB); PG8_STAGE(PG8_SA(1, 0), cA + kstep, voffA); PG8_STAGE(PG8_SB(1, 1), cB + hstep + kstep, voffB);
        PG8_WAIT_V(6); PG8_BAR;
    }
    for (;;) {
        const bool has_next = S.next(ui + 1, nxt);
        const char* nA = has_next ? (const char*)g.A + (size_t)nxt.pm * tstep : cA; const char* nB = has_next ? (const char*)g.Bt + (size_t)nxt.pn * tstep : cB;
        for (int t = 0; t < nt; t += 2) {
            const bool last = (t == nt - 2);
            const char* a1 = cA + (size_t)(t + 1) * kstep;
            const char* a2 = last ? nA : cA + (size_t)(t + 2) * kstep; const char* b2 = last ? nB : cB + (size_t)(t + 2) * kstep;
            const char* a3 = a2 + kstep; const char* b3 = b2 + kstep;
            if (last && has_next) S.a_ready(nxt);
            if constexpr (SP2) {
            PG8_LDB(B0, 0, 0); PG8_LDB(B1, 0, 1); PG8_SCHED; PG8_LDA(At, 0, 0); PG8_STAGE(PG8_SA(1, 1), a1 + hstep, voffA);
            PG8_WAIT_V(8); PG8_WAIT_L(0); PG8_BAR; PG8_MMA(0, 0, At, B0); PG8_MMA(0, 1, At, B1); PG8_BAR; PG8_SCHED;
            PG8_LDA(At, 0, 1); PG8_STAGE(PG8_SB(0, 0), b2, voffB); PG8_STAGE(PG8_SB(0, 1), b2 + hstep, voffB); PG8_STAGE(PG8_SA(0, 0), a2, voffA);
            PG8_WAIT_V(8); PG8_WAIT_L(0); PG8_BAR; PG8_MMA(1, 0, At, B0); PG8_MMA(1, 1, At, B1); PG8_BAR; PG8_SCHED;
            PG8_LDB(B0, 1, 0); PG8_LDB(B1, 1, 1); PG8_SCHED; PG8_LDA(At, 1, 0); PG8_STAGE(PG8_SA(0, 1), a2 + hstep, voffA);
            PG8_WAIT_V(8); PG8_WAIT_L(0); PG8_BAR; PG8_MMA(0, 0, At, B0); PG8_MMA(0, 1, At, B1); PG8_BAR; PG8_SCHED;
            PG8_LDA(At, 1, 1); PG8_STAGE(PG8_SB(1, 0), b3, voffB); PG8_STAGE(PG8_SB(1, 1), b3 + hstep, voffB); PG8_STAGE(PG8_SA(1, 0), a3, voffA);
            PG8_WAIT_V(8); PG8_WAIT_L(0); PG8_BAR; PG8_MMA(1, 0, At, B0); PG8_MMA(1, 1, At, B1); PG8_BAR; PG8_SCHED;
            } else {
            PG8_LDB(B0, 0, 0); PG8_SCHED; PG8_LDA(At, 0, 0); PG8_STAGE(PG8_SA(1, 1), a1 + hstep, voffA);
            PG8_WAIT_L(8); PG8_BAR; PG8_WAIT_L(0); PG8_MMA(0, 0, At, B0); PG8_BAR; PG8_SCHED;
            PG8_LDB(B1, 0, 1); PG8_STAGE(PG8_SB(0, 0), b2, voffB);
            PG8_BAR; PG8_WAIT_L(0); PG8_MMA(0, 1, At, B1); PG8_BAR;
            PG8_LDA(At, 0, 1); PG8_STAGE(PG8_SA(0, 0), a2, voffA);
            PG8_BAR; PG8_WAIT_L(0); PG8_MMA(1, 0, At, B0); PG8_BAR; PG8_SCHED;
            PG8_STAGE(PG8_SB(0, 1), b2 + hstep, voffB);
            PG8_WAIT_V(6); PG8_BAR; PG8_MMA(1, 1, At, B1); PG8_BAR;
            PG8_LDB(B0, 1, 0); PG8_SCHED; PG8_LDA(At, 1, 0); PG8_STAGE(PG8_SA(0, 1), a2 + hstep, voffA);
            PG8_WAIT_L(8); PG8_BAR; PG8_WAIT_L(0); PG8_MMA(0, 0, At, B0); PG8_BAR; PG8_SCHED;
            PG8_LDB(B1, 1, 1); PG8_STAGE(PG8_SB(1, 0), b3, voffB);
            PG8_BAR; PG8_WAIT_L(0); PG8_MMA(0, 1, At, B1); PG8_BAR;
            PG8_LDA(At, 1, 1); PG8_STAGE(PG8_SA(1, 0), a3, voffA);
            PG8_BAR; PG8_WAIT_L(0); PG8_MMA(1, 0, At, B0); PG8_BAR; PG8_SCHED;
            PG8_STAGE(PG8_SB(1, 1), b3 + hstep, voffB);
            PG8_WAIT_V(6); PG8_BAR; PG8_MMA(1, 1, At, B1); PG8_BAR;
            }
        }
        if constexpr (ALIGN_EPI) { if (wr == 0) PG8_BAR; }
        if constexpr (!Epi::AFTER_DRAIN) { E(acc, cur, wr, wc, fr, fq); S.done(cur); }
        if (!has_next) break;
#pragma unroll
        for (int a = 0; a < 2; ++a)
#pragma unroll
            for (int b = 0; b < 2; ++b)
#pragma unroll
                for (int m = 0; m < 4; ++m)
#pragma unroll
                    for (int n = 0; n < 2; ++n) acc[a][b][m][n] = (f32x4){0.f, 0.f, 0.f, 0.f};
        cur = nxt; cA = nA; cB = nB; ++ui;
        if constexpr (ALIGN_EPI) { if (wr == 1) PG8_BAR; }
    }
    PG8_WAIT_V(0);
    if constexpr (!ALIGN_EPI) { if (wr == 0) PG8_BAR; }
    PG8_BAR;
    if constexpr (Epi::AFTER_DRAIN) { E.fused(acc, cur, wr, wc, fr, fq, lds, wid, lane); S.done(cur); }
#undef PG8_SA
#undef PG8_SB
#undef PG8_STAGE
#undef PG8_LDA
#undef PG8_LDB
#undef PG8_MMA
#undef PG8_WAIT_V
#undef PG8_WAIT_L
#undef PG8_BAR
#undef PG8_SCHED
}
}

constexpr int NB = 8, SEQ = 4096, DM = 1024, NL = 2, CTXL = 256;
constexpr int NLAT = NB * SEQ, NCTX = NB * CTXL, NROW = NLAT + NCTX;
constexpr int DFF = 2816, NPJ = 2816, INW = 2824, NMODW = 9 * DM;
constexpr float LN_EPS = 1e-5f, ALPHA = 1.41421356237f;
constexpr int C_AQ = 0, C_AK = 256, C_AV = 384, C_BZ = 512, C_BX = 768, C_CQ = 1536, C_CK = 1792, C_CV = 1920, C_DQ = 2048, C_DK = 2304, C_DV = 2560;
constexpr int C_DTSRC = 1536;
constexpr size_t MiB = 1u << 20;
constexpr size_t WS_MOD = 0;
constexpr size_t WS_DT = 1 * MiB;
constexpr size_t WS_W = 4 * MiB, WS_WL = 41 * MiB;
constexpr size_t WO_W1A = 0, WO_W2A = 11 * MiB, WO_WIN = 16 * MiB + MiB / 2, WO_WOUT = 22 * MiB, WO_W1B = 24 * MiB, WO_W2B = 35 * MiB;
constexpr size_t WS_A = 86 * MiB;
constexpr size_t WS_ACT = 154 * MiB;
constexpr size_t WS_U = 341 * MiB;
constexpr size_t WS_O = 392 * MiB;
constexpr size_t WS_XC = 460 * MiB;
constexpr size_t WS_Y = 468 * MiB;
constexpr size_t WS_END = 512 * MiB;
constexpr int RING_BYTES = 131072, ROPE_OFF = RING_BYTES, LDS_BYTES = 147456;
constexpr int NWAVES = 8;

#define LAS __attribute__((address_space(3)))
#define DI __device__ __forceinline__
typedef unsigned short bf16;
typedef unsigned v4u __attribute__((ext_vector_type(4)));
typedef unsigned v2u __attribute__((ext_vector_type(2)));
typedef float f32x4 __attribute__((ext_vector_type(4)));

DI float bf2f(unsigned b) { return __uint_as_float(b << 16); }
DI float bflo(unsigned w) { return __uint_as_float(w << 16); }
DI float bfhi(unsigned w) { return __uint_as_float(w & 0xffff0000u); }
DI unsigned f2bf(float f) { unsigned u = __float_as_uint(f); return (u + 0x7fffu + ((u >> 16) & 1u)) >> 16; }
DI unsigned pk2(float lo, float hi) { return f2bf(lo) | (f2bf(hi) << 16); }
DI float wave_sum(float v) {
#pragma unroll
    for (int o = 1; o < 64; o <<= 1) v += __shfl_xor(v, o);
    return v;
}
DI float silu(float x) { return x / (1.0f + __expf(-x)); }

struct Args { const float* in[24]; float* out; unsigned char* ws; };
typedef const __attribute__((address_space(4))) Args* KArgs;
DI KArgs kargs() { KArgs p = (KArgs)__builtin_amdgcn_kernarg_segment_ptr(); asm volatile("" : "+s"(p)); return p; }

struct Frame {
    LAS unsigned char* lds;
    int tid, lane, wave, G, gw, ngw;
};
DI Frame mkframe() { Frame F; extern __shared__ __attribute__((aligned(16))) unsigned char lds_base[]; F.lds = (LAS unsigned char*)lds_base;
    int t = threadIdx.x; asm volatile("" : "+v"(t)); F.tid = t; F.lane = t & 63; F.wave = __builtin_amdgcn_readfirstlane(t >> 6);
    F.G = gridDim.x; F.gw = blockIdx.x * NWAVES + F.wave; F.ngw = F.G * NWAVES; return F; }
DI bf16* wbuf(KArgs KA, int l, size_t off) { return (bf16*)((KA->ws) + WS_W + (size_t)l * WS_WL + off); }

DI void transpose_item(const float* W, int ldw, int k0, int n0, bf16* WT, int ldt, int drow0, LAS float* scr, int lane) {
#pragma unroll 8
    for (int i = 0; i < 32; ++i) { const int kk = 2 * i + (lane >> 5); scr[kk * 33 + (lane & 31)] = W[(size_t)(k0 + kk) * ldw + n0 + (lane & 31)]; }
    asm volatile("s_waitcnt lgkmcnt(0)" ::: "memory");
    const int c = lane & 7;
#pragma unroll
    for (int j = 0; j < 4; ++j) { const int n = (lane >> 3) + 8 * j; const LAS float* s = scr + (8 * c) * 33 + n;
        v4u o; o.x = pk2(s[0 * 33], s[1 * 33]); o.y = pk2(s[2 * 33], s[3 * 33]); o.z = pk2(s[4 * 33], s[5 * 33]); o.w = pk2(s[6 * 33], s[7 * 33]);
        *(v4u*)(WT + (size_t)(drow0 + n) * ldt + k0 + 8 * c) = o; }
    asm volatile("s_waitcnt lgkmcnt(0)" ::: "memory");
}
DI void p0a() {
    KArgs KA = kargs(); Frame F = mkframe();
    {
        LAS float* sv = (LAS float*)F.lds;
        for (int it = blockIdx.x; it < NL * 16 * 9; it += F.G) {
            const int l = it / 144, kc = (it % 144) / 9, cb = it % 9;
            __syncthreads();
            for (int i = F.tid; i < 576; i += 512) { const int r = i >> 6, kk = i & 63; const float v = r < 8 ? KA->in[1][r * DM + kc * 64 + kk] : KA->in[3][kc * 64 + kk]; sv[i] = silu(v); }
            __syncthreads();
            const int cg4 = F.tid & 255, kh = F.tid >> 8, col = cb * 1024 + 4 * cg4;
            f32x4 acc[9];
#pragma unroll
            for (int r = 0; r < 9; ++r) acc[r] = (f32x4){0.f, 0.f, 0.f, 0.f};
            const float* wp = KA->in[4] + ((size_t)l * DM + kc * 64 + kh * 32) * NMODW + col;
#pragma unroll 4
            for (int kk = 0; kk < 32; ++kk) { const f32x4 w = *(const f32x4*)(wp + (size_t)kk * NMODW);
#pragma unroll
                for (int r = 0; r < 9; ++r) acc[r] += w * sv[r * 64 + kh * 32 + kk]; }
#pragma unroll
            for (int r = 0; r < 9; ++r) *(f32x4*)(((float*)(KA->ws + WS_ACT)) + ((size_t)(l * 32 + kc * 2 + kh) * 9 + r) * NMODW + col) = acc[r];
        }
        __syncthreads();
    }
    LAS float* scr = (LAS float*)(F.lds + F.wave * 16384);
    constexpr int I1 = 16 * 176, I2 = 44 * 32, I3 = 16 * 88, I4 = 16 * 32, IL = 2 * I1 + 2 * I2 + I3 + I4;
    for (int it = F.gw; it < NL * IL; it += F.ngw) {
        const int l = it / IL; int r = it % IL;
        if (r < I1 || (r >= I1 + I2 + I3 + I4 && r < 2 * I1 + I2 + I3 + I4)) {
            const bool second = r >= I1; if (second) r -= I1 + I2 + I3 + I4;
            const int kb = r / 176, nb = r % 176, n0 = nb * 32;
            const int drow = n0 < DFF ? 256 * (n0 >> 7) + (n0 & 127) : 256 * ((n0 - DFF) >> 7) + 128 + ((n0 - DFF) & 127);
            transpose_item((second ? KA->in[22] : KA->in[8]) + (size_t)l * DM * 2 * DFF, 2 * DFF, kb * 64, n0, wbuf(KA, l, second ? WO_W1B : WO_W1A), DM, drow, scr, F.lane);
            continue; }
        r -= I1;
        if (r < I2) { const int kb = r / 32, nb = r % 32; transpose_item(KA->in[9] + (size_t)l * DFF * DM, DM, kb * 64, nb * 32, wbuf(KA, l, WO_W2A), DFF, nb * 32, scr, F.lane); continue; }
        r -= I2;
        if (r < I3) { const int kb = r / 88, nb = r % 88; const int n0 = nb < 48 ? nb * 32 : 1544 + (nb - 48) * 32;
            transpose_item(KA->in[10] + (size_t)l * DM * INW, INW, kb * 64, n0, wbuf(KA, l, WO_WIN), DM, nb * 32, scr, F.lane); continue; }
        r -= I3;
        if (r < I4) { const int kb = r / 32, nb = r % 32; transpose_item(KA->in[11] + (size_t)l * DM * DM, DM, kb * 64, nb * 32, wbuf(KA, l, WO_WOUT), DM, nb * 32, scr, F.lane); continue; }
        r -= I4 + I1;
        { const int kb = r / 32, nb = r % 32; transpose_item(KA->in[23] + (size_t)l * DFF * DM, DM, kb * 64, nb * 32, wbuf(KA, l, WO_W2B), DFF, nb * 32, scr, F.lane); }
    }
}
DI void p0b() {
    KArgs KA = kargs(); Frame F = mkframe();
    for (int i = blockIdx.x * 512 + F.tid; i < NL * 9 * NMODW; i += F.G * 512) {
        const int l = i / (9 * NMODW), rr = (i / NMODW) % 9, n = i % NMODW;
        float s = KA->in[5][l * NMODW + n];
        for (int p = 0; p < 32; ++p) s += ((float*)(KA->ws + WS_ACT))[((size_t)(l * 32 + p) * 9 + rr) * NMODW + n];
        ((float*)(KA->ws + WS_MOD))[i] = s;
    }
}
DI const float* modp(KArgs KA, int l, int mb, int idx) { return ((float*)(KA->ws + WS_MOD)) + ((size_t)(l * 9 + mb) * 9 + idx) * DM; }
DI void p0c() {
    KArgs KA = kargs(); Frame F = mkframe();
    for (int row = F.gw; row < NROW; row += F.ngw) {
        const int mb = row < NLAT ? (row >> 12) : 8;
        const float* src = row < NLAT ? KA->in[0] + (size_t)row * DM : KA->in[2] + (size_t)(row - NLAT) * DM;
        float* dst = row < NLAT ? (KA->out) + (size_t)row * DM : ((float*)(KA->ws + WS_XC)) + (size_t)(row - NLAT) * DM;
        const float* sh = modp(KA, 0, mb, 0); const float* sc = modp(KA, 0, mb, 1);
#pragma unroll
        for (int j = 0; j < 4; ++j) { const int n = 4 * F.lane + 256 * j; const f32x4 v = *(const f32x4*)(src + n); *(f32x4*)(dst + n) = v;
            const f32x4 a = v * (1.0f + *(const f32x4*)(sc + n)) + *(const f32x4*)(sh + n);
            v2u w; w.x = pk2(a.x, a.y); w.y = pk2(a.z, a.w); *(v2u*)(((bf16*)(KA->ws + WS_A)) + (size_t)row * DM + n) = w; }
    }
}
template <bool DTP>
DI void ln_pass(int l, int gidx, float gmul, int lnidx, int nl, int nsh, int nrows) {
    KArgs KA = kargs(); Frame F = mkframe();
    LAS float* wdt = (LAS float*)F.lds;
    if (DTP) { __syncthreads(); for (int i = F.tid; i < 8192; i += 512) wdt[i] = KA->in[10][((size_t)l * DM + (i >> 3)) * INW + C_DTSRC + (i & 7)]; __syncthreads(); }
    const float* g = KA->in[6] + (l * 3 + lnidx) * DM; const float* bb = KA->in[7] + (l * 3 + lnidx) * DM;
    for (int row = F.gw; row < nrows; row += F.ngw) {
        const int mb = row < NLAT ? (row >> 12) : 8;
        float* xrow = row < NLAT ? (KA->out) + (size_t)row * DM : ((float*)(KA->ws + WS_XC)) + (size_t)(row - NLAT) * DM;
        const bf16* frow = ((bf16*)(KA->ws + WS_O)) + (size_t)row * DM;
        const float* gate = modp(KA, l, mb, gidx);
        f32x4 v[4]; float s = 0.f;
#pragma unroll
        for (int j = 0; j < 4; ++j) { const int n = 4 * F.lane + 256 * j; const f32x4 xv = *(const f32x4*)(xrow + n); const v2u fw = *(const v2u*)(frow + n); const f32x4 gt = *(const f32x4*)(gate + n);
            const f32x4 fv = (f32x4){bflo(fw.x), bfhi(fw.x), bflo(fw.y), bfhi(fw.y)};
            v[j] = xv * ALPHA + gt * fv * gmul; s += (v[j].x + v[j].y) + (v[j].z + v[j].w); }
        const float mean = wave_sum(s) * (1.f / DM); float s2 = 0.f;
#pragma unroll
        for (int j = 0; j < 4; ++j) { v[j] = v[j] - mean; s2 += (v[j].x * v[j].x + v[j].y * v[j].y) + (v[j].z * v[j].z + v[j].w * v[j].w); }
        const float rstd = 1.f / sqrtf(wave_sum(s2) * (1.f / DM) + LN_EPS);
        float dt[8];
#pragma unroll
        for (int q = 0; q < 8; ++q) dt[q] = 0.f;
#pragma unroll
        for (int j = 0; j < 4; ++j) { const int n = 4 * F.lane + 256 * j;
            const f32x4 y = v[j] * rstd * *(const f32x4*)(g + n) + *(const f32x4*)(bb + n);
            *(f32x4*)(xrow + n) = y;
            if (nsh >= 0) { const f32x4 a = y * (1.0f + *(const f32x4*)(modp(KA, nl, mb, nsh + 1) + n)) + *(const f32x4*)(modp(KA, nl, mb, nsh) + n);
                v2u w; w.x = pk2(a.x, a.y); w.y = pk2(a.z, a.w); *(v2u*)(((bf16*)(KA->ws + WS_A)) + (size_t)row * DM + n) = w;
                if (DTP) {
#pragma unroll
                    for (int e = 0; e < 4; ++e) { const f32x4 w0 = *(const LAS f32x4*)(wdt + (n + e) * 8), w1 = *(const LAS f32x4*)(wdt + (n + e) * 8 + 4); const float ae = a[e];
                        dt[0] += ae * w0.x; dt[1] += ae * w0.y; dt[2] += ae * w0.z; dt[3] += ae * w0.w; dt[4] += ae * w1.x; dt[5] += ae * w1.y; dt[6] += ae * w1.z; dt[7] += ae * w1.w; } } }
        }
        if (DTP) {
#pragma unroll
            for (int q = 0; q < 8; ++q) dt[q] = wave_sum(dt[q]);
            if (F.lane == 0) { *(f32x4*)(((float*)(KA->ws + WS_DT)) + (size_t)row * 8) = (f32x4){dt[0], dt[1], dt[2], dt[3]}; *(f32x4*)(((float*)(KA->ws + WS_DT)) + (size_t)row * 8 + 4) = (f32x4){dt[4], dt[5], dt[6], dt[7]}; }
        }
    }
}
DI void prep_pass(int l) {
    KArgs KA = kargs(); Frame F = mkframe();
    const LAS float* rc = (const LAS float*)(F.lds + ROPE_OFF); const LAS float* rs = rc + 1024;
    bf16* P = ((bf16*)(KA->ws + WS_ACT));
    const int hf = F.lane >> 5, li = F.lane & 31, ra = li >> 4, ri = li & 15, d1 = ra * 32 + ri, d2 = d1 + 16;
    for (int row = F.gw; row < NROW; row += F.ngw) {
        const bool lat = row < NLAT; const int t = row & 4095;
        const int pos = ra == 0 ? (t >> 6) : (t & 63);
        const float cs = rc[pos * 16 + ri], sn = rs[pos * 16 + ri];
        bf16* pr = P + (size_t)row * NPJ;
#pragma unroll
        for (int it = 0; it < 6; ++it) {
            const int hh = 2 * it + hf;
            const bool isc = hh >= 6; const int h6 = isc ? hh - 6 : hh;
            const int col = (isc ? (h6 < 4 ? C_CQ + h6 * 64 : C_CK + (h6 - 4) * 64) : (h6 < 4 ? C_AQ + h6 * 64 : C_AK + (h6 - 4) * 64));
            float x1 = bf2f(pr[col + d1]), x2 = bf2f(pr[col + d2]);
            float ss = x1 * x1 + x2 * x2;
#pragma unroll
            for (int o = 1; o < 32; o <<= 1) ss += __shfl_xor(ss, o);
            if (isc) { const float r = 1.f / sqrtf(ss * (1.f / 64.f) + LN_EPS); const float* gn = (h6 < 4 ? KA->in[19] : KA->in[20]) + l * 64; x1 = x1 * r * gn[d1]; x2 = x2 * r * gn[d2]; }
            if (lat) { const float y1 = x1 * cs - x2 * sn, y2 = x1 * sn + x2 * cs; x1 = y1; x2 = y2; }
            if (isc || lat) { pr[col + d1] = (bf16)f2bf(x1); pr[col + d2] = (bf16)f2bf(x2); }
        }
        const int Ls = lat ? SEQ : CTXL; const int tt = lat ? t : (row - NLAT) & 255;
#pragma unroll
        for (int j = 0; j < 3; ++j) { const int ch = 4 * F.lane + 256 * j;
            f32x4 acc = *(const f32x4*)(KA->in[15] + l * 768 + ch);
#pragma unroll
            for (int k = 0; k < 5; ++k) { const int t2 = tt + k - 2;
                if (t2 >= 0 && t2 < Ls) { const v2u w = *(const v2u*)(P + (size_t)(row + k - 2) * NPJ + C_BX + ch); const f32x4 cw = *(const f32x4*)(KA->in[14] + (l * 5 + k) * 768 + ch);
                    acc += cw * (f32x4){bflo(w.x), bfhi(w.x), bflo(w.y), bfhi(w.y)}; } }
            v2u o; o.x = pk2(silu(acc.x), silu(acc.y)); o.y = pk2(silu(acc.z), silu(acc.w)); *(v2u*)(((bf16*)(KA->ws + WS_U)) + (size_t)row * 768 + ch) = o; }
        if (F.lane < 8) { const float v = ((float*)(KA->ws + WS_DT))[(size_t)row * 8 + F.lane] + KA->in[16][l * 8 + F.lane]; ((float*)(KA->ws + WS_DT))[(size_t)row * 8 + F.lane] = fmaxf(v, 0.f) + log1pf(__expf(-fabsf(v))); }
    }
}
DI void nkey(const float (&q)[64], float (&o)[64], float& m, float& l, const bf16* kr, const bf16* vr, float bias) {
    float s = bias;
#pragma unroll
    for (int c = 0; c < 8; ++c) { const v4u w = *(const v4u*)(kr + 8 * c);
        s += q[8 * c] * bflo(w.x) + q[8 * c + 1] * bfhi(w.x) + q[8 * c + 2] * bflo(w.y) + q[8 * c + 3] * bfhi(w.y) + q[8 * c + 4] * bflo(w.z) + q[8 * c + 5] * bfhi(w.z) + q[8 * c + 6] * bflo(w.w) + q[8 * c + 7] * bfhi(w.w); }
    const float mn = fmaxf(m, s), cf = __expf(m - mn), p = __expf(s - mn);
    l = l * cf + p; m = mn;
#pragma unroll
    for (int c = 0; c < 8; ++c) { const v4u w = *(const v4u*)(vr + 8 * c);
        o[8 * c] = o[8 * c] * cf + p * bflo(w.x); o[8 * c + 1] = o[8 * c + 1] * cf + p * bfhi(w.x); o[8 * c + 2] = o[8 * c + 2] * cf + p * bflo(w.y); o[8 * c + 3] = o[8 * c + 3] * cf + p * bfhi(w.y);
        o[8 * c + 4] = o[8 * c + 4] * cf + p * bflo(w.z); o[8 * c + 5] = o[8 * c + 5] * cf + p * bfhi(w.z); o[8 * c + 6] = o[8 * c + 6] * cf + p * bflo(w.w); o[8 * c + 7] = o[8 * c + 7] * cf + p * bfhi(w.w); }
}
template <int TYPE>
DI void naive_attn(int l, int row, int h, bool ctxq) {
    KArgs KA = kargs(); Frame F = mkframe();
    const bf16* P = ((bf16*)(KA->ws + WS_ACT));
    const int qcol = (TYPE == 0 ? C_AQ : TYPE == 1 ? C_CQ : C_DQ) + h * 64;
    const int kvh = TYPE == 2 ? h : (h >> 1);
    const int kcol = (TYPE == 0 ? C_AK : TYPE == 1 ? C_CK : C_DK) + kvh * 64, vcol = (TYPE == 0 ? C_AV : TYPE == 1 ? C_CV : C_DV) + kvh * 64;
    float q[64], o[64]; float m = -1e30f, ls = 0.f;
#pragma unroll
    for (int c = 0; c < 8; ++c) { const v4u w = *(const v4u*)(P + (size_t)row * NPJ + qcol + 8 * c);
        q[8 * c] = 0.125f * bflo(w.x); q[8 * c + 1] = 0.125f * bfhi(w.x); q[8 * c + 2] = 0.125f * bflo(w.y); q[8 * c + 3] = 0.125f * bfhi(w.y);
        q[8 * c + 4] = 0.125f * bflo(w.z); q[8 * c + 5] = 0.125f * bfhi(w.z); q[8 * c + 6] = 0.125f * bflo(w.w); q[8 * c + 7] = 0.125f * bfhi(w.w); }
#pragma unroll
    for (int d = 0; d < 64; ++d) o[d] = 0.f;
    int b;
    if (!ctxq) {
        b = row >> 12; const int t = row & 4095;
        if (TYPE == 0) { const int k0 = max(t - 128, 0), k1 = min(t + 128, SEQ - 1);
            for (int k = k0; k <= k1; ++k) { const bf16* kp = P + (size_t)(b * SEQ + k) * NPJ; nkey(q, o, m, ls, kp + kcol, kp + vcol, 0.f); } }
        else if (TYPE == 1) { for (int k = 0; k < SEQ; ++k) { const bf16* kp = P + (size_t)(b * SEQ + k) * NPJ; nkey(q, o, m, ls, kp + kcol, kp + vcol, 0.f); } }
        else { const int r = t >> 6, c = t & 63; const int rs = min(max(r - 4, 0), 56), cs = min(max(c - 8, 0), 48);
            for (int a = 0; a < 8; ++a) { const float* bp = KA->in[21] + ((size_t)(l * 4 + h) * 15 + (rs + a - r + 7)) * 31 + (cs - c + 15);
                for (int k = 0; k < 16; ++k) { const bf16* kp = P + (size_t)(b * SEQ + (rs + a) * 64 + cs + k) * NPJ; nkey(q, o, m, ls, kp + kcol, kp + vcol, bp[k]); } } }
    } else b = (row - NLAT) >> 8;
    for (int k = 0; k < CTXL; ++k) { const bf16* kp = P + (size_t)(NLAT + b * CTXL + k) * NPJ; nkey(q, o, m, ls, kp + kcol, kp + vcol, 0.f); }
    if (TYPE == 0) { const float sk = KA->in[13][l * 4 + h]; const float mn = fmaxf(m, sk), cf = __expf(m - mn); ls = ls * cf + __expf(sk - mn);
#pragma unroll
        for (int d = 0; d < 64; ++d) o[d] *= cf; }
    const float inv = 1.f / ls;
    bf16* op = ((bf16*)(KA->ws + WS_O)) + (size_t)row * DM + (TYPE == 0 ? 0 : TYPE == 1 ? 512 : 768) + h * 64;
#pragma unroll
    for (int c = 0; c < 8; ++c) { v4u w; w.x = pk2(o[8 * c] * inv, o[8 * c + 1] * inv); w.y = pk2(o[8 * c + 2] * inv, o[8 * c + 3] * inv); w.z = pk2(o[8 * c + 4] * inv, o[8 * c + 5] * inv); w.w = pk2(o[8 * c + 6] * inv, o[8 * c + 7] * inv);
        *(v4u*)(op + 8 * c) = w; }
}
DI void naive_ssd(int l, int item) {
    KArgs KA = kargs(); Frame F = mkframe();
    const int b = item >> 3, dir = (item >> 2) & 1, h = item & 3, g = h >> 1;
    const int p = F.tid >> 3, ng = F.tid & 7;
    const float A = -__expf(KA->in[17][l * 8 + dir * 4 + h]);
    bf16* Y = dir ? (((bf16*)(KA->ws + WS_Y) + (size_t)NROW * 256)) : ((bf16*)(KA->ws + WS_Y));
    float hs[16];
#pragma unroll
    for (int i = 0; i < 16; ++i) hs[i] = 0.f;
    for (int ph = 0; ph < 2; ++ph) {
        const int ns = ph ? SEQ : CTXL, base = ph ? b * SEQ : NLAT + b * CTXL;
#pragma unroll 4
        for (int s = 0; s < ns; ++s) {
            const int row = base + (dir ? ns - 1 - s : s);
            const float dt = ((float*)(KA->ws + WS_DT))[(size_t)row * 8 + dir * 4 + h];
            const bf16* ur = ((bf16*)(KA->ws + WS_U)) + (size_t)row * 768;
            const float xv = bf2f(ur[h * 64 + p]);
            const v4u b0 = *(const v4u*)(ur + 256 + g * 128 + ng * 16), b1 = *(const v4u*)(ur + 256 + g * 128 + ng * 16 + 8);
            const v4u c0 = *(const v4u*)(ur + 512 + g * 128 + ng * 16), c1 = *(const v4u*)(ur + 512 + g * 128 + ng * 16 + 8);
            const float dA = __expf(dt * A), dx = dt * xv;
            const unsigned bw[8] = {b0.x, b0.y, b0.z, b0.w, b1.x, b1.y, b1.z, b1.w}, cw[8] = {c0.x, c0.y, c0.z, c0.w, c1.x, c1.y, c1.z, c1.w};
            float y = 0.f;
#pragma unroll
            for (int i = 0; i < 8; ++i) { hs[2 * i] = hs[2 * i] * dA + dx * bflo(bw[i]); hs[2 * i + 1] = hs[2 * i + 1] * dA + dx * bfhi(bw[i]); y += bflo(cw[i]) * hs[2 * i] + bfhi(cw[i]) * hs[2 * i + 1]; }
            y += __shfl_xor(y, 1); y += __shfl_xor(y, 2); y += __shfl_xor(y, 4);
            if (ng == 0) Y[(size_t)row * 256 + h * 64 + p] = (bf16)f2bf(y);
        }
    }
}
DI void mixers_naive(int l, bool last) {
    Frame F = mkframe();
    const int nAttL = 64 * 12, nAttC = last ? 0 : 4 * 12, nItems = 64 + nAttL + nAttC;
    for (int it = blockIdx.x; it < nItems; it += F.G) {
        if (it < 64) { naive_ssd(l, it); continue; }
        int r = it - 64; bool cq = false; int rowbase;
        if (r >= nAttL) { r -= nAttL; cq = true; }
        const int rb = r / 12, ty = (r % 12) >> 2, h = r & 3;
        rowbase = cq ? NLAT + rb * 512 : rb * 512;
        const int row = rowbase + F.tid;
        if (ty == 0) naive_attn<0>(l, row, h, cq); else if (ty == 1) naive_attn<1>(l, row, h, cq); else naive_attn<2>(l, row, h, cq);
    }
}
typedef float f32x16 __attribute__((ext_vector_type(16)));
typedef short s16x4 __attribute__((ext_vector_type(4)));
typedef short bf16x8v __attribute__((ext_vector_type(8)));
typedef short v4i16_t __attribute__((ext_vector_type(4)));
typedef float f32x2_t __attribute__((ext_vector_type(2))); typedef __bf16 bf16x2_t __attribute__((ext_vector_type(2)));
DI unsigned cvtpk(float lo, float hi) { f32x2_t v = {lo, hi}; bf16x2_t b = __builtin_convertvector(v, bf16x2_t); return __builtin_bit_cast(unsigned, b); }
DI s16x4 vtr(const LAS unsigned char* p) { return __builtin_bit_cast(s16x4, __builtin_amdgcn_ds_read_tr16_b64_v4i16((LAS v4i16_t*)p)); }
DI int crow16(int i, int h) { return (i & 3) + 8 * (i >> 2) + 4 * h; }
constexpr int AT_KRS = 144, AT_VRS = 192, AT_KB = 64 * AT_KRS, AT_BUF = AT_KB + 64 * AT_VRS, AT_RPB = 2 * AT_BUF;
constexpr float LOG2E = 1.4426950408889634f, AT_SC = 0.125f * LOG2E;
template <int TYPE>
DI void attn_unit(KArgs KA, const Frame& F, int l, int unit, bool ctxq) {
    const bf16* P = (const bf16*)(KA->ws + WS_ACT);
    const int L = F.lane, w = F.wave, r = L & 31, h2 = L >> 5, i16 = L & 15;
    int b, head, kvh, p0, qpos0, t0 = 0, nloc = 0;
    if (TYPE != 2) { int g, pb; if (!ctxq) { b = unit >> 6; g = (unit >> 5) & 1; pb = unit & 31; } else { b = unit >> 2; g = (unit >> 1) & 1; pb = unit & 1; }
        head = 2 * g + (w >> 2); kvh = g; p0 = pb * 128; qpos0 = p0 + 32 * (w & 3);
        if (!ctxq) { if (TYPE == 1) { t0 = 0; nloc = 64; } else { t0 = max(0, 2 * (pb - 1)); nloc = min(64, 2 * (pb + 2)) - t0; } } }
    else { int rb; if (!ctxq) { b = unit >> 6; head = (unit >> 4) & 3; rb = unit & 15; } else { b = unit >> 2; head = unit & 3; rb = 0; }
        kvh = head; p0 = rb * 256; qpos0 = p0 + 32 * w;
        if (!ctxq) { const int r0 = rb * 4; t0 = min(max(r0 - 4, 0), 56); nloc = min(max(r0 - 1, 0), 56) + 8 - t0; } }
    const int qcol = (TYPE == 0 ? C_AQ : TYPE == 1 ? C_CQ : C_DQ) + head * 64;
    const int kcol = (TYPE == 0 ? C_AK : TYPE == 1 ? C_CK : C_DK) + kvh * 64, vcol = (TYPE == 0 ? C_AV : TYPE == 1 ? C_CV : C_DV) + kvh * 64;
    const int qrow = (ctxq ? NLAT + b * CTXL : b * SEQ) + qpos0 + r;
    const int nt = nloc + 4;
    bf16x8v qf[4];
#pragma unroll
    for (int ks = 0; ks < 4; ++ks) qf[ks] = *(const bf16x8v*)(P + (size_t)qrow * NPJ + qcol + ks * 16 + 8 * h2);
    LAS unsigned char* lb = F.lds;
    if (TYPE == 2) { LAS float* rp = (LAS float*)(lb + AT_RPB); for (int i = F.tid; i < 465; i += 512) rp[i] = KA->in[21][(size_t)(l * 4 + head) * 465 + i] * LOG2E; }
    const int srow = F.tid >> 3, sch = F.tid & 7;
#define TILE_ROW0(i) ((i) < nloc ? b * SEQ + (t0 + (i)) * 64 : NLAT + b * CTXL + ((i) - nloc) * 64)
    v4u kreg, vreg;
    { const bf16* src = P + (size_t)(TILE_ROW0(0) + srow) * NPJ; kreg = *(const v4u*)(src + kcol + sch * 8); vreg = *(const v4u*)(src + vcol + sch * 8); }
    *(LAS v4u*)(lb + srow * AT_KRS + sch * 16) = kreg; *(LAS v4u*)(lb + AT_KB + srow * AT_VRS + sch * 16) = vreg;
    __syncthreads();
    f32x16 oacc[2];
#pragma unroll
    for (int i = 0; i < 16; ++i) { oacc[0][i] = 0.f; oacc[1][i] = 0.f; }
    float m = -1e30f, lsum = 0.f;
    const int qpos = qpos0 + r;
    const int gr = qpos0 >> 6, rs = min(max(gr - 4, 0), 56), qc = qpos & 63, cs = min(max(qc - 8, 0), 48);
    for (int i = 0; i < nt; ++i) {
        const LAS unsigned char* kb_ = lb + (i & 1) * AT_BUF; const LAS unsigned char* vb_ = kb_ + AT_KB;
        if (i + 1 < nt) { const bf16* src = P + (size_t)(TILE_ROW0(i + 1) + srow) * NPJ; kreg = *(const v4u*)(src + kcol + sch * 8); vreg = *(const v4u*)(src + vcol + sch * 8); }
        const bool loc = i < nloc;
        bool skip = false;
        const int k0 = (t0 + i) * 64;
        if (loc && TYPE == 0) skip = (k0 + 63 < qpos0 - 128) || (k0 > qpos0 + 31 + 128);
        if (loc && TYPE == 2) skip = (t0 + i < rs) || (t0 + i >= rs + 8);
        if (!skip) {
            f32x16 sacc[2];
#pragma unroll
            for (int kb = 0; kb < 2; ++kb) {
#pragma unroll
                for (int q = 0; q < 16; ++q) sacc[kb][q] = 0.f;
#pragma unroll
                for (int ks = 0; ks < 4; ++ks) { const bf16x8v kf = *(const LAS bf16x8v*)(kb_ + (kb * 32 + r) * AT_KRS + ks * 32 + 16 * h2);
                    sacc[kb] = __builtin_amdgcn_mfma_f32_32x32x16_bf16(kf, qf[ks], sacc[kb], 0, 0, 0); }
            }
            float tmax = -INFINITY;
#pragma unroll
            for (int kb = 0; kb < 2; ++kb)
#pragma unroll
                for (int q = 0; q < 16; ++q) { float s = sacc[kb][q] * AT_SC; const int kk = kb * 32 + crow16(q, h2);
                    if (TYPE == 0 && loc) { const int d = k0 + kk - qpos; if (d > 128 || d < -128) s = -INFINITY; }
                    if (TYPE == 2 && loc) { const int dc = kk - cs; const LAS float* rp = (const LAS float*)(lb + AT_RPB);
                        if (dc < 0 || dc >= 16) s = -INFINITY; else s += rp[(t0 + i - gr + 7) * 31 + (kk - qc + 15)]; }
                    sacc[kb][q] = s; tmax = fmaxf(tmax, s); }
            tmax = fmaxf(tmax, __shfl_xor(tmax, 32));
            const float mn = fmaxf(m, tmax), alpha = __builtin_amdgcn_exp2f(m - mn); m = mn;
            float psum = 0.f;
#pragma unroll
            for (int kb = 0; kb < 2; ++kb)
#pragma unroll
                for (int q = 0; q < 16; ++q) { const float p = __builtin_amdgcn_exp2f(sacc[kb][q] - mn); sacc[kb][q] = p; psum += p; }
            lsum = lsum * alpha + psum;
#pragma unroll
            for (int q = 0; q < 16; ++q) { oacc[0][q] *= alpha; oacc[1][q] *= alpha; }
#pragma unroll
            for (int kb = 0; kb < 2; ++kb)
#pragma unroll
                for (int s = 0; s < 2; ++s) {
                    v4u pw; pw.x = cvtpk(sacc[kb][8 * s], sacc[kb][8 * s + 1]); pw.y = cvtpk(sacc[kb][8 * s + 2], sacc[kb][8 * s + 3]); pw.z = cvtpk(sacc[kb][8 * s + 4], sacc[kb][8 * s + 5]); pw.w = cvtpk(sacc[kb][8 * s + 6], sacc[kb][8 * s + 7]);
                    const bf16x8v pf = __builtin_bit_cast(bf16x8v, pw);
#pragma unroll
                    for (int db = 0; db < 2; ++db) {
                        const LAS unsigned char* va = vb_ + (kb * 32 + 16 * s + 4 * h2 + (i16 >> 2)) * AT_VRS + (db * 32 + 16 * ((L >> 4) & 1) + 4 * (i16 & 3)) * 2;
                        const s16x4 lo = vtr(va), hi = vtr(va + 8 * AT_VRS);
                        const bf16x8v vf = (bf16x8v){lo[0], lo[1], lo[2], lo[3], hi[0], hi[1], hi[2], hi[3]};
                        oacc[db] = __builtin_amdgcn_mfma_f32_32x32x16_bf16(vf, pf, oacc[db], 0, 0, 0); }
                }
        }
        if (i + 1 < nt) { LAS unsigned char* nb = lb + ((i + 1) & 1) * AT_BUF; *(LAS v4u*)(nb + srow * AT_KRS + sch * 16) = kreg; *(LAS v4u*)(nb + AT_KB + srow * AT_VRS + sch * 16) = vreg; }
        __syncthreads();
    }
    lsum += __shfl_xor(lsum, 32);
    if (TYPE == 0) lsum += __builtin_amdgcn_exp2f(KA->in[13][l * 4 + head] * LOG2E - m);
    const float inv = 1.f / lsum;
    bf16* op = (bf16*)(KA->ws + WS_O) + (size_t)qrow * DM + (TYPE == 0 ? 0 : TYPE == 1 ? 512 : 768) + head * 64;
#pragma unroll
    for (int db = 0; db < 2; ++db)
#pragma unroll
        for (int q4 = 0; q4 < 4; ++q4) { v2u o; o.x = cvtpk(oacc[db][4 * q4] * inv, oacc[db][4 * q4 + 1] * inv); o.y = cvtpk(oacc[db][4 * q4 + 2] * inv, oacc[db][4 * q4 + 3] * inv);
            *(v2u*)(op + db * 32 + 8 * q4 + 4 * h2) = o; }
}
DI void mixers_flash(int l, bool last) {
    KArgs KA = kargs(); Frame F = mkframe();
    const int nL = 1536, nC = last ? 0 : 96, nItems = 64 + nL + nC;
    for (int it = blockIdx.x; it < nItems; it += F.G) {
        if (it < 64) { naive_ssd(l, it); __syncthreads(); continue; }
        int u = it - 64; bool cq = false;
        if (u >= nL) { u -= nL; cq = true; }
        const int ty = u % 3, un = u / 3;
        if (ty == 0) attn_unit<1>(KA, F, l, un, cq); else if (ty == 1) attn_unit<0>(KA, F, l, un, cq); else attn_unit<2>(KA, F, l, un, cq);
    }
}
DI void merge_pass(int l, int nrows) {
    KArgs KA = kargs(); Frame F = mkframe();
    const bf16* P = ((bf16*)(KA->ws + WS_ACT));
    const int hh = F.lane >> 4;
    const float dsk = KA->in[18][l * 4 + hh];
    for (int row = F.gw; row < nrows; row += F.ngw) {
        f32x4 v[4];
#pragma unroll
        for (int j = 0; j < 4; ++j) { const int n = 4 * F.lane + 256 * j;
            if (j == 1) { const int cn = 4 * F.lane; const v2u yfw = *(const v2u*)(((bf16*)(KA->ws + WS_Y)) + (size_t)row * 256 + cn), ybw = *(const v2u*)((((bf16*)(KA->ws + WS_Y) + (size_t)NROW * 256)) + (size_t)row * 256 + cn);
                const f32x4 yf = (f32x4){bflo(yfw.x), bfhi(yfw.x), bflo(yfw.y), bfhi(yfw.y)}, yb = (f32x4){bflo(ybw.x), bfhi(ybw.x), bflo(ybw.y), bfhi(ybw.y)};
                const v2u xw = *(const v2u*)(((bf16*)(KA->ws + WS_U)) + (size_t)row * 768 + cn), zw = *(const v2u*)(P + (size_t)row * NPJ + C_BZ + cn);
                const f32x4 xs = (f32x4){bflo(xw.x), bfhi(xw.x), bflo(xw.y), bfhi(xw.y)}, z = (f32x4){bflo(zw.x), bfhi(zw.x), bflo(zw.y), bfhi(zw.y)};
                const f32x4 y = yf + yb + xs * dsk;
                v[j] = (f32x4){y.x * silu(z.x), y.y * silu(z.y), y.z * silu(z.z), y.w * silu(z.w)}; }
            else { const v2u w = *(const v2u*)(((bf16*)(KA->ws + WS_O)) + (size_t)row * DM + n); v[j] = (f32x4){bflo(w.x), bfhi(w.x), bflo(w.y), bfhi(w.y)}; } }
#pragma unroll
        for (int j = 0; j < 4; ++j) { const int n = 4 * F.lane + 256 * j;
            const float ss = wave_sum((v[j].x * v[j].x + v[j].y * v[j].y) + (v[j].z * v[j].z + v[j].w * v[j].w));
            const float r = 1.f / sqrtf(ss * (1.f / 256.f) + LN_EPS);
            const f32x4 a = v[j] * r * *(const f32x4*)(KA->in[12] + l * DM + n);
            v2u w; w.x = pk2(a.x, a.y); w.y = pk2(a.z, a.w); *(v2u*)(((bf16*)(KA->ws + WS_A)) + (size_t)row * DM + n) = w; }
    }
}
__global__ void __launch_bounds__(NWAVES * 64, 2) mega_fwd(Args args) {
    extern __shared__ __attribute__((aligned(16))) unsigned char lds[];
    cg::grid_group grid = cg::this_grid();
    { LAS float* rc = (LAS float*)((LAS unsigned char*)lds + ROPE_OFF);
      for (int i = threadIdx.x; i < 1024; i += 512) { const int pos = i >> 4, fi = i & 15; const float inv = exp2f(-(float)fi * (13.287712379549449f / 16.f)); const float ang = (float)pos * inv; rc[i] = cosf(ang); rc[1024 + i] = sinf(ang); } }
    __syncthreads();

    p0a(); grid.sync();
    p0b(); grid.sync();
    p0c(); grid.sync();
    for (int l = 0; l < NL; ++l) {
        const bool last = (l == NL - 1); const int mrows = last ? NLAT : NROW;
        { KArgs KA = kargs(); pg8::Gemm g{((bf16*)(KA->ws + WS_A)), wbuf(KA, l, WO_W1A), NROW, 2 * DFF, DM}; pg8::StaticOrder S; S.init(NROW, 2 * DFF, (int)gridDim.x, (int)blockIdx.x); pg8::EpiSwiGLU E{((bf16*)(KA->ws + WS_ACT)), DFF};
          pg8::gemm_phase<pg8::EpiSwiGLU, pg8::StaticOrder, true, false>((LAS unsigned char*)lds, g, S, E); }
        grid.sync();
        { KArgs KA = kargs(); pg8::Gemm g{((bf16*)(KA->ws + WS_ACT)), wbuf(KA, l, WO_W2A), NROW, DM, DFF}; pg8::StaticOrder S; S.init(NROW, DM, (int)gridDim.x, (int)blockIdx.x); pg8::EpiBf16 E{((bf16*)(KA->ws + WS_O)), DM};
          pg8::gemm_phase<pg8::EpiBf16, pg8::StaticOrder, true, false>((LAS unsigned char*)lds, g, S, E); }
        grid.sync();
        ln_pass<true>(l, 2, 0.5f, 0, l, 3, NROW); grid.sync();
        { KArgs KA = kargs(); pg8::Gemm g{((bf16*)(KA->ws + WS_A)), wbuf(KA, l, WO_WIN), NROW, NPJ, DM}; pg8::StaticOrder S; S.init(NROW, NPJ, (int)gridDim.x, (int)blockIdx.x); pg8::EpiBf16 E{((bf16*)(KA->ws + WS_ACT)), NPJ};
          pg8::gemm_phase<pg8::EpiBf16, pg8::StaticOrder, true, false>((LAS unsigned char*)lds, g, S, E); }
        grid.sync();
        prep_pass(l); grid.sync();
        mixers_flash(l, last); grid.sync();
        merge_pass(l, mrows); grid.sync();
        { KArgs KA = kargs(); pg8::Gemm g{((bf16*)(KA->ws + WS_A)), wbuf(KA, l, WO_WOUT), mrows, DM, DM}; pg8::StaticOrder S; S.init(mrows, DM, (int)gridDim.x, (int)blockIdx.x); pg8::EpiBf16 E{((bf16*)(KA->ws + WS_O)), DM};
          pg8::gemm_phase<pg8::EpiBf16, pg8::StaticOrder, true, false>((LAS unsigned char*)lds, g, S, E); }
        grid.sync();
        ln_pass<false>(l, 5, 1.0f, 1, l, 6, mrows); grid.sync();
        { KArgs KA = kargs(); pg8::Gemm g{((bf16*)(KA->ws + WS_A)), wbuf(KA, l, WO_W1B), mrows, 2 * DFF, DM}; pg8::StaticOrder S; S.init(mrows, 2 * DFF, (int)gridDim.x, (int)blockIdx.x); pg8::EpiSwiGLU E{((bf16*)(KA->ws + WS_ACT)), DFF};
          pg8::gemm_phase<pg8::EpiSwiGLU, pg8::StaticOrder, true, false>((LAS unsigned char*)lds, g, S, E); }
        grid.sync();
        { KArgs KA = kargs(); pg8::Gemm g{((bf16*)(KA->ws + WS_ACT)), wbuf(KA, l, WO_W2B), mrows, DM, DFF}; pg8::StaticOrder S; S.init(mrows, DM, (int)gridDim.x, (int)blockIdx.x); pg8::EpiBf16 E{((bf16*)(KA->ws + WS_O)), DM};
          pg8::gemm_phase<pg8::EpiBf16, pg8::StaticOrder, true, false>((LAS unsigned char*)lds, g, S, E); }
        grid.sync();
        ln_pass<false>(l, 8, 0.5f, 2, l + 1, last ? -1 : 0, mrows);
        if (!last) grid.sync();
    }
}

extern "C" void kernel_launch(void* const* d_in, const int* in_sizes, int n_in, void* d_out, int out_size, void* d_ws, size_t ws_size, hipStream_t stream) {
    static int grid = 0;
    if (grid == 0) {
        if (n_in != 24 || out_size != NLAT * DM || ws_size < WS_END) { fprintf(stderr, "kernel_launch: unexpected shapes: n_in %d out %d ws %zu\n", n_in, out_size, ws_size); grid = -1; return; }
        int dev = 0, cus = 0, per_cu = 0;
        hipGetDevice(&dev); hipDeviceGetAttribute(&cus, hipDeviceAttributeMultiprocessorCount, dev);
        if (hipFuncSetAttribute((const void*)mega_fwd, hipFuncAttributeMaxDynamicSharedMemorySize, LDS_BYTES) != hipSuccess) { fprintf(stderr, "kernel_launch: hipFuncSetAttribute failed\n"); grid = -1; return; }
        if (hipOccupancyMaxActiveBlocksPerMultiprocessor(&per_cu, (const void*)mega_fwd, NWAVES * 64, LDS_BYTES) != hipSuccess || per_cu < 1) { fprintf(stderr, "kernel_launch: occupancy query says %d\n", per_cu); per_cu = 1; }
        (void)hipGetLastError();
        grid = cus;
    }
    if (grid < 0) return;
    Args a{};
    for (int i = 0; i < 24; ++i) a.in[i] = (const float*)d_in[i];
    a.out = (float*)d_out; a.ws = (unsigned char*)d_ws;
    void* kargs[] = {&a};
    hipError_t e = hipLaunchCooperativeKernel((const void*)mega_fwd, dim3(grid), dim3(NWAVES * 64), kargs, LDS_BYTES, stream);
    if (e != hipSuccess) fprintf(stderr, "kernel_launch: cooperative launch failed: %s (grid %d)\n", hipGetErrorString(e), grid);
}
```

```cpp
#include <hip/hip_runtime.h>
#include <hip/hip_cooperative_groups.h>
#include <cstdio>
#include <cstdint>
namespace cg = cooperative_groups;
namespace pg8 {
#define PG8_LAS __attribute__((address_space(3)))
typedef unsigned short bf16_t;
typedef short bf16x8 __attribute__((ext_vector_type(8)));
typedef float f32x4 __attribute__((ext_vector_type(4)));
typedef unsigned u32x4 __attribute__((ext_vector_type(4)));
constexpr int BM = 256, BK = 64, HALF = 128, HTB = HALF * BK * 2  , STAGE_BYTES = 8 * HTB, NXCD = 8, WGM = 8;

__host__ __device__ __forceinline__ int lds_byte(int r, int c) { const int st = (r >> 4) * 2 + (c >> 5), rr = r & 15, cc = c & 31, ob = rr * 64 + cc * 2; return st * 1024 + (ob ^ (((ob >> 9) & 1) << 5)); }
__host__ __device__ __forceinline__ void stage_rc(int b, int& R, int& C) { const int st = b / 1024, sb = b % 1024, swz = sb ^ (((sb >> 9) & 1) << 5); R = (st >> 1) * 16 + swz / 64; C = (st & 1) * 32 + (swz % 64) / 2; }
__host__ __device__ __forceinline__ int perm32(int rho) { const int n = rho >> 4, i = rho & 15; return 8 * (i >> 2) + 4 * n + (i & 3); }

struct Unit { int pm, pn; };
struct Gemm { const bf16_t* A; const bf16_t* Bt; int M, N, K; };

struct StaticOrder {
    int nM, nN, nwg, G, c;
    __host__ __device__ void init(int M, int N, int G_, int c_) { nM = M / BM; nN = N / BM; nwg = nM * nN; G = G_; c = c_; }
    __host__ __device__ bool next(int i, Unit& u) const {
        const long L = (long)i * G + c; if (L >= nwg) return false;
        int wgid = (int)L; { const int q = nwg / NXCD, r = nwg % NXCD, xcd = wgid % NXCD, off = wgid / NXCD; wgid = (xcd < r ? xcd * (q + 1) : r * (q + 1) + (xcd - r) * q) + off; }
        const int nig = WGM * nN, gid = wgid / nig, fm = gid * WGM, gsz = (nM - fm) < WGM ? (nM - fm) : WGM;
        u.pm = fm + ((wgid % nig) % gsz); u.pn = (wgid % nig) / gsz; return true;
    }
    __device__ __forceinline__ void a_ready(const Unit&) const {}
    __device__ __forceinline__ void done(const Unit&) const {}
};

__device__ __forceinline__ unsigned cvt_pk_bf16(float lo, float hi) { unsigned r; asm volatile("v_cvt_pk_bf16_f32 %0, %1, %2" : "=v"(r) : "v"(lo), "v"(hi)); return r; }
struct EpiBf16 {
    static constexpr bool PERM = true, AFTER_DRAIN = false;
    bf16_t* O; int ldc;
    __device__ __forceinline__ void operator()(const f32x4 (&acc)[2][2][4][2], const Unit& u, int wr, int wc, int fr, int fq) const {
        const int row0 = u.pm * BM + wr * 64 + fr; const int col0 = u.pn * BM + wc * 32 + 8 * fq;
#pragma unroll
        for (int ai = 0; ai < 2; ++ai)
#pragma unroll
            for (int m = 0; m < 4; ++m) { bf16_t* rowp = O + (size_t)(row0 + ai * HALF + m * 16) * ldc + col0;
#pragma unroll
                for (int bj = 0; bj < 2; ++bj) { const f32x4 v0 = acc[ai][bj][m][0], v1 = acc[ai][bj][m][1];
                    u32x4 w; w.x = cvt_pk_bf16(v0[0], v0[1]); w.y = cvt_pk_bf16(v0[2], v0[3]); w.z = cvt_pk_bf16(v1[0], v1[1]); w.w = cvt_pk_bf16(v1[2], v1[3]);
                    *(u32x4*)(rowp + bj * HALF) = w; } }
    }
};
__device__ __forceinline__ float silu_f(float x) { return x * __builtin_amdgcn_rcpf(1.0f + __expf(-x)); }
struct EpiSwiGLU {
    static constexpr bool PERM = true, AFTER_DRAIN = false;
    bf16_t* O; int ldc;
    __device__ __forceinline__ void operator()(const f32x4 (&acc)[2][2][4][2], const Unit& u, int wr, int wc, int fr, int fq) const {
        const int row0 = u.pm * BM + wr * 64 + fr; const int col0 = u.pn * HALF + wc * 32 + 8 * fq;
#pragma unroll
        for (int ai = 0; ai < 2; ++ai)
#pragma unroll
            for (int m = 0; m < 4; ++m) { bf16_t* rowp = O + (size_t)(row0 + ai * HALF + m * 16) * ldc + col0;
                const f32x4 a0 = acc[ai][0][m][0], a1 = acc[ai][0][m][1], u0 = acc[ai][1][m][0], u1 = acc[ai][1][m][1];
                u32x4 w;
                w.x = cvt_pk_bf16(silu_f(a0[0]) * u0[0], silu_f(a0[1]) * u0[1]); w.y = cvt_pk_bf16(silu_f(a0[2]) * u0[2], silu_f(a0[3]) * u0[3]);
                w.z = cvt_pk_bf16(silu_f(a1[0]) * u1[0], silu_f(a1[1]) * u1[1]); w.w = cvt_pk_bf16(silu_f(a1[2]) * u1[2], silu_f(a1[3]) * u1[3]);
                *(u32x4*)rowp = w; }
    }
};
template <class Epi, class Sched, bool ALIGN_EPI = false, bool SP2 = false>
__device__ __forceinline__ void gemm_phase(PG8_LAS unsigned char* lds, const Gemm g, const Sched& S, const Epi& E) {
    const int tid = threadIdx.x, wid = __builtin_amdgcn_readfirstlane(tid >> 6), lane = tid & 63, wr = wid >> 2, wc = wid & 3, fr = lane & 15, fq = lane >> 4;
    const int K = g.K, nt = K / BK;
    unsigned voffA[2], voffB[2];
#pragma unroll
    for (int i = 0; i < 2; ++i) { int R, C; stage_rc(tid * 16 + i * 8192, R, C); const int Rb = Epi::PERM ? ((R & ~31) + perm32(R & 31)) : R;
        voffA[i] = (unsigned)(R * K + C) * 2u; voffB[i] = (unsigned)(Rb * K + C) * 2u; }
    const size_t kstep = (size_t)(BK * 2);
    const size_t hstep = (size_t)HALF * K * 2;
    const size_t tstep = 2 * hstep;
    const unsigned ldsw = (unsigned)wid * 1024u;
    const int aoff = lds_byte(wr * 64 + fr, fq * 8), boff = lds_byte(wc * 32 + fr, fq * 8);
#define PG8_SA(b, h) (((b) * 2 + (h)) * HTB)
#define PG8_SB(b, h) ((4 + (b) * 2 + (h)) * HTB)
#define PG8_STAGE(bufoff, gbase, voff) do { _Pragma("unroll") for (int _i = 0; _i < 2; ++_i) \
        __builtin_amdgcn_global_load_lds((const unsigned*)((const char*)(gbase) + (voff)[_i]), (PG8_LAS unsigned*)(lds + (bufoff) + ldsw + _i * 8192), 16, 0, 0); } while (0)
#define PG8_LDA(dst, b, h) do { _Pragma("unroll") for (int m = 0; m < 4; ++m) _Pragma("unroll") for (int k = 0; k < 2; ++k) dst[m][k] = *(const PG8_LAS bf16x8*)(lds + PG8_SA(b, h) + aoff + m * 2048 + k * 1024); } while (0)
#define PG8_LDB(dst, b, h) do { _Pragma("unroll") for (int n = 0; n < 2; ++n) _Pragma("unroll") for (int k = 0; k < 2; ++k) dst[n][k] = *(const PG8_LAS bf16x8*)(lds + PG8_SB(b, h) + boff + n * 2048 + k * 1024); } while (0)
#define PG8_MMA(ai, bj, At, Bt) do { __builtin_amdgcn_s_setprio(1); _Pragma("unroll") for (int m = 0; m < 4; ++m) _Pragma("unroll") for (int n = 0; n < 2; ++n) _Pragma("unroll") for (int k = 0; k < 2; ++k) \
        acc[ai][bj][m][n] = __builtin_amdgcn_mfma_f32_16x16x32_bf16(Bt[n][k], At[m][k], acc[ai][bj][m][n], 0, 0, 0); __builtin_amdgcn_s_setprio(0); } while (0)
#define PG8_WAIT_V(n) asm volatile("s_waitcnt vmcnt(" #n ")" ::: "memory")
#define PG8_WAIT_L(n) asm volatile("s_waitcnt lgkmcnt(" #n ")" ::: "memory")
#define PG8_BAR __builtin_amdgcn_s_barrier()
#define PG8_SCHED __builtin_amdgcn_sched_barrier(0)
    Unit cur, nxt; int ui = 0;
    if (!S.next(0, cur)) return;
    f32x4 acc[2][2][4][2];
#pragma unroll
    for (int a = 0; a < 2; ++a)
#pragma unroll
        for (int b = 0; b < 2; ++b)
#pragma unroll
            for (int m = 0; m < 4; ++m)
#pragma unroll
                for (int n = 0; n < 2; ++n) acc[a][b][m][n] = (f32x4){0.f, 0.f, 0.f, 0.f};
    bf16x8 At[4][2], B0[2][2], B1[2][2];
    const char* cA = (const char*)g.A + (size_t)cur.pm * tstep; const char* cB = (const char*)g.Bt + (size_t)cur.pn * tstep;
    S.a_ready(cur);
    if constexpr (SP2) {
        PG8_STAGE(PG8_SB(0, 0), cB, voffB); PG8_STAGE(PG8_SB(0, 1), cB + hstep, voffB); PG8_STAGE(PG8_SA(0, 0), cA, voffA); PG8_STAGE(PG8_SA(0, 1), cA + hstep, voffA);
        if (wr == 1) PG8_BAR;
        PG8_WAIT_V(2); PG8_BAR;
        PG8_STAGE(PG8_SB(1, 0), cB + kstep, voffB); PG8_STAGE(PG8_SA(1, 0), cA + kstep, voffA); PG8_STAGE(PG8_SB(1, 1), cB + hstep + kstep, voffB);
        PG8_WAIT_V(6); PG8_BAR;
    } else {
        PG8_STAGE(PG8_SB(0, 0), cB, voffB); PG8_STAGE(PG8_SA(0, 0), cA, voffA); PG8_STAGE(PG8_SB(0, 1), cB + hstep, voffB); PG8_STAGE(PG8_SA(0, 1), cA + hstep, voffA);
        if (wr == 1) PG8_BAR;
        PG8_WAIT_V(4); PG8_BAR;
        PG8_STAGE(PG8_SB(1, 0), cB + kstep, voffB); PG8_STAGE(PG8_SA(1, 0), cA + kstep, voffA); PG8_STAGE(PG8_SB(1, 1), cB + hstep + kstep, voffB);
        PG8_WAIT_V(6); PG8_BAR;
    }
    for (;;) {
        const bool has_next = S.next(ui + 1, nxt);
        const char* nA = has_next ? (const char*)g.A + (size_t)nxt.pm * tstep : cA; const char* nB = has_next ? (const char*)g.Bt + (size_t)nxt.pn * tstep : cB;
        for (int t = 0; t < nt; t += 2) {
            const bool last = (t == nt - 2);
            const char* a1 = cA + (size_t)(t + 1) * kstep;
            const char* a2 = last ? nA : cA + (size_t)(t + 2) * kstep; const char* b2 = last ? nB : cB + (size_t)(t + 2) * kstep;
            const char* a3 = a2 + kstep; const char* b3 = b2 + kstep;
            if (last && has_next) S.a_ready(nxt);
            if constexpr (SP2) {
            PG8_LDB(B0, 0, 0); PG8_LDB(B1, 0, 1); PG8_SCHED; PG8_LDA(At, 0, 0); PG8_STAGE(PG8_SA(1, 1), a1 + hstep, voffA);
            PG8_WAIT_V(8); PG8_WAIT_L(0); PG8_BAR; PG8_MMA(0, 0, At, B0); PG8_MMA(0, 1, At, B1); PG8_BAR; PG8_SCHED;
            PG8_LDA(At, 0, 1); PG8_STAGE(PG8_SB(0, 0), b2, voffB); PG8_STAGE(PG8_SB(0, 1), b2 + hstep, voffB); PG8_STAGE(PG8_SA(0, 0), a2, voffA);
            PG8_WAIT_V(8); PG8_WAIT_L(0); PG8_BAR; PG8_MMA(1, 0, At, B0); PG8_MMA(1, 1, At, B1); PG8_BAR; PG8_SCHED;
            PG8_LDB(B0, 1, 0); PG8_LDB(B1, 1, 1); PG8_SCHED; PG8_LDA(At, 1, 0); PG8_STAGE(PG8_SA(0, 1), a2 + hstep, voffA);
            PG8_WAIT_V(8); PG8_WAIT_L(0); PG8_BAR; PG8_MMA(0, 0, At, B0); PG8_MMA(0, 1, At, B1); PG8_BAR; PG8_SCHED;
            PG8_LDA(At, 1, 1); PG8_STAGE(PG8_SB(1, 0), b3, voffB); PG8_STAGE(PG8_SB(1, 1), b3 + hstep, voffB); PG8_STAGE(PG8_SA(1, 0), a3, voffA);
            PG8_WAIT_V(8); PG8_WAIT_L(0); PG8_BAR; PG8_MMA(1, 0, At, B0); PG8_MMA(1, 1, At, B1); PG8_BAR; PG8_SCHED;
            } else {
            PG8_LDB(B0, 0, 0); PG8_SCHED; PG8_LDA(At, 0, 0); PG8_STAGE(PG8_SA(1, 1), a1 + hstep, voffA);
            PG8_WAIT_L(8); PG8_BAR; PG8_WAIT_L(0); PG8_MMA(0, 0, At, B0); PG8_BAR; PG8_SCHED;
            PG8_LDB(B1, 0, 1); PG8_STAGE(PG8_SB(0, 0), b2, voffB);
            PG8_BAR; PG8_WAIT_L(0); PG8_MMA(0, 1, At, B1); PG8_BAR;
            PG8_LDA(At, 0, 1); PG8_STAGE(PG8_SA(0, 0), a2, voffA);
            PG8_BAR; PG8_WAIT_L(0); PG8_MMA(1, 0, At, B0); PG8_BAR; PG8_SCHED;
            PG8_STAGE(PG8_SB(0, 1), b2 + hstep, voffB);
            PG8_WAIT_V(6); PG8_BAR; PG8_MMA(1, 1, At, B1); PG8_BAR;
            PG8_LDB(B0, 1, 0); PG8_SCHED; PG8_LDA(At, 1, 0); PG8_STAGE(PG8_SA(0, 1), a2 + hstep, voffA);
            PG8_WAIT_L(8); PG8_BAR; PG8_WAIT_L(0); PG8_MMA(0, 0, At, B0); PG8_BAR; PG8_SCHED;
            PG8_LDB(B1, 1, 1); PG8_STAGE(PG8_SB(1, 0), b3, voffB);
            PG8_BAR; PG8_WAIT_L(0); PG8_MMA(0, 1, At, B1); PG8_BAR;
            PG8_LDA(At, 1, 1); PG8_STAGE(PG8_SA(1, 0), a3, voffA);
            PG8_BAR; PG8_WAIT_L(0); PG8_MMA(1, 0, At, B0); PG8_BAR; PG8_SCHED;
            PG8_STAGE(PG8_SB(1, 1), b3 + hstep, voffB);
            PG8_WAIT_V(6); PG8_BAR; PG8_MMA(1, 1, At, B1); PG8_BAR;
            }
        }
        if constexpr (ALIGN_EPI) { if (wr == 0) PG8_BAR; }
        if constexpr (!Epi::AFTER_DRAIN) { E(acc, cur, wr, wc, fr, fq); S.done(cur); }
        if (!has_next) break;
#pragma unroll
        for (int a = 0; a < 2; ++a)
#pragma unroll
            for (int b = 0; b < 2; ++b)
#pragma unroll
                for (int m = 0; m < 4; ++m)
#pragma unroll
                    for (int n = 0; n < 2; ++n) acc[a][b][m][n] = (f32x4){0.f, 0.f, 0.f, 0.f};
        cur = nxt; cA = nA; cB = nB; ++ui;
        if constexpr (ALIGN_EPI) { if (wr == 1) PG8_BAR; }
    }
    PG8_WAIT_V(0);
    if constexpr (!ALIGN_EPI) { if (wr == 0) PG8_BAR; }
    PG8_BAR;
    if constexpr (Epi::AFTER_DRAIN) { E.fused(acc, cur, wr, wc, fr, fq, lds, wid, lane); S.done(cur); }
#undef PG8_SA
#undef PG8_SB
#undef PG8_STAGE
#undef PG8_LDA
#undef PG8_LDB
#undef PG8_MMA
#undef PG8_WAIT_V
#undef PG8_WAIT_L
#undef PG8_BAR
#undef PG8_SCHED
}
}

constexpr int NB = 8, SEQ = 4096, DM = 1024, NL = 2, CTXL = 256;
constexpr int NLAT = NB * SEQ, NCTX = NB * CTXL, NROW = NLAT + NCTX;
constexpr int DFF = 2816, NPJ = 2816, INW = 2824, NMODW = 9 * DM;
constexpr float LN_EPS = 1e-5f, ALPHA = 1.41421356237f;
constexpr int C_AQ = 0, C_AK = 256, C_AV = 384, C_BZ = 512, C_BX = 768, C_CQ = 1536, C_CK = 1792, C_CV = 1920, C_DQ = 2048, C_DK = 2304, C_DV = 2560;
constexpr int C_DTSRC = 1536;
constexpr size_t MiB = 1u << 20;
constexpr size_t WS_MOD = 0;
constexpr size_t WS_DT = 1 * MiB;
constexpr size_t WS_W = 4 * MiB, WS_WL = 41 * MiB;
constexpr size_t WO_W1A = 0, WO_W2A = 11 * MiB, WO_WIN = 16 * MiB + MiB / 2, WO_WOUT = 22 * MiB, WO_W1B = 24 * MiB, WO_W2B = 35 * MiB;
constexpr size_t WS_A = 86 * MiB;
constexpr size_t WS_ACT = 154 * MiB;
constexpr size_t WS_U = 341 * MiB;
constexpr size_t WS_O = 392 * MiB;
constexpr size_t WS_XC = 460 * MiB;
constexpr size_t WS_Y = 468 * MiB;
constexpr size_t WS_END = 512 * MiB;
constexpr int RING_BYTES = 131072, ROPE_OFF = RING_BYTES, LDS_BYTES = 147456;
constexpr int NWAVES = 8;

#define LAS __attribute__((address_space(3)))
#define DI __device__ __forceinline__
typedef unsigned short bf16;
typedef unsigned v4u __attribute__((ext_vector_type(4)));
typedef unsigned v2u __attribute__((ext_vector_type(2)));
typedef float f32x4 __attribute__((ext_vector_type(4)));

DI float bf2f(unsigned b) { return __uint_as_float(b << 16); }
DI float bflo(unsigned w) { return __uint_as_float(w << 16); }
DI float bfhi(unsigned w) { return __uint_as_float(w & 0xffff0000u); }
DI unsigned f2bf(float f) { unsigned u = __float_as_uint(f); return (u + 0x7fffu + ((u >> 16) & 1u)) >> 16; }
DI unsigned pk2(float lo, float hi) { return f2bf(lo) | (f2bf(hi) << 16); }
DI float wave_sum(float v) {
#pragma unroll
    for (int o = 1; o < 64; o <<= 1) v += __shfl_xor(v, o);
    return v;
}
DI float silu(float x) { return x / (1.0f + __expf(-x)); }

struct Args { const float* in[24]; float* out; unsigned char* ws; };
typedef const __attribute__((address_space(4))) Args* KArgs;
DI KArgs kargs() { KArgs p = (KArgs)__builtin_amdgcn_kernarg_segment_ptr(); asm volatile("" : "+s"(p)); return p; }

struct Frame {
    LAS unsigned char* lds;
    int tid, lane, wave, G, gw, ngw;
};
DI Frame mkframe() { Frame F; extern __shared__ __attribute__((aligned(16))) unsigned char lds_base[]; F.lds = (LAS unsigned char*)lds_base;
    int t = threadIdx.x; asm volatile("" : "+v"(t)); F.tid = t; F.lane = t & 63; F.wave = __builtin_amdgcn_readfirstlane(t >> 6);
    F.G = gridDim.x; F.gw = blockIdx.x * NWAVES + F.wave; F.ngw = F.G * NWAVES; return F; }
DI bf16* wbuf(KArgs KA, int l, size_t off) { return (bf16*)((KA->ws) + WS_W + (size_t)l * WS_WL + off); }

DI void transpose_item(const float* W, int ldw, int k0, int n0, bf16* WT, int ldt, int drow0, LAS float* scr, int lane) {
#pragma unroll 8
    for (int i = 0; i < 32; ++i) { const int kk = 2 * i + (lane >> 5); scr[kk * 33 + (lane & 31)] = W[(size_t)(k0 + kk) * ldw + n0 + (lane & 31)]; }
    asm volatile("s_waitcnt lgkmcnt(0)" ::: "memory");
    const int c = lane & 7;
#pragma unroll
    for (int j = 0; j < 4; ++j) { const int n = (lane >> 3) + 8 * j; const LAS float* s = scr + (8 * c) * 33 + n;
        v4u o; o.x = pk2(s[0 * 33], s[1 * 33]); o.y = pk2(s[2 * 33], s[3 * 33]); o.z = pk2(s[4 * 33], s[5 * 33]); o.w = pk2(s[6 * 33], s[7 * 33]);
        *(v4u*)(WT + (size_t)(drow0 + n) * ldt + k0 + 8 * c) = o; }
    asm volatile("s_waitcnt lgkmcnt(0)" ::: "memory");
}
DI void p0a() {
    KArgs KA = kargs(); Frame F = mkframe();
    {
        LAS float* sv = (LAS float*)F.lds;
        for (int it = blockIdx.x; it < NL * 16 * 9; it += F.G) {
            const int l = it / 144, kc = (it % 144) / 9, cb = it % 9;
            __syncthreads();
            for (int i = F.tid; i < 576; i += 512) { const int r = i >> 6, kk = i & 63; const float v = r < 8 ? KA->in[1][r * DM + kc * 64 + kk] : KA->in[3][kc * 64 + kk]; sv[i] = silu(v); }
            __syncthreads();
            const int cg4 = F.tid & 255, kh = F.tid >> 8, col = cb * 1024 + 4 * cg4;
            f32x4 acc[9];
#pragma unroll
            for (int r = 0; r < 9; ++r) acc[r] = (f32x4){0.f, 0.f, 0.f, 0.f};
            const float* wp = KA->in[4] + ((size_t)l * DM + kc * 64 + kh * 32) * NMODW + col;
#pragma unroll 4
            for (int kk = 0; kk < 32; ++kk) { const f32x4 w = *(const f32x4*)(wp + (size_t)kk * NMODW);
#pragma unroll
                for (int r = 0; r < 9; ++r) acc[r] += w * sv[r * 64 + kh * 32 + kk]; }
#pragma unroll
            for (int r = 0; r < 9; ++r) *(f32x4*)(((float*)(KA->ws + WS_ACT)) + ((size_t)(l * 32 + kc * 2 + kh) * 9 + r) * NMODW + col) = acc[r];
        }
        __syncthreads();
    }
    LAS float* scr = (LAS float*)(F.lds + F.wave * 16384);
    constexpr int I1 = 16 * 176, I2 = 44 * 32, I3 = 16 * 88, I4 = 16 * 32, IL = 2 * I1 + 2 * I2 + I3 + I4;
    for (int it = F.gw; it < NL * IL; it += F.ngw) {
        const int l = it / IL; int r = it % IL;
        if (r < I1 || (r >= I1 + I2 + I3 + I4 && r < 2 * I1 + I2 + I3 + I4)) {
            const bool second = r >= I1; if (second) r -= I1 + I2 + I3 + I4;
            const int kb = r / 176, nb = r % 176, n0 = nb * 32;
            const int drow = n0 < DFF ? 256 * (n0 >> 7) + (n0 & 127) : 256 * ((n0 - DFF) >> 7) + 128 + ((n0 - DFF) & 127);
            transpose_item((second ? KA->in[22] : KA->in[8]) + (size_t)l * DM * 2 * DFF, 2 * DFF, kb * 64, n0, wbuf(KA, l, second ? WO_W1B : WO_W1A), DM, drow, scr, F.lane);
            continue; }
        r -= I1;
        if (r < I2) { const int kb = r / 32, nb = r % 32; transpose_item(KA->in[9] + (size_t)l * DFF * DM, DM, kb * 64, nb * 32, wbuf(KA, l, WO_W2A), DFF, nb * 32, scr, F.lane); continue; }
        r -= I2;
        if (r < I3) { const int kb = r / 88, nb = r % 88; const int n0 = nb < 48 ? nb * 32 : 1544 + (nb - 48) * 32;
            transpose_item(KA->in[10] + (size_t)l * DM * INW, INW, kb * 64, n0, wbuf(KA, l, WO_WIN), DM, nb * 32, scr, F.lane); continue; }
        r -= I3;
        if (r < I4) { const int kb = r / 32, nb = r % 32; transpose_item(KA->in[11] + (size_t)l * DM * DM, DM, kb * 64, nb * 32, wbuf(KA, l, WO_WOUT), DM, nb * 32, scr, F.lane); continue; }
        r -= I4 + I1;
        { const int kb = r / 32, nb = r % 32; transpose_item(KA->in[23] + (size_t)l * DFF * DM, DM, kb * 64, nb * 32, wbuf(KA, l, WO_W2B), DFF, nb * 32, scr, F.lane); }
    }
}
DI void p0b() {
    KArgs KA = kargs(); Frame F = mkframe();
    for (int i = blockIdx.x * 512 + F.tid; i < NL * 9 * NMODW; i += F.G * 512) {
        const int l = i / (9 * NMODW), rr = (i / NMODW) % 9, n = i % NMODW;
        float s = KA->in[5][l * NMODW + n];
        for (int p = 0; p < 32; ++p) s += ((float*)(KA->ws + WS_ACT))[((size_t)(l * 32 + p) * 9 + rr) * NMODW + n];
        ((float*)(KA->ws + WS_MOD))[i] = s;
    }
}
DI const float* modp(KArgs KA, int l, int mb, int idx) { return ((float*)(KA->ws + WS_MOD)) + ((size_t)(l * 9 + mb) * 9 + idx) * DM; }
DI void p0c() {
    KArgs KA = kargs(); Frame F = mkframe();
    for (int row = F.gw; row < NROW; row += F.ngw) {
        const int mb = row < NLAT ? (row >> 12) : 8;
        const float* src = row < NLAT ? KA->in[0] + (size_t)row * DM : KA->in[2] + (size_t)(row - NLAT) * DM;
        float* dst = row < NLAT ? (KA->out) + (size_t)row * DM : ((float*)(KA->ws + WS_XC)) + (size_t)(row - NLAT) * DM;
        const float* sh = modp(KA, 0, mb, 0); const float* sc = modp(KA, 0, mb, 1);
#pragma unroll
        for (int j = 0; j < 4; ++j) { const int n = 4 * F.lane + 256 * j; const f32x4 v = *(const f32x4*)(src + n); *(f32x4*)(dst + n) = v;
            const f32x4 a = v * (1.0f + *(const f32x4*)(sc + n)) + *(const f32x4*)(sh + n);
            v2u w; w.x = pk2(a.x, a.y); w.y = pk2(a.z, a.w); *(v2u*)(((bf16*)(KA->ws + WS_A)) + (size_t)row * DM + n) = w; }
    }
}
template <bool DTP>
DI void ln_pass(int l, int gidx, float gmul, int lnidx, int nl, int nsh, int nrows) {
    KArgs KA = kargs(); Frame F = mkframe();
    LAS float* wdt = (LAS float*)F.lds;
    if (DTP) { __syncthreads(); for (int i = F.tid; i < 8192; i += 512) wdt[i] = KA->in[10][((size_t)l * DM + (i >> 3)) * INW + C_DTSRC + (i & 7)]; __syncthreads(); }
    const float* g = KA->in[6] + (l * 3 + lnidx) * DM; const float* bb = KA->in[7] + (l * 3 + lnidx) * DM;
    for (int row = F.gw; row < nrows; row += F.ngw) {
        const int mb = row < NLAT ? (row >> 12) : 8;
        float* xrow = row < NLAT ? (KA->out) + (size_t)row * DM : ((float*)(KA->ws + WS_XC)) + (size_t)(row - NLAT) * DM;
        const bf16* frow = ((bf16*)(KA->ws + WS_O)) + (size_t)row * DM;
        const float* gate = modp(KA, l, mb, gidx);
        f32x4 v[4]; float s = 0.f;
#pragma unroll
        for (int j = 0; j < 4; ++j) { const int n = 4 * F.lane + 256 * j; const f32x4 xv = *(const f32x4*)(xrow + n); const v2u fw = *(const v2u*)(frow + n); const f32x4 gt = *(const f32x4*)(gate + n);
            const f32x4 fv = (f32x4){bflo(fw.x), bfhi(fw.x), bflo(fw.y), bfhi(fw.y)};
            v[j] = xv * ALPHA + gt * fv * gmul; s += (v[j].x + v[j].y) + (v[j].z + v[j].w); }
        const float mean = wave_sum(s) * (1.f / DM); float s2 = 0.f;
#pragma unroll
        for (int j = 0; j < 4; ++j) { v[j] = v[j] - mean; s2 += (v[j].x * v[j].x + v[j].y * v[j].y) + (v[j].z * v[j].z + v[j].w * v[j].w); }
        const float rstd = 1.f / sqrtf(wave_sum(s2) * (1.f / DM) + LN_EPS);
        float dt[8];
#pragma unroll
        for (int q = 0; q < 8; ++q) dt[q] = 0.f;
#pragma unroll
        for (int j = 0; j < 4; ++j) { const int n = 4 * F.lane + 256 * j;
            const f32x4 y = v[j] * rstd * *(const f32x4*)(g + n) + *(const f32x4*)(bb + n);
            *(f32x4*)(xrow + n) = y;
            if (nsh >= 0) { const f32x4 a = y * (1.0f + *(const f32x4*)(modp(KA, nl, mb, nsh + 1) + n)) + *(const f32x4*)(modp(KA, nl, mb, nsh) + n);
                v2u w; w.x = pk2(a.x, a.y); w.y = pk2(a.z, a.w); *(v2u*)(((bf16*)(KA->ws + WS_A)) + (size_t)row * DM + n) = w;
                if (DTP) {
#pragma unroll
                    for (int e = 0; e < 4; ++e) { const f32x4 w0 = *(const LAS f32x4*)(wdt + (n + e) * 8), w1 = *(const LAS f32x4*)(wdt + (n + e) * 8 + 4); const float ae = a[e];
                        dt[0] += ae * w0.x; dt[1] += ae * w0.y; dt[2] += ae * w0.z; dt[3] += ae * w0.w; dt[4] += ae * w1.x; dt[5] += ae * w1.y; dt[6] += ae * w1.z; dt[7] += ae * w1.w; } } }
        }
        if (DTP) {
#pragma unroll
            for (int q = 0; q < 8; ++q) dt[q] = wave_sum(dt[q]);
            if (F.lane == 0) { *(f32x4*)(((float*)(KA->ws + WS_DT)) + (size_t)row * 8) = (f32x4){dt[0], dt[1], dt[2], dt[3]}; *(f32x4*)(((float*)(KA->ws + WS_DT)) + (size_t)row * 8 + 4) = (f32x4){dt[4], dt[5], dt[6], dt[7]}; }
        }
    }
}
DI void prep_pass(int l) {
    KArgs KA = kargs(); Frame F = mkframe();
    const LAS float* rc = (const LAS float*)(F.lds + ROPE_OFF); const LAS float* rs = rc + 1024;
    bf16* P = ((bf16*)(KA->ws + WS_ACT));
    const int hf = F.lane >> 5, li = F.lane & 31, ra = li >> 4, ri = li & 15, d1 = ra * 32 + ri, d2 = d1 + 16;
    for (int row = F.gw; row < NROW; row += F.ngw) {
        const bool lat = row < NLAT; const int t = row & 4095;
        const int pos = ra == 0 ? (t >> 6) : (t & 63);
        const float cs = rc[pos * 16 + ri], sn = rs[pos * 16 + ri];
        bf16* pr = P + (size_t)row * NPJ;
#pragma unroll
        for (int it = 0; it < 6; ++it) {
            const int hh = 2 * it + hf;
            const bool isc = hh >= 6; const int h6 = isc ? hh - 6 : hh;
            const int col = (isc ? (h6 < 4 ? C_CQ + h6 * 64 : C_CK + (h6 - 4) * 64) : (h6 < 4 ? C_AQ + h6 * 64 : C_AK + (h6 - 4) * 64));
            float x1 = bf2f(pr[col + d1]), x2 = bf2f(pr[col + d2]);
            float ss = x1 * x1 + x2 * x2;
#pragma unroll
            for (int o = 1; o < 32; o <<= 1) ss += __shfl_xor(ss, o);
            if (isc) { const float r = 1.f / sqrtf(ss * (1.f / 64.f) + LN_EPS); const float* gn = (h6 < 4 ? KA->in[19] : KA->in[20]) + l * 64; x1 = x1 * r * gn[d1]; x2 = x2 * r * gn[d2]; }
            if (lat) { const float y1 = x1 * cs - x2 * sn, y2 = x1 * sn + x2 * cs; x1 = y1; x2 = y2; }
            if (isc || lat) { pr[col + d1] = (bf16)f2bf(x1); pr[col + d2] = (bf16)f2bf(x2); }
        }
        const int Ls = lat ? SEQ : CTXL; const int tt = lat ? t : (row - NLAT) & 255;
#pragma unroll
        for (int j = 0; j < 3; ++j) { const int ch = 4 * F.lane + 256 * j;
            f32x4 acc = *(const f32x4*)(KA->in[15] + l * 768 + ch);
#pragma unroll
            for (int k = 0; k < 5; ++k) { const int t2 = tt + k - 2;
                if (t2 >= 0 && t2 < Ls) { const v2u w = *(const v2u*)(P + (size_t)(row + k - 2) * NPJ + C_BX + ch); const f32x4 cw = *(const f32x4*)(KA->in[14] + (l * 5 + k) * 768 + ch);
                    acc += cw * (f32x4){bflo(w.x), bfhi(w.x), bflo(w.y), bfhi(w.y)}; } }
            v2u o; o.x = pk2(silu(acc.x), silu(acc.y)); o.y = pk2(silu(acc.z), silu(acc.w)); *(v2u*)(((bf16*)(KA->ws + WS_U)) + (size_t)row * 768 + ch) = o; }
        if (F.lane < 8) { const float v = ((float*)(KA->ws + WS_DT))[(size_t)row * 8 + F.lane] + KA->in[16][l * 8 + F.lane]; ((float*)(KA->ws + WS_DT))[(size_t)row * 8 + F.lane] = fmaxf(v, 0.f) + log1pf(__expf(-fabsf(v))); }
    }
}
DI void nkey(const float (&q)[64], float (&o)[64], float& m, float& l, const bf16* kr, const bf16* vr, float bias) {
    float s = bias;
#pragma unroll
    for (int c = 0; c < 8; ++c) { const v4u w = *(const v4u*)(kr + 8 * c);
        s += q[8 * c] * bflo(w.x) + q[8 * c + 1] * bfhi(w.x) + q[8 * c + 2] * bflo(w.y) + q[8 * c + 3] * bfhi(w.y) + q[8 * c + 4] * bflo(w.z) + q[8 * c + 5] * bfhi(w.z) + q[8 * c + 6] * bflo(w.w) + q[8 * c + 7] * bfhi(w.w); }
    const float mn = fmaxf(m, s), cf = __expf(m - mn), p = __expf(s - mn);
    l = l * cf + p; m = mn;
#pragma unroll
    for (int c = 0; c < 8; ++c) { const v4u w = *(const v4u*)(vr + 8 * c);
        o[8 * c] = o[8 * c] * cf + p * bflo(w.x); o[8 * c + 1] = o[8 * c + 1] * cf + p * bfhi(w.x); o[8 * c + 2] = o[8 * c + 2] * cf + p * bflo(w.y); o[8 * c + 3] = o[8 * c + 3] * cf + p * bfhi(w.y);
        o[8 * c + 4] = o[8 * c + 4] * cf + p * bflo(w.z); o[8 * c + 5] = o[8 * c + 5] * cf + p * bfhi(w.z); o[8 * c + 6] = o[8 * c + 6] * cf + p * bflo(w.w); o[8 * c + 7] = o[8 * c + 7] * cf + p * bfhi(w.w); }
}
template <int TYPE>
DI void naive_attn(int l, int row, int h, bool ctxq) {
    KArgs KA = kargs(); Frame F = mkframe();
    const bf16* P = ((bf16*)(KA->ws + WS_ACT));
    const int qcol = (TYPE == 0 ? C_AQ : TYPE == 1 ? C_CQ : C_DQ) + h * 64;
    const int kvh = TYPE == 2 ? h : (h >> 1);
    const int kcol = (TYPE == 0 ? C_AK : TYPE == 1 ? C_CK : C_DK) + kvh * 64, vcol = (TYPE == 0 ? C_AV : TYPE == 1 ? C_CV : C_DV) + kvh * 64;
    float q[64], o[64]; float m = -1e30f, ls = 0.f;
#pragma unroll
    for (int c = 0; c < 8; ++c) { const v4u w = *(const v4u*)(P + (size_t)row * NPJ + qcol + 8 * c);
        q[8 * c] = 0.125f * bflo(w.x); q[8 * c + 1] = 0.125f * bfhi(w.x); q[8 * c + 2] = 0.125f * bflo(w.y); q[8 * c + 3] = 0.125f * bfhi(w.y);
        q[8 * c + 4] = 0.125f * bflo(w.z); q[8 * c + 5] = 0.125f * bfhi(w.z); q[8 * c + 6] = 0.125f * bflo(w.w); q[8 * c + 7] = 0.125f * bfhi(w.w); }
#pragma unroll
    for (int d = 0; d < 64; ++d) o[d] = 0.f;
    int b;
    if (!ctxq) {
        b = row >> 12; const int t = row & 4095;
        if (TYPE == 0) { const int k0 = max(t - 128, 0), k1 = min(t + 128, SEQ - 1);
            for (int k = k0; k <= k1; ++k) { const bf16* kp = P + (size_t)(b * SEQ + k) * NPJ; nkey(q, o, m, ls, kp + kcol, kp + vcol, 0.f); } }
        else if (TYPE == 1) { for (int k = 0; k < SEQ; ++k) { const bf16* kp = P + (size_t)(b * SEQ + k) * NPJ; nkey(q, o, m, ls, kp + kcol, kp + vcol, 0.f); } }
        else { const int r = t >> 6, c = t & 63; const int rs = min(max(r - 4, 0), 56), cs = min(max(c - 8, 0), 48);
            for (int a = 0; a < 8; ++a) { const float* bp = KA->in[21] + ((size_t)(l * 4 + h) * 15 + (rs + a - r + 7)) * 31 + (cs - c + 15);
                for (int k = 0; k < 16; ++k) { const bf16* kp = P + (size_t)(b * SEQ + (rs + a) * 64 + cs + k) * NPJ; nkey(q, o, m, ls, kp + kcol, kp + vcol, bp[k]); } } }
    } else b = (row - NLAT) >> 8;
    for (int k = 0; k < CTXL; ++k) { const bf16* kp = P + (size_t)(NLAT + b * CTXL + k) * NPJ; nkey(q, o, m, ls, kp + kcol, kp + vcol, 0.f); }
    if (TYPE == 0) { const float sk = KA->in[13][l * 4 + h]; const float mn = fmaxf(m, sk), cf = __expf(m - mn); ls = ls * cf + __expf(sk - mn);
#pragma unroll
        for (int d = 0; d < 64; ++d) o[d] *= cf; }
    const float inv = 1.f / ls;
    bf16* op = ((bf16*)(KA->ws + WS_O)) + (size_t)row * DM + (TYPE == 0 ? 0 : TYPE == 1 ? 512 : 768) + h * 64;
#pragma unroll
    for (int c = 0; c < 8; ++c) { v4u w; w.x = pk2(o[8 * c] * inv, o[8 * c + 1] * inv); w.y = pk2(o[8 * c + 2] * inv, o[8 * c + 3] * inv); w.z = pk2(o[8 * c + 4] * inv, o[8 * c + 5] * inv); w.w = pk2(o[8 * c + 6] * inv, o[8 * c + 7] * inv);
        *(v4u*)(op + 8 * c) = w; }
}
DI void naive_ssd(int l, int item) {
    KArgs KA = kargs(); Frame F = mkframe();
    const int b = item >> 3, dir = (item >> 2) & 1, h = item & 3, g = h >> 1;
    const int p = F.tid >> 3, ng = F.tid & 7;
    const float A = -__expf(KA->in[17][l * 8 + dir * 4 + h]);
    bf16* Y = dir ? (((bf16*)(KA->ws + WS_Y) + (size_t)NROW * 256)) : ((bf16*)(KA->ws + WS_Y));
    float hs[16];
#pragma unroll
    for (int i = 0; i < 16; ++i) hs[i] = 0.f;
    for (int ph = 0; ph < 2; ++ph) {
        const int ns = ph ? SEQ : CTXL, base = ph ? b * SEQ : NLAT + b * CTXL;
#pragma unroll 4
        for (int s = 0; s < ns; ++s) {
            const int row = base + (dir ? ns - 1 - s : s);
            const float dt = ((float*)(KA->ws + WS_DT))[(size_t)row * 8 + dir * 4 + h];
            const bf16* ur = ((bf16*)(KA->ws + WS_U)) + (size_t)row * 768;
            const float xv = bf2f(ur[h * 64 + p]);
            const v4u b0 = *(const v4u*)(ur + 256 + g * 128 + ng * 16), b1 = *(const v4u*)(ur + 256 + g * 128 + ng * 16 + 8);
            const v4u c0 = *(const v4u*)(ur + 512 + g * 128 + ng * 16), c1 = *(const v4u*)(ur + 512 + g * 128 + ng * 16 + 8);
            const float dA = __expf(dt * A), dx = dt * xv;
            const unsigned bw[8] = {b0.x, b0.y, b0.z, b0.w, b1.x, b1.y, b1.z, b1.w}, cw[8] = {c0.x, c0.y, c0.z, c0.w, c1.x, c1.y, c1.z, c1.w};
            float y = 0.f;
#pragma unroll
            for (int i = 0; i < 8; ++i) { hs[2 * i] = hs[2 * i] * dA + dx * bflo(bw[i]); hs[2 * i + 1] = hs[2 * i + 1] * dA + dx * bfhi(bw[i]); y += bflo(cw[i]) * hs[2 * i] + bfhi(cw[i]) * hs[2 * i + 1]; }
            y += __shfl_xor(y, 1); y += __shfl_xor(y, 2); y += __shfl_xor(y, 4);
            if (ng == 0) Y[(size_t)row * 256 + h * 64 + p] = (bf16)f2bf(y);
        }
    }
}
DI void mixers_naive(int l, bool last) {
    Frame F = mkframe();
    const int nAttL = 64 * 12, nAttC = last ? 0 : 4 * 12, nItems = 64 + nAttL + nAttC;
    for (int it = blockIdx.x; it < nItems; it += F.G) {
        if (it < 64) { naive_ssd(l, it); continue; }
        int r = it - 64; bool cq = false; int rowbase;
        if (r >= nAttL) { r -= nAttL; cq = true; }
        const int rb = r / 12, ty = (r % 12) >> 2, h = r & 3;
        rowbase = cq ? NLAT + rb * 512 : rb * 512;
        const int row = rowbase + F.tid;
        if (ty == 0) naive_attn<0>(l, row, h, cq); else if (ty == 1) naive_attn<1>(l, row, h, cq); else naive_attn<2>(l, row, h, cq);
    }
}
typedef float f32x16 __attribute__((ext_vector_type(16)));
typedef short s16x4 __attribute__((ext_vector_type(4)));
typedef short bf16x8v __attribute__((ext_vector_type(8)));
typedef short v4i16_t __attribute__((ext_vector_type(4)));
typedef float f32x2_t __attribute__((ext_vector_type(2))); typedef __bf16 bf16x2_t __attribute__((ext_vector_type(2)));
DI unsigned cvtpk(float lo, float hi) { f32x2_t v = {lo, hi}; bf16x2_t b = __builtin_convertvector(v, bf16x2_t); return __builtin_bit_cast(unsigned, b); }
DI s16x4 vtr(const LAS unsigned char* p) { return __builtin_bit_cast(s16x4, __builtin_amdgcn_ds_read_tr16_b64_v4i16((LAS v4i16_t*)p)); }
DI int crow16(int i, int h) { return (i & 3) + 8 * (i >> 2) + 4 * h; }
constexpr int AT_KRS = 144, AT_VRS = 192, AT_KB = 64 * AT_KRS, AT_BUF = AT_KB + 64 * AT_VRS, AT_RPB = 2 * AT_BUF;
constexpr float LOG2E = 1.4426950408889634f, AT_SC = 0.125f * LOG2E;
template <int TYPE>
DI void attn_unit(KArgs KA, const Frame& F, int l, int unit, bool ctxq) {
    const bf16* P = (const bf16*)(KA->ws + WS_ACT);
    const int L = F.lane, w = F.wave, r = L & 31, h2 = L >> 5, i16 = L & 15;
    int b, head, kvh, p0, qpos0, t0 = 0, nloc = 0;
    if (TYPE != 2) { int g, pb; if (!ctxq) { b = unit >> 6; g = (unit >> 5) & 1; pb = unit & 31; } else { b = unit >> 2; g = (unit >> 1) & 1; pb = unit & 1; }
        head = 2 * g + (w >> 2); kvh = g; p0 = pb * 128; qpos0 = p0 + 32 * (w & 3);
        if (!ctxq) { if (TYPE == 1) { t0 = 0; nloc = 64; } else { t0 = max(0, 2 * (pb - 1)); nloc = min(64, 2 * (pb + 2)) - t0; } } }
    else { int rb; if (!ctxq) { b = unit >> 6; head = (unit >> 4) & 3; rb = unit & 15; } else { b = unit >> 2; head = unit & 3; rb = 0; }
        kvh = head; p0 = rb * 256; qpos0 = p0 + 32 * w;
        if (!ctxq) { const int r0 = rb * 4; t0 = min(max(r0 - 4, 0), 56); nloc = min(max(r0 - 1, 0), 56) + 8 - t0; } }
    const int qcol = (TYPE == 0 ? C_AQ : TYPE == 1 ? C_CQ : C_DQ) + head * 64;
    const int kcol = (TYPE == 0 ? C_AK : TYPE == 1 ? C_CK : C_DK) + kvh * 64, vcol = (TYPE == 0 ? C_AV : TYPE == 1 ? C_CV : C_DV) + kvh * 64;
    const int qrow = (ctxq ? NLAT + b * CTXL : b * SEQ) + qpos0 + r;
    const int nt = nloc + 4;
    bf16x8v qf[4];
#pragma unroll
    for (int ks = 0; ks < 4; ++ks) qf[ks] = *(const bf16x8v*)(P + (size_t)qrow * NPJ + qcol + ks * 16 + 8 * h2);
    LAS unsigned char* lb = F.lds;
    if (TYPE == 2) { LAS float* rp = (LAS float*)(lb + AT_RPB); for (int i = F.tid; i < 465; i += 512) rp[i] = KA->in[21][(size_t)(l * 4 + head) * 465 + i] * LOG2E; }
    const int srow = F.tid >> 3, sch = F.tid & 7;
#define TILE_ROW0(i) ((i) < nloc ? b * SEQ + (t0 + (i)) * 64 : NLAT + b * CTXL + ((i) - nloc) * 64)
    v4u kreg, vreg;
    { const bf16* src = P + (size_t)(TILE_ROW0(0) + srow) * NPJ; kreg = *(const v4u*)(src + kcol + sch * 8); vreg = *(const v4u*)(src + vcol + sch * 8); }
    *(LAS v4u*)(lb + srow * AT_KRS + sch * 16) = kreg; *(LAS v4u*)(lb + AT_KB + srow * AT_VRS + sch * 16) = vreg;
    __syncthreads();
    f32x16 oacc[2];
#pragma unroll
    for (int i = 0; i < 16; ++i) { oacc[0][i] = 0.f; oacc[1][i] = 0.f; }
    float m = -1e30f, lsum = 0.f;
    const int qpos = qpos0 + r;
    const int gr = qpos0 >> 6, rs = min(max(gr - 4, 0), 56), qc = qpos & 63, cs = min(max(qc - 8, 0), 48);
    for (int i = 0; i < nt; ++i) {
        const LAS unsigned char* kb_ = lb + (i & 1) * AT_BUF; const LAS unsigned char* vb_ = kb_ + AT_KB;
        if (i + 1 < nt) { const bf16* src = P + (size_t)(TILE_ROW0(i + 1) + srow) * NPJ; kreg = *(const v4u*)(src + kcol + sch * 8); vreg = *(const v4u*)(src + vcol + sch * 8); }
        const bool loc = i < nloc;
        bool skip = false;
        const int k0 = (t0 + i) * 64;
        if (loc && TYPE == 0) skip = (k0 + 63 < qpos0 - 128) || (k0 > qpos0 + 31 + 128);
        if (loc && TYPE == 2) skip = (t0 + i < rs) || (t0 + i >= rs + 8);
        if (!skip) {
            f32x16 sacc[2];
#pragma unroll
            for (int kb = 0; kb < 2; ++kb) {
#pragma unroll
                for (int q = 0; q < 16; ++q) sacc[kb][q] = 0.f;
#pragma unroll
                for (int ks = 0; ks < 4; ++ks) { const bf16x8v kf = *(const LAS bf16x8v*)(kb_ + (kb * 32 + r) * AT_KRS + ks * 32 + 16 * h2);
                    sacc[kb] = __builtin_amdgcn_mfma_f32_32x32x16_bf16(kf, qf[ks], sacc[kb], 0, 0, 0); }
            }
            float tmax = -INFINITY;
#pragma unroll
            for (int kb = 0; kb < 2; ++kb)
#pragma unroll
                for (int q = 0; q < 16; ++q) { float s = sacc[kb][q] * AT_SC; const int kk = kb * 32 + crow16(q, h2);
                    if (TYPE == 0 && loc) { const int d = k0 + kk - qpos; if (d > 128 || d < -128) s = -INFINITY; }
                    if (TYPE == 2 && loc) { const int dc = kk - cs; const LAS float* rp = (const LAS float*)(lb + AT_RPB);
                        if (dc < 0 || dc >= 16) s = -INFINITY; else s += rp[(t0 + i - gr + 7) * 31 + (kk - qc + 15)]; }
                    sacc[kb][q] = s; tmax = fmaxf(tmax, s); }
            tmax = fmaxf(tmax, __shfl_xor(tmax, 32));
            const float mn = fmaxf(m, tmax), alpha = __builtin_amdgcn_exp2f(m - mn); m = mn;
            float psum = 0.f;
#pragma unroll
            for (int kb = 0; kb < 2; ++kb)
#pragma unroll
                for (int q = 0; q < 16; ++q) { const float p = __builtin_amdgcn_exp2f(sacc[kb][q] - mn); sacc[kb][q] = p; psum += p; }
            lsum = lsum * alpha + psum;
#pragma unroll
            for (int q = 0; q < 16; ++q) { oacc[0][q] *= alpha; oacc[1][q] *= alpha; }
#pragma unroll
            for (int kb = 0; kb < 2; ++kb)
#pragma unroll
                for (int s = 0; s < 2; ++s) {
                    v4u pw; pw.x = cvtpk(sacc[kb][8 * s], sacc[kb][8 * s + 1]); pw.y = cvtpk(sacc[kb][8 * s + 2], sacc[kb][8 * s + 3]); pw.z = cvtpk(sacc[kb][8 * s + 4], sacc[kb][8 * s + 5]); pw.w = cvtpk(sacc[kb][8 * s + 6], sacc[kb][8 * s + 7]);
                    const bf16x8v pf = __builtin_bit_cast(bf16x8v, pw);
#pragma unroll
                    for (int db = 0; db < 2; ++db) {
                        const LAS unsigned char* va = vb_ + (kb * 32 + 16 * s + 4 * h2 + (i16 >> 2)) * AT_VRS + (db * 32 + 16 * ((L >> 4) & 1) + 4 * (i16 & 3)) * 2;
                        const s16x4 lo = vtr(va), hi = vtr(va + 8 * AT_VRS);
                        const bf16x8v vf = (bf16x8v){lo[0], lo[1], lo[2], lo[3], hi[0], hi[1], hi[2], hi[3]};
                        oacc[db] = __builtin_amdgcn_mfma_f32_32x32x16_bf16(vf, pf, oacc[db], 0, 0, 0); }
                }
        }
        if (i + 1 < nt) { LAS unsigned char* nb = lb + ((i + 1) & 1) * AT_BUF; *(LAS v4u*)(nb + srow * AT_KRS + sch * 16) = kreg; *(LAS v4u*)(nb + AT_KB + srow * AT_VRS + sch * 16) = vreg; }
        __syncthreads();
    }
    lsum += __shfl_xor(lsum, 32);
    if (TYPE == 0) lsum += __builtin_amdgcn_exp2f(KA->in[13][l * 4 + head] * LOG2E - m);
    const float inv = 1.f / lsum;
    bf16* op = (bf16*)(KA->ws + WS_O) + (size_t)qrow * DM + (TYPE == 0 ? 0 : TYPE == 1 ? 512 : 768) + head * 64;
#pragma unroll
    for (int db = 0; db < 2; ++db)
#pragma unroll
        for (int q4 = 0; q4 < 4; ++q4) { v2u o; o.x = cvtpk(oacc[db][4 * q4] * inv, oacc[db][4 * q4 + 1] * inv); o.y = cvtpk(oacc[db][4 * q4 + 2] * inv, oacc[db][4 * q4 + 3] * inv);
            *(v2u*)(op + db * 32 + 8 * q4 + 4 * h2) = o; }
}
constexpr size_t WS_ST = WS_A;
constexpr size_t WS_DEC = 3 * MiB;
constexpr int SS_B = 0, SS_BRS = 272, SS_X = 34816, SS_XRS = 192, SS_X2 = 59392, SS_HF = 83968, SS_HB = 101376, SS_ARR = 118784;
DI int slot_row(int b, int slot) { return slot < 2 ? NLAT + b * CTXL + slot * 128 : b * SEQ + (slot - 2) * 128; }
DI void ssd_stage_dt(KArgs KA, const Frame& F, int l, int h, int rowbase, LAS float* arr) {
    const float* DTB = (const float*)(KA->ws + WS_DT);
    if (F.tid < 128) { const float df = DTB[(size_t)(rowbase + F.tid) * 8 + h], db = DTB[(size_t)(rowbase + F.tid) * 8 + 4 + h];
        const float Af = -__expf(KA->in[17][l * 8 + h]) * LOG2E, Ab = -__expf(KA->in[17][l * 8 + 4 + h]) * LOG2E;
        arr[F.tid] = df * Af; arr[128 + F.tid] = db * Ab; arr[256 + F.tid] = df; arr[384 + F.tid] = db; }
    __syncthreads();
    if (F.wave < 2) { const int L = F.lane; const bool rev = F.wave == 1;
        const float v0 = rev ? arr[128 + 127 - 2 * L] : arr[2 * L], v1 = rev ? arr[128 + 126 - 2 * L] : arr[2 * L + 1];
        float t = v0 + v1;
#pragma unroll
        for (int o = 1; o < 64; o <<= 1) { const float u = __shfl_up(t, o); if (L >= o) t += u; }
        if (rev) { arr[640 + 127 - 2 * L] = t - v1; arr[640 + 126 - 2 * L] = t; } else { arr[512 + 2 * L] = t - v1; arr[512 + 2 * L + 1] = t; } }
    __syncthreads();
}
DI void ssd_stage_B(KArgs KA, const Frame& F, int g, int rowbase) {
    const bf16* U = (const bf16*)(KA->ws + WS_U);
    const int row = F.tid >> 2, pc = F.tid & 3; const bf16* src = U + (size_t)(rowbase + row) * 768 + 256 + g * 128 + pc * 32;
#pragma unroll
    for (int k = 0; k < 4; ++k) *(LAS v4u*)(F.lds + SS_B + row * SS_BRS + pc * 64 + k * 16) = *(const v4u*)(src + k * 8);
}
DI v4u scale8(v4u w, float s) { v4u o; o.x = cvtpk(bflo(w.x) * s, bfhi(w.x) * s); o.y = cvtpk(bflo(w.y) * s, bfhi(w.y) * s); o.z = cvtpk(bflo(w.z) * s, bfhi(w.z) * s); o.w = cvtpk(bflo(w.w) * s, bfhi(w.w) * s); return o; }
DI void ssd_states(KArgs KA, const Frame& F, int l, int item) {
    const int slot = item % 34, bh = item / 34, b = bh >> 2, h = bh & 3, g = h >> 1, rowbase = slot_row(b, slot);
    const int L = F.lane, w = F.wave, r = L & 31, h2 = L >> 5, i16 = L & 15, grp = (L >> 4) & 1;
    LAS float* arr = (LAS float*)(F.lds + SS_ARR);
    ssd_stage_dt(KA, F, l, h, rowbase, arr);
    ssd_stage_B(KA, F, g, rowbase);
    { const bf16* U = (const bf16*)(KA->ws + WS_U); const int row = F.tid >> 2, pc = F.tid & 3; const bf16* src = U + (size_t)(rowbase + row) * 768 + h * 64 + pc * 16;
      const v4u x0 = *(const v4u*)src, x1 = *(const v4u*)(src + 8);
      const float wf = __builtin_amdgcn_exp2f(arr[512 + 127] - arr[512 + row]) * arr[256 + row], wb = __builtin_amdgcn_exp2f(arr[640] - arr[640 + row]) * arr[384 + row];
      *(LAS v4u*)(F.lds + SS_X + row * SS_XRS + pc * 32) = scale8(x0, wf); *(LAS v4u*)(F.lds + SS_X + row * SS_XRS + pc * 32 + 16) = scale8(x1, wf);
      *(LAS v4u*)(F.lds + SS_X2 + row * SS_XRS + pc * 32) = scale8(x0, wb); *(LAS v4u*)(F.lds + SS_X2 + row * SS_XRS + pc * 32 + 16) = scale8(x1, wb); }
    __syncthreads();
    const int pblk = w >> 2, nblk = w & 3;
    float* ST = (float*)(KA->ws + WS_ST); float* DEC = (float*)(KA->ws + WS_DEC);
#pragma unroll
    for (int dir = 0; dir < 2; ++dir) {
        f32x16 acc;
#pragma unroll
        for (int q = 0; q < 16; ++q) acc[q] = 0.f;
        const LAS unsigned char* xb = F.lds + (dir ? SS_X2 : SS_X);
#pragma unroll
        for (int ks = 0; ks < 8; ++ks) {
            const LAS unsigned char* xa = xb + (ks * 16 + 8 * h2 + (i16 >> 2)) * SS_XRS + (pblk * 32 + 16 * grp + 4 * (i16 & 3)) * 2;
            const s16x4 xlo = vtr(xa), xhi = vtr(xa + 4 * SS_XRS);
            const LAS unsigned char* ba = F.lds + SS_B + (ks * 16 + 8 * h2 + (i16 >> 2)) * SS_BRS + (nblk * 32 + 16 * grp + 4 * (i16 & 3)) * 2;
            const s16x4 blo = vtr(ba), bhi_ = vtr(ba + 4 * SS_BRS);
            const bf16x8v xf = (bf16x8v){xlo[0], xlo[1], xlo[2], xlo[3], xhi[0], xhi[1], xhi[2], xhi[3]}, bfr = (bf16x8v){blo[0], blo[1], blo[2], blo[3], bhi_[0], bhi_[1], bhi_[2], bhi_[3]};
            acc = __builtin_amdgcn_mfma_f32_32x32x16_bf16(xf, bfr, acc, 0, 0, 0); }
        float* dst = ST + ((size_t)((bh * 2 + dir) * 34 + slot)) * 8192;
#pragma unroll
        for (int q = 0; q < 16; ++q) dst[(pblk * 32 + crow16(q, h2)) * 128 + nblk * 32 + r] = acc[q];
        if (F.tid == 0) DEC[(bh * 2 + dir) * 34 + slot] = __builtin_amdgcn_exp2f(dir ? arr[640] : arr[512 + 127]);
    }
    __syncthreads();
}
DI void ssd_scan() {
    KArgs KA = kargs(); Frame F = mkframe();
    float* ST = (float*)(KA->ws + WS_ST); const float* DEC = (const float*)(KA->ws + WS_DEC);
    for (int gt = blockIdx.x * 512 + F.tid; gt < 64 * 2048; gt += F.G * 512) {
        const int chain = gt >> 11, e4 = gt & 2047, dir = chain & 1;
        float* base = ST + (size_t)chain * 34 * 8192 + e4 * 4;
        f32x4 hc = (f32x4){0.f, 0.f, 0.f, 0.f};
#pragma unroll 2
        for (int k = 0; k < 34; ++k) { const int slot = dir == 0 ? k : (k < 2 ? 1 - k : 35 - k);
            f32x4* p = (f32x4*)(base + (size_t)slot * 8192); const f32x4 t = *p; *p = hc; hc = hc * DEC[chain * 34 + slot] + t; }
    }
}
DI void ssd_outputs(KArgs KA, const Frame& F, int l, int item) {
    const int slot = item % 34, bh = item / 34, b = bh >> 2, h = bh & 3, g = h >> 1, rowbase = slot_row(b, slot);
    const int L = F.lane, w = F.wave, r = L & 31, h2 = L >> 5, i16 = L & 15, grp = (L >> 4) & 1;
    LAS float* arr = (LAS float*)(F.lds + SS_ARR);
    const bf16* U = (const bf16*)(KA->ws + WS_U);
    const int ib = w & 3, pb = w >> 2, ipos = ib * 32 + r;
    bf16x8v cfq[8];
#pragma unroll
    for (int ks = 0; ks < 8; ++ks) cfq[ks] = *(const bf16x8v*)(U + (size_t)(rowbase + ipos) * 768 + 512 + g * 128 + ks * 16 + 8 * h2);
    ssd_stage_dt(KA, F, l, h, rowbase, arr);
    ssd_stage_B(KA, F, g, rowbase);
    { const int row = F.tid >> 2, pc = F.tid & 3; const bf16* src = U + (size_t)(rowbase + row) * 768 + h * 64 + pc * 16;
      *(LAS v4u*)(F.lds + SS_X + row * SS_XRS + pc * 32) = *(const v4u*)src; *(LAS v4u*)(F.lds + SS_X + row * SS_XRS + pc * 32 + 16) = *(const v4u*)(src + 8); }
    { const float* ST = (const float*)(KA->ws + WS_ST); const int p = F.tid >> 3, pc = F.tid & 7;
#pragma unroll
      for (int dir = 0; dir < 2; ++dir) { const float* s = ST + ((size_t)((bh * 2 + dir) * 34 + slot)) * 8192 + p * 128 + pc * 16;
          const f32x4 a0 = *(const f32x4*)s, a1 = *(const f32x4*)(s + 4), a2 = *(const f32x4*)(s + 8), a3 = *(const f32x4*)(s + 12);
          v4u o0, o1; o0.x = cvtpk(a0.x, a0.y); o0.y = cvtpk(a0.z, a0.w); o0.z = cvtpk(a1.x, a1.y); o0.w = cvtpk(a1.z, a1.w); o1.x = cvtpk(a2.x, a2.y); o1.y = cvtpk(a2.z, a2.w); o1.z = cvtpk(a3.x, a3.y); o1.w = cvtpk(a3.z, a3.w);
          LAS unsigned char* d = F.lds + (dir ? SS_HB : SS_HF) + p * SS_BRS + pc * 32; *(LAS v4u*)d = o0; *(LAS v4u*)(d + 16) = o1; } }
    __syncthreads();
    const float cfi = arr[512 + ipos], cbi = arr[640 + ipos];
    f32x16 yacc;
#pragma unroll
    for (int q = 0; q < 16; ++q) yacc[q] = 0.f;
#pragma unroll
    for (int jb = 0; jb < 4; ++jb) {
        f32x16 acc;
#pragma unroll
        for (int q = 0; q < 16; ++q) acc[q] = 0.f;
#pragma unroll
        for (int ks = 0; ks < 8; ++ks) { const bf16x8v bfr = *(const LAS bf16x8v*)(F.lds + SS_B + (jb * 32 + r) * SS_BRS + ks * 32 + 16 * h2);
            acc = __builtin_amdgcn_mfma_f32_32x32x16_bf16(bfr, cfq[ks], acc, 0, 0, 0); }
#pragma unroll
        for (int q = 0; q < 16; ++q) { const int j = jb * 32 + crow16(q, h2);
            float wt = 0.f;
            if (j <= ipos) wt += __builtin_amdgcn_exp2f(cfi - arr[512 + j]) * arr[256 + j];
            if (j >= ipos) wt += __builtin_amdgcn_exp2f(cbi - arr[640 + j]) * arr[384 + j];
            acc[q] *= wt; }
#pragma unroll
        for (int s = 0; s < 2; ++s) {
            v4u pw; pw.x = cvtpk(acc[8 * s], acc[8 * s + 1]); pw.y = cvtpk(acc[8 * s + 2], acc[8 * s + 3]); pw.z = cvtpk(acc[8 * s + 4], acc[8 * s + 5]); pw.w = cvtpk(acc[8 * s + 6], acc[8 * s + 7]);
            const bf16x8v pf = __builtin_bit_cast(bf16x8v, pw);
            const LAS unsigned char* xa = F.lds + SS_X + (jb * 32 + 16 * s + 4 * h2 + (i16 >> 2)) * SS_XRS + (pb * 32 + 16 * grp + 4 * (i16 & 3)) * 2;
            const s16x4 lo = vtr(xa), hi = vtr(xa + 8 * SS_XRS);
            const bf16x8v xf = (bf16x8v){lo[0], lo[1], lo[2], lo[3], hi[0], hi[1], hi[2], hi[3]};
            yacc = __builtin_amdgcn_mfma_f32_32x32x16_bf16(xf, pf, yacc, 0, 0, 0); }
    }
#pragma unroll
    for (int dir = 0; dir < 2; ++dir) {
        f32x16 tacc;
#pragma unroll
        for (int q = 0; q < 16; ++q) tacc[q] = 0.f;
#pragma unroll
        for (int ks = 0; ks < 8; ++ks) { const bf16x8v hfr = *(const LAS bf16x8v*)(F.lds + (dir ? SS_HB : SS_HF) + (pb * 32 + r) * SS_BRS + ks * 32 + 16 * h2);
            tacc = __builtin_amdgcn_mfma_f32_32x32x16_bf16(hfr, cfq[ks], tacc, 0, 0, 0); }
        const float sc = __builtin_amdgcn_exp2f(dir ? cbi : cfi);
#pragma unroll
        for (int q = 0; q < 16; ++q) yacc[q] += sc * tacc[q];
    }
    bf16* yp = (bf16*)(KA->ws + WS_Y) + (size_t)(rowbase + ipos) * 256 + h * 64 + pb * 32;
#pragma unroll
    for (int q4 = 0; q4 < 4; ++q4) { v2u o; o.x = cvtpk(yacc[4 * q4], yacc[4 * q4 + 1]); o.y = cvtpk(yacc[4 * q4 + 2], yacc[4 * q4 + 3]); *(v2u*)(yp + 8 * q4 + 4 * h2) = o; }
    __syncthreads();
}
DI void ssd_outputs_phase(int l, bool last) {
    KArgs KA = kargs(); Frame F = mkframe();
    for (int it = blockIdx.x; it < 32 * 34; it += F.G) { if (last && (it % 34) < 2) continue; ssd_outputs(KA, F, l, it); }
}
DI void mixers_flash(int l, bool last) {
    KArgs KA = kargs(); Frame F = mkframe();
    const int nS = 32 * 34, nL = 1536, nC = last ? 0 : 96, nItems = nS + nL + nC;
    for (int it = blockIdx.x; it < nItems; it += F.G) {
        if (it < nS) { ssd_states(KA, F, l, it); continue; }
        int u = it - nS; bool cq = false;
        if (u >= nL) { u -= nL; cq = true; }
        const int ty = u % 3, un = u / 3;
        if (ty == 0) attn_unit<1>(KA, F, l, un, cq); else if (ty == 1) attn_unit<0>(KA, F, l, un, cq); else attn_unit<2>(KA, F, l, un, cq);
    }
}
DI void merge_pass(int l, int nrows) {
    KArgs KA = kargs(); Frame F = mkframe();
    const bf16* P = ((bf16*)(KA->ws + WS_ACT));
    const int hh = F.lane >> 4;
    const float dsk = KA->in[18][l * 4 + hh];
    for (int row = F.gw; row < nrows; row += F.ngw) {
        f32x4 v[4];
#pragma unroll
        for (int j = 0; j < 4; ++j) { const int n = 4 * F.lane + 256 * j;
            if (j == 1) { const int cn = 4 * F.lane; const v2u yfw = *(const v2u*)(((bf16*)(KA->ws + WS_Y)) + (size_t)row * 256 + cn);
                const f32x4 yf = (f32x4){bflo(yfw.x), bfhi(yfw.x), bflo(yfw.y), bfhi(yfw.y)};
                const v2u xw = *(const v2u*)(((bf16*)(KA->ws + WS_U)) + (size_t)row * 768 + cn), zw = *(const v2u*)(P + (size_t)row * NPJ + C_BZ + cn);
                const f32x4 xs = (f32x4){bflo(xw.x), bfhi(xw.x), bflo(xw.y), bfhi(xw.y)}, z = (f32x4){bflo(zw.x), bfhi(zw.x), bflo(zw.y), bfhi(zw.y)};
                const f32x4 y = yf + xs * dsk;
                v[j] = (f32x4){y.x * silu(z.x), y.y * silu(z.y), y.z * silu(z.z), y.w * silu(z.w)}; }
            else { const v2u w = *(const v2u*)(((bf16*)(KA->ws + WS_O)) + (size_t)row * DM + n); v[j] = (f32x4){bflo(w.x), bfhi(w.x), bflo(w.y), bfhi(w.y)}; } }
#pragma unroll
        for (int j = 0; j < 4; ++j) { const int n = 4 * F.lane + 256 * j;
            const float ss = wave_sum((v[j].x * v[j].x + v[j].y * v[j].y) + (v[j].z * v[j].z + v[j].w * v[j].w));
            const float r = 1.f / sqrtf(ss * (1.f / 256.f) + LN_EPS);
            const f32x4 a = v[j] * r * *(const f32x4*)(KA->in[12] + l * DM + n);
            v2u w; w.x = pk2(a.x, a.y); w.y = pk2(a.z, a.w); *(v2u*)(((bf16*)(KA->ws + WS_A)) + (size_t)row * DM + n) = w; }
    }
}
__global__ void __launch_bounds__(NWAVES * 64, 2) mega_fwd(Args args) {
    extern __shared__ __attribute__((aligned(16))) unsigned char lds[];
    cg::grid_group grid = cg::this_grid();
    { LAS float* rc = (LAS float*)((LAS unsigned char*)lds + ROPE_OFF);
      for (int i = threadIdx.x; i < 1024; i += 512) { const int pos = i >> 4, fi = i & 15; const float inv = exp2f(-(float)fi * (13.287712379549449f / 16.f)); const float ang = (float)pos * inv; rc[i] = cosf(ang); rc[1024 + i] = sinf(ang); } }
    __syncthreads();

    p0a(); grid.sync();
    p0b(); grid.sync();
    p0c(); grid.sync();
    for (int l = 0; l < NL; ++l) {
        const bool last = (l == NL - 1); const int mrows = last ? NLAT : NROW;
        { KArgs KA = kargs(); pg8::Gemm g{((bf16*)(KA->ws + WS_A)), wbuf(KA, l, WO_W1A), NROW, 2 * DFF, DM}; pg8::StaticOrder S; S.init(NROW, 2 * DFF, (int)gridDim.x, (int)blockIdx.x); pg8::EpiSwiGLU E{((bf16*)(KA->ws + WS_ACT)), DFF};
          pg8::gemm_phase<pg8::EpiSwiGLU, pg8::StaticOrder, true, false>((LAS unsigned char*)lds, g, S, E); }
        grid.sync();
        { KArgs KA = kargs(); pg8::Gemm g{((bf16*)(KA->ws + WS_ACT)), wbuf(KA, l, WO_W2A), NROW, DM, DFF}; pg8::StaticOrder S; S.init(NROW, DM, (int)gridDim.x, (int)blockIdx.x); pg8::EpiBf16 E{((bf16*)(KA->ws + WS_O)), DM};
          pg8::gemm_phase<pg8::EpiBf16, pg8::StaticOrder, true, false>((LAS unsigned char*)lds, g, S, E); }
        grid.sync();
        ln_pass<true>(l, 2, 0.5f, 0, l, 3, NROW); grid.sync();
        { KArgs KA = kargs(); pg8::Gemm g{((bf16*)(KA->ws + WS_A)), wbuf(KA, l, WO_WIN), NROW, NPJ, DM}; pg8::StaticOrder S; S.init(NROW, NPJ, (int)gridDim.x, (int)blockIdx.x); pg8::EpiBf16 E{((bf16*)(KA->ws + WS_ACT)), NPJ};
          pg8::gemm_phase<pg8::EpiBf16, pg8::StaticOrder, true, false>((LAS unsigned char*)lds, g, S, E); }
        grid.sync();
        prep_pass(l); grid.sync();
        mixers_flash(l, last); grid.sync();
        ssd_scan(); grid.sync();
        ssd_outputs_phase(l, last); grid.sync();
        merge_pass(l, mrows); grid.sync();
        { KArgs KA = kargs(); pg8::Gemm g{((bf16*)(KA->ws + WS_A)), wbuf(KA, l, WO_WOUT), mrows, DM, DM}; pg8::StaticOrder S; S.init(mrows, DM, (int)gridDim.x, (int)blockIdx.x); pg8::EpiBf16 E{((bf16*)(KA->ws + WS_O)), DM};
          pg8::gemm_phase<pg8::EpiBf16, pg8::StaticOrder, true, false>((LAS unsigned char*)lds, g, S, E); }
        grid.sync();
        ln_pass<false>(l, 5, 1.0f, 1, l, 6, mrows); grid.sync();
        { KArgs KA = kargs(); pg8::Gemm g{((bf16*)(KA->ws + WS_A)), wbuf(KA, l, WO_W1B), mrows, 2 * DFF, DM}; pg8::StaticOrder S; S.init(mrows, 2 * DFF, (int)gridDim.x, (int)blockIdx.x); pg8::EpiSwiGLU E{((bf16*)(KA->ws + WS_ACT)), DFF};
          pg8::gemm_phase<pg8::EpiSwiGLU, pg8::StaticOrder, true, false>((LAS unsigned char*)lds, g, S, E); }
        grid.sync();
        { KArgs KA = kargs(); pg8::Gemm g{((bf16*)(KA->ws + WS_ACT)), wbuf(KA, l, WO_W2B), mrows, DM, DFF}; pg8::StaticOrder S; S.init(mrows, DM, (int)gridDim.x, (int)blockIdx.x); pg8::EpiBf16 E{((bf16*)(KA->ws + WS_O)), DM};
          pg8::gemm_phase<pg8::EpiBf16, pg8::StaticOrder, true, false>((LAS unsigned char*)lds, g, S, E); }
        grid.sync();
        ln_pass<false>(l, 8, 0.5f, 2, l + 1, last ? -1 : 0, mrows);
        if (!last) grid.sync();
    }
}

extern "C" void kernel_launch(void* const* d_in, const int* in_sizes, int n_in, void* d_out, int out_size, void* d_ws, size_t ws_size, hipStream_t stream) {
    static int grid = 0;
    if (grid == 0) {
        if (n_in != 24 || out_size != NLAT * DM || ws_size < WS_END) { fprintf(stderr, "kernel_launch: unexpected shapes: n_in %d out %d ws %zu\n", n_in, out_size, ws_size); grid = -1; return; }
        int dev = 0, cus = 0, per_cu = 0;
        hipGetDevice(&dev); hipDeviceGetAttribute(&cus, hipDeviceAttributeMultiprocessorCount, dev);
        if (hipFuncSetAttribute((const void*)mega_fwd, hipFuncAttributeMaxDynamicSharedMemorySize, LDS_BYTES) != hipSuccess) { fprintf(stderr, "kernel_launch: hipFuncSetAttribute failed\n"); grid = -1; return; }
        if (hipOccupancyMaxActiveBlocksPerMultiprocessor(&per_cu, (const void*)mega_fwd, NWAVES * 64, LDS_BYTES) != hipSuccess || per_cu < 1) { fprintf(stderr, "kernel_launch: occupancy query says %d\n", per_cu); per_cu = 1; }
        (void)hipGetLastError();
        grid = cus;
    }
    if (grid < 0) return;
    Args a{};
    for (int i = 0; i < 24; ++i) a.in[i] = (const float*)d_in[i];
    a.out = (float*)d_out; a.ws = (unsigned char*)d_ws;
    void* kargs[] = {&a};
    hipError_t e = hipLaunchCooperativeKernel((const void*)mega_fwd, dim3(grid), dim3(NWAVES * 64), kargs, LDS_BYTES, stream);
    if (e != hipSuccess) fprintf(stderr, "kernel_launch: cooperative launch failed: %s (grid %d)\n", hipGetErrorString(e), grid);
}
```

```cpp
#include <hip/hip_runtime.h>
#include <hip/hip_cooperative_groups.h>
#include <cstdio>
#include <cstdint>
namespace cg = cooperative_groups;
namespace pg8 {
#define PG8_LAS __attribute__((address_space(3)))
typedef unsigned short bf16_t;
typedef short bf16x8 __attribute__((ext_vector_type(8)));
typedef float f32x4 __attribute__((ext_vector_type(4)));
typedef unsigned u32x4 __attribute__((ext_vector_type(4)));
constexpr int BM = 256, BK = 64, HALF = 128, HTB = HALF * BK * 2  , STAGE_BYTES = 8 * HTB, NXCD = 8, WGM = 8;

__host__ __device__ __forceinline__ int lds_byte(int r, int c) { const int st = (r >> 4) * 2 + (c >> 5), rr = r & 15, cc = c & 31, ob = rr * 64 + cc * 2; return st * 1024 + (ob ^ (((ob >> 9) & 1) << 5)); }
__host__ __device__ __forceinline__ void stage_rc(int b, int& R, int& C) { const int st = b / 1024, sb = b % 1024, swz = sb ^ (((sb >> 9) & 1) << 5); R = (st >> 1) * 16 + swz / 64; C = (st & 1) * 32 + (swz % 64) / 2; }
__host__ __device__ __forceinline__ int perm32(int rho) { const int n = rho >> 4, i = rho & 15; return 8 * (i >> 2) + 4 * n + (i & 3); }

struct Unit { int pm, pn; };
struct Gemm { const bf16_t* A; const bf16_t* Bt; int M, N, K; };

struct StaticOrder {
    int nM, nN, nwg, G, c;
    __host__ __device__ void init(int M, int N, int G_, int c_) { nM = M / BM; nN = N / BM; nwg = nM * nN; G = G_; c = c_; }
    __host__ __device__ bool next(int i, Unit& u) const {
        const long L = (long)i * G + c; if (L >= nwg) return false;
        int wgid = (int)L; { const int q = nwg / NXCD, r = nwg % NXCD, xcd = wgid % NXCD, off = wgid / NXCD; wgid = (xcd < r ? xcd * (q + 1) : r * (q + 1) + (xcd - r) * q) + off; }
        const int nig = WGM * nN, gid = wgid / nig, fm = gid * WGM, gsz = (nM - fm) < WGM ? (nM - fm) : WGM;
        u.pm = fm + ((wgid % nig) % gsz); u.pn = (wgid % nig) / gsz; return true;
    }
    __device__ __forceinline__ void a_ready(const Unit&) const {}
    __device__ __forceinline__ void done(const Unit&) const {}
};

__device__ __forceinline__ unsigned cvt_pk_bf16(float lo, float hi) { unsigned r; asm volatile("v_cvt_pk_bf16_f32 %0, %1, %2" : "=v"(r) : "v"(lo), "v"(hi)); return r; }
struct EpiBf16 {
    static constexpr bool PERM = true, AFTER_DRAIN = false;
    bf16_t* O; int ldc;
    __device__ __forceinline__ void operator()(const f32x4 (&acc)[2][2][4][2], const Unit& u, int wr, int wc, int fr, int fq) const {
        const int row0 = u.pm * BM + wr * 64 + fr; const int col0 = u.pn * BM + wc * 32 + 8 * fq;
#pragma unroll
        for (int ai = 0; ai < 2; ++ai)
#pragma unroll
            for (int m = 0; m < 4; ++m) { bf16_t* rowp = O + (size_t)(row0 + ai * HALF + m * 16) * ldc + col0;
#pragma unroll
                for (int bj = 0; bj < 2; ++bj) { const f32x4 v0 = acc[ai][bj][m][0], v1 = acc[ai][bj][m][1];
                    u32x4 w; w.x = cvt_pk_bf16(v0[0], v0[1]); w.y = cvt_pk_bf16(v0[2], v0[3]); w.z = cvt_pk_bf16(v1[0], v1[1]); w.w = cvt_pk_bf16(v1[2], v1[3]);
                    *(u32x4*)(rowp + bj * HALF) = w; } }
    }
};
__device__ __forceinline__ float silu_f(float x) { return x * __builtin_amdgcn_rcpf(1.0f + __expf(-x)); }
struct EpiSwiGLU {
    static constexpr bool PERM = true, AFTER_DRAIN = false;
    bf16_t* O; int ldc;
    __device__ __forceinline__ void operator()(const f32x4 (&acc)[2][2][4][2], const Unit& u, int wr, int wc, int fr, int fq) const {
        const int row0 = u.pm * BM + wr * 64 + fr; const int col0 = u.pn * HALF + wc * 32 + 8 * fq;
#pragma unroll
        for (int ai = 0; ai < 2; ++ai)
#pragma unroll
            for (int m = 0; m < 4; ++m) { bf16_t* rowp = O + (size_t)(row0 + ai * HALF + m * 16) * ldc + col0;
                const f32x4 a0 = acc[ai][0][m][0], a1 = acc[ai][0][m][1], u0 = acc[ai][1][m][0], u1 = acc[ai][1][m][1];
                u32x4 w;
                w.x = cvt_pk_bf16(silu_f(a0[0]) * u0[0], silu_f(a0[1]) * u0[1]); w.y = cvt_pk_bf16(silu_f(a0[2]) * u0[2], silu_f(a0[3]) * u0[3]);
                w.z = cvt_pk_bf16(silu_f(a1[0]) * u1[0], silu_f(a1[1]) * u1[1]); w.w = cvt_pk_bf16(silu_f(a1[2]) * u1[2], silu_f(a1[3]) * u1[3]);
                *(u32x4*)rowp = w; }
    }
};
template <class Epi, class Sched, bool ALIGN_EPI = false, bool SP2 = false>
__device__ __forceinline__ void gemm_phase(PG8_LAS unsigned char* lds, const Gemm g, const Sched& S, const Epi& E) {
    int tid_l = threadIdx.x; asm volatile("" : "+v"(tid_l));
    const int tid = tid_l, wid = __builtin_amdgcn_readfirstlane(tid >> 6), lane = tid & 63, wr = wid >> 2, wc = wid & 3, fr = lane & 15, fq = lane >> 4;
    const int K = g.K, nt = K / BK;
    unsigned voffA[2], voffB[2];
#pragma unroll
    for (int i = 0; i < 2; ++i) { int R, C; stage_rc(tid * 16 + i * 8192, R, C); const int Rb = Epi::PERM ? ((R & ~31) + perm32(R & 31)) : R;
        voffA[i] = (unsigned)(R * K + C) * 2u; voffB[i] = (unsigned)(Rb * K + C) * 2u; }
    const size_t kstep = (size_t)(BK * 2);
    const size_t hstep = (size_t)HALF * K * 2;
    const size_t tstep = 2 * hstep;
    const unsigned ldsw = (unsigned)wid * 1024u;
    const int aoff = lds_byte(wr * 64 + fr, fq * 8), boff = lds_byte(wc * 32 + fr, fq * 8);
#define PG8_SA(b, h) (((b) * 2 + (h)) * HTB)
#define PG8_SB(b, h) ((4 + (b) * 2 + (h)) * HTB)
#define PG8_STAGE(bufoff, gbase, voff) do { _Pragma("unroll") for (int _i = 0; _i < 2; ++_i) \
        __builtin_amdgcn_global_load_lds((const unsigned*)((const char*)(gbase) + (voff)[_i]), (PG8_LAS unsigned*)(lds + (bufoff) + ldsw + _i * 8192), 16, 0, 0); } while (0)
#define PG8_LDA(dst, b, h) do { _Pragma("unroll") for (int m = 0; m < 4; ++m) _Pragma("unroll") for (int k = 0; k < 2; ++k) dst[m][k] = *(const PG8_LAS bf16x8*)(lds + PG8_SA(b, h) + aoff + m * 2048 + k * 1024); } while (0)
#define PG8_LDB(dst, b, h) do { _Pragma("unroll") for (int n = 0; n < 2; ++n) _Pragma("unroll") for (int k = 0; k < 2; ++k) dst[n][k] = *(const PG8_LAS bf16x8*)(lds + PG8_SB(b, h) + boff + n * 2048 + k * 1024); } while (0)
#define PG8_MMA(ai, bj, At, Bt) do { __builtin_amdgcn_s_setprio(1); _Pragma("unroll") for (int m = 0; m < 4; ++m) _Pragma("unroll") for (int n = 0; n < 2; ++n) _Pragma("unroll") for (int k = 0; k < 2; ++k) \
        acc[ai][bj][m][n] = __builtin_amdgcn_mfma_f32_16x16x32_bf16(Bt[n][k], At[m][k], acc[ai][bj][m][n], 0, 0, 0); __builtin_amdgcn_s_setprio(0); } while (0)
#define PG8_WAIT_V(n) asm volatile("s_waitcnt vmcnt(" #n ")" ::: "memory")
#define PG8_WAIT_L(n) asm volatile("s_waitcnt lgkmcnt(" #n ")" ::: "memory")
#define PG8_BAR __builtin_amdgcn_s_barrier()
#define PG8_SCHED __builtin_amdgcn_sched_barrier(0)
    Unit cur, nxt; int ui = 0;
    if (!S.next(0, cur)) return;
    f32x4 acc[2][2][4][2];
#pragma unroll
    for (int a = 0; a < 2; ++a)
#pragma unroll
        for (int b = 0; b < 2; ++b)
#pragma unroll
            for (int m = 0; m < 4; ++m)
#pragma unroll
                for (int n = 0; n < 2; ++n) acc[a][b][m][n] = (f32x4){0.f, 0.f, 0.f, 0.f};
    bf16x8 At[4][2], B0[2][2], B1[2][2];
    const char* cA = (const char*)g.A + (size_t)cur.pm * tstep; const char* cB = (const char*)g.Bt + (size_t)cur.pn * tstep;
    S.a_ready(cur);
    if constexpr (SP2) {
        PG8_STAGE(PG8_SB(0, 0), cB, voffB); PG8_STAGE(PG8_SB(0, 1), cB + hstep, voffB); PG8_STAGE(PG8_SA(0, 0), cA, voffA); PG8_STAGE(PG8_SA(0, 1), cA + hstep, voffA);
        if (wr == 1) PG8_BAR;
        PG8_WAIT_V(2); PG8_BAR;
        PG8_STAGE(PG8_SB(1, 0), cB + kstep, voffB); PG8_STAGE(PG8_SA(1, 0), cA + kstep, voffA); PG8_STAGE(PG8_SB(1, 1), cB + hstep + kstep, voffB);
        PG8_WAIT_V(6); PG8_BAR;
    } else {
        PG8_STAGE(PG8_SB(0, 0), cB, voffB); PG8_STAGE(PG8_SA(0, 0), cA, voffA); PG8_STAGE(PG8_SB(0, 1), cB + hstep, voffB); PG8_STAGE(PG8_SA(0, 1), cA + hstep, voffA);
        if (wr == 1) PG8_BAR;
        PG8_WAIT_V(4); PG8_BAR;
        PG8_STAGE(PG8_SB(1, 0), cB + kstep, voffB); PG8_STAGE(PG8_SA(1, 0), cA + kstep, voffA); PG8_STAGE(PG8_SB(1, 1), cB + hstep + kstep, voffB);
        PG8_WAIT_V(6); PG8_BAR;
    }
    for (;;) {
        const bool has_next = S.next(ui + 1, nxt);
        const char* nA = has_next ? (const char*)g.A + (size_t)nxt.pm * tstep : cA; const char* nB = has_next ? (const char*)g.Bt + (size_t)nxt.pn * tstep : cB;
        for (int t = 0; t < nt; t += 2) {
            const bool last = (t == nt - 2);
            const char* a1 = cA + (size_t)(t + 1) * kstep;
            const char* a2 = last ? nA : cA + (size_t)(t + 2) * kstep; const char* b2 = last ? nB : cB + (size_t)(t + 2) * kstep;
            const char* a3 = a2 + kstep; const char* b3 = b2 + kstep;
            if (last && has_next) S.a_ready(nxt);
            if constexpr (SP2) {
            PG8_LDB(B0, 0, 0); PG8_LDB(B1, 0, 1); PG8_SCHED; PG8_LDA(At, 0, 0); PG8_STAGE(PG8_SA(1, 1), a1 + hstep, voffA);
            PG8_WAIT_V(8); PG8_WAIT_L(0); PG8_BAR; PG8_MMA(0, 0, At, B0); PG8_MMA(0, 1, At, B1); PG8_BAR; PG8_SCHED;
            PG8_LDA(At, 0, 1); PG8_STAGE(PG8_SB(0, 0), b2, voffB); PG8_STAGE(PG8_SB(0, 1), b2 + hstep, voffB); PG8_STAGE(PG8_SA(0, 0), a2, voffA);
            PG8_WAIT_V(8); PG8_WAIT_L(0); PG8_BAR; PG8_MMA(1, 0, At, B0); PG8_MMA(1, 1, At, B1); PG8_BAR; PG8_SCHED;
            PG8_LDB(B0, 1, 0); PG8_LDB(B1, 1, 1); PG8_SCHED; PG8_LDA(At, 1, 0); PG8_STAGE(PG8_SA(0, 1), a2 + hstep, voffA);
            PG8_WAIT_V(8); PG8_WAIT_L(0); PG8_BAR; PG8_MMA(0, 0, At, B0); PG8_MMA(0, 1, At, B1); PG8_BAR; PG8_SCHED;
            PG8_LDA(At, 1, 1); PG8_STAGE(PG8_SB(1, 0), b3, voffB); PG8_STAGE(PG8_SB(1, 1), b3 + hstep, voffB); PG8_STAGE(PG8_SA(1, 0), a3, voffA);
            PG8_WAIT_V(8); PG8_WAIT_L(0); PG8_BAR; PG8_MMA(1, 0, At, B0); PG8_MMA(1, 1, At, B1); PG8_BAR; PG8_SCHED;
            } else {
            PG8_LDB(B0, 0, 0); PG8_SCHED; PG8_LDA(At, 0, 0); PG8_STAGE(PG8_SA(1, 1), a1 + hstep, voffA);
            PG8_WAIT_L(8); PG8_BAR; PG8_WAIT_L(0); PG8_MMA(0, 0, At, B0); PG8_BAR; PG8_SCHED;
            PG8_LDB(B1, 0, 1); PG8_STAGE(PG8_SB(0, 0), b2, voffB);
            PG8_BAR; PG8_WAIT_L(0); PG8_MMA(0, 1, At, B1); PG8_BAR;
            PG8_LDA(At, 0, 1); PG8_STAGE(PG8_SA(0, 0), a2, voffA);
            PG8_BAR; PG8_WAIT_L(0); PG8_MMA(1, 0, At, B0); PG8_BAR; PG8_SCHED;
            PG8_STAGE(PG8_SB(0, 1), b2 + hstep, voffB);
            PG8_WAIT_V(6); PG8_BAR; PG8_MMA(1, 1, At, B1); PG8_BAR;
            PG8_LDB(B0, 1, 0); PG8_SCHED; PG8_LDA(At, 1, 0); PG8_STAGE(PG8_SA(0, 1), a2 + hstep, voffA);
            PG8_WAIT_L(8); PG8_BAR; PG8_WAIT_L(0); PG8_MMA(0, 0, At, B0); PG8_BAR; PG8_SCHED;
            PG8_LDB(B1, 1, 1); PG8_STAGE(PG8_SB(1, 0), b3, voffB);
            PG8_BAR; PG8_WAIT_L(0); PG8_MMA(0, 1, At, B1); PG8_BAR;
            PG8_LDA(At, 1, 1); PG8_STAGE(PG8_SA(1, 0), a3, voffA);
            PG8_BAR; PG8_WAIT_L(0); PG8_MMA(1, 0, At, B0); PG8_BAR; PG8_SCHED;
            PG8_STAGE(PG8_SB(1, 1), b3 + hstep, voffB);
            PG8_WAIT_V(6); PG8_BAR; PG8_MMA(1, 1, At, B1); PG8_BAR;
            }
        }
        if constexpr (ALIGN_EPI) { if (wr == 0) PG8_BAR; }
        if constexpr (!Epi::AFTER_DRAIN) { E(acc, cur, wr, wc, fr, fq); S.done(cur); }
        if (!has_next) break;
#pragma unroll
        for (int a = 0; a < 2; ++a)
#pragma unroll
            for (int b = 0; b < 2; ++b)
#pragma unroll
                for (int m = 0; m < 4; ++m)
#pragma unroll
                    for (int n = 0; n < 2; ++n) acc[a][b][m][n] = (f32x4){0.f, 0.f, 0.f, 0.f};
        cur = nxt; cA = nA; cB = nB; ++ui;
        if constexpr (ALIGN_EPI) { if (wr == 1) PG8_BAR; }
    }
    PG8_WAIT_V(0);
    if constexpr (!ALIGN_EPI) { if (wr == 0) PG8_BAR; }
    PG8_BAR;
    if constexpr (Epi::AFTER_DRAIN) { E.fused(acc, cur, wr, wc, fr, fq, lds, wid, lane); S.done(cur); }
#undef PG8_SA
#undef PG8_SB
#undef PG8_STAGE
#undef PG8_LDA
#undef PG8_LDB
#undef PG8_MMA
#undef PG8_WAIT_V
#undef PG8_WAIT_L
#undef PG8_BAR
#undef PG8_SCHED
}
}

constexpr int NB = 8, SEQ = 4096, DM = 1024, NL = 2, CTXL = 256;
constexpr int NLAT = NB * SEQ, NCTX = NB * CTXL, NROW = NLAT + NCTX;
constexpr int DFF = 2816, NPJ = 2816, INW = 2824, NMODW = 9 * DM;
constexpr float LN_EPS = 1e-5f, ALPHA = 1.41421356237f;
constexpr int C_AQ = 0, C_AK = 256, C_AV = 384, C_BZ = 512, C_BX = 768, C_CQ = 1536, C_CK = 1792, C_CV = 1920, C_DQ = 2048, C_DK = 2304, C_DV = 2560;
constexpr int C_DTSRC = 1536;
constexpr size_t MiB = 1u << 20;
constexpr size_t WS_MOD = 0;
constexpr size_t WS_DT = 1 * MiB;
constexpr size_t WS_W = 4 * MiB, WS_WL = 41 * MiB;
constexpr size_t WO_W1A = 0, WO_W2A = 11 * MiB, WO_WIN = 16 * MiB + MiB / 2, WO_WOUT = 22 * MiB, WO_W1B = 24 * MiB, WO_W2B = 35 * MiB;
constexpr size_t WS_A = 86 * MiB;
constexpr size_t WS_ACT = 154 * MiB;
constexpr size_t WS_U = 341 * MiB;
constexpr size_t WS_O = 392 * MiB;
constexpr size_t WS_XC = 460 * MiB;
constexpr size_t WS_Y = 468 * MiB;
constexpr size_t WS_END = 512 * MiB;
constexpr int RING_BYTES = 131072, ROPE_OFF = RING_BYTES, LDS_BYTES = 147456;
constexpr int NWAVES = 8;
constexpr bool GEMM_SP2 = true;

#define LAS __attribute__((address_space(3)))
#define DI __device__ __forceinline__
typedef unsigned short bf16;
typedef unsigned v4u __attribute__((ext_vector_type(4)));
typedef unsigned v2u __attribute__((ext_vector_type(2)));
typedef float f32x4 __attribute__((ext_vector_type(4)));

DI float bf2f(unsigned b) { return __uint_as_float(b << 16); }
DI float bflo(unsigned w) { return __uint_as_float(w << 16); }
DI float bfhi(unsigned w) { return __uint_as_float(w & 0xffff0000u); }
DI unsigned f2bf(float f) { unsigned u = __float_as_uint(f); return (u + 0x7fffu + ((u >> 16) & 1u)) >> 16; }
DI unsigned pk2(float lo, float hi) { return f2bf(lo) | (f2bf(hi) << 16); }
typedef float f32x2_t __attribute__((ext_vector_type(2))); typedef __bf16 bf16x2_t __attribute__((ext_vector_type(2)));
DI unsigned cvtpk(float lo, float hi) { f32x2_t v = {lo, hi}; bf16x2_t b = __builtin_convertvector(v, bf16x2_t); return __builtin_bit_cast(unsigned, b); }
DI float wave_sum(float v) {
#pragma unroll
    for (int o = 1; o < 64; o <<= 1) v += __shfl_xor(v, o);
    return v;
}
DI float silu(float x) { return x / (1.0f + __expf(-x)); }

struct Args { const float* in[24]; float* out; unsigned char* ws; };
typedef const __attribute__((address_space(4))) Args* KArgs;
DI KArgs kargs() { KArgs p = (KArgs)__builtin_amdgcn_kernarg_segment_ptr(); asm volatile("" : "+s"(p)); return p; }

struct Frame {
    LAS unsigned char* lds;
    int tid, lane, wave, G, gw, ngw;
};
DI Frame mkframe() { Frame F; extern __shared__ __attribute__((aligned(16))) unsigned char lds_base[]; F.lds = (LAS unsigned char*)lds_base;
    int t = threadIdx.x; asm volatile("" : "+v"(t)); F.tid = t; F.lane = t & 63; F.wave = __builtin_amdgcn_readfirstlane(t >> 6);
    F.G = gridDim.x; F.gw = blockIdx.x * NWAVES + F.wave; F.ngw = F.G * NWAVES; return F; }
DI bf16* wbuf(KArgs KA, int l, size_t off) { return (bf16*)((KA->ws) + WS_W + (size_t)l * WS_WL + off); }

DI void transpose_item(const float* W, int ldw, int k0, int n0, bf16* WT, int ldt, int drow0, LAS float* scr, int lane) {
    float tv[32];
#pragma unroll
    for (int i = 0; i < 32; ++i) tv[i] = W[(size_t)(k0 + 2 * i + (lane >> 5)) * ldw + n0 + (lane & 31)];
#pragma unroll
    for (int i = 0; i < 32; ++i) scr[(2 * i + (lane >> 5)) * 33 + (lane & 31)] = tv[i];
    asm volatile("s_waitcnt lgkmcnt(0)" ::: "memory");
    const int c = lane & 7;
#pragma unroll
    for (int j = 0; j < 4; ++j) { const int n = (lane >> 3) + 8 * j; const LAS float* s = scr + (8 * c) * 33 + n;
        v4u o; o.x = pk2(s[0 * 33], s[1 * 33]); o.y = pk2(s[2 * 33], s[3 * 33]); o.z = pk2(s[4 * 33], s[5 * 33]); o.w = pk2(s[6 * 33], s[7 * 33]);
        *(v4u*)(WT + (size_t)(drow0 + n) * ldt + k0 + 8 * c) = o; }
    asm volatile("s_waitcnt lgkmcnt(0)" ::: "memory");
}
DI void p0a() {
    KArgs KA = kargs(); Frame F = mkframe();
    {
        LAS float* sv = (LAS float*)F.lds;
        for (int it = blockIdx.x; it < NL * 16 * 9; it += F.G) {
            const int l = it / 144, kc = (it % 144) / 9, cb = it % 9;
            __syncthreads();
            for (int i = F.tid; i < 576; i += 512) { const int r = i >> 6, kk = i & 63; const float v = r < 8 ? KA->in[1][r * DM + kc * 64 + kk] : KA->in[3][kc * 64 + kk]; sv[i] = silu(v); }
            __syncthreads();
            const int cg4 = F.tid & 255, kh = F.tid >> 8, col = cb * 1024 + 4 * cg4;
            f32x4 acc[9];
#pragma unroll
            for (int r = 0; r < 9; ++r) acc[r] = (f32x4){0.f, 0.f, 0.f, 0.f};
            const float* wp = KA->in[4] + ((size_t)l * DM + kc * 64 + kh * 32) * NMODW + col;
#pragma unroll 8
            for (int kk = 0; kk < 32; ++kk) { const f32x4 w = *(const f32x4*)(wp + (size_t)kk * NMODW);
#pragma unroll
                for (int r = 0; r < 9; ++r) acc[r] += w * sv[r * 64 + kh * 32 + kk]; }
#pragma unroll
            for (int r = 0; r < 9; ++r) *(f32x4*)(((float*)(KA->ws + WS_ACT)) + ((size_t)(l * 32 + kc * 2 + kh) * 9 + r) * NMODW + col) = acc[r];
        }
        __syncthreads();
    }
    LAS float* scr = (LAS float*)(F.lds + F.wave * 16384);
    constexpr int I1 = 16 * 176, I2 = 44 * 32, I3 = 16 * 88, I4 = 16 * 32, IL = 2 * I1 + 2 * I2 + I3 + I4;
    for (int it = F.gw; it < NL * IL; it += F.ngw) {
        const int l = it / IL; int r = it % IL;
        if (r < I1 || (r >= I1 + I2 + I3 + I4 && r < 2 * I1 + I2 + I3 + I4)) {
            const bool second = r >= I1; if (second) r -= I1 + I2 + I3 + I4;
            const int kb = r / 176, nb = r % 176, n0 = nb * 32;
            const int drow = n0 < DFF ? 256 * (n0 >> 7) + (n0 & 127) : 256 * ((n0 - DFF) >> 7) + 128 + ((n0 - DFF) & 127);
            transpose_item((second ? KA->in[22] : KA->in[8]) + (size_t)l * DM * 2 * DFF, 2 * DFF, kb * 64, n0, wbuf(KA, l, second ? WO_W1B : WO_W1A), DM, drow, scr, F.lane);
            continue; }
        r -= I1;
        if (r < I2) { const int kb = r / 32, nb = r % 32; transpose_item(KA->in[9] + (size_t)l * DFF * DM, DM, kb * 64, nb * 32, wbuf(KA, l, WO_W2A), DFF, nb * 32, scr, F.lane); continue; }
        r -= I2;
        if (r < I3) { const int kb = r / 88, nb = r % 88; const int n0 = nb < 48 ? nb * 32 : 1544 + (nb - 48) * 32;
            transpose_item(KA->in[10] + (size_t)l * DM * INW, INW, kb * 64, n0, wbuf(KA, l, WO_WIN), DM, nb * 32, scr, F.lane); continue; }
        r -= I3;
        if (r < I4) { const int kb = r / 32, nb = r % 32; transpose_item(KA->in[11] + (size_t)l * DM * DM, DM, kb * 64, nb * 32, wbuf(KA, l, WO_WOUT), DM, nb * 32, scr, F.lane); continue; }
        r -= I4 + I1;
        { const int kb = r / 32, nb = r % 32; transpose_item(KA->in[23] + (size_t)l * DFF * DM, DM, kb * 64, nb * 32, wbuf(KA, l, WO_W2B), DFF, nb * 32, scr, F.lane); }
    }
}
DI void p0b() {
    KArgs KA = kargs(); Frame F = mkframe();
    for (int i = blockIdx.x * 512 + F.tid; i < NL * 9 * NMODW; i += F.G * 512) {
        const int l = i / (9 * NMODW), rr = (i / NMODW) % 9, n = i % NMODW;
        float s = KA->in[5][l * NMODW + n];
        for (int p = 0; p < 32; ++p) s += ((float*)(KA->ws + WS_ACT))[((size_t)(l * 32 + p) * 9 + rr) * NMODW + n];
        ((float*)(KA->ws + WS_MOD))[i] = s;
    }
}
DI const float* modp(KArgs KA, int l, int mb, int idx) { return ((float*)(KA->ws + WS_MOD)) + ((size_t)(l * 9 + mb) * 9 + idx) * DM; }
DI void p0c() {
    KArgs KA = kargs(); Frame F = mkframe();
    for (int row = F.gw; row < NROW; row += F.ngw) {
        const int mb = row < NLAT ? (row >> 12) : 8;
        const float* src = row < NLAT ? KA->in[0] + (size_t)row * DM : KA->in[2] + (size_t)(row - NLAT) * DM;
        const float* sh = modp(KA, 0, mb, 0); const float* sc = modp(KA, 0, mb, 1);
#pragma unroll
        for (int j = 0; j < 4; ++j) { const int n = 4 * F.lane + 256 * j; const f32x4 v = *(const f32x4*)(src + n);
            const f32x4 a = v * (1.0f + *(const f32x4*)(sc + n)) + *(const f32x4*)(sh + n);
            v2u w; w.x = pk2(a.x, a.y); w.y = pk2(a.z, a.w); *(v2u*)(((bf16*)(KA->ws + WS_A)) + (size_t)row * DM + n) = w; }
    }
}
DI void ln_pass(int l, int gidx, float gmul, int lnidx, int nl, int nsh, int row0, int nrows, int wg0, int nwgs, const bool DTP) {
    KArgs KA = kargs(); Frame F = mkframe();
    F.gw = row0 + ((int)blockIdx.x - wg0) * NWAVES + F.wave; F.ngw = nwgs * NWAVES;
    LAS float* wdt = (LAS float*)F.lds;
    if (DTP) { __syncthreads(); for (int i = F.tid; i < 8192; i += 512) wdt[i] = KA->in[10][((size_t)l * DM + (i >> 3)) * INW + C_DTSRC + (i & 7)]; __syncthreads(); }
    const float* g = KA->in[6] + (l * 3 + lnidx) * DM; const float* bb = KA->in[7] + (l * 3 + lnidx) * DM;
    float* const xlat = KA->out; float* const xctx = (float*)(KA->ws + WS_XC); const bf16* const fbase = (const bf16*)(KA->ws + WS_O);
    const bool fromin = (l == 0 && lnidx == 0);
    const float* const slat = fromin ? KA->in[0] : (const float*)xlat; const float* const sctx = fromin ? KA->in[2] : (const float*)xctx;
    f32x4 xn[4]; v2u fn[4];
    if (F.gw < nrows) { const int row = F.gw; const float* xr = row < NLAT ? slat + (size_t)row * DM : sctx + (size_t)(row - NLAT) * DM;
#pragma unroll
        for (int j = 0; j < 4; ++j) { const int n = 4 * F.lane + 256 * j; xn[j] = *(const f32x4*)(xr + n); fn[j] = *(const v2u*)(fbase + (size_t)row * DM + n); } }
    for (int row = F.gw; row < nrows; row += F.ngw) {
        const int mb = row < NLAT ? (row >> 12) : 8;
        float* xrow = row < NLAT ? xlat + (size_t)row * DM : xctx + (size_t)(row - NLAT) * DM;
        const float* gate = modp(KA, l, mb, gidx);
        f32x4 v[4]; float s = 0.f;
#pragma unroll
        for (int j = 0; j < 4; ++j) { const int n = 4 * F.lane + 256 * j; const f32x4 gt = *(const f32x4*)(gate + n);
            const f32x4 fv = (f32x4){bflo(fn[j].x), bfhi(fn[j].x), bflo(fn[j].y), bfhi(fn[j].y)};
            v[j] = xn[j] * ALPHA + gt * fv * gmul; s += (v[j].x + v[j].y) + (v[j].z + v[j].w); }
        { const int nrow = row + F.ngw;
          if (nrow < nrows) { const float* xr = nrow < NLAT ? slat + (size_t)nrow * DM : sctx + (size_t)(nrow - NLAT) * DM;
#pragma unroll
            for (int j = 0; j < 4; ++j) { const int n = 4 * F.lane + 256 * j; xn[j] = *(const f32x4*)(xr + n); fn[j] = *(const v2u*)(fbase + (size_t)nrow * DM + n); } } }
        const float mean = wave_sum(s) * (1.f / DM); float s2 = 0.f;
#pragma unroll
        for (int j = 0; j < 4; ++j) { v[j] = v[j] - mean; s2 += (v[j].x * v[j].x + v[j].y * v[j].y) + (v[j].z * v[j].z + v[j].w * v[j].w); }
        const float rstd = 1.f / sqrtf(wave_sum(s2) * (1.f / DM) + LN_EPS);
        float dt[8];
#pragma unroll
        for (int q = 0; q < 8; ++q) dt[q] = 0.f;
#pragma unroll
        for (int j = 0; j < 4; ++j) { const int n = 4 * F.lane + 256 * j;
            const f32x4 y = v[j] * rstd * *(const f32x4*)(g + n) + *(const f32x4*)(bb + n);
            *(f32x4*)(xrow + n) = y;
            if (nsh >= 0) { const f32x4 a = y * (1.0f + *(const f32x4*)(modp(KA, nl, mb, nsh + 1) + n)) + *(const f32x4*)(modp(KA, nl, mb, nsh) + n);
                v2u w; w.x = cvtpk(a.x, a.y); w.y = cvtpk(a.z, a.w); *(v2u*)(((bf16*)(KA->ws + WS_A)) + (size_t)row * DM + n) = w;
                if (DTP) {
#pragma unroll
                    for (int e = 0; e < 4; ++e) { const f32x4 w0 = *(const LAS f32x4*)(wdt + (n + e) * 8), w1 = *(const LAS f32x4*)(wdt + (n + e) * 8 + 4); const float ae = a[e];
                        dt[0] += ae * w0.x; dt[1] += ae * w0.y; dt[2] += ae * w0.z; dt[3] += ae * w0.w; dt[4] += ae * w1.x; dt[5] += ae * w1.y; dt[6] += ae * w1.z; dt[7] += ae * w1.w; } } }
        }
        if (DTP) {
#pragma unroll
            for (int q = 0; q < 8; ++q) dt[q] = wave_sum(dt[q]);
            if (F.lane == 0) { *(f32x4*)(((float*)(KA->ws + WS_DT)) + (size_t)row * 8) = (f32x4){dt[0], dt[1], dt[2], dt[3]}; *(f32x4*)(((float*)(KA->ws + WS_DT)) + (size_t)row * 8 + 4) = (f32x4){dt[4], dt[5], dt[6], dt[7]}; }
        }
    }
}
DI void prep_pass(int l) {
    KArgs KA = kargs(); Frame F = mkframe();
    const LAS float* rc = (const LAS float*)(F.lds + ROPE_OFF); const LAS float* rsn = rc + 1024;
    bf16* P = (bf16*)(KA->ws + WS_ACT); bf16* U = (bf16*)(KA->ws + WS_U); float* DTB = (float*)(KA->ws + WS_DT);
    const int hv = F.lane >> 5, s = F.lane & 31, hsub = s >> 3, ra = (s >> 2) & 1, ig = s & 3, d1 = ra * 32 + 4 * ig, d2 = d1 + 16;
    constexpr int NBLK = NROW / 8;
    for (int item = F.gw; item < 4 * NBLK; item += F.ngw) {
        const int part = item / NBLK, rb = item - part * NBLK;
        const int row8 = rb * 8; const bool lat = row8 < NLAT;
        if (part == 0) {
#pragma unroll 1
        for (int rr = 0; rr < 4; ++rr) {
            const int row = row8 + 2 * rr + hv; const int t = row & 4095;
            const int pos = ra == 0 ? (t >> 6) : (t & 63);
            const f32x4 cs = *(const LAS f32x4*)(rc + pos * 16 + 4 * ig), sn = *(const LAS f32x4*)(rsn + pos * 16 + 4 * ig);
            bf16* pr = P + (size_t)row * NPJ;
#pragma unroll
            for (int it = 0; it < 3; ++it) {
                const int hh = it * 4 + hsub;
                const bool isc = hh >= 6; const int h6 = isc ? hh - 6 : hh;
                const int col = (isc ? (h6 < 4 ? C_CQ + h6 * 64 : C_CK + (h6 - 4) * 64) : (h6 < 4 ? C_AQ + h6 * 64 : C_AK + (h6 - 4) * 64));
                const v2u w1 = *(const v2u*)(pr + col + d1), w2 = *(const v2u*)(pr + col + d2);
                f32x4 x1 = (f32x4){bflo(w1.x), bfhi(w1.x), bflo(w1.y), bfhi(w1.y)}, x2 = (f32x4){bflo(w2.x), bfhi(w2.x), bflo(w2.y), bfhi(w2.y)};
                float ss = (x1.x * x1.x + x1.y * x1.y) + (x1.z * x1.z + x1.w * x1.w) + (x2.x * x2.x + x2.y * x2.y) + (x2.z * x2.z + x2.w * x2.w);
                ss += __shfl_xor(ss, 1); ss += __shfl_xor(ss, 2); ss += __shfl_xor(ss, 4);
                if (isc) { const float r = 1.f / sqrtf(ss * (1.f / 64.f) + LN_EPS); const float* gn = (h6 < 4 ? KA->in[19] : KA->in[20]) + l * 64;
                    x1 = x1 * r * *(const f32x4*)(gn + d1); x2 = x2 * r * *(const f32x4*)(gn + d2); }
                if (lat) { const f32x4 y1 = x1 * cs - x2 * sn, y2 = x1 * sn + x2 * cs; x1 = y1; x2 = y2; }
                if (isc || lat) { v2u o1, o2; o1.x = cvtpk(x1.x, x1.y); o1.y = cvtpk(x1.z, x1.w); o2.x = cvtpk(x2.x, x2.y); o2.y = cvtpk(x2.z, x2.w);
                    *(v2u*)(pr + col + d1) = o1; *(v2u*)(pr + col + d2) = o2; }
            }
        }
        { const int row = row8 + (F.lane >> 3), q = F.lane & 7; const float v = DTB[(size_t)row * 8 + q] + KA->in[16][l * 8 + q]; DTB[(size_t)row * 8 + q] = fmaxf(v, 0.f) + log1pf(__expf(-fabsf(v))); }
        } else {
        const int Ls = lat ? SEQ : CTXL; const int tt0 = lat ? (row8 & 4095) : ((row8 - NLAT) & 255);
        { const int j = part - 1; const int ch = 4 * F.lane + 256 * j;
            const f32x4 bias = *(const f32x4*)(KA->in[15] + l * 768 + ch);
            f32x4 cw[5];
#pragma unroll
            for (int k = 0; k < 5; ++k) cw[k] = *(const f32x4*)(KA->in[14] + (l * 5 + k) * 768 + ch);
            f32x4 xw[12];
#pragma unroll
            for (int q = 0; q < 12; ++q) { const int t2 = tt0 + q - 2;
                if (t2 >= 0 && t2 < Ls) { const v2u w = *(const v2u*)(P + (size_t)(row8 + q - 2) * NPJ + C_BX + ch); xw[q] = (f32x4){bflo(w.x), bfhi(w.x), bflo(w.y), bfhi(w.y)}; }
                else xw[q] = (f32x4){0.f, 0.f, 0.f, 0.f}; }
#pragma unroll
            for (int q = 0; q < 8; ++q) { f32x4 acc = bias;
#pragma unroll
                for (int k = 0; k < 5; ++k) acc += cw[k] * xw[q + k];
                v2u o; o.x = cvtpk(silu(acc.x), silu(acc.y)); o.y = cvtpk(silu(acc.z), silu(acc.w)); *(v2u*)(U + (size_t)(row8 + q) * 768 + ch) = o; }
        }
        }
    }
}
DI void nkey(const float (&q)[64], float (&o)[64], float& m, float& l, const bf16* kr, const bf16* vr, float bias) {
    float s = bias;
#pragma unroll
    for (int c = 0; c < 8; ++c) { const v4u w = *(const v4u*)(kr + 8 * c);
        s += q[8 * c] * bflo(w.x) + q[8 * c + 1] * bfhi(w.x) + q[8 * c + 2] * bflo(w.y) + q[8 * c + 3] * bfhi(w.y) + q[8 * c + 4] * bflo(w.z) + q[8 * c + 5] * bfhi(w.z) + q[8 * c + 6] * bflo(w.w) + q[8 * c + 7] * bfhi(w.w); }
    const float mn = fmaxf(m, s), cf = __expf(m - mn), p = __expf(s - mn);
    l = l * cf + p; m = mn;
#pragma unroll
    for (int c = 0; c < 8; ++c) { const v4u w = *(const v4u*)(vr + 8 * c);
        o[8 * c] = o[8 * c] * cf + p * bflo(w.x); o[8 * c + 1] = o[8 * c + 1] * cf + p * bfhi(w.x); o[8 * c + 2] = o[8 * c + 2] * cf + p * bflo(w.y); o[8 * c + 3] = o[8 * c + 3] * cf + p * bfhi(w.y);
        o[8 * c + 4] = o[8 * c + 4] * cf + p * bflo(w.z); o[8 * c + 5] = o[8 * c + 5] * cf + p * bfhi(w.z); o[8 * c + 6] = o[8 * c + 6] * cf + p * bflo(w.w); o[8 * c + 7] = o[8 * c + 7] * cf + p * bfhi(w.w); }
}
template <int TYPE>
DI void naive_attn(int l, int row, int h, bool ctxq) {
    KArgs KA = kargs(); Frame F = mkframe();
    const bf16* P = ((bf16*)(KA->ws + WS_ACT));
    const int qcol = (TYPE == 0 ? C_AQ : TYPE == 1 ? C_CQ : C_DQ) + h * 64;
    const int kvh = TYPE == 2 ? h : (h >> 1);
    const int kcol = (TYPE == 0 ? C_AK : TYPE == 1 ? C_CK : C_DK) + kvh * 64, vcol = (TYPE == 0 ? C_AV : TYPE == 1 ? C_CV : C_DV) + kvh * 64;
    float q[64], o[64]; float m = -1e30f, ls = 0.f;
#pragma unroll
    for (int c = 0; c < 8; ++c) { const v4u w = *(const v4u*)(P + (size_t)row * NPJ + qcol + 8 * c);
        q[8 * c] = 0.125f * bflo(w.x); q[8 * c + 1] = 0.125f * bfhi(w.x); q[8 * c + 2] = 0.125f * bflo(w.y); q[8 * c + 3] = 0.125f * bfhi(w.y);
        q[8 * c + 4] = 0.125f * bflo(w.z); q[8 * c + 5] = 0.125f * bfhi(w.z); q[8 * c + 6] = 0.125f * bflo(w.w); q[8 * c + 7] = 0.125f * bfhi(w.w); }
#pragma unroll
    for (int d = 0; d < 64; ++d) o[d] = 0.f;
    int b;
    if (!ctxq) {
        b = row >> 12; const int t = row & 4095;
        if (TYPE == 0) { const int k0 = max(t - 128, 0), k1 = min(t + 128, SEQ - 1);
            for (int k = k0; k <= k1; ++k) { const bf16* kp = P + (size_t)(b * SEQ + k) * NPJ; nkey(q, o, m, ls, kp + kcol, kp + vcol, 0.f); } }
        else if (TYPE == 1) { for (int k = 0; k < SEQ; ++k) { const bf16* kp = P + (size_t)(b * SEQ + k) * NPJ; nkey(q, o, m, ls, kp + kcol, kp + vcol, 0.f); } }
        else { const int r = t >> 6, c = t & 63; const int rs = min(max(r - 4, 0), 56), cs = min(max(c - 8, 0), 48);
            for (int a = 0; a < 8; ++a) { const float* bp = KA->in[21] + ((size_t)(l * 4 + h) * 15 + (rs + a - r + 7)) * 31 + (cs - c + 15);
                for (int k = 0; k < 16; ++k) { const bf16* kp = P + (size_t)(b * SEQ + (rs + a) * 64 + cs + k) * NPJ; nkey(q, o, m, ls, kp + kcol, kp + vcol, bp[k]); } } }
    } else b = (row - NLAT) >> 8;
    for (int k = 0; k < CTXL; ++k) { const bf16* kp = P + (size_t)(NLAT + b * CTXL + k) * NPJ; nkey(q, o, m, ls, kp + kcol, kp + vcol, 0.f); }
    if (TYPE == 0) { const float sk = KA->in[13][l * 4 + h]; const float mn = fmaxf(m, sk), cf = __expf(m - mn); ls = ls * cf + __expf(sk - mn);
#pragma unroll
        for (int d = 0; d < 64; ++d) o[d] *= cf; }
    const float inv = 1.f / ls;
    bf16* op = ((bf16*)(KA->ws + WS_O)) + (size_t)row * DM + (TYPE == 0 ? 0 : TYPE == 1 ? 512 : 768) + h * 64;
#pragma unroll
    for (int c = 0; c < 8; ++c) { v4u w; w.x = pk2(o[8 * c] * inv, o[8 * c + 1] * inv); w.y = pk2(o[8 * c + 2] * inv, o[8 * c + 3] * inv); w.z = pk2(o[8 * c + 4] * inv, o[8 * c + 5] * inv); w.w = pk2(o[8 * c + 6] * inv, o[8 * c + 7] * inv);
        *(v4u*)(op + 8 * c) = w; }
}
DI void naive_ssd(int l, int item) {
    KArgs KA = kargs(); Frame F = mkframe();
    const int b = item >> 3, dir = (item >> 2) & 1, h = item & 3, g = h >> 1;
    const int p = F.tid >> 3, ng = F.tid & 7;
    const float A = -__expf(KA->in[17][l * 8 + dir * 4 + h]);
    bf16* Y = dir ? (((bf16*)(KA->ws + WS_Y) + (size_t)NROW * 256)) : ((bf16*)(KA->ws + WS_Y));
    float hs[16];
#pragma unroll
    for (int i = 0; i < 16; ++i) hs[i] = 0.f;
    for (int ph = 0; ph < 2; ++ph) {
        const int ns = ph ? SEQ : CTXL, base = ph ? b * SEQ : NLAT + b * CTXL;
#pragma unroll 4
        for (int s = 0; s < ns; ++s) {
            const int row = base + (dir ? ns - 1 - s : s);
            const float dt = ((float*)(KA->ws + WS_DT))[(size_t)row * 8 + dir * 4 + h];
            const bf16* ur = ((bf16*)(KA->ws + WS_U)) + (size_t)row * 768;
            const float xv = bf2f(ur[h * 64 + p]);
            const v4u b0 = *(const v4u*)(ur + 256 + g * 128 + ng * 16), b1 = *(const v4u*)(ur + 256 + g * 128 + ng * 16 + 8);
            const v4u c0 = *(const v4u*)(ur + 512 + g * 128 + ng * 16), c1 = *(const v4u*)(ur + 512 + g * 128 + ng * 16 + 8);
            const float dA = __expf(dt * A), dx = dt * xv;
            const unsigned bw[8] = {b0.x, b0.y, b0.z, b0.w, b1.x, b1.y, b1.z, b1.w}, cw[8] = {c0.x, c0.y, c0.z, c0.w, c1.x, c1.y, c1.z, c1.w};
            float y = 0.f;
#pragma unroll
            for (int i = 0; i < 8; ++i) { hs[2 * i] = hs[2 * i] * dA + dx * bflo(bw[i]); hs[2 * i + 1] = hs[2 * i + 1] * dA + dx * bfhi(bw[i]); y += bflo(cw[i]) * hs[2 * i] + bfhi(cw[i]) * hs[2 * i + 1]; }
            y += __shfl_xor(y, 1); y += __shfl_xor(y, 2); y += __shfl_xor(y, 4);
            if (ng == 0) Y[(size_t)row * 256 + h * 64 + p] = (bf16)f2bf(y);
        }
    }
}
DI void mixers_naive(int l, bool last) {
    Frame F = mkframe();
    const int nAttL = 64 * 12, nAttC = last ? 0 : 4 * 12, nItems = 64 + nAttL + nAttC;
    for (int it = blockIdx.x; it < nItems; it += F.G) {
        if (it < 64) { naive_ssd(l, it); continue; }
        int r = it - 64; bool cq = false; int rowbase;
        if (r >= nAttL) { r -= nAttL; cq = true; }
        const int rb = r / 12, ty = (r % 12) >> 2, h = r & 3;
        rowbase = cq ? NLAT + rb * 512 : rb * 512;
        const int row = rowbase + F.tid;
        if (ty == 0) naive_attn<0>(l, row, h, cq); else if (ty == 1) naive_attn<1>(l, row, h, cq); else naive_attn<2>(l, row, h, cq);
    }
}
typedef float f32x16 __attribute__((ext_vector_type(16)));
typedef short s16x4 __attribute__((ext_vector_type(4)));
typedef short bf16x8v __attribute__((ext_vector_type(8)));
typedef short v4i16_t __attribute__((ext_vector_type(4)));
DI s16x4 vtr(const LAS unsigned char* p) { return __builtin_bit_cast(s16x4, __builtin_amdgcn_ds_read_tr16_b64_v4i16((LAS v4i16_t*)p)); }
DI int crow16(int i, int h) { return (i & 3) + 8 * (i >> 2) + 4 * h; }
constexpr int AT_KRS = 144, AT_VRS = 192, AT_KB = 64 * AT_KRS, AT_BUF = AT_KB + 64 * AT_VRS, AT_RPB = 2 * AT_BUF;
constexpr float LOG2E = 1.4426950408889634f, AT_SC = 0.125f * LOG2E;
template <int TYPE>
DI void attn_unit(KArgs KA, const Frame& F, int l, int unit, bool ctxq) {
    const bf16* P = (const bf16*)(KA->ws + WS_ACT);
    const int L = F.lane, w = F.wave, r = L & 31, h2 = L >> 5, i16 = L & 15;
    int b, head, kvh, p0, qpos0, t0 = 0, nloc = 0;
    if (TYPE != 2) { int g, pb; if (!ctxq) { b = unit >> 6; g = (unit >> 5) & 1; pb = unit & 31; } else { b = unit >> 2; g = (unit >> 1) & 1; pb = unit & 1; }
        head = 2 * g + (w >> 2); kvh = g; p0 = pb * 128; qpos0 = p0 + 32 * (w & 3);
        if (!ctxq) { if (TYPE == 1) { t0 = 0; nloc = 64; } else { t0 = max(0, 2 * (pb - 1)); nloc = min(64, 2 * (pb + 2)) - t0; } } }
    else { int rb; if (!ctxq) { b = unit >> 6; head = (unit >> 4) & 3; rb = unit & 15; } else { b = unit >> 2; head = unit & 3; rb = 0; }
        kvh = head; p0 = rb * 256; qpos0 = p0 + 32 * w;
        if (!ctxq) { const int r0 = rb * 4; t0 = min(max(r0 - 4, 0), 56); nloc = min(max(r0 - 1, 0), 56) + 8 - t0; } }
    const int qcol = (TYPE == 0 ? C_AQ : TYPE == 1 ? C_CQ : C_DQ) + head * 64;
    const int kcol = (TYPE == 0 ? C_AK : TYPE == 1 ? C_CK : C_DK) + kvh * 64, vcol = (TYPE == 0 ? C_AV : TYPE == 1 ? C_CV : C_DV) + kvh * 64;
    const int qrow = (ctxq ? NLAT + b * CTXL : b * SEQ) + qpos0 + r;
    const int nt = nloc + 4;
    bf16x8v qf[4];
#pragma unroll
    for (int ks = 0; ks < 4; ++ks) qf[ks] = *(const bf16x8v*)(P + (size_t)qrow * NPJ + qcol + ks * 16 + 8 * h2);
    LAS unsigned char* lb = F.lds;
    if (TYPE == 2) { LAS float* rp = (LAS float*)(lb + AT_RPB); for (int i = F.tid; i < 465; i += 512) rp[i] = KA->in[21][(size_t)(l * 4 + head) * 465 + i] * 8.0f; }
    const int srow = F.tid >> 3, sch = F.tid & 7;
#define TILE_ROW0(i) ((i) < nloc ? b * SEQ + (t0 + (i)) * 64 : NLAT + b * CTXL + ((i) - nloc) * 64)
    v4u kreg, vreg;
    { const bf16* src = P + (size_t)(TILE_ROW0(0) + srow) * NPJ; kreg = *(const v4u*)(src + kcol + sch * 8); vreg = *(const v4u*)(src + vcol + sch * 8); }
    *(LAS v4u*)(lb + srow * AT_KRS + sch * 16) = kreg; *(LAS v4u*)(lb + AT_KB + srow * AT_VRS + sch * 16) = vreg;
    __syncthreads();
    f32x16 oacc[2];
#pragma unroll
    for (int i = 0; i < 16; ++i) { oacc[0][i] = 0.f; oacc[1][i] = 0.f; }
    float m = -1e30f, lsum = 0.f;
    if (TYPE == 1) {
        float gq = fabsf(KA->in[19][l * 64 + L]), gk = fabsf(KA->in[20][l * 64 + L]);
#pragma unroll
        for (int o = 1; o < 64; o <<= 1) { gq = fmaxf(gq, __shfl_xor(gq, o)); gk = fmaxf(gk, __shfl_xor(gk, o)); }
        m = 64.0f * 1.03f * gq * gk;
    }
    const int qpos = qpos0 + r;
    const int gr = qpos0 >> 6, rs = min(max(gr - 4, 0), 56), qc = qpos & 63, cs = min(max(qc - 8, 0), 48);
    for (int i = 0; i < nt; ++i) {
        const LAS unsigned char* kb_ = lb + (i & 1) * AT_BUF; const LAS unsigned char* vb_ = kb_ + AT_KB;
        if (i + 1 < nt) { const bf16* src = P + (size_t)(TILE_ROW0(i + 1) + srow) * NPJ; kreg = *(const v4u*)(src + kcol + sch * 8); vreg = *(const v4u*)(src + vcol + sch * 8); }
        const bool loc = i < nloc;
        bool skip = false;
        const int k0 = (t0 + i) * 64;
        if (loc && TYPE == 0) skip = (k0 + 63 < qpos0 - 128) || (k0 > qpos0 + 31 + 128);
        if (loc && TYPE == 2) skip = (t0 + i < rs) || (t0 + i >= rs + 8);
        if (!skip) {
            f32x16 sacc[2];
            bf16x8v kf[2][4], vf[2][2][2];
#pragma unroll
            for (int kb = 0; kb < 2; ++kb)
#pragma unroll
                for (int ks = 0; ks < 4; ++ks) kf[kb][ks] = *(const LAS bf16x8v*)(kb_ + (kb * 32 + r) * AT_KRS + ks * 32 + 16 * h2);
#pragma unroll
            for (int kb = 0; kb < 2; ++kb)
#pragma unroll
                for (int s = 0; s < 2; ++s)
#pragma unroll
                    for (int db = 0; db < 2; ++db) {
                        const LAS unsigned char* va = vb_ + (kb * 32 + 16 * s + 4 * h2 + (i16 >> 2)) * AT_VRS + (db * 32 + 16 * ((L >> 4) & 1) + 4 * (i16 & 3)) * 2;
                        const s16x4 lo = vtr(va), hi = vtr(va + 8 * AT_VRS);
                        vf[kb][s][db] = (bf16x8v){lo[0], lo[1], lo[2], lo[3], hi[0], hi[1], hi[2], hi[3]}; }
            __builtin_amdgcn_sched_barrier(0);
#pragma unroll
            for (int kb = 0; kb < 2; ++kb) {
#pragma unroll
                for (int q = 0; q < 16; ++q) sacc[kb][q] = 0.f;
#pragma unroll
                for (int ks = 0; ks < 4; ++ks) sacc[kb] = __builtin_amdgcn_mfma_f32_32x32x16_bf16(kf[kb][ks], qf[ks], sacc[kb], 0, 0, 0);
            }
            float tmax = -INFINITY;
            if ((TYPE == 0 || TYPE == 2) && loc) {
#pragma unroll
                for (int kb = 0; kb < 2; ++kb)
#pragma unroll
                    for (int q = 0; q < 16; ++q) { float s = sacc[kb][q]; const int kk = kb * 32 + crow16(q, h2);
                        if (TYPE == 0) { const int d = k0 + kk - qpos; if (d > 128 || d < -128) s = -INFINITY; }
                        if (TYPE == 2) { const int dc = kk - cs; const LAS float* rp = (const LAS float*)(lb + AT_RPB);
                            if (dc < 0 || dc >= 16) s = -INFINITY; else s += rp[(t0 + i - gr + 7) * 31 + (kk - qc + 15)]; }
                        sacc[kb][q] = s; }
            }
            if (TYPE != 1) {
#pragma unroll
                for (int kb = 0; kb < 2; ++kb)
#pragma unroll
                    for (int q = 0; q < 16; ++q) tmax = fmaxf(tmax, sacc[kb][q]);
                tmax = fmaxf(tmax, __shfl_xor(tmax, 32));
                const float mn = fmaxf(m, tmax);
                if (__any(mn > m)) {
                    const float alpha = __builtin_amdgcn_exp2f((m - mn) * AT_SC);
                    lsum *= alpha;
#pragma unroll
                    for (int q = 0; q < 16; ++q) { oacc[0][q] *= alpha; oacc[1][q] *= alpha; }
                }
                m = mn;
            }
            const float mns = -m * AT_SC;
            float psum = 0.f;
#pragma unroll
            for (int kb = 0; kb < 2; ++kb)
#pragma unroll
                for (int q = 0; q < 16; ++q) { const float p = __builtin_amdgcn_exp2f(__builtin_fmaf(sacc[kb][q], AT_SC, mns)); sacc[kb][q] = p; psum += p; }
            lsum += psum;
#pragma unroll
            for (int kb = 0; kb < 2; ++kb)
#pragma unroll
                for (int s = 0; s < 2; ++s) {
                    v4u pw; pw.x = cvtpk(sacc[kb][8 * s], sacc[kb][8 * s + 1]); pw.y = cvtpk(sacc[kb][8 * s + 2], sacc[kb][8 * s + 3]); pw.z = cvtpk(sacc[kb][8 * s + 4], sacc[kb][8 * s + 5]); pw.w = cvtpk(sacc[kb][8 * s + 6], sacc[kb][8 * s + 7]);
                    const bf16x8v pf = __builtin_bit_cast(bf16x8v, pw);
#pragma unroll
                    for (int db = 0; db < 2; ++db) oacc[db] = __builtin_amdgcn_mfma_f32_32x32x16_bf16(vf[kb][s][db], pf, oacc[db], 0, 0, 0);
                }
        }
        if (i + 1 < nt) { LAS unsigned char* nb = lb + ((i + 1) & 1) * AT_BUF; *(LAS v4u*)(nb + srow * AT_KRS + sch * 16) = kreg; *(LAS v4u*)(nb + AT_KB + srow * AT_VRS + sch * 16) = vreg; }
        __syncthreads();
    }
    lsum += __shfl_xor(lsum, 32);
    if (TYPE == 0) lsum += __builtin_amdgcn_exp2f(KA->in[13][l * 4 + head] * LOG2E - m * AT_SC);
    const float inv = 1.f / lsum;
    bf16* op = (bf16*)(KA->ws + WS_O) + (size_t)qrow * DM + (TYPE == 0 ? 0 : TYPE == 1 ? 512 : 768) + head * 64;
#pragma unroll
    for (int db = 0; db < 2; ++db)
#pragma unroll
        for (int q4 = 0; q4 < 4; ++q4) { v2u o; o.x = cvtpk(oacc[db][4 * q4] * inv, oacc[db][4 * q4 + 1] * inv); o.y = cvtpk(oacc[db][4 * q4 + 2] * inv, oacc[db][4 * q4 + 3] * inv);
            *(v2u*)(op + db * 32 + 8 * q4 + 4 * h2) = o; }
}
constexpr size_t WS_ST = WS_A;
constexpr size_t WS_DEC = 3 * MiB;
constexpr int SS_B = 0, SS_BRS = 272, SS_X = 34816, SS_XRS = 192, SS_X2 = 59392, SS_HF = 83968, SS_HB = 101376, SS_ARR = 118784;
DI int slot_row(int b, int slot) { return slot < 2 ? NLAT + b * CTXL + slot * 128 : b * SEQ + (slot - 2) * 128; }
DI void ssd_stage_dt(KArgs KA, const Frame& F, int l, int h, int rowbase, LAS float* arr) {
    const float* DTB = (const float*)(KA->ws + WS_DT);
    if (F.tid < 128) { const float df = DTB[(size_t)(rowbase + F.tid) * 8 + h], db = DTB[(size_t)(rowbase + F.tid) * 8 + 4 + h];
        const float Af = -__expf(KA->in[17][l * 8 + h]) * LOG2E, Ab = -__expf(KA->in[17][l * 8 + 4 + h]) * LOG2E;
        arr[F.tid] = df * Af; arr[128 + F.tid] = db * Ab; arr[256 + F.tid] = df; arr[384 + F.tid] = db; }
    __syncthreads();
    if (F.wave < 2) { const int L = F.lane; const bool rev = F.wave == 1;
        const float v0 = rev ? arr[128 + 127 - 2 * L] : arr[2 * L], v1 = rev ? arr[128 + 126 - 2 * L] : arr[2 * L + 1];
        float t = v0 + v1;
#pragma unroll
        for (int o = 1; o < 64; o <<= 1) { const float u = __shfl_up(t, o); if (L >= o) t += u; }
        if (rev) { arr[640 + 127 - 2 * L] = t - v1; arr[640 + 126 - 2 * L] = t; } else { arr[512 + 2 * L] = t - v1; arr[512 + 2 * L + 1] = t; } }
    __syncthreads();
}
struct BRegs { v4u v[4]; };
DI BRegs ssd_load_B(KArgs KA, const Frame& F, int g, int rowbase) {
    const bf16* U = (const bf16*)(KA->ws + WS_U);
    const int row = F.tid >> 2, pc = F.tid & 3; const bf16* src = U + (size_t)(rowbase + row) * 768 + 256 + g * 128 + pc * 32;
    BRegs b;
#pragma unroll
    for (int k = 0; k < 4; ++k) b.v[k] = *(const v4u*)(src + k * 8);
    return b;
}
DI void ssd_store_B(const Frame& F, const BRegs& b) {
    const int row = F.tid >> 2, pc = F.tid & 3;
#pragma unroll
    for (int k = 0; k < 4; ++k) *(LAS v4u*)(F.lds + SS_B + row * SS_BRS + pc * 64 + k * 16) = b.v[k];
}
DI v4u scale8(v4u w, float s) { v4u o; o.x = cvtpk(bflo(w.x) * s, bfhi(w.x) * s); o.y = cvtpk(bflo(w.y) * s, bfhi(w.y) * s); o.z = cvtpk(bflo(w.z) * s, bfhi(w.z) * s); o.w = cvtpk(bflo(w.w) * s, bfhi(w.w) * s); return o; }
DI void ssd_states(KArgs KA, const Frame& F, int l, int item) {
    const int slot = item % 34, bh = item / 34, b = bh >> 2, h = bh & 3, g = h >> 1, rowbase = slot_row(b, slot);
    const int L = F.lane, w = F.wave, r = L & 31, h2 = L >> 5, i16 = L & 15, grp = (L >> 4) & 1;
    LAS float* arr = (LAS float*)(F.lds + SS_ARR);
    const BRegs breg = ssd_load_B(KA, F, g, rowbase);
    v4u x0, x1;
    { const bf16* U = (const bf16*)(KA->ws + WS_U); const int row = F.tid >> 2, pc = F.tid & 3; const bf16* src = U + (size_t)(rowbase + row) * 768 + h * 64 + pc * 16; x0 = *(const v4u*)src; x1 = *(const v4u*)(src + 8); }
    ssd_stage_dt(KA, F, l, h, rowbase, arr);
    ssd_store_B(F, breg);
    { const int row = F.tid >> 2, pc = F.tid & 3;
      const float wf = __builtin_amdgcn_exp2f(arr[512 + 127] - arr[512 + row]) * arr[256 + row], wb = __builtin_amdgcn_exp2f(arr[640] - arr[640 + row]) * arr[384 + row];
      *(LAS v4u*)(F.lds + SS_X + row * SS_XRS + pc * 32) = scale8(x0, wf); *(LAS v4u*)(F.lds + SS_X + row * SS_XRS + pc * 32 + 16) = scale8(x1, wf);
      *(LAS v4u*)(F.lds + SS_X2 + row * SS_XRS + pc * 32) = scale8(x0, wb); *(LAS v4u*)(F.lds + SS_X2 + row * SS_XRS + pc * 32 + 16) = scale8(x1, wb); }
    __syncthreads();
    const int pblk = w >> 2, nblk = w & 3;
    bf16* ST = (bf16*)(KA->ws + WS_ST); float* DEC = (float*)(KA->ws + WS_DEC);
#pragma unroll
    for (int dir = 0; dir < 2; ++dir) {
        f32x16 acc;
#pragma unroll
        for (int q = 0; q < 16; ++q) acc[q] = 0.f;
        const LAS unsigned char* xb = F.lds + (dir ? SS_X2 : SS_X);
#pragma unroll
        for (int ks = 0; ks < 8; ++ks) {
            const LAS unsigned char* xa = xb + (ks * 16 + 8 * h2 + (i16 >> 2)) * SS_XRS + (pblk * 32 + 16 * grp + 4 * (i16 & 3)) * 2;
            const s16x4 xlo = vtr(xa), xhi = vtr(xa + 4 * SS_XRS);
            const LAS unsigned char* ba = F.lds + SS_B + (ks * 16 + 8 * h2 + (i16 >> 2)) * SS_BRS + (nblk * 32 + 16 * grp + 4 * (i16 & 3)) * 2;
            const s16x4 blo = vtr(ba), bhi_ = vtr(ba + 4 * SS_BRS);
            const bf16x8v xf = (bf16x8v){xlo[0], xlo[1], xlo[2], xlo[3], xhi[0], xhi[1], xhi[2], xhi[3]}, bfr = (bf16x8v){blo[0], blo[1], blo[2], blo[3], bhi_[0], bhi_[1], bhi_[2], bhi_[3]};
            acc = __builtin_amdgcn_mfma_f32_32x32x16_bf16(xf, bfr, acc, 0, 0, 0); }
        bf16* dst = ST + ((size_t)((bh * 2 + dir) * 34 + slot)) * 8192;
#pragma unroll
        for (int q = 0; q < 16; ++q) dst[(pblk * 32 + crow16(q, h2)) * 128 + nblk * 32 + r] = (bf16)(cvtpk(acc[q], 0.f) & 0xffffu);
        if (F.tid == 0) DEC[(bh * 2 + dir) * 34 + slot] = __builtin_amdgcn_exp2f(dir ? arr[640] : arr[512 + 127]);
    }
    __syncthreads();
}
DI void ssd_scan() {
    KArgs KA = kargs(); Frame F = mkframe();
    bf16* ST = (bf16*)(KA->ws + WS_ST); const float* DEC = (const float*)(KA->ws + WS_DEC);
    for (int gt = blockIdx.x * 512 + F.tid; gt < 64 * 2048; gt += F.G * 512) {
        const int chain = gt >> 11, e4 = gt & 2047, dir = chain & 1;
        bf16* base = ST + (size_t)chain * 34 * 8192 + e4 * 4;
        v2u tw[34]; float dc[34];
#pragma unroll
        for (int k = 0; k < 34; ++k) { const int slot = dir == 0 ? k : (k < 2 ? 1 - k : 35 - k); tw[k] = *(const v2u*)(base + (size_t)slot * 8192); dc[k] = DEC[chain * 34 + slot]; }
        f32x4 hc = (f32x4){0.f, 0.f, 0.f, 0.f};
#pragma unroll
        for (int k = 0; k < 34; ++k) { const int slot = dir == 0 ? k : (k < 2 ? 1 - k : 35 - k);
            const f32x4 t = (f32x4){bflo(tw[k].x), bfhi(tw[k].x), bflo(tw[k].y), bfhi(tw[k].y)};
            v2u ow; ow.x = cvtpk(hc.x, hc.y); ow.y = cvtpk(hc.z, hc.w); *(v2u*)(base + (size_t)slot * 8192) = ow; hc = hc * dc[k] + t; }
    }
}
DI void ssd_outputs(KArgs KA, const Frame& F, int l, int item) {
    const int slot = item % 34, bh = item / 34, b = bh >> 2, h = bh & 3, g = h >> 1, rowbase = slot_row(b, slot);
    const int L = F.lane, w = F.wave, r = L & 31, h2 = L >> 5, i16 = L & 15, grp = (L >> 4) & 1;
    LAS float* arr = (LAS float*)(F.lds + SS_ARR);
    const bf16* U = (const bf16*)(KA->ws + WS_U);
    const int ib = w & 3, pb = w >> 2, ipos = ib * 32 + r;
    bf16x8v cfq[8];
#pragma unroll
    for (int ks = 0; ks < 8; ++ks) cfq[ks] = *(const bf16x8v*)(U + (size_t)(rowbase + ipos) * 768 + 512 + g * 128 + ks * 16 + 8 * h2);
    const BRegs breg = ssd_load_B(KA, F, g, rowbase);
    v4u x0, x1, hf0, hf1, hb0, hb1;
    { const int row = F.tid >> 2, pc = F.tid & 3; const bf16* src = U + (size_t)(rowbase + row) * 768 + h * 64 + pc * 16; x0 = *(const v4u*)src; x1 = *(const v4u*)(src + 8); }
    { const bf16* ST = (const bf16*)(KA->ws + WS_ST); const int p = F.tid >> 3, pc = F.tid & 7;
      const bf16* sf = ST + ((size_t)((bh * 2 + 0) * 34 + slot)) * 8192 + p * 128 + pc * 16; const bf16* sb = ST + ((size_t)((bh * 2 + 1) * 34 + slot)) * 8192 + p * 128 + pc * 16;
      hf0 = *(const v4u*)sf; hf1 = *(const v4u*)(sf + 8); hb0 = *(const v4u*)sb; hb1 = *(const v4u*)(sb + 8); }
    ssd_stage_dt(KA, F, l, h, rowbase, arr);
    ssd_store_B(F, breg);
    { const int row = F.tid >> 2, pc = F.tid & 3; *(LAS v4u*)(F.lds + SS_X + row * SS_XRS + pc * 32) = x0; *(LAS v4u*)(F.lds + SS_X + row * SS_XRS + pc * 32 + 16) = x1; }
    { const int p = F.tid >> 3, pc = F.tid & 7; LAS unsigned char* d = F.lds + SS_HF + p * SS_BRS + pc * 32; *(LAS v4u*)d = hf0; *(LAS v4u*)(d + 16) = hf1;
      LAS unsigned char* e = F.lds + SS_HB + p * SS_BRS + pc * 32; *(LAS v4u*)e = hb0; *(LAS v4u*)(e + 16) = hb1; }
    __syncthreads();
    const float cfi = arr[512 + ipos], cbi = arr[640 + ipos];
    f32x16 yacc;
#pragma unroll
    for (int q = 0; q < 16; ++q) yacc[q] = 0.f;
#pragma unroll
    for (int jb = 0; jb < 4; ++jb) {
        f32x16 acc;
#pragma unroll
        for (int q = 0; q < 16; ++q) acc[q] = 0.f;
#pragma unroll
        for (int ks = 0; ks < 8; ++ks) { const bf16x8v bfr = *(const LAS bf16x8v*)(F.lds + SS_B + (jb * 32 + r) * SS_BRS + ks * 32 + 16 * h2);
            acc = __builtin_amdgcn_mfma_f32_32x32x16_bf16(bfr, cfq[ks], acc, 0, 0, 0); }
#pragma unroll
        for (int q = 0; q < 16; ++q) { const int j = jb * 32 + crow16(q, h2);
            float wt = 0.f;
            if (j <= ipos) wt += __builtin_amdgcn_exp2f(cfi - arr[512 + j]) * arr[256 + j];
            if (j >= ipos) wt += __builtin_amdgcn_exp2f(cbi - arr[640 + j]) * arr[384 + j];
            acc[q] *= wt; }
#pragma unroll
        for (int s = 0; s < 2; ++s) {
            v4u pw; pw.x = cvtpk(acc[8 * s], acc[8 * s + 1]); pw.y = cvtpk(acc[8 * s + 2], acc[8 * s + 3]); pw.z = cvtpk(acc[8 * s + 4], acc[8 * s + 5]); pw.w = cvtpk(acc[8 * s + 6], acc[8 * s + 7]);
            const bf16x8v pf = __builtin_bit_cast(bf16x8v, pw);
            const LAS unsigned char* xa = F.lds + SS_X + (jb * 32 + 16 * s + 4 * h2 + (i16 >> 2)) * SS_XRS + (pb * 32 + 16 * grp + 4 * (i16 & 3)) * 2;
            const s16x4 lo = vtr(xa), hi = vtr(xa + 8 * SS_XRS);
            const bf16x8v xf = (bf16x8v){lo[0], lo[1], lo[2], lo[3], hi[0], hi[1], hi[2], hi[3]};
            yacc = __builtin_amdgcn_mfma_f32_32x32x16_bf16(xf, pf, yacc, 0, 0, 0); }
    }
#pragma unroll
    for (int dir = 0; dir < 2; ++dir) {
        f32x16 tacc;
#pragma unroll
        for (int q = 0; q < 16; ++q) tacc[q] = 0.f;
#pragma unroll
        for (int ks = 0; ks < 8; ++ks) { const bf16x8v hfr = *(const LAS bf16x8v*)(F.lds + (dir ? SS_HB : SS_HF) + (pb * 32 + r) * SS_BRS + ks * 32 + 16 * h2);
            tacc = __builtin_amdgcn_mfma_f32_32x32x16_bf16(hfr, cfq[ks], tacc, 0, 0, 0); }
        const float sc = __builtin_amdgcn_exp2f(dir ? cbi : cfi);
#pragma unroll
        for (int q = 0; q < 16; ++q) yacc[q] += sc * tacc[q];
    }
    bf16* yp = (bf16*)(KA->ws + WS_Y) + (size_t)(rowbase + ipos) * 256 + h * 64 + pb * 32;
#pragma unroll
    for (int q4 = 0; q4 < 4; ++q4) { v2u o; o.x = cvtpk(yacc[4 * q4], yacc[4 * q4 + 1]); o.y = cvtpk(yacc[4 * q4 + 2], yacc[4 * q4 + 3]); *(v2u*)(yp + 8 * q4 + 4 * h2) = o; }
    __syncthreads();
}
DI void ssd_outputs_phase(int l, bool last) {
    KArgs KA = kargs(); Frame F = mkframe();
    for (int it = blockIdx.x; it < 32 * 34; it += F.G) { if (last && (it % 34) < 2) continue; ssd_outputs(KA, F, l, it); }
}
DI void mixers_flash(int l, bool last) {
    KArgs KA = kargs(); Frame F = mkframe();
    const int nS = 32 * 34, nL = 1536, nC = last ? 0 : 96, nItems = nS + nL + nC;
    for (int it = blockIdx.x; it < nItems; it += F.G) {
        if (it < nS) { ssd_states(KA, F, l, it); continue; }
        int u = it - nS; bool cq = false;
        if (u >= nL) { u -= nL; cq = true; }
        const int ty = u % 3, un = u / 3;
        if (ty == 0) attn_unit<1>(KA, F, l, un, cq); else if (ty == 1) attn_unit<0>(KA, F, l, un, cq); else attn_unit<2>(KA, F, l, un, cq);
    }
}
DI void merge_pass(int l, int nrows) {
    KArgs KA = kargs(); Frame F = mkframe();
    const bf16* P = (const bf16*)(KA->ws + WS_ACT); const bf16* O = (const bf16*)(KA->ws + WS_O); const bf16* Y = (const bf16*)(KA->ws + WS_Y); const bf16* U = (const bf16*)(KA->ws + WS_U);
    bf16* A = (bf16*)(KA->ws + WS_A);
    const int hh = F.lane >> 4, cn = 4 * F.lane;
    const float dsk = KA->in[18][l * 4 + hh];
    v2u o0, o2, o3, yw, xw, zw;
#define MERGE_LOAD(r_) do { o0 = *(const v2u*)(O + (size_t)(r_) * DM + cn); o2 = *(const v2u*)(O + (size_t)(r_) * DM + 512 + cn); o3 = *(const v2u*)(O + (size_t)(r_) * DM + 768 + cn); \
        yw = *(const v2u*)(Y + (size_t)(r_) * 256 + cn); xw = *(const v2u*)(U + (size_t)(r_) * 768 + cn); zw = *(const v2u*)(P + (size_t)(r_) * NPJ + C_BZ + cn); } while (0)
    if (F.gw < nrows) MERGE_LOAD(F.gw);
    for (int row = F.gw; row < nrows; row += F.ngw) {
        f32x4 v[4];
        v[0] = (f32x4){bflo(o0.x), bfhi(o0.x), bflo(o0.y), bfhi(o0.y)}; v[2] = (f32x4){bflo(o2.x), bfhi(o2.x), bflo(o2.y), bfhi(o2.y)}; v[3] = (f32x4){bflo(o3.x), bfhi(o3.x), bflo(o3.y), bfhi(o3.y)};
        { const f32x4 yf = (f32x4){bflo(yw.x), bfhi(yw.x), bflo(yw.y), bfhi(yw.y)}, xs = (f32x4){bflo(xw.x), bfhi(xw.x), bflo(xw.y), bfhi(xw.y)}, z = (f32x4){bflo(zw.x), bfhi(zw.x), bflo(zw.y), bfhi(zw.y)};
          const f32x4 y = yf + xs * dsk; v[1] = (f32x4){y.x * silu(z.x), y.y * silu(z.y), y.z * silu(z.z), y.w * silu(z.w)}; }
        if (row + F.ngw < nrows) MERGE_LOAD(row + F.ngw);
#pragma unroll
        for (int j = 0; j < 4; ++j) { const int n = 4 * F.lane + 256 * j;
            const float ss = wave_sum((v[j].x * v[j].x + v[j].y * v[j].y) + (v[j].z * v[j].z + v[j].w * v[j].w));
            const float r = 1.f / sqrtf(ss * (1.f / 256.f) + LN_EPS);
            const f32x4 a = v[j] * r * *(const f32x4*)(KA->in[12] + l * DM + n);
            v2u w; w.x = cvtpk(a.x, a.y); w.y = cvtpk(a.z, a.w); *(v2u*)(A + (size_t)row * DM + n) = w; }
    }
#undef MERGE_LOAD
}
constexpr size_t WS_CTL = 3 * MiB + 512 * 1024, CTL_BYTES = 16384;
constexpr int MISC_OFF = 139264;
#define XB_TMO      128
#define XB_XCNT(j)  (256  + 64 * (j))
#define XB_XSUB(j)  (1280 + 64 * (j))
#define XB_XGEN(j)  (2304 + 64 * (j))
#define XB_TOP      3328
#define XB_TOPGEN   3392
#define XCD_BAR_WORDS 3456
#define XB_SPIN_CAP (1u << 18)

__device__ __forceinline__ unsigned xb_ld(unsigned* p)              { return __hip_atomic_load(p, __ATOMIC_RELAXED, __HIP_MEMORY_SCOPE_AGENT); }
__device__ __forceinline__ unsigned xb_add(unsigned* p, unsigned v) { return __hip_atomic_fetch_add(p, v, __ATOMIC_RELAXED, __HIP_MEMORY_SCOPE_AGENT); }
__device__ __forceinline__ unsigned xb_xcc_id() { return (unsigned)__builtin_amdgcn_s_getreg((3 << 11) | 20) & 0xFu; }
#define XB_SPIN(cond, bar) do { unsigned _sp = 0; while (cond) { __builtin_amdgcn_s_sleep(1); \
    if ((++_sp & 255u) == 0u) { if (xb_ld(&(bar)[XB_TMO])) break; if (_sp > XB_SPIN_CAP) { atomicAdd(&(bar)[XB_TMO], 1u); break; } } } } while (0)

struct XcdBarrier {
    unsigned* bar; unsigned x;
    volatile LAS unsigned* st;
};

__device__ __forceinline__ XcdBarrier xcd_barrier_post(unsigned* bar, volatile LAS unsigned* st) {
    XcdBarrier b; b.bar = bar; b.x = xb_xcc_id(); b.st = st;
    if (threadIdx.x == 0) (void)xb_add(&bar[XB_XCNT(b.x)], 1u);
    return b;
}
__device__ __forceinline__ void xcd_barrier_complete(unsigned* bar, unsigned x, unsigned& nloc, unsigned& nx) {
    const unsigned G = gridDim.x * gridDim.y * gridDim.z;
    unsigned sum, cnt, mine, sp = 0u;
    for (;;) {
        sum = 0u; cnt = 0u; mine = 0u;
#pragma unroll
        for (unsigned j = 0; j < 16; ++j) { const unsigned c = xb_ld(&bar[XB_XCNT(j)]); sum += c; cnt += (c > 0u) ? 1u : 0u; mine = (j == x) ? c : mine; }
        if (sum == G) break;
        __builtin_amdgcn_s_sleep(1);
        if ((++sp & 255u) == 0u) { if (xb_ld(&bar[XB_TMO])) break; if (sp > XB_SPIN_CAP) { atomicAdd(&bar[XB_TMO], 1u); break; } }
    }
    nloc = mine > 0u ? mine : 1u; nx = cnt > 0u ? cnt : 1u;
}

__device__ __forceinline__ void xcd_barrier(const XcdBarrier& b) {
    asm volatile("s_waitcnt vmcnt(0)" ::: "memory");
    __syncthreads();
    if (threadIdx.x == 0) {
        unsigned* bar = b.bar;
        __builtin_amdgcn_s_waitcnt(0);
        unsigned nloc = b.st[0], nx = b.st[1];
        if (nloc == 0u) { xcd_barrier_complete(bar, b.x, nloc, nx); b.st[0] = nloc; b.st[1] = nx; }
        const unsigned old = xb_add(&bar[XB_XSUB(b.x)], 1u);
        const unsigned gen = old / nloc;
        if (old + 1u == (gen + 1u) * nloc) {
            __builtin_amdgcn_fence(__ATOMIC_RELEASE, "agent");
            asm volatile("s_waitcnt vmcnt(0)" ::: "memory");
            const unsigned og = xb_add(&bar[XB_TOP], 1u);
            const unsigned tg = og / nx;
            if (og + 1u == (tg + 1u) * nx) xb_add(&bar[XB_TOPGEN], 1u);
            else XB_SPIN(xb_ld(&bar[XB_TOPGEN]) == tg, bar);
            __builtin_amdgcn_fence(__ATOMIC_ACQUIRE, "agent");
            xb_add(&bar[XB_XGEN(b.x)], 1u);
            asm volatile("s_waitcnt vmcnt(0)" ::: "memory");
        } else {
            XB_SPIN(xb_ld(&bar[XB_XGEN(b.x)]) == gen, bar);
            __builtin_amdgcn_fence(__ATOMIC_ACQUIRE, "agent");
            asm volatile("s_waitcnt vmcnt(0)" ::: "memory");
        }
    }
    __syncthreads();
}

#define GRID_BAR() do { XcdBarrier b_; b_.bar = (unsigned*)(kargs()->ws + WS_CTL); b_.x = xb_xcc_id(); b_.st = (volatile LAS unsigned*)((LAS unsigned char*)lds + MISC_OFF); xcd_barrier(b_); } while (0)
#ifndef PROBE_GRP
#define PROBE_GRP 0
#endif
#define TIMED(grp, ...) do { unsigned long long t0_ = 0; if (PROBE_GRP == (grp)) t0_ = __builtin_amdgcn_s_memrealtime(); __VA_ARGS__; \
    if (PROBE_GRP == (grp) && blockIdx.x == 0) { const unsigned long long dt_ = __builtin_amdgcn_s_memrealtime() - t0_; const unsigned long long t1_ = __builtin_amdgcn_s_memrealtime(); \
        while (__builtin_amdgcn_s_memrealtime() - t1_ < 2 * dt_) __builtin_amdgcn_s_sleep(8); } } while (0)
__global__ void __launch_bounds__(NWAVES * 64, 2) mega_fwd(Args args) {
    extern __shared__ __attribute__((aligned(16))) unsigned char lds[];
    cg::grid_group grid = cg::this_grid();
    if (threadIdx.x < 2) ((volatile LAS unsigned*)((LAS unsigned char*)lds + MISC_OFF))[threadIdx.x] = 0u;
    __syncthreads();
    (void)xcd_barrier_post((unsigned*)(kargs()->ws + WS_CTL), (volatile LAS unsigned*)((LAS unsigned char*)lds + MISC_OFF));
    { LAS float* rc = (LAS float*)((LAS unsigned char*)lds + ROPE_OFF);
      for (int i = threadIdx.x; i < 1024; i += 512) { const int pos = i >> 4, fi = i & 15; const float inv = exp2f(-(float)fi * (13.287712379549449f / 16.f)); const float ang = (float)pos * inv; rc[i] = cosf(ang); rc[1024 + i] = sinf(ang); } }
    __syncthreads();

    if (args.ws == nullptr) grid.sync();
    p0a(); GRID_BAR(); p0b(); GRID_BAR(); p0c(); GRID_BAR();
    for (int l = 0; l < NL; ++l) {
        const bool last = (l == NL - 1); const int mrows = last ? NLAT : NROW;
        for (int s = 0; s < 3; ++s) {
            if (s != 1) {
                const bool second = (s == 2); const int rows = (second && last) ? NLAT : NROW;
                { KArgs KA = kargs(); pg8::Gemm g{((bf16*)(KA->ws + WS_A)), wbuf(KA, l, second ? WO_W1B : WO_W1A), rows, 2 * DFF, DM}; pg8::StaticOrder S; S.init(rows, 2 * DFF, (int)gridDim.x, (int)blockIdx.x); pg8::EpiSwiGLU E{((bf16*)(KA->ws + WS_ACT)), DFF};
                  pg8::gemm_phase<pg8::EpiSwiGLU, pg8::StaticOrder, true, GEMM_SP2>((LAS unsigned char*)lds, g, S, E); }
                GRID_BAR();
                { KArgs KA = kargs(); pg8::Gemm g{((bf16*)(KA->ws + WS_ACT)), wbuf(KA, l, second ? WO_W2B : WO_W2A), NLAT, DM, DFF}; pg8::StaticOrder S; S.init(NLAT, DM, (int)gridDim.x, (int)blockIdx.x); pg8::EpiBf16 E{((bf16*)(KA->ws + WS_O)), DM};
                  pg8::gemm_phase<pg8::EpiBf16, pg8::StaticOrder, true, GEMM_SP2>((LAS unsigned char*)lds, g, S, E); }
                GRID_BAR();
                const bool split = (rows == NROW);
                const int gidx = second ? 8 : 2, lnidx = second ? 2 : 0, nl = second ? l + 1 : l, nsh = second ? (last ? -1 : 0) : 3;
                if (split && blockIdx.x < 32) {
                    KArgs KA = kargs(); pg8::Gemm g{((bf16*)(KA->ws + WS_ACT)) + (size_t)NLAT * DFF, wbuf(KA, l, second ? WO_W2B : WO_W2A), NCTX, DM, DFF}; pg8::StaticOrder S; S.init(NCTX, DM, 32, (int)blockIdx.x);
                    pg8::EpiBf16 E{((bf16*)(KA->ws + WS_O)) + (size_t)NLAT * DM, DM};
                    pg8::gemm_phase<pg8::EpiBf16, pg8::StaticOrder, true, GEMM_SP2>((LAS unsigned char*)lds, g, S, E);
                } else ln_pass(l, gidx, 0.5f, lnidx, nl, nsh, 0, NLAT, split ? 32 : 0, split ? (int)gridDim.x - 32 : (int)gridDim.x, !second);
                if (split) { GRID_BAR(); ln_pass(l, gidx, 0.5f, lnidx, nl, nsh, NLAT, NROW, 0, (int)gridDim.x, !second); }
                if (!(second && last)) GRID_BAR();
            } else {
                { KArgs KA = kargs(); pg8::Gemm g{((bf16*)(KA->ws + WS_A)), wbuf(KA, l, WO_WIN), NROW, NPJ, DM}; pg8::StaticOrder S; S.init(NROW, NPJ, (int)gridDim.x, (int)blockIdx.x); pg8::EpiBf16 E{((bf16*)(KA->ws + WS_ACT)), NPJ};
                  pg8::gemm_phase<pg8::EpiBf16, pg8::StaticOrder, true, GEMM_SP2>((LAS unsigned char*)lds, g, S, E); }
                GRID_BAR();
                prep_pass(l); GRID_BAR();
                mixers_flash(l, last); GRID_BAR();
                ssd_scan(); GRID_BAR();
                ssd_outputs_phase(l, last); GRID_BAR();
                merge_pass(l, mrows); GRID_BAR();
                { KArgs KA = kargs(); pg8::Gemm g{((bf16*)(KA->ws + WS_A)), wbuf(KA, l, WO_WOUT), mrows, DM, DM}; pg8::StaticOrder S; S.init(mrows, DM, (int)gridDim.x, (int)blockIdx.x); pg8::EpiBf16 E{((bf16*)(KA->ws + WS_O)), DM};
                  pg8::gemm_phase<pg8::EpiBf16, pg8::StaticOrder, true, GEMM_SP2>((LAS unsigned char*)lds, g, S, E); }
                GRID_BAR();
                ln_pass(l, 5, 1.0f, 1, l, 6, 0, mrows, 0, (int)gridDim.x, false); GRID_BAR();
            }
        }
    }
}

extern "C" void kernel_launch(void* const* d_in, const int* in_sizes, int n_in, void* d_out, int out_size, void* d_ws, size_t ws_size, hipStream_t stream) {
    static int grid = 0;
    if (grid == 0) {
        if (n_in != 24 || out_size != NLAT * DM || ws_size < WS_END) { fprintf(stderr, "kernel_launch: unexpected shapes: n_in %d out %d ws %zu\n", n_in, out_size, ws_size); grid = -1; return; }
        int dev = 0, cus = 0, per_cu = 0;
        hipGetDevice(&dev); hipDeviceGetAttribute(&cus, hipDeviceAttributeMultiprocessorCount, dev);
        if (hipFuncSetAttribute((const void*)mega_fwd, hipFuncAttributeMaxDynamicSharedMemorySize, LDS_BYTES) != hipSuccess) { fprintf(stderr, "kernel_launch: hipFuncSetAttribute failed\n"); grid = -1; return; }
        if (hipOccupancyMaxActiveBlocksPerMultiprocessor(&per_cu, (const void*)mega_fwd, NWAVES * 64, LDS_BYTES) != hipSuccess || per_cu < 1) { fprintf(stderr, "kernel_launch: occupancy query says %d\n", per_cu); per_cu = 1; }
        (void)hipGetLastError();
        grid = cus;
    }
    if (grid < 0) return;
    if (hipMemsetAsync((char*)d_ws + WS_CTL, 0, CTL_BYTES, stream) != hipSuccess) { fprintf(stderr, "kernel_launch: memset of the barrier words failed\n"); return; }
    Args a{};
    for (int i = 0; i < 24; ++i) a.in[i] = (const float*)d_in[i];
    a.out = (float*)d_out; a.ws = (unsigned char*)d_ws;
    void* kargs[] = {&a};
    hipError_t e = hipLaunchCooperativeKernel((const void*)mega_fwd, dim3(grid), dim3(NWAVES * 64), kargs, LDS_BYTES, stream);
    if (e != hipSuccess) fprintf(stderr, "kernel_launch: cooperative launch failed: %s (grid %d)\n", hipGetErrorString(e), grid);
}
```

```cpp
#include <hip/hip_runtime.h>
#include <hip/hip_cooperative_groups.h>
#include <cstdio>
#include <cstdint>
namespace cg = cooperative_groups;
namespace pg8 {
#define PG8_LAS __attribute__((address_space(3)))
typedef unsigned short bf16_t;
typedef short bf16x8 __attribute__((ext_vector_type(8)));
typedef float f32x4 __attribute__((ext_vector_type(4)));
typedef unsigned u32x4 __attribute__((ext_vector_type(4)));
constexpr int BM = 256, BK = 64, HALF = 128, HTB = HALF * BK * 2  , STAGE_BYTES = 8 * HTB, NXCD = 8, WGM = 8;

__host__ __device__ __forceinline__ int lds_byte(int r, int c) { const int st = (r >> 4) * 2 + (c >> 5), rr = r & 15, cc = c & 31, ob = rr * 64 + cc * 2; return st * 1024 + (ob ^ (((ob >> 9) & 1) << 5)); }
__host__ __device__ __forceinline__ void stage_rc(int b, int& R, int& C) { const int st = b / 1024, sb = b % 1024, swz = sb ^ (((sb >> 9) & 1) << 5); R = (st >> 1) * 16 + swz / 64; C = (st & 1) * 32 + (swz % 64) / 2; }
__host__ __device__ __forceinline__ int perm32(int rho) { const int n = rho >> 4, i = rho & 15; return 8 * (i >> 2) + 4 * n + (i & 3); }

struct Unit { int pm, pn; };
struct Gemm { const bf16_t* A; const bf16_t* Bt; int M, N, K; };

struct StaticOrder {
    int nM, nN, nwg, G, c;
    __host__ __device__ void init(int M, int N, int G_, int c_) { nM = M / BM; nN = N / BM; nwg = nM * nN; G = G_; c = c_; }
    __host__ __device__ bool next(int i, Unit& u) const {
        const long L = (long)i * G + c; if (L >= nwg) return false;
        int wgid = (int)L; { const int q = nwg / NXCD, r = nwg % NXCD, xcd = wgid % NXCD, off = wgid / NXCD; wgid = (xcd < r ? xcd * (q + 1) : r * (q + 1) + (xcd - r) * q) + off; }
        const int nig = WGM * nN, gid = wgid / nig, fm = gid * WGM, gsz = (nM - fm) < WGM ? (nM - fm) : WGM;
        u.pm = fm + ((wgid % nig) % gsz); u.pn = (wgid % nig) / gsz; return true;
    }
    __device__ __forceinline__ void a_ready(const Unit&) const {}
    __device__ __forceinline__ void done(const Unit&) const {}
};

__device__ __forceinline__ unsigned cvt_pk_bf16(float lo, float hi) { unsigned r; asm volatile("v_cvt_pk_bf16_f32 %0, %1, %2" : "=v"(r) : "v"(lo), "v"(hi)); return r; }
struct EpiBf16 {
    static constexpr bool PERM = true, AFTER_DRAIN = false;
    bf16_t* O; int ldc;
    __device__ __forceinline__ void operator()(const f32x4 (&acc)[2][2][4][2], const Unit& u, int wr, int wc, int fr, int fq) const {
        const int row0 = u.pm * BM + wr * 64 + fr; const int col0 = u.pn * BM + wc * 32 + 8 * fq;
#pragma unroll
        for (int ai = 0; ai < 2; ++ai)
#pragma unroll
            for (int m = 0; m < 4; ++m) { bf16_t* rowp = O + (size_t)(row0 + ai * HALF + m * 16) * ldc + col0;
#pragma unroll
                for (int bj = 0; bj < 2; ++bj) { const f32x4 v0 = acc[ai][bj][m][0], v1 = acc[ai][bj][m][1];
                    u32x4 w; w.x = cvt_pk_bf16(v0[0], v0[1]); w.y = cvt_pk_bf16(v0[2], v0[3]); w.z = cvt_pk_bf16(v1[0], v1[1]); w.w = cvt_pk_bf16(v1[2], v1[3]);
                    *(u32x4*)(rowp + bj * HALF) = w; } }
    }
};
__device__ __forceinline__ float silu_f(float x) { return x * __builtin_amdgcn_rcpf(1.0f + __expf(-x)); }
struct EpiSwiGLU {
    static constexpr bool PERM = true, AFTER_DRAIN = false;
    bf16_t* O; int ldc;
    __device__ __forceinline__ void operator()(const f32x4 (&acc)[2][2][4][2], const Unit& u, int wr, int wc, int fr, int fq) const {
        const int row0 = u.pm * BM + wr * 64 + fr; const int col0 = u.pn * HALF + wc * 32 + 8 * fq;
#pragma unroll
        for (int ai = 0; ai < 2; ++ai)
#pragma unroll
            for (int m = 0; m < 4; ++m) { bf16_t* rowp = O + (size_t)(row0 + ai * HALF + m * 16) * ldc + col0;
                const f32x4 a0 = acc[ai][0][m][0], a1 = acc[ai][0][m][1], u0 = acc[ai][1][m][0], u1 = acc[ai][1][m][1];
                u32x4 w;
                w.x = cvt_pk_bf16(silu_f(a0[0]) * u0[0], silu_f(a0[1]) * u0[1]); w.y = cvt_pk_bf16(silu_f(a0[2]) * u0[2], silu_f(a0[3]) * u0[3]);
                w.z = cvt_pk_bf16(silu_f(a1[0]) * u1[0], silu_f(a1[1]) * u1[1]); w.w = cvt_pk_bf16(silu_f(a1[2]) * u1[2], silu_f(a1[3]) * u1[3]);
                *(u32x4*)rowp = w; }
    }
};
template <class Epi, class Sched, bool ALIGN_EPI = false, bool SP2 = false>
__device__ __forceinline__ void gemm_phase(PG8_LAS unsigned char* lds, const Gemm g, const Sched& S, const Epi& E) {
    int tid_l = threadIdx.x; asm volatile("" : "+v"(tid_l));
    const int tid = tid_l, wid = __builtin_amdgcn_readfirstlane(tid >> 6), lane = tid & 63, wr = wid >> 2, wc = wid & 3, fr = lane & 15, fq = lane >> 4;
    const int K = g.K, nt = K / BK;
    unsigned voffA[2], voffB[2];
#pragma unroll
    for (int i = 0; i < 2; ++i) { int R, C; stage_rc(tid * 16 + i * 8192, R, C); const int Rb = Epi::PERM ? ((R & ~31) + perm32(R & 31)) : R;
        voffA[i] = (unsigned)(R * K + C) * 2u; voffB[i] = (unsigned)(Rb * K + C) * 2u; }
    const size_t kstep = (size_t)(BK * 2);
    const size_t hstep = (size_t)HALF * K * 2;
    const size_t tstep = 2 * hstep;
    const unsigned ldsw = (unsigned)wid * 1024u;
    const int aoff = lds_byte(wr * 64 + fr, fq * 8), boff = lds_byte(wc * 32 + fr, fq * 8);
#define PG8_SA(b, h) (((b) * 2 + (h)) * HTB)
#define PG8_SB(b, h) ((4 + (b) * 2 + (h)) * HTB)
#define PG8_STAGE(bufoff, gbase, voff) do { _Pragma("unroll") for (int _i = 0; _i < 2; ++_i) \
        __builtin_amdgcn_global_load_lds((const unsigned*)((const char*)(gbase) + (voff)[_i]), (PG8_LAS unsigned*)(lds + (bufoff) + ldsw + _i * 8192), 16, 0, 0); } while (0)
#define PG8_LDA(dst, b, h) do { _Pragma("unroll") for (int m = 0; m < 4; ++m) _Pragma("unroll") for (int k = 0; k < 2; ++k) dst[m][k] = *(const PG8_LAS bf16x8*)(lds + PG8_SA(b, h) + aoff + m * 2048 + k * 1024); } while (0)
#define PG8_LDB(dst, b, h) do { _Pragma("unroll") for (int n = 0; n < 2; ++n) _Pragma("unroll") for (int k = 0; k < 2; ++k) dst[n][k] = *(const PG8_LAS bf16x8*)(lds + PG8_SB(b, h) + boff + n * 2048 + k * 1024); } while (0)
#define PG8_MMA(ai, bj, At, Bt) do { __builtin_amdgcn_s_setprio(1); _Pragma("unroll") for (int m = 0; m < 4; ++m) _Pragma("unroll") for (int n = 0; n < 2; ++n) _Pragma("unroll") for (int k = 0; k < 2; ++k) \
        acc[ai][bj][m][n] = __builtin_amdgcn_mfma_f32_16x16x32_bf16(Bt[n][k], At[m][k], acc[ai][bj][m][n], 0, 0, 0); __builtin_amdgcn_s_setprio(0); } while (0)
#define PG8_WAIT_V(n) asm volatile("s_waitcnt vmcnt(" #n ")" ::: "memory")
#define PG8_WAIT_L(n) asm volatile("s_waitcnt lgkmcnt(" #n ")" ::: "memory")
#define PG8_BAR __builtin_amdgcn_s_barrier()
#define PG8_SCHED __builtin_amdgcn_sched_barrier(0)
    Unit cur, nxt; int ui = 0;
    if (!S.next(0, cur)) return;
    f32x4 acc[2][2][4][2];
#pragma unroll
    for (int a = 0; a < 2; ++a)
#pragma unroll
        for (int b = 0; b < 2; ++b)
#pragma unroll
            for (int m = 0; m < 4; ++m)
#pragma unroll
                for (int n = 0; n < 2; ++n) acc[a][b][m][n] = (f32x4){0.f, 0.f, 0.f, 0.f};
    bf16x8 At[4][2], B0[2][2], B1[2][2];
    const char* cA = (const char*)g.A + (size_t)cur.pm * tstep; const char* cB = (const char*)g.Bt + (size_t)cur.pn * tstep;
    S.a_ready(cur);
    if constexpr (SP2) {
        PG8_STAGE(PG8_SB(0, 0), cB, voffB); PG8_STAGE(PG8_SB(0, 1), cB + hstep, voffB); PG8_STAGE(PG8_SA(0, 0), cA, voffA); PG8_STAGE(PG8_SA(0, 1), cA + hstep, voffA);
        if (wr == 1) PG8_BAR;
        PG8_WAIT_V(2); PG8_BAR;
        PG8_STAGE(PG8_SB(1, 0), cB + kstep, voffB); PG8_STAGE(PG8_SA(1, 0), cA + kstep, voffA); PG8_STAGE(PG8_SB(1, 1), cB + hstep + kstep, voffB);
        PG8_WAIT_V(6); PG8_BAR;
    } else {
        PG8_STAGE(PG8_SB(0, 0), cB, voffB); PG8_STAGE(PG8_SA(0, 0), cA, voffA); PG8_STAGE(PG8_SB(0, 1), cB + hstep, voffB); PG8_STAGE(PG8_SA(0, 1), cA + hstep, voffA);
        if (wr == 1) PG8_BAR;
        PG8_WAIT_V(4); PG8_BAR;
        PG8_STAGE(PG8_SB(1, 0), cB + kstep, voffB); PG8_STAGE(PG8_SA(1, 0), cA + kstep, voffA); PG8_STAGE(PG8_SB(1, 1), cB + hstep + kstep, voffB);
        PG8_WAIT_V(6); PG8_BAR;
    }
    for (;;) {
        const bool has_next = S.next(ui + 1, nxt);
        const char* nA = has_next ? (const char*)g.A + (size_t)nxt.pm * tstep : cA; const char* nB = has_next ? (const char*)g.Bt + (size_t)nxt.pn * tstep : cB;
        for (int t = 0; t < nt; t += 2) {
            const bool last = (t == nt - 2);
            const char* a1 = cA + (size_t)(t + 1) * kstep;
            const char* a2 = last ? nA : cA + (size_t)(t + 2) * kstep; const char* b2 = last ? nB : cB + (size_t)(t + 2) * kstep;
            const char* a3 = a2 + kstep; const char* b3 = b2 + kstep;
            if (last && has_next) S.a_ready(nxt);
            if constexpr (SP2) {
            PG8_LDB(B0, 0, 0); PG8_LDB(B1, 0, 1); PG8_SCHED; PG8_LDA(At, 0, 0); PG8_STAGE(PG8_SA(1, 1), a1 + hstep, voffA);
            PG8_WAIT_V(8); PG8_WAIT_L(0); PG8_BAR; PG8_MMA(0, 0, At, B0); PG8_MMA(0, 1, At, B1); PG8_BAR; PG8_SCHED;
            PG8_LDA(At, 0, 1); PG8_STAGE(PG8_SB(0, 0), b2, voffB); PG8_STAGE(PG8_SB(0, 1), b2 + hstep, voffB); PG8_STAGE(PG8_SA(0, 0), a2, voffA);
            PG8_WAIT_V(8); PG8_WAIT_L(0); PG8_BAR; PG8_MMA(1, 0, At, B0); PG8_MMA(1, 1, At, B1); PG8_BAR; PG8_SCHED;
            PG8_LDB(B0, 1, 0); PG8_LDB(B1, 1, 1); PG8_SCHED; PG8_LDA(At, 1, 0); PG8_STAGE(PG8_SA(0, 1), a2 + hstep, voffA);
            PG8_WAIT_V(8); PG8_WAIT_L(0); PG8_BAR; PG8_MMA(0, 0, At, B0); PG8_MMA(0, 1, At, B1); PG8_BAR; PG8_SCHED;
            PG8_LDA(At, 1, 1); PG8_STAGE(PG8_SB(1, 0), b3, voffB); PG8_STAGE(PG8_SB(1, 1), b3 + hstep, voffB); PG8_STAGE(PG8_SA(1, 0), a3, voffA);
            PG8_WAIT_V(8); PG8_WAIT_L(0); PG8_BAR; PG8_MMA(1, 0, At, B0); PG8_MMA(1, 1, At, B1); PG8_BAR; PG8_SCHED;
            } else {
            PG8_LDB(B0, 0, 0); PG8_SCHED; PG8_LDA(At, 0, 0); PG8_STAGE(PG8_SA(1, 1), a1 + hstep, voffA);
            PG8_WAIT_L(8); PG8_BAR; PG8_WAIT_L(0); PG8_MMA(0, 0, At, B0); PG8_BAR; PG8_SCHED;
            PG8_LDB(B1, 0, 1); PG8_STAGE(PG8_SB(0, 0), b2, voffB);
            PG8_BAR; PG8_WAIT_L(0); PG8_MMA(0, 1, At, B1); PG8_BAR;
            PG8_LDA(At, 0, 1); PG8_STAGE(PG8_SA(0, 0), a2, voffA);
            PG8_BAR; PG8_WAIT_L(0); PG8_MMA(1, 0, At, B0); PG8_BAR; PG8_SCHED;
            PG8_STAGE(PG8_SB(0, 1), b2 + hstep, voffB);
            PG8_WAIT_V(6); PG8_BAR; PG8_MMA(1, 1, At, B1); PG8_BAR;
            PG8_LDB(B0, 1, 0); PG8_SCHED; PG8_LDA(At, 1, 0); PG8_STAGE(PG8_SA(0, 1), a2 + hstep, voffA);
            PG8_WAIT_L(8); PG8_BAR; PG8_WAIT_L(0); PG8_MMA(0, 0, At, B0); PG8_BAR; PG8_SCHED;
            PG8_LDB(B1, 1, 1); PG8_STAGE(PG8_SB(1, 0), b3, voffB);
            PG8_BAR; PG8_WAIT_L(0); PG8_MMA(0, 1, At, B1); PG8_BAR;
            PG8_LDA(At, 1, 1); PG8_STAGE(PG8_SA(1, 0), a3, voffA);
            PG8_BAR; PG8_WAIT_L(0); PG8_MMA(1, 0, At, B0); PG8_BAR; PG8_SCHED;
            PG8_STAGE(PG8_SB(1, 1), b3 + hstep, voffB);
            PG8_WAIT_V(6); PG8_BAR; PG8_MMA(1, 1, At, B1); PG8_BAR;
            }
        }
        if constexpr (ALIGN_EPI) { if (wr == 0) PG8_BAR; }
        if constexpr (!Epi::AFTER_DRAIN) { E(acc, cur, wr, wc, fr, fq); S.done(cur); }
        if (!has_next) break;
#pragma unroll
        for (int a = 0; a < 2; ++a)
#pragma unroll
            for (int b = 0; b < 2; ++b)
#pragma unroll
                for (int m = 0; m < 4; ++m)
#pragma unroll
                    for (int n = 0; n < 2; ++n) acc[a][b][m][n] = (f32x4){0.f, 0.f, 0.f, 0.f};
        cur = nxt; cA = nA; cB = nB; ++ui;
        if constexpr (ALIGN_EPI) { if (wr == 1) PG8_BAR; }
    }
    PG8_WAIT_V(0);
    if constexpr (!ALIGN_EPI) { if (wr == 0) PG8_BAR; }
    PG8_BAR;
    if constexpr (Epi::AFTER_DRAIN) { E.fused(acc, cur, wr, wc, fr, fq, lds, wid, lane); S.done(cur); }
#undef PG8_SA
#undef PG8_SB
#undef PG8_STAGE
#undef PG8_LDA
#undef PG8_LDB
#undef PG8_MMA
#undef PG8_WAIT_V
#undef PG8_WAIT_L
#undef PG8_BAR
#undef PG8_SCHED
}
}

constexpr int NB = 8, SEQ = 4096, DM = 1024, NL = 2, CTXL = 256;
constexpr int NLAT = NB * SEQ, NCTX = NB * CTXL, NROW = NLAT + NCTX;
constexpr int DFF = 2816, NPJ = 2816, INW = 2824, NMODW = 9 * DM;
constexpr float LN_EPS = 1e-5f, ALPHA = 1.41421356237f;
constexpr int C_AQ = 0, C_AK = 256, C_AV = 384, C_BZ = 512, C_BX = 768, C_CQ = 1536, C_CK = 1792, C_CV = 1920, C_DQ = 2048, C_DK = 2304, C_DV = 2560;
constexpr int C_DTSRC = 1536;
constexpr size_t MiB = 1u << 20;
constexpr size_t WS_MOD = 0;
constexpr size_t WS_DT = 1 * MiB;
constexpr size_t WS_W = 4 * MiB, WS_WL = 41 * MiB;
constexpr size_t WO_W1A = 0, WO_W2A = 11 * MiB, WO_WIN = 16 * MiB + MiB / 2, WO_WOUT = 22 * MiB, WO_W1B = 24 * MiB, WO_W2B = 35 * MiB;
constexpr size_t WS_A = 86 * MiB;
constexpr size_t WS_ACT = 154 * MiB;
constexpr size_t WS_U = 341 * MiB;
constexpr size_t WS_O = 392 * MiB;
constexpr size_t WS_XC = 460 * MiB;
constexpr size_t WS_Y = 468 * MiB;
constexpr size_t WS_END = 512 * MiB;
constexpr int RING_BYTES = 131072, ROPE_OFF = RING_BYTES, LDS_BYTES = 147456;
constexpr int NWAVES = 8;
constexpr bool GEMM_SP2 = true;

#define LAS __attribute__((address_space(3)))
#define DI __device__ __forceinline__
typedef unsigned short bf16;
typedef unsigned v4u __attribute__((ext_vector_type(4)));
typedef unsigned v2u __attribute__((ext_vector_type(2)));
typedef float f32x4 __attribute__((ext_vector_type(4)));

DI float bf2f(unsigned b) { return __uint_as_float(b << 16); }
DI float bflo(unsigned w) { return __uint_as_float(w << 16); }
DI float bfhi(unsigned w) { return __uint_as_float(w & 0xffff0000u); }
DI unsigned f2bf(float f) { unsigned u = __float_as_uint(f); return (u + 0x7fffu + ((u >> 16) & 1u)) >> 16; }
DI unsigned pk2(float lo, float hi) { return f2bf(lo) | (f2bf(hi) << 16); }
typedef float f32x2_t __attribute__((ext_vector_type(2))); typedef __bf16 bf16x2_t __attribute__((ext_vector_type(2)));
DI unsigned cvtpk(float lo, float hi) { f32x2_t v = {lo, hi}; bf16x2_t b = __builtin_convertvector(v, bf16x2_t); return __builtin_bit_cast(unsigned, b); }
DI float wave_sum(float v) {
#pragma unroll
    for (int o = 1; o < 64; o <<= 1) v += __shfl_xor(v, o);
    return v;
}
DI float silu(float x) { return x / (1.0f + __expf(-x)); }

struct Args { const float* in[24]; float* out; unsigned char* ws; };
typedef const __attribute__((address_space(4))) Args* KArgs;
DI KArgs kargs() { KArgs p = (KArgs)__builtin_amdgcn_kernarg_segment_ptr(); asm volatile("" : "+s"(p)); return p; }

struct Frame {
    LAS unsigned char* lds;
    int tid, lane, wave, G, gw, ngw;
};
DI Frame mkframe() { Frame F; extern __shared__ __attribute__((aligned(16))) unsigned char lds_base[]; F.lds = (LAS unsigned char*)lds_base;
    int t = threadIdx.x; asm volatile("" : "+v"(t)); F.tid = t; F.lane = t & 63; F.wave = __builtin_amdgcn_readfirstlane(t >> 6);
    F.G = gridDim.x; F.gw = blockIdx.x * NWAVES + F.wave; F.ngw = F.G * NWAVES; return F; }
DI bf16* wbuf(KArgs KA, int l, size_t off) { return (bf16*)((KA->ws) + WS_W + (size_t)l * WS_WL + off); }

DI void transpose_item(const float* W, int ldw, int k0, int n0, bf16* WT, int ldt, int drow0, LAS float* scr, int lane) {
    float tv[32];
#pragma unroll
    for (int i = 0; i < 32; ++i) tv[i] = W[(size_t)(k0 + 2 * i + (lane >> 5)) * ldw + n0 + (lane & 31)];
#pragma unroll
    for (int i = 0; i < 32; ++i) scr[(2 * i + (lane >> 5)) * 33 + (lane & 31)] = tv[i];
    asm volatile("s_waitcnt lgkmcnt(0)" ::: "memory");
    const int c = lane & 7;
#pragma unroll
    for (int j = 0; j < 4; ++j) { const int n = (lane >> 3) + 8 * j; const LAS float* s = scr + (8 * c) * 33 + n;
        v4u o; o.x = pk2(s[0 * 33], s[1 * 33]); o.y = pk2(s[2 * 33], s[3 * 33]); o.z = pk2(s[4 * 33], s[5 * 33]); o.w = pk2(s[6 * 33], s[7 * 33]);
        *(v4u*)(WT + (size_t)(drow0 + n) * ldt + k0 + 8 * c) = o; }
    asm volatile("s_waitcnt lgkmcnt(0)" ::: "memory");
}
DI void p0a() {
    KArgs KA = kargs(); Frame F = mkframe();
    {
        LAS float* sv = (LAS float*)F.lds;
        for (int it = blockIdx.x; it < NL * 16 * 9; it += F.G) {
            const int l = it / 144, kc = (it % 144) / 9, cb = it % 9;
            __syncthreads();
            for (int i = F.tid; i < 576; i += 512) { const int r = i >> 6, kk = i & 63; const float v = r < 8 ? KA->in[1][r * DM + kc * 64 + kk] : KA->in[3][kc * 64 + kk]; sv[i] = silu(v); }
            __syncthreads();
            const int cg4 = F.tid & 255, kh = F.tid >> 8, col = cb * 1024 + 4 * cg4;
            f32x4 acc[9];
#pragma unroll
            for (int r = 0; r < 9; ++r) acc[r] = (f32x4){0.f, 0.f, 0.f, 0.f};
            const float* wp = KA->in[4] + ((size_t)l * DM + kc * 64 + kh * 32) * NMODW + col;
#pragma unroll 8
            for (int kk = 0; kk < 32; ++kk) { const f32x4 w = *(const f32x4*)(wp + (size_t)kk * NMODW);
#pragma unroll
                for (int r = 0; r < 9; ++r) acc[r] += w * sv[r * 64 + kh * 32 + kk]; }
#pragma unroll
            for (int r = 0; r < 9; ++r) *(f32x4*)(((float*)(KA->ws + WS_ACT)) + ((size_t)(l * 32 + kc * 2 + kh) * 9 + r) * NMODW + col) = acc[r];
        }
        __syncthreads();
    }
    LAS float* scr = (LAS float*)(F.lds + F.wave * 16384);
    constexpr int I1 = 16 * 176, I2 = 44 * 32, I3 = 16 * 88, I4 = 16 * 32, IL = 2 * I1 + 2 * I2 + I3 + I4;
    for (int it = F.gw; it < NL * IL; it += F.ngw) {
        const int l = it / IL; int r = it % IL;
        if (r < I1 || (r >= I1 + I2 + I3 + I4 && r < 2 * I1 + I2 + I3 + I4)) {
            const bool second = r >= I1; if (second) r -= I1 + I2 + I3 + I4;
            const int kb = r / 176, nb = r % 176, n0 = nb * 32;
            const int drow = n0 < DFF ? 256 * (n0 >> 7) + (n0 & 127) : 256 * ((n0 - DFF) >> 7) + 128 + ((n0 - DFF) & 127);
            transpose_item((second ? KA->in[22] : KA->in[8]) + (size_t)l * DM * 2 * DFF, 2 * DFF, kb * 64, n0, wbuf(KA, l, second ? WO_W1B : WO_W1A), DM, drow, scr, F.lane);
            continue; }
        r -= I1;
        if (r < I2) { const int kb = r / 32, nb = r % 32; transpose_item(KA->in[9] + (size_t)l * DFF * DM, DM, kb * 64, nb * 32, wbuf(KA, l, WO_W2A), DFF, nb * 32, scr, F.lane); continue; }
        r -= I2;
        if (r < I3) { const int kb = r / 88, nb = r % 88; const int n0 = nb < 48 ? nb * 32 : 1544 + (nb - 48) * 32;
            transpose_item(KA->in[10] + (size_t)l * DM * INW, INW, kb * 64, n0, wbuf(KA, l, WO_WIN), DM, nb * 32, scr, F.lane); continue; }
        r -= I3;
        if (r < I4) { const int kb = r / 32, nb = r % 32; transpose_item(KA->in[11] + (size_t)l * DM * DM, DM, kb * 64, nb * 32, wbuf(KA, l, WO_WOUT), DM, nb * 32, scr, F.lane); continue; }
        r -= I4 + I1;
        { const int kb = r / 32, nb = r % 32; transpose_item(KA->in[23] + (size_t)l * DFF * DM, DM, kb * 64, nb * 32, wbuf(KA, l, WO_W2B), DFF, nb * 32, scr, F.lane); }
    }
}
DI void p0b() {
    KArgs KA = kargs(); Frame F = mkframe();
    for (int i = blockIdx.x * 512 + F.tid; i < NL * 9 * NMODW; i += F.G * 512) {
        const int l = i / (9 * NMODW), rr = (i / NMODW) % 9, n = i % NMODW;
        float s = KA->in[5][l * NMODW + n];
        for (int p = 0; p < 32; ++p) s += ((float*)(KA->ws + WS_ACT))[((size_t)(l * 32 + p) * 9 + rr) * NMODW + n];
        ((float*)(KA->ws + WS_MOD))[i] = s;
    }
}
DI const float* modp(KArgs KA, int l, int mb, int idx) { return ((float*)(KA->ws + WS_MOD)) + ((size_t)(l * 9 + mb) * 9 + idx) * DM; }
DI void p0c() {
    KArgs KA = kargs(); Frame F = mkframe();
    for (int row = F.gw; row < NROW; row += F.ngw) {
        const int mb = row < NLAT ? (row >> 12) : 8;
        const float* src = row < NLAT ? KA->in[0] + (size_t)row * DM : KA->in[2] + (size_t)(row - NLAT) * DM;
        const float* sh = modp(KA, 0, mb, 0); const float* sc = modp(KA, 0, mb, 1);
#pragma unroll
        for (int j = 0; j < 4; ++j) { const int n = 4 * F.lane + 256 * j; const f32x4 v = *(const f32x4*)(src + n);
            const f32x4 a = v * (1.0f + *(const f32x4*)(sc + n)) + *(const f32x4*)(sh + n);
            v2u w; w.x = pk2(a.x, a.y); w.y = pk2(a.z, a.w); *(v2u*)(((bf16*)(KA->ws + WS_A)) + (size_t)row * DM + n) = w; }
    }
}
DI void ln_pass(int l, int gidx, float gmul, int lnidx, int nl, int nsh, int row0, int nrows, int wg0, int nwgs, const bool DTP) {
    KArgs KA = kargs(); Frame F = mkframe();
    F.gw = row0 + ((int)blockIdx.x - wg0) * NWAVES + F.wave; F.ngw = nwgs * NWAVES;
    LAS float* wdt = (LAS float*)F.lds;
    if (DTP) { __syncthreads(); for (int i = F.tid; i < 8192; i += 512) wdt[i] = KA->in[10][((size_t)l * DM + (i >> 3)) * INW + C_DTSRC + (i & 7)]; __syncthreads(); }
    const float* g = KA->in[6] + (l * 3 + lnidx) * DM; const float* bb = KA->in[7] + (l * 3 + lnidx) * DM;
    float* const xlat = KA->out; float* const xctx = (float*)(KA->ws + WS_XC); const bf16* const fbase = (const bf16*)(KA->ws + WS_O);
    const bool fromin = (l == 0 && lnidx == 0);
    const float* const slat = fromin ? KA->in[0] : (const float*)xlat; const float* const sctx = fromin ? KA->in[2] : (const float*)xctx;
    f32x4 xn[4]; v2u fn[4];
    if (F.gw < nrows) { const int row = F.gw; const float* xr = row < NLAT ? slat + (size_t)row * DM : sctx + (size_t)(row - NLAT) * DM;
#pragma unroll
        for (int j = 0; j < 4; ++j) { const int n = 4 * F.lane + 256 * j; xn[j] = *(const f32x4*)(xr + n); fn[j] = *(const v2u*)(fbase + (size_t)row * DM + n); } }
    for (int row = F.gw; row < nrows; row += F.ngw) {
        const int mb = row < NLAT ? (row >> 12) : 8;
        float* xrow = row < NLAT ? xlat + (size_t)row * DM : xctx + (size_t)(row - NLAT) * DM;
        const float* gate = modp(KA, l, mb, gidx);
        f32x4 v[4]; float s = 0.f;
#pragma unroll
        for (int j = 0; j < 4; ++j) { const int n = 4 * F.lane + 256 * j; const f32x4 gt = *(const f32x4*)(gate + n);
            const f32x4 fv = (f32x4){bflo(fn[j].x), bfhi(fn[j].x), bflo(fn[j].y), bfhi(fn[j].y)};
            v[j] = xn[j] * ALPHA + gt * fv * gmul; s += (v[j].x + v[j].y) + (v[j].z + v[j].w); }
        { const int nrow = row + F.ngw;
          if (nrow < nrows) { const float* xr = nrow < NLAT ? slat + (size_t)nrow * DM : sctx + (size_t)(nrow - NLAT) * DM;
#pragma unroll
            for (int j = 0; j < 4; ++j) { const int n = 4 * F.lane + 256 * j; xn[j] = *(const f32x4*)(xr + n); fn[j] = *(const v2u*)(fbase + (size_t)nrow * DM + n); } } }
        const float mean = wave_sum(s) * (1.f / DM); float s2 = 0.f;
#pragma unroll
        for (int j = 0; j < 4; ++j) { v[j] = v[j] - mean; s2 += (v[j].x * v[j].x + v[j].y * v[j].y) + (v[j].z * v[j].z + v[j].w * v[j].w); }
        const float rstd = 1.f / sqrtf(wave_sum(s2) * (1.f / DM) + LN_EPS);
        float dt[8];
#pragma unroll
        for (int q = 0; q < 8; ++q) dt[q] = 0.f;
#pragma unroll
        for (int j = 0; j < 4; ++j) { const int n = 4 * F.lane + 256 * j;
            const f32x4 y = v[j] * rstd * *(const f32x4*)(g + n) + *(const f32x4*)(bb + n);
            *(f32x4*)(xrow + n) = y;
            if (nsh >= 0) { const f32x4 a = y * (1.0f + *(const f32x4*)(modp(KA, nl, mb, nsh + 1) + n)) + *(const f32x4*)(modp(KA, nl, mb, nsh) + n);
                v2u w; w.x = cvtpk(a.x, a.y); w.y = cvtpk(a.z, a.w); *(v2u*)(((bf16*)(KA->ws + WS_A)) + (size_t)row * DM + n) = w;
                if (DTP) {
#pragma unroll
                    for (int e = 0; e < 4; ++e) { const f32x4 w0 = *(const LAS f32x4*)(wdt + (n + e) * 8), w1 = *(const LAS f32x4*)(wdt + (n + e) * 8 + 4); const float ae = a[e];
                        dt[0] += ae * w0.x; dt[1] += ae * w0.y; dt[2] += ae * w0.z; dt[3] += ae * w0.w; dt[4] += ae * w1.x; dt[5] += ae * w1.y; dt[6] += ae * w1.z; dt[7] += ae * w1.w; } } }
        }
        if (DTP) {
#pragma unroll
            for (int q = 0; q < 8; ++q) dt[q] = wave_sum(dt[q]);
            if (F.lane == 0) { *(f32x4*)(((float*)(KA->ws + WS_DT)) + (size_t)row * 8) = (f32x4){dt[0], dt[1], dt[2], dt[3]}; *(f32x4*)(((float*)(KA->ws + WS_DT)) + (size_t)row * 8 + 4) = (f32x4){dt[4], dt[5], dt[6], dt[7]}; }
        }
    }
}
DI void prep_pass(int l) {
    KArgs KA = kargs(); Frame F = mkframe();
    const LAS float* rc = (const LAS float*)(F.lds + ROPE_OFF); const LAS float* rsn = rc + 1024;
    bf16* P = (bf16*)(KA->ws + WS_ACT); bf16* U = (bf16*)(KA->ws + WS_U); float* DTB = (float*)(KA->ws + WS_DT);
    const int hv = F.lane >> 5, s = F.lane & 31, hsub = s >> 3, ra = (s >> 2) & 1, ig = s & 3, d1 = ra * 32 + 4 * ig, d2 = d1 + 16;
    constexpr int NBLK = NROW / 8;
    for (int item = F.gw; item < 4 * NBLK; item += F.ngw) {
        const int part = item / NBLK, rb = item - part * NBLK;
        const int row8 = rb * 8; const bool lat = row8 < NLAT;
        if (part == 0) {
#pragma unroll 1
        for (int rr = 0; rr < 4; ++rr) {
            const int row = row8 + 2 * rr + hv; const int t = row & 4095;
            const int pos = ra == 0 ? (t >> 6) : (t & 63);
            const f32x4 cs = *(const LAS f32x4*)(rc + pos * 16 + 4 * ig), sn = *(const LAS f32x4*)(rsn + pos * 16 + 4 * ig);
            bf16* pr = P + (size_t)row * NPJ;
#pragma unroll
            for (int it = 0; it < 3; ++it) {
                const int hh = it * 4 + hsub;
                const bool isc = hh >= 6; const int h6 = isc ? hh - 6 : hh;
                const int col = (isc ? (h6 < 4 ? C_CQ + h6 * 64 : C_CK + (h6 - 4) * 64) : (h6 < 4 ? C_AQ + h6 * 64 : C_AK + (h6 - 4) * 64));
                const v2u w1 = *(const v2u*)(pr + col + d1), w2 = *(const v2u*)(pr + col + d2);
                f32x4 x1 = (f32x4){bflo(w1.x), bfhi(w1.x), bflo(w1.y), bfhi(w1.y)}, x2 = (f32x4){bflo(w2.x), bfhi(w2.x), bflo(w2.y), bfhi(w2.y)};
                float ss = (x1.x * x1.x + x1.y * x1.y) + (x1.z * x1.z + x1.w * x1.w) + (x2.x * x2.x + x2.y * x2.y) + (x2.z * x2.z + x2.w * x2.w);
                ss += __shfl_xor(ss, 1); ss += __shfl_xor(ss, 2); ss += __shfl_xor(ss, 4);
                if (isc) { const float r = (h6 < 4 ? 0.125f * 1.4426950408889634f : 1.0f) / sqrtf(ss * (1.f / 64.f) + LN_EPS); const float* gn = (h6 < 4 ? KA->in[19] : KA->in[20]) + l * 64;
                    x1 = x1 * r * *(const f32x4*)(gn + d1); x2 = x2 * r * *(const f32x4*)(gn + d2); }
                if (lat) { const f32x4 y1 = x1 * cs - x2 * sn, y2 = x1 * sn + x2 * cs; x1 = y1; x2 = y2; }
                if (isc || lat) { v2u o1, o2; o1.x = cvtpk(x1.x, x1.y); o1.y = cvtpk(x1.z, x1.w); o2.x = cvtpk(x2.x, x2.y); o2.y = cvtpk(x2.z, x2.w);
                    *(v2u*)(pr + col + d1) = o1; *(v2u*)(pr + col + d2) = o2; }
            }
        }
        { const int row = row8 + (F.lane >> 3), q = F.lane & 7; const float v = DTB[(size_t)row * 8 + q] + KA->in[16][l * 8 + q]; DTB[(size_t)row * 8 + q] = fmaxf(v, 0.f) + log1pf(__expf(-fabsf(v))); }
        } else {
        const int Ls = lat ? SEQ : CTXL; const int tt0 = lat ? (row8 & 4095) : ((row8 - NLAT) & 255);
        { const int j = part - 1; const int ch = 4 * F.lane + 256 * j;
            const f32x4 bias = *(const f32x4*)(KA->in[15] + l * 768 + ch);
            f32x4 cw[5];
#pragma unroll
            for (int k = 0; k < 5; ++k) cw[k] = *(const f32x4*)(KA->in[14] + (l * 5 + k) * 768 + ch);
            f32x4 xw[12];
#pragma unroll
            for (int q = 0; q < 12; ++q) { const int t2 = tt0 + q - 2;
                if (t2 >= 0 && t2 < Ls) { const v2u w = *(const v2u*)(P + (size_t)(row8 + q - 2) * NPJ + C_BX + ch); xw[q] = (f32x4){bflo(w.x), bfhi(w.x), bflo(w.y), bfhi(w.y)}; }
                else xw[q] = (f32x4){0.f, 0.f, 0.f, 0.f}; }
#pragma unroll
            for (int q = 0; q < 8; ++q) { f32x4 acc = bias;
#pragma unroll
                for (int k = 0; k < 5; ++k) acc += cw[k] * xw[q + k];
                v2u o; o.x = cvtpk(silu(acc.x), silu(acc.y)); o.y = cvtpk(silu(acc.z), silu(acc.w)); *(v2u*)(U + (size_t)(row8 + q) * 768 + ch) = o; }
        }
        }
    }
}
DI void nkey(const float (&q)[64], float (&o)[64], float& m, float& l, const bf16* kr, const bf16* vr, float bias) {
    float s = bias;
#pragma unroll
    for (int c = 0; c < 8; ++c) { const v4u w = *(const v4u*)(kr + 8 * c);
        s += q[8 * c] * bflo(w.x) + q[8 * c + 1] * bfhi(w.x) + q[8 * c + 2] * bflo(w.y) + q[8 * c + 3] * bfhi(w.y) + q[8 * c + 4] * bflo(w.z) + q[8 * c + 5] * bfhi(w.z) + q[8 * c + 6] * bflo(w.w) + q[8 * c + 7] * bfhi(w.w); }
    const float mn = fmaxf(m, s), cf = __expf(m - mn), p = __expf(s - mn);
    l = l * cf + p; m = mn;
#pragma unroll
    for (int c = 0; c < 8; ++c) { const v4u w = *(const v4u*)(vr + 8 * c);
        o[8 * c] = o[8 * c] * cf + p * bflo(w.x); o[8 * c + 1] = o[8 * c + 1] * cf + p * bfhi(w.x); o[8 * c + 2] = o[8 * c + 2] * cf + p * bflo(w.y); o[8 * c + 3] = o[8 * c + 3] * cf + p * bfhi(w.y);
        o[8 * c + 4] = o[8 * c + 4] * cf + p * bflo(w.z); o[8 * c + 5] = o[8 * c + 5] * cf + p * bfhi(w.z); o[8 * c + 6] = o[8 * c + 6] * cf + p * bflo(w.w); o[8 * c + 7] = o[8 * c + 7] * cf + p * bfhi(w.w); }
}
template <int TYPE>
DI void naive_attn(int l, int row, int h, bool ctxq) {
    KArgs KA = kargs(); Frame F = mkframe();
    const bf16* P = ((bf16*)(KA->ws + WS_ACT));
    const int qcol = (TYPE == 0 ? C_AQ : TYPE == 1 ? C_CQ : C_DQ) + h * 64;
    const int kvh = TYPE == 2 ? h : (h >> 1);
    const int kcol = (TYPE == 0 ? C_AK : TYPE == 1 ? C_CK : C_DK) + kvh * 64, vcol = (TYPE == 0 ? C_AV : TYPE == 1 ? C_CV : C_DV) + kvh * 64;
    float q[64], o[64]; float m = -1e30f, ls = 0.f;
#pragma unroll
    for (int c = 0; c < 8; ++c) { const v4u w = *(const v4u*)(P + (size_t)row * NPJ + qcol + 8 * c);
        q[8 * c] = 0.125f * bflo(w.x); q[8 * c + 1] = 0.125f * bfhi(w.x); q[8 * c + 2] = 0.125f * bflo(w.y); q[8 * c + 3] = 0.125f * bfhi(w.y);
        q[8 * c + 4] = 0.125f * bflo(w.z); q[8 * c + 5] = 0.125f * bfhi(w.z); q[8 * c + 6] = 0.125f * bflo(w.w); q[8 * c + 7] = 0.125f * bfhi(w.w); }
#pragma unroll
    for (int d = 0; d < 64; ++d) o[d] = 0.f;
    int b;
    if (!ctxq) {
        b = row >> 12; const int t = row & 4095;
        if (TYPE == 0) { const int k0 = max(t - 128, 0), k1 = min(t + 128, SEQ - 1);
            for (int k = k0; k <= k1; ++k) { const bf16* kp = P + (size_t)(b * SEQ + k) * NPJ; nkey(q, o, m, ls, kp + kcol, kp + vcol, 0.f); } }
        else if (TYPE == 1) { for (int k = 0; k < SEQ; ++k) { const bf16* kp = P + (size_t)(b * SEQ + k) * NPJ; nkey(q, o, m, ls, kp + kcol, kp + vcol, 0.f); } }
        else { const int r = t >> 6, c = t & 63; const int rs = min(max(r - 4, 0), 56), cs = min(max(c - 8, 0), 48);
            for (int a = 0; a < 8; ++a) { const float* bp = KA->in[21] + ((size_t)(l * 4 + h) * 15 + (rs + a - r + 7)) * 31 + (cs - c + 15);
                for (int k = 0; k < 16; ++k) { const bf16* kp = P + (size_t)(b * SEQ + (rs + a) * 64 + cs + k) * NPJ; nkey(q, o, m, ls, kp + kcol, kp + vcol, bp[k]); } } }
    } else b = (row - NLAT) >> 8;
    for (int k = 0; k < CTXL; ++k) { const bf16* kp = P + (size_t)(NLAT + b * CTXL + k) * NPJ; nkey(q, o, m, ls, kp + kcol, kp + vcol, 0.f); }
    if (TYPE == 0) { const float sk = KA->in[13][l * 4 + h]; const float mn = fmaxf(m, sk), cf = __expf(m - mn); ls = ls * cf + __expf(sk - mn);
#pragma unroll
        for (int d = 0; d < 64; ++d) o[d] *= cf; }
    const float inv = 1.f / ls;
    bf16* op = ((bf16*)(KA->ws + WS_O)) + (size_t)row * DM + (TYPE == 0 ? 0 : TYPE == 1 ? 512 : 768) + h * 64;
#pragma unroll
    for (int c = 0; c < 8; ++c) { v4u w; w.x = pk2(o[8 * c] * inv, o[8 * c + 1] * inv); w.y = pk2(o[8 * c + 2] * inv, o[8 * c + 3] * inv); w.z = pk2(o[8 * c + 4] * inv, o[8 * c + 5] * inv); w.w = pk2(o[8 * c + 6] * inv, o[8 * c + 7] * inv);
        *(v4u*)(op + 8 * c) = w; }
}
DI void naive_ssd(int l, int item) {
    KArgs KA = kargs(); Frame F = mkframe();
    const int b = item >> 3, dir = (item >> 2) & 1, h = item & 3, g = h >> 1;
    const int p = F.tid >> 3, ng = F.tid & 7;
    const float A = -__expf(KA->in[17][l * 8 + dir * 4 + h]);
    bf16* Y = dir ? (((bf16*)(KA->ws + WS_Y) + (size_t)NROW * 256)) : ((bf16*)(KA->ws + WS_Y));
    float hs[16];
#pragma unroll
    for (int i = 0; i < 16; ++i) hs[i] = 0.f;
    for (int ph = 0; ph < 2; ++ph) {
        const int ns = ph ? SEQ : CTXL, base = ph ? b * SEQ : NLAT + b * CTXL;
#pragma unroll 4
        for (int s = 0; s < ns; ++s) {
            const int row = base + (dir ? ns - 1 - s : s);
            const float dt = ((float*)(KA->ws + WS_DT))[(size_t)row * 8 + dir * 4 + h];
            const bf16* ur = ((bf16*)(KA->ws + WS_U)) + (size_t)row * 768;
            const float xv = bf2f(ur[h * 64 + p]);
            const v4u b0 = *(const v4u*)(ur + 256 + g * 128 + ng * 16), b1 = *(const v4u*)(ur + 256 + g * 128 + ng * 16 + 8);
            const v4u c0 = *(const v4u*)(ur + 512 + g * 128 + ng * 16), c1 = *(const v4u*)(ur + 512 + g * 128 + ng * 16 + 8);
            const float dA = __expf(dt * A), dx = dt * xv;
            const unsigned bw[8] = {b0.x, b0.y, b0.z, b0.w, b1.x, b1.y, b1.z, b1.w}, cw[8] = {c0.x, c0.y, c0.z, c0.w, c1.x, c1.y, c1.z, c1.w};
            float y = 0.f;
#pragma unroll
            for (int i = 0; i < 8; ++i) { hs[2 * i] = hs[2 * i] * dA + dx * bflo(bw[i]); hs[2 * i + 1] = hs[2 * i + 1] * dA + dx * bfhi(bw[i]); y += bflo(cw[i]) * hs[2 * i] + bfhi(cw[i]) * hs[2 * i + 1]; }
            y += __shfl_xor(y, 1); y += __shfl_xor(y, 2); y += __shfl_xor(y, 4);
            if (ng == 0) Y[(size_t)row * 256 + h * 64 + p] = (bf16)f2bf(y);
        }
    }
}
DI void mixers_naive(int l, bool last) {
    Frame F = mkframe();
    const int nAttL = 64 * 12, nAttC = last ? 0 : 4 * 12, nItems = 64 + nAttL + nAttC;
    for (int it = blockIdx.x; it < nItems; it += F.G) {
        if (it < 64) { naive_ssd(l, it); continue; }
        int r = it - 64; bool cq = false; int rowbase;
        if (r >= nAttL) { r -= nAttL; cq = true; }
        const int rb = r / 12, ty = (r % 12) >> 2, h = r & 3;
        rowbase = cq ? NLAT + rb * 512 : rb * 512;
        const int row = rowbase + F.tid;
        if (ty == 0) naive_attn<0>(l, row, h, cq); else if (ty == 1) naive_attn<1>(l, row, h, cq); else naive_attn<2>(l, row, h, cq);
    }
}
typedef float f32x16 __attribute__((ext_vector_type(16)));
typedef short s16x4 __attribute__((ext_vector_type(4)));
typedef short bf16x8v __attribute__((ext_vector_type(8)));
typedef short v4i16_t __attribute__((ext_vector_type(4)));
DI s16x4 vtr(const LAS unsigned char* p) { return __builtin_bit_cast(s16x4, __builtin_amdgcn_ds_read_tr16_b64_v4i16((LAS v4i16_t*)p)); }
DI int crow16(int i, int h) { return (i & 3) + 8 * (i >> 2) + 4 * h; }
constexpr int AT_KRS = 144, AT_VRS = 192, AT_KB = 64 * AT_KRS, AT_BUF = AT_KB + 64 * AT_VRS, AT_RPB = 2 * AT_BUF;
constexpr float LOG2E = 1.4426950408889634f, AT_SC = 0.125f * LOG2E;
template <int TYPE>
DI void attn_unit(KArgs KA, const Frame& F, int l, int unit, bool ctxq) {
    const bf16* P = (const bf16*)(KA->ws + WS_ACT);
    const int L = F.lane, w = F.wave, r = L & 31, h2 = L >> 5, i16 = L & 15;
    int b, head, kvh, p0, qpos0, t0 = 0, nloc = 0;
    if (TYPE != 2) { int g, pb; if (!ctxq) { b = unit >> 6; g = (unit >> 5) & 1; pb = unit & 31; } else { b = unit >> 2; g = (unit >> 1) & 1; pb = unit & 1; }
        head = 2 * g + (w >> 2); kvh = g; p0 = pb * 128; qpos0 = p0 + 32 * (w & 3);
        if (!ctxq) { if (TYPE == 1) { t0 = 0; nloc = 64; } else { t0 = max(0, 2 * (pb - 1)); nloc = min(64, 2 * (pb + 2)) - t0; } } }
    else { int rb; if (!ctxq) { b = unit >> 6; head = (unit >> 4) & 3; rb = unit & 15; } else { b = unit >> 2; head = unit & 3; rb = 0; }
        kvh = head; p0 = rb * 256; qpos0 = p0 + 32 * w;
        if (!ctxq) { const int r0 = rb * 4; t0 = min(max(r0 - 4, 0), 56); nloc = min(max(r0 - 1, 0), 56) + 8 - t0; } }
    const int qcol = (TYPE == 0 ? C_AQ : TYPE == 1 ? C_CQ : C_DQ) + head * 64;
    const int kcol = (TYPE == 0 ? C_AK : TYPE == 1 ? C_CK : C_DK) + kvh * 64, vcol = (TYPE == 0 ? C_AV : TYPE == 1 ? C_CV : C_DV) + kvh * 64;
    const int qrow = (ctxq ? NLAT + b * CTXL : b * SEQ) + qpos0 + r;
    const int nt = nloc + 4;
    bf16x8v qf[4];
#pragma unroll
    for (int ks = 0; ks < 4; ++ks) qf[ks] = *(const bf16x8v*)(P + (size_t)qrow * NPJ + qcol + ks * 16 + 8 * h2);
    LAS unsigned char* lb = F.lds;
    if (TYPE == 2) { LAS float* rp = (LAS float*)(lb + AT_RPB); for (int i = F.tid; i < 465; i += 512) rp[i] = KA->in[21][(size_t)(l * 4 + head) * 465 + i] * 8.0f; }
    const int srow = F.tid >> 3, sch = F.tid & 7;
#define TILE_ROW0(i) ((i) < nloc ? b * SEQ + (t0 + (i)) * 64 : NLAT + b * CTXL + ((i) - nloc) * 64)
    v4u kreg, vreg;
    { const bf16* src = P + (size_t)(TILE_ROW0(0) + srow) * NPJ; kreg = *(const v4u*)(src + kcol + sch * 8); vreg = *(const v4u*)(src + vcol + sch * 8); }
    *(LAS v4u*)(lb + srow * AT_KRS + sch * 16) = kreg; *(LAS v4u*)(lb + AT_KB + srow * AT_VRS + sch * 16) = vreg;
    __syncthreads();
    f32x16 oacc[2];
#pragma unroll
    for (int i = 0; i < 16; ++i) { oacc[0][i] = 0.f; oacc[1][i] = 0.f; }
    float m = -1e30f, lsum = 0.f;
    if (TYPE == 1) {
        float gq = fabsf(KA->in[19][l * 64 + L]), gk = fabsf(KA->in[20][l * 64 + L]);
#pragma unroll
        for (int o = 1; o < 64; o <<= 1) { gq = fmaxf(gq, __shfl_xor(gq, o)); gk = fmaxf(gk, __shfl_xor(gk, o)); }
        m = 64.0f * 1.03f * gq * gk * AT_SC;
    }
    const int qpos = qpos0 + r;
    const int gr = qpos0 >> 6, rs = min(max(gr - 4, 0), 56), qc = qpos & 63, cs = min(max(qc - 8, 0), 48);
    for (int i = 0; i < nt; ++i) {
        const LAS unsigned char* kb_ = lb + (i & 1) * AT_BUF; const LAS unsigned char* vb_ = kb_ + AT_KB;
        if (i + 1 < nt) { const bf16* src = P + (size_t)(TILE_ROW0(i + 1) + srow) * NPJ; kreg = *(const v4u*)(src + kcol + sch * 8); vreg = *(const v4u*)(src + vcol + sch * 8); }
        const bool loc = i < nloc;
        bool skip = false;
        const int k0 = (t0 + i) * 64;
        if (loc && TYPE == 0) skip = (k0 + 63 < qpos0 - 128) || (k0 > qpos0 + 31 + 128);
        if (loc && TYPE == 2) skip = (t0 + i < rs) || (t0 + i >= rs + 8);
        if (!skip) {
            f32x16 sacc[2];
            bf16x8v kf[2][4], vf[2][2][2];
#pragma unroll
            for (int kb = 0; kb < 2; ++kb)
#pragma unroll
                for (int ks = 0; ks < 4; ++ks) kf[kb][ks] = *(const LAS bf16x8v*)(kb_ + (kb * 32 + r) * AT_KRS + ks * 32 + 16 * h2);
#pragma unroll
            for (int kb = 0; kb < 2; ++kb)
#pragma unroll
                for (int s = 0; s < 2; ++s)
#pragma unroll
                    for (int db = 0; db < 2; ++db) {
                        const LAS unsigned char* va = vb_ + (kb * 32 + 16 * s + 4 * h2 + (i16 >> 2)) * AT_VRS + (db * 32 + 16 * ((L >> 4) & 1) + 4 * (i16 & 3)) * 2;
                        const s16x4 lo = vtr(va), hi = vtr(va + 8 * AT_VRS);
                        vf[kb][s][db] = (bf16x8v){lo[0], lo[1], lo[2], lo[3], hi[0], hi[1], hi[2], hi[3]}; }
            __builtin_amdgcn_sched_barrier(0);
#pragma unroll
            for (int kb = 0; kb < 2; ++kb) {
#pragma unroll
                for (int q = 0; q < 16; ++q) sacc[kb][q] = (TYPE == 1) ? -m : 0.f;
#pragma unroll
                for (int ks = 0; ks < 4; ++ks) sacc[kb] = __builtin_amdgcn_mfma_f32_32x32x16_bf16(kf[kb][ks], qf[ks], sacc[kb], 0, 0, 0);
            }
            float tmax = -INFINITY;
            if ((TYPE == 0 || TYPE == 2) && loc) {
#pragma unroll
                for (int kb = 0; kb < 2; ++kb)
#pragma unroll
                    for (int q = 0; q < 16; ++q) { float s = sacc[kb][q]; const int kk = kb * 32 + crow16(q, h2);
                        if (TYPE == 0) { const int d = k0 + kk - qpos; if (d > 128 || d < -128) s = -INFINITY; }
                        if (TYPE == 2) { const int dc = kk - cs; const LAS float* rp = (const LAS float*)(lb + AT_RPB);
                            if (dc < 0 || dc >= 16) s = -INFINITY; else s += rp[(t0 + i - gr + 7) * 31 + (kk - qc + 15)]; }
                        sacc[kb][q] = s; }
            }
            if (TYPE != 1) {
#pragma unroll
                for (int kb = 0; kb < 2; ++kb)
#pragma unroll
                    for (int q = 0; q < 16; ++q) tmax = fmaxf(tmax, sacc[kb][q]);
                tmax = fmaxf(tmax, __shfl_xor(tmax, 32));
                const float mn = fmaxf(m, tmax);
                if (__any(mn > m)) {
                    const float alpha = __builtin_amdgcn_exp2f((m - mn) * AT_SC);
                    lsum *= alpha;
#pragma unroll
                    for (int q = 0; q < 16; ++q) { oacc[0][q] *= alpha; oacc[1][q] *= alpha; }
                }
                m = mn;
            }
            const float mns = -m * AT_SC;
            float psum = 0.f;
#pragma unroll
            for (int kb = 0; kb < 2; ++kb)
#pragma unroll
                for (int q = 0; q < 16; ++q) { const float p = (TYPE == 1) ? __builtin_amdgcn_exp2f(sacc[kb][q]) : __builtin_amdgcn_exp2f(__builtin_fmaf(sacc[kb][q], AT_SC, mns)); sacc[kb][q] = p; psum += p; }
            lsum += psum;
#pragma unroll
            for (int kb = 0; kb < 2; ++kb)
#pragma unroll
                for (int s = 0; s < 2; ++s) {
                    v4u pw; pw.x = cvtpk(sacc[kb][8 * s], sacc[kb][8 * s + 1]); pw.y = cvtpk(sacc[kb][8 * s + 2], sacc[kb][8 * s + 3]); pw.z = cvtpk(sacc[kb][8 * s + 4], sacc[kb][8 * s + 5]); pw.w = cvtpk(sacc[kb][8 * s + 6], sacc[kb][8 * s + 7]);
                    const bf16x8v pf = __builtin_bit_cast(bf16x8v, pw);
#pragma unroll
                    for (int db = 0; db < 2; ++db) oacc[db] = __builtin_amdgcn_mfma_f32_32x32x16_bf16(vf[kb][s][db], pf, oacc[db], 0, 0, 0);
                }
        }
        if (i + 1 < nt) { LAS unsigned char* nb = lb + ((i + 1) & 1) * AT_BUF; *(LAS v4u*)(nb + srow * AT_KRS + sch * 16) = kreg; *(LAS v4u*)(nb + AT_KB + srow * AT_VRS + sch * 16) = vreg; }
        __syncthreads();
    }
    lsum += __shfl_xor(lsum, 32);
    if (TYPE == 0) lsum += __builtin_amdgcn_exp2f(KA->in[13][l * 4 + head] * LOG2E - m * AT_SC);
    const float inv = 1.f / lsum;
    bf16* op = (bf16*)(KA->ws + WS_O) + (size_t)qrow * DM + (TYPE == 0 ? 0 : TYPE == 1 ? 512 : 768) + head * 64;
#pragma unroll
    for (int db = 0; db < 2; ++db)
#pragma unroll
        for (int q4 = 0; q4 < 4; ++q4) { v2u o; o.x = cvtpk(oacc[db][4 * q4] * inv, oacc[db][4 * q4 + 1] * inv); o.y = cvtpk(oacc[db][4 * q4 + 2] * inv, oacc[db][4 * q4 + 3] * inv);
            *(v2u*)(op + db * 32 + 8 * q4 + 4 * h2) = o; }
}
constexpr size_t WS_ST = WS_A;
constexpr size_t WS_DEC = 3 * MiB;
constexpr int SS_B = 0, SS_BRS = 272, SS_X = 34816, SS_XRS = 192, SS_X2 = 59392, SS_HF = 83968, SS_HB = 101376, SS_ARR = 118784;
DI int slot_row(int b, int slot) { return slot < 2 ? NLAT + b * CTXL + slot * 128 : b * SEQ + (slot - 2) * 128; }
DI void ssd_stage_dt(KArgs KA, const Frame& F, int l, int h, int rowbase, LAS float* arr) {
    const float* DTB = (const float*)(KA->ws + WS_DT);
    if (F.tid < 128) { const float df = DTB[(size_t)(rowbase + F.tid) * 8 + h], db = DTB[(size_t)(rowbase + F.tid) * 8 + 4 + h];
        const float Af = -__expf(KA->in[17][l * 8 + h]) * LOG2E, Ab = -__expf(KA->in[17][l * 8 + 4 + h]) * LOG2E;
        arr[F.tid] = df * Af; arr[128 + F.tid] = db * Ab; arr[256 + F.tid] = df; arr[384 + F.tid] = db; }
    __syncthreads();
    if (F.wave < 2) { const int L = F.lane; const bool rev = F.wave == 1;
        const float v0 = rev ? arr[128 + 127 - 2 * L] : arr[2 * L], v1 = rev ? arr[128 + 126 - 2 * L] : arr[2 * L + 1];
        float t = v0 + v1;
#pragma unroll
        for (int o = 1; o < 64; o <<= 1) { const float u = __shfl_up(t, o); if (L >= o) t += u; }
        if (rev) { arr[640 + 127 - 2 * L] = t - v1; arr[640 + 126 - 2 * L] = t; } else { arr[512 + 2 * L] = t - v1; arr[512 + 2 * L + 1] = t; } }
    __syncthreads();
}
struct BRegs { v4u v[4]; };
DI BRegs ssd_load_B(KArgs KA, const Frame& F, int g, int rowbase) {
    const bf16* U = (const bf16*)(KA->ws + WS_U);
    const int row = F.tid >> 2, pc = F.tid & 3; const bf16* src = U + (size_t)(rowbase + row) * 768 + 256 + g * 128 + pc * 32;
    BRegs b;
#pragma unroll
    for (int k = 0; k < 4; ++k) b.v[k] = *(const v4u*)(src + k * 8);
    return b;
}
DI void ssd_store_B(const Frame& F, const BRegs& b) {
    const int row = F.tid >> 2, pc = F.tid & 3;
#pragma unroll
    for (int k = 0; k < 4; ++k) *(LAS v4u*)(F.lds + SS_B + row * SS_BRS + pc * 64 + k * 16) = b.v[k];
}
DI v4u scale8(v4u w, float s) { v4u o; o.x = cvtpk(bflo(w.x) * s, bfhi(w.x) * s); o.y = cvtpk(bflo(w.y) * s, bfhi(w.y) * s); o.z = cvtpk(bflo(w.z) * s, bfhi(w.z) * s); o.w = cvtpk(bflo(w.w) * s, bfhi(w.w) * s); return o; }
DI void ssd_states(KArgs KA, const Frame& F, int l, int item) {
    const int slot = item % 34, bh = item / 34, b = bh >> 2, h = bh & 3, g = h >> 1, rowbase = slot_row(b, slot);
    const int L = F.lane, w = F.wave, r = L & 31, h2 = L >> 5, i16 = L & 15, grp = (L >> 4) & 1;
    LAS float* arr = (LAS float*)(F.lds + SS_ARR);
    const BRegs breg = ssd_load_B(KA, F, g, rowbase);
    v4u x0, x1;
    { const bf16* U = (const bf16*)(KA->ws + WS_U); const int row = F.tid >> 2, pc = F.tid & 3; const bf16* src = U + (size_t)(rowbase + row) * 768 + h * 64 + pc * 16; x0 = *(const v4u*)src; x1 = *(const v4u*)(src + 8); }
    ssd_stage_dt(KA, F, l, h, rowbase, arr);
    ssd_store_B(F, breg);
    { const int row = F.tid >> 2, pc = F.tid & 3;
      const float wf = __builtin_amdgcn_exp2f(arr[512 + 127] - arr[512 + row]) * arr[256 + row], wb = __builtin_amdgcn_exp2f(arr[640] - arr[640 + row]) * arr[384 + row];
      *(LAS v4u*)(F.lds + SS_X + row * SS_XRS + pc * 32) = scale8(x0, wf); *(LAS v4u*)(F.lds + SS_X + row * SS_XRS + pc * 32 + 16) = scale8(x1, wf);
      *(LAS v4u*)(F.lds + SS_X2 + row * SS_XRS + pc * 32) = scale8(x0, wb); *(LAS v4u*)(F.lds + SS_X2 + row * SS_XRS + pc * 32 + 16) = scale8(x1, wb); }
    __syncthreads();
    const int pblk = w >> 2, nblk = w & 3;
    bf16* ST = (bf16*)(KA->ws + WS_ST); float* DEC = (float*)(KA->ws + WS_DEC);
#pragma unroll
    for (int dir = 0; dir < 2; ++dir) {
        f32x16 acc;
#pragma unroll
        for (int q = 0; q < 16; ++q) acc[q] = 0.f;
        const LAS unsigned char* xb = F.lds + (dir ? SS_X2 : SS_X);
#pragma unroll
        for (int ks = 0; ks < 8; ++ks) {
            const LAS unsigned char* xa = xb + (ks * 16 + 8 * h2 + (i16 >> 2)) * SS_XRS + (pblk * 32 + 16 * grp + 4 * (i16 & 3)) * 2;
            const s16x4 xlo = vtr(xa), xhi = vtr(xa + 4 * SS_XRS);
            const LAS unsigned char* ba = F.lds + SS_B + (ks * 16 + 8 * h2 + (i16 >> 2)) * SS_BRS + (nblk * 32 + 16 * grp + 4 * (i16 & 3)) * 2;
            const s16x4 blo = vtr(ba), bhi_ = vtr(ba + 4 * SS_BRS);
            const bf16x8v xf = (bf16x8v){xlo[0], xlo[1], xlo[2], xlo[3], xhi[0], xhi[1], xhi[2], xhi[3]}, bfr = (bf16x8v){blo[0], blo[1], blo[2], blo[3], bhi_[0], bhi_[1], bhi_[2], bhi_[3]};
            acc = __builtin_amdgcn_mfma_f32_32x32x16_bf16(xf, bfr, acc, 0, 0, 0); }
        bf16* dst = ST + ((size_t)((bh * 2 + dir) * 34 + slot)) * 8192;
#pragma unroll
        for (int q = 0; q < 16; ++q) dst[(pblk * 32 + crow16(q, h2)) * 128 + nblk * 32 + r] = (bf16)(cvtpk(acc[q], 0.f) & 0xffffu);
        if (F.tid == 0) DEC[(bh * 2 + dir) * 34 + slot] = __builtin_amdgcn_exp2f(dir ? arr[640] : arr[512 + 127]);
    }
    __syncthreads();
}
DI void ssd_scan() {
    KArgs KA = kargs(); Frame F = mkframe();
    bf16* ST = (bf16*)(KA->ws + WS_ST); const float* DEC = (const float*)(KA->ws + WS_DEC);
    for (int gt = blockIdx.x * 512 + F.tid; gt < 64 * 2048; gt += F.G * 512) {
        const int chain = gt >> 11, e4 = gt & 2047, dir = chain & 1;
        bf16* base = ST + (size_t)chain * 34 * 8192 + e4 * 4;
        v2u tw[34]; float dc[34];
#pragma unroll
        for (int k = 0; k < 34; ++k) { const int slot = dir == 0 ? k : (k < 2 ? 1 - k : 35 - k); tw[k] = *(const v2u*)(base + (size_t)slot * 8192); dc[k] = DEC[chain * 34 + slot]; }
        f32x4 hc = (f32x4){0.f, 0.f, 0.f, 0.f};
#pragma unroll
        for (int k = 0; k < 34; ++k) { const int slot = dir == 0 ? k : (k < 2 ? 1 - k : 35 - k);
            const f32x4 t = (f32x4){bflo(tw[k].x), bfhi(tw[k].x), bflo(tw[k].y), bfhi(tw[k].y)};
            v2u ow; ow.x = cvtpk(hc.x, hc.y); ow.y = cvtpk(hc.z, hc.w); *(v2u*)(base + (size_t)slot * 8192) = ow; hc = hc * dc[k] + t; }
    }
}
DI void ssd_outputs(KArgs KA, const Frame& F, int l, int item) {
    const int slot = item % 34, bh = item / 34, b = bh >> 2, h = bh & 3, g = h >> 1, rowbase = slot_row(b, slot);
    const int L = F.lane, w = F.wave, r = L & 31, h2 = L >> 5, i16 = L & 15, grp = (L >> 4) & 1;
    LAS float* arr = (LAS float*)(F.lds + SS_ARR);
    const bf16* U = (const bf16*)(KA->ws + WS_U);
    const int ib = w & 3, pb = w >> 2, ipos = ib * 32 + r;
    bf16x8v cfq[8];
#pragma unroll
    for (int ks = 0; ks < 8; ++ks) cfq[ks] = *(const bf16x8v*)(U + (size_t)(rowbase + ipos) * 768 + 512 + g * 128 + ks * 16 + 8 * h2);
    const BRegs breg = ssd_load_B(KA, F, g, rowbase);
    v4u x0, x1, hf0, hf1, hb0, hb1;
    { const int row = F.tid >> 2, pc = F.tid & 3; const bf16* src = U + (size_t)(rowbase + row) * 768 + h * 64 + pc * 16; x0 = *(const v4u*)src; x1 = *(const v4u*)(src + 8); }
    { const bf16* ST = (const bf16*)(KA->ws + WS_ST); const int p = F.tid >> 3, pc = F.tid & 7;
      const bf16* sf = ST + ((size_t)((bh * 2 + 0) * 34 + slot)) * 8192 + p * 128 + pc * 16; const bf16* sb = ST + ((size_t)((bh * 2 + 1) * 34 + slot)) * 8192 + p * 128 + pc * 16;
      hf0 = *(const v4u*)sf; hf1 = *(const v4u*)(sf + 8); hb0 = *(const v4u*)sb; hb1 = *(const v4u*)(sb + 8); }
    ssd_stage_dt(KA, F, l, h, rowbase, arr);
    ssd_store_B(F, breg);
    { const int row = F.tid >> 2, pc = F.tid & 3; *(LAS v4u*)(F.lds + SS_X + row * SS_XRS + pc * 32) = x0; *(LAS v4u*)(F.lds + SS_X + row * SS_XRS + pc * 32 + 16) = x1; }
    { const int p = F.tid >> 3, pc = F.tid & 7; LAS unsigned char* d = F.lds + SS_HF + p * SS_BRS + pc * 32; *(LAS v4u*)d = hf0; *(LAS v4u*)(d + 16) = hf1;
      LAS unsigned char* e = F.lds + SS_HB + p * SS_BRS + pc * 32; *(LAS v4u*)e = hb0; *(LAS v4u*)(e + 16) = hb1; }
    __syncthreads();
    const float cfi = arr[512 + ipos], cbi = arr[640 + ipos];
    f32x16 yacc;
#pragma unroll
    for (int q = 0; q < 16; ++q) yacc[q] = 0.f;
#pragma unroll
    for (int jb = 0; jb < 4; ++jb) {
        f32x16 acc;
#pragma unroll
        for (int q = 0; q < 16; ++q) acc[q] = 0.f;
#pragma unroll
        for (int ks = 0; ks < 8; ++ks) { const bf16x8v bfr = *(const LAS bf16x8v*)(F.lds + SS_B + (jb * 32 + r) * SS_BRS + ks * 32 + 16 * h2);
            acc = __builtin_amdgcn_mfma_f32_32x32x16_bf16(bfr, cfq[ks], acc, 0, 0, 0); }
        if (jb < ib) {
#pragma unroll
            for (int q = 0; q < 16; ++q) { const int j = jb * 32 + crow16(q, h2); acc[q] *= __builtin_amdgcn_exp2f(cfi - arr[512 + j]) * arr[256 + j]; }
        } else if (jb > ib) {
#pragma unroll
            for (int q = 0; q < 16; ++q) { const int j = jb * 32 + crow16(q, h2); acc[q] *= __builtin_amdgcn_exp2f(cbi - arr[640 + j]) * arr[384 + j]; }
        } else {
            int rl = r; asm volatile("" : "+v"(rl));
#pragma unroll
            for (int q = 0; q < 16; ++q) { const int jl = crow16(q, h2), j = jb * 32 + jl;
                float wt = 0.f;
                if (jl <= rl) wt += __builtin_amdgcn_exp2f(cfi - arr[512 + j]) * arr[256 + j];
                if (jl >= rl) wt += __builtin_amdgcn_exp2f(cbi - arr[640 + j]) * arr[384 + j];
                acc[q] *= wt; }
        }
#pragma unroll
        for (int s = 0; s < 2; ++s) {
            v4u pw; pw.x = cvtpk(acc[8 * s], acc[8 * s + 1]); pw.y = cvtpk(acc[8 * s + 2], acc[8 * s + 3]); pw.z = cvtpk(acc[8 * s + 4], acc[8 * s + 5]); pw.w = cvtpk(acc[8 * s + 6], acc[8 * s + 7]);
            const bf16x8v pf = __builtin_bit_cast(bf16x8v, pw);
            const LAS unsigned char* xa = F.lds + SS_X + (jb * 32 + 16 * s + 4 * h2 + (i16 >> 2)) * SS_XRS + (pb * 32 + 16 * grp + 4 * (i16 & 3)) * 2;
            const s16x4 lo = vtr(xa), hi = vtr(xa + 8 * SS_XRS);
            const bf16x8v xf = (bf16x8v){lo[0], lo[1], lo[2], lo[3], hi[0], hi[1], hi[2], hi[3]};
            yacc = __builtin_amdgcn_mfma_f32_32x32x16_bf16(xf, pf, yacc, 0, 0, 0); }
    }
#pragma unroll
    for (int dir = 0; dir < 2; ++dir) {
        f32x16 tacc;
#pragma unroll
        for (int q = 0; q < 16; ++q) tacc[q] = 0.f;
#pragma unroll
        for (int ks = 0; ks < 8; ++ks) { const bf16x8v hfr = *(const LAS bf16x8v*)(F.lds + (dir ? SS_HB : SS_HF) + (pb * 32 + r) * SS_BRS + ks * 32 + 16 * h2);
            tacc = __builtin_amdgcn_mfma_f32_32x32x16_bf16(hfr, cfq[ks], tacc, 0, 0, 0); }
        const float sc = __builtin_amdgcn_exp2f(dir ? cbi : cfi);
#pragma unroll
        for (int q = 0; q < 16; ++q) yacc[q] += sc * tacc[q];
    }
    bf16* yp = (bf16*)(KA->ws + WS_Y) + (size_t)(rowbase + ipos) * 256 + h * 64 + pb * 32;
#pragma unroll
    for (int q4 = 0; q4 < 4; ++q4) { v2u o; o.x = cvtpk(yacc[4 * q4], yacc[4 * q4 + 1]); o.y = cvtpk(yacc[4 * q4 + 2], yacc[4 * q4 + 3]); *(v2u*)(yp + 8 * q4 + 4 * h2) = o; }
    __syncthreads();
}
DI void ssd_outputs_phase(int l, bool last) {
    KArgs KA = kargs(); Frame F = mkframe();
    for (int it = blockIdx.x; it < 32 * 34; it += F.G) { if (last && (it % 34) < 2) continue; ssd_outputs(KA, F, l, it); }
}
DI void mixers_flash(int l, bool last) {
    KArgs KA = kargs(); Frame F = mkframe();
    const int nS = 32 * 34, nL = 1536, nC = last ? 0 : 96, nItems = nS + nL + nC;
    for (int it = blockIdx.x; it < nItems; it += F.G) {
        if (it < nS) { ssd_states(KA, F, l, it); continue; }
        int u = it - nS; bool cq = false;
        if (u >= nL) { u -= nL; cq = true; }
        const int ty = u % 3, un = u / 3;
        if (ty == 0) attn_unit<1>(KA, F, l, un, cq); else if (ty == 1) attn_unit<0>(KA, F, l, un, cq); else attn_unit<2>(KA, F, l, un, cq);
    }
}
DI void merge_pass(int l, int nrows) {
    KArgs KA = kargs(); Frame F = mkframe();
    const bf16* P = (const bf16*)(KA->ws + WS_ACT); const bf16* O = (const bf16*)(KA->ws + WS_O); const bf16* Y = (const bf16*)(KA->ws + WS_Y); const bf16* U = (const bf16*)(KA->ws + WS_U);
    bf16* A = (bf16*)(KA->ws + WS_A);
    const int hh = F.lane >> 4, cn = 4 * F.lane;
    const float dsk = KA->in[18][l * 4 + hh];
    v2u o0, o2, o3, yw, xw, zw;
#define MERGE_LOAD(r_) do { o0 = *(const v2u*)(O + (size_t)(r_) * DM + cn); o2 = *(const v2u*)(O + (size_t)(r_) * DM + 512 + cn); o3 = *(const v2u*)(O + (size_t)(r_) * DM + 768 + cn); \
        yw = *(const v2u*)(Y + (size_t)(r_) * 256 + cn); xw = *(const v2u*)(U + (size_t)(r_) * 768 + cn); zw = *(const v2u*)(P + (size_t)(r_) * NPJ + C_BZ + cn); } while (0)
    if (F.gw < nrows) MERGE_LOAD(F.gw);
    for (int row = F.gw; row < nrows; row += F.ngw) {
        f32x4 v[4];
        v[0] = (f32x4){bflo(o0.x), bfhi(o0.x), bflo(o0.y), bfhi(o0.y)}; v[2] = (f32x4){bflo(o2.x), bfhi(o2.x), bflo(o2.y), bfhi(o2.y)}; v[3] = (f32x4){bflo(o3.x), bfhi(o3.x), bflo(o3.y), bfhi(o3.y)};
        { const f32x4 yf = (f32x4){bflo(yw.x), bfhi(yw.x), bflo(yw.y), bfhi(yw.y)}, xs = (f32x4){bflo(xw.x), bfhi(xw.x), bflo(xw.y), bfhi(xw.y)}, z = (f32x4){bflo(zw.x), bfhi(zw.x), bflo(zw.y), bfhi(zw.y)};
          const f32x4 y = yf + xs * dsk; v[1] = (f32x4){y.x * silu(z.x), y.y * silu(z.y), y.z * silu(z.z), y.w * silu(z.w)}; }
        if (row + F.ngw < nrows) MERGE_LOAD(row + F.ngw);
#pragma unroll
        for (int j = 0; j < 4; ++j) { const int n = 4 * F.lane + 256 * j;
            const float ss = wave_sum((v[j].x * v[j].x + v[j].y * v[j].y) + (v[j].z * v[j].z + v[j].w * v[j].w));
            const float r = 1.f / sqrtf(ss * (1.f / 256.f) + LN_EPS);
            const f32x4 a = v[j] * r * *(const f32x4*)(KA->in[12] + l * DM + n);
            v2u w; w.x = cvtpk(a.x, a.y); w.y = cvtpk(a.z, a.w); *(v2u*)(A + (size_t)row * DM + n) = w; }
    }
#undef MERGE_LOAD
}
constexpr size_t WS_CTL = 3 * MiB + 512 * 1024, CTL_BYTES = 16384;
constexpr int MISC_OFF = 139264;
#define XB_TMO      128
#define XB_XCNT(j)  (256  + 64 * (j))
#define XB_XSUB(j)  (1280 + 64 * (j))
#define XB_XGEN(j)  (2304 + 64 * (j))
#define XB_TOP      3328
#define XB_TOPGEN   3392
#define XCD_BAR_WORDS 3456
#define XB_SPIN_CAP (1u << 18)

__device__ __forceinline__ unsigned xb_ld(unsigned* p)              { return __hip_atomic_load(p, __ATOMIC_RELAXED, __HIP_MEMORY_SCOPE_AGENT); }
__device__ __forceinline__ unsigned xb_add(unsigned* p, unsigned v) { return __hip_atomic_fetch_add(p, v, __ATOMIC_RELAXED, __HIP_MEMORY_SCOPE_AGENT); }
__device__ __forceinline__ unsigned xb_xcc_id() { return (unsigned)__builtin_amdgcn_s_getreg((3 << 11) | 20) & 0xFu; }
#define XB_SPIN(cond, bar) do { unsigned _sp = 0; while (cond) { __builtin_amdgcn_s_sleep(1); \
    if ((++_sp & 255u) == 0u) { if (xb_ld(&(bar)[XB_TMO])) break; if (_sp > XB_SPIN_CAP) { atomicAdd(&(bar)[XB_TMO], 1u); break; } } } } while (0)

struct XcdBarrier {
    unsigned* bar; unsigned x;
    volatile LAS unsigned* st;
};

__device__ __forceinline__ XcdBarrier xcd_barrier_post(unsigned* bar, volatile LAS unsigned* st) {
    XcdBarrier b; b.bar = bar; b.x = xb_xcc_id(); b.st = st;
    if (threadIdx.x == 0) (void)xb_add(&bar[XB_XCNT(b.x)], 1u);
    return b;
}
__device__ __forceinline__ void xcd_barrier_complete(unsigned* bar, unsigned x, unsigned& nloc, unsigned& nx) {
    const unsigned G = gridDim.x * gridDim.y * gridDim.z;
    unsigned sum, cnt, mine, sp = 0u;
    for (;;) {
        sum = 0u; cnt = 0u; mine = 0u;
#pragma unroll
        for (unsigned j = 0; j < 16; ++j) { const unsigned c = xb_ld(&bar[XB_XCNT(j)]); sum += c; cnt += (c > 0u) ? 1u : 0u; mine = (j == x) ? c : mine; }
        if (sum == G) break;
        __builtin_amdgcn_s_sleep(1);
        if ((++sp & 255u) == 0u) { if (xb_ld(&bar[XB_TMO])) break; if (sp > XB_SPIN_CAP) { atomicAdd(&bar[XB_TMO], 1u); break; } }
    }
    nloc = mine > 0u ? mine : 1u; nx = cnt > 0u ? cnt : 1u;
}

__device__ __forceinline__ void xcd_barrier(const XcdBarrier& b) {
    asm volatile("s_waitcnt vmcnt(0)" ::: "memory");
    __syncthreads();
    if (threadIdx.x == 0) {
        unsigned* bar = b.bar;
        __builtin_amdgcn_s_waitcnt(0);
        unsigned nloc = b.st[0], nx = b.st[1];
        if (nloc == 0u) { xcd_barrier_complete(bar, b.x, nloc, nx); b.st[0] = nloc; b.st[1] = nx; }
        const unsigned old = xb_add(&bar[XB_XSUB(b.x)], 1u);
        const unsigned gen = old / nloc;
        if (old + 1u == (gen + 1u) * nloc) {
            __builtin_amdgcn_fence(__ATOMIC_RELEASE, "agent");
            asm volatile("s_waitcnt vmcnt(0)" ::: "memory");
            const unsigned og = xb_add(&bar[XB_TOP], 1u);
            const unsigned tg = og / nx;
            if (og + 1u == (tg + 1u) * nx) xb_add(&bar[XB_TOPGEN], 1u);
            else XB_SPIN(xb_ld(&bar[XB_TOPGEN]) == tg, bar);
            __builtin_amdgcn_fence(__ATOMIC_ACQUIRE, "agent");
            xb_add(&bar[XB_XGEN(b.x)], 1u);
            asm volatile("s_waitcnt vmcnt(0)" ::: "memory");
        } else {
            XB_SPIN(xb_ld(&bar[XB_XGEN(b.x)]) == gen, bar);
            __builtin_amdgcn_fence(__ATOMIC_ACQUIRE, "agent");
            asm volatile("s_waitcnt vmcnt(0)" ::: "memory");
        }
    }
    __syncthreads();
}

#define GRID_BAR() do { XcdBarrier b_; b_.bar = (unsigned*)(kargs()->ws + WS_CTL); b_.x = xb_xcc_id(); b_.st = (volatile LAS unsigned*)((LAS unsigned char*)lds + MISC_OFF); xcd_barrier(b_); } while (0)
#ifndef PROBE_GRP
#define PROBE_GRP 0
#endif
#define TIMED(grp, ...) do { unsigned long long t0_ = 0; if (PROBE_GRP == (grp)) t0_ = __builtin_amdgcn_s_memrealtime(); __VA_ARGS__; \
    if (PROBE_GRP == (grp) && blockIdx.x == 0) { const unsigned long long dt_ = __builtin_amdgcn_s_memrealtime() - t0_; const unsigned long long t1_ = __builtin_amdgcn_s_memrealtime(); \
        while (__builtin_amdgcn_s_memrealtime() - t1_ < 2 * dt_) __builtin_amdgcn_s_sleep(8); } } while (0)
__global__ void __launch_bounds__(NWAVES * 64, 2) mega_fwd(Args args) {
    extern __shared__ __attribute__((aligned(16))) unsigned char lds[];
    cg::grid_group grid = cg::this_grid();
    if (threadIdx.x < 2) ((volatile LAS unsigned*)((LAS unsigned char*)lds + MISC_OFF))[threadIdx.x] = 0u;
    __syncthreads();
    (void)xcd_barrier_post((unsigned*)(kargs()->ws + WS_CTL), (volatile LAS unsigned*)((LAS unsigned char*)lds + MISC_OFF));
    { LAS float* rc = (LAS float*)((LAS unsigned char*)lds + ROPE_OFF);
      for (int i = threadIdx.x; i < 1024; i += 512) { const int pos = i >> 4, fi = i & 15; const float inv = exp2f(-(float)fi * (13.287712379549449f / 16.f)); const float ang = (float)pos * inv; rc[i] = cosf(ang); rc[1024 + i] = sinf(ang); } }
    __syncthreads();

    if (args.ws == nullptr) grid.sync();
    p0a(); GRID_BAR(); p0b(); GRID_BAR(); p0c(); GRID_BAR();
    for (int l = 0; l < NL; ++l) {
        const bool last = (l == NL - 1); const int mrows = last ? NLAT : NROW;
        for (int s = 0; s < 3; ++s) {
            if (s != 1) {
                const bool second = (s == 2); const int rows = (second && last) ? NLAT : NROW;
                { KArgs KA = kargs(); pg8::Gemm g{((bf16*)(KA->ws + WS_A)), wbuf(KA, l, second ? WO_W1B : WO_W1A), rows, 2 * DFF, DM}; pg8::StaticOrder S; S.init(rows, 2 * DFF, (int)gridDim.x, (int)blockIdx.x); pg8::EpiSwiGLU E{((bf16*)(KA->ws + WS_ACT)), DFF};
                  pg8::gemm_phase<pg8::EpiSwiGLU, pg8::StaticOrder, true, GEMM_SP2>((LAS unsigned char*)lds, g, S, E); }
                GRID_BAR();
                { KArgs KA = kargs(); pg8::Gemm g{((bf16*)(KA->ws + WS_ACT)), wbuf(KA, l, second ? WO_W2B : WO_W2A), NLAT, DM, DFF}; pg8::StaticOrder S; S.init(NLAT, DM, (int)gridDim.x, (int)blockIdx.x); pg8::EpiBf16 E{((bf16*)(KA->ws + WS_O)), DM};
                  pg8::gemm_phase<pg8::EpiBf16, pg8::StaticOrder, true, GEMM_SP2>((LAS unsigned char*)lds, g, S, E); }
                GRID_BAR();
                const bool split = (rows == NROW);
                const int gidx = second ? 8 : 2, lnidx = second ? 2 : 0, nl = second ? l + 1 : l, nsh = second ? (last ? -1 : 0) : 3;
                if (split && blockIdx.x < 32) {
                    KArgs KA = kargs(); pg8::Gemm g{((bf16*)(KA->ws + WS_ACT)) + (size_t)NLAT * DFF, wbuf(KA, l, second ? WO_W2B : WO_W2A), NCTX, DM, DFF}; pg8::StaticOrder S; S.init(NCTX, DM, 32, (int)blockIdx.x);
                    pg8::EpiBf16 E{((bf16*)(KA->ws + WS_O)) + (size_t)NLAT * DM, DM};
                    pg8::gemm_phase<pg8::EpiBf16, pg8::StaticOrder, true, GEMM_SP2>((LAS unsigned char*)lds, g, S, E);
                } else ln_pass(l, gidx, 0.5f, lnidx, nl, nsh, 0, NLAT, split ? 32 : 0, split ? (int)gridDim.x - 32 : (int)gridDim.x, !second);
                if (split) { GRID_BAR(); ln_pass(l, gidx, 0.5f, lnidx, nl, nsh, NLAT, NROW, 0, (int)gridDim.x, !second); }
                if (!(second && last)) GRID_BAR();
            } else {
                { KArgs KA = kargs(); pg8::Gemm g{((bf16*)(KA->ws + WS_A)), wbuf(KA, l, WO_WIN), NROW, NPJ, DM}; pg8::StaticOrder S; S.init(NROW, NPJ, (int)gridDim.x, (int)blockIdx.x); pg8::EpiBf16 E{((bf16*)(KA->ws + WS_ACT)), NPJ};
                  pg8::gemm_phase<pg8::EpiBf16, pg8::StaticOrder, true, GEMM_SP2>((LAS unsigned char*)lds, g, S, E); }
                GRID_BAR();
                prep_pass(l); GRID_BAR();
                mixers_flash(l, last); GRID_BAR();
                ssd_scan(); GRID_BAR();
                ssd_outputs_phase(l, last); GRID_BAR();
                merge_pass(l, mrows); GRID_BAR();
                { KArgs KA = kargs(); pg8::Gemm g{((bf16*)(KA->ws + WS_A)), wbuf(KA, l, WO_WOUT), mrows, DM, DM}; pg8::StaticOrder S; S.init(mrows, DM, (int)gridDim.x, (int)blockIdx.x); pg8::EpiBf16 E{((bf16*)(KA->ws + WS_O)), DM};
                  pg8::gemm_phase<pg8::EpiBf16, pg8::StaticOrder, true, GEMM_SP2>((LAS unsigned char*)lds, g, S, E); }
                GRID_BAR();
                ln_pass(l, 5, 1.0f, 1, l, 6, 0, mrows, 0, (int)gridDim.x, false); GRID_BAR();
            }
        }
    }
}

extern "C" void kernel_launch(void* const* d_in, const int* in_sizes, int n_in, void* d_out, int out_size, void* d_ws, size_t ws_size, hipStream_t stream) {
    static int grid = 0;
    if (grid == 0) {
        if (n_in != 24 || out_size != NLAT * DM || ws_size < WS_END) { fprintf(stderr, "kernel_launch: unexpected shapes: n_in %d out %d ws %zu\n", n_in, out_size, ws_size); grid = -1; return; }
        int dev = 0, cus = 0, per_cu = 0;
        hipGetDevice(&dev); hipDeviceGetAttribute(&cus, hipDeviceAttributeMultiprocessorCount, dev);
        if (hipFuncSetAttribute((const void*)mega_fwd, hipFuncAttributeMaxDynamicSharedMemorySize, LDS_BYTES) != hipSuccess) { fprintf(stderr, "kernel_launch: hipFuncSetAttribute failed\n"); grid = -1; return; }
        if (hipOccupancyMaxActiveBlocksPerMultiprocessor(&per_cu, (const void*)mega_fwd, NWAVES * 64, LDS_BYTES) != hipSuccess || per_cu < 1) { fprintf(stderr, "kernel_launch: occupancy query says %d\n", per_cu); per_cu = 1; }
        (void)hipGetLastError();
        grid = cus;
    }
    if (grid < 0) return;
    if (hipMemsetAsync((char*)d_ws + WS_CTL, 0, CTL_BYTES, stream) != hipSuccess) { fprintf(stderr, "kernel_launch: memset of the barrier words failed\n"); return; }
    Args a{};
    for (int i = 0; i < 24; ++i) a.in[i] = (const float*)d_in[i];
    a.out = (float*)d_out; a.ws = (unsigned char*)d_ws;
    void* kargs[] = {&a};
    hipError_t e = hipLaunchCooperativeKernel((const void*)mega_fwd, dim3(grid), dim3(NWAVES * 64), kargs, LDS_BYTES, stream);
    if (e != hipSuccess) fprintf(stderr, "kernel_launch: cooperative launch failed: %s (grid %d)\n", hipGetErrorString(e), grid);
}
```

```cpp
#include <hip/hip_runtime.h>
#include <hip/hip_cooperative_groups.h>
#include <cstdio>
#include <cstdint>
namespace cg = cooperative_groups;
namespace pg8 {
#define PG8_LAS __attribute__((address_space(3)))
typedef unsigned short bf16_t;
typedef short bf16x8 __attribute__((ext_vector_type(8)));
typedef float f32x4 __attribute__((ext_vector_type(4)));
typedef unsigned u32x4 __attribute__((ext_vector_type(4)));
constexpr int BM = 256, BK = 64, HALF = 128, HTB = HALF * BK * 2  , STAGE_BYTES = 8 * HTB, NXCD = 8, WGM = 8;

__host__ __device__ __forceinline__ int lds_byte(int r, int c) { const int st = (r >> 4) * 2 + (c >> 5), rr = r & 15, cc = c & 31, ob = rr * 64 + cc * 2; return st * 1024 + (ob ^ (((ob >> 9) & 1) << 5)); }
__host__ __device__ __forceinline__ void stage_rc(int b, int& R, int& C) { const int st = b / 1024, sb = b % 1024, swz = sb ^ (((sb >> 9) & 1) << 5); R = (st >> 1) * 16 + swz / 64; C = (st & 1) * 32 + (swz % 64) / 2; }
__host__ __device__ __forceinline__ int perm32(int rho) { const int n = rho >> 4, i = rho & 15; return 8 * (i >> 2) + 4 * n + (i & 3); }

struct Unit { int pm, pn; };
struct Gemm { const bf16_t* A; const bf16_t* Bt; int M, N, K; };

struct StaticOrder {
    int nM, nN, nwg, G, c;
    __host__ __device__ void init(int M, int N, int G_, int c_) { nM = M / BM; nN = N / BM; nwg = nM * nN; G = G_; c = c_; }
    __host__ __device__ bool next(int i, Unit& u) const {
        const long L = (long)i * G + c; if (L >= nwg) return false;
        int wgid = (int)L; { const int q = nwg / NXCD, r = nwg % NXCD, xcd = wgid % NXCD, off = wgid / NXCD; wgid = (xcd < r ? xcd * (q + 1) : r * (q + 1) + (xcd - r) * q) + off; }
        const int nig = WGM * nN, gid = wgid / nig, fm = gid * WGM, gsz = (nM - fm) < WGM ? (nM - fm) : WGM;
        u.pm = fm + ((wgid % nig) % gsz); u.pn = (wgid % nig) / gsz; return true;
    }
    __device__ __forceinline__ void a_ready(const Unit&) const {}
    __device__ __forceinline__ void done(const Unit&) const {}
};

__device__ __forceinline__ unsigned cvt_pk_bf16(float lo, float hi) { unsigned r; asm volatile("v_cvt_pk_bf16_f32 %0, %1, %2" : "=v"(r) : "v"(lo), "v"(hi)); return r; }
struct EpiBf16 {
    static constexpr bool PERM = true, AFTER_DRAIN = false;
    bf16_t* O; int ldc;
    __device__ __forceinline__ void operator()(const f32x4 (&acc)[2][2][4][2], const Unit& u, int wr, int wc, int fr, int fq) const {
        const int row0 = u.pm * BM + wr * 64 + fr; const int col0 = u.pn * BM + wc * 32 + 8 * fq;
#pragma unroll
        for (int ai = 0; ai < 2; ++ai)
#pragma unroll
            for (int m = 0; m < 4; ++m) { bf16_t* rowp = O + (size_t)(row0 + ai * HALF + m * 16) * ldc + col0;
#pragma unroll
                for (int bj = 0; bj < 2; ++bj) { const f32x4 v0 = acc[ai][bj][m][0], v1 = acc[ai][bj][m][1];
                    u32x4 w; w.x = cvt_pk_bf16(v0[0], v0[1]); w.y = cvt_pk_bf16(v0[2], v0[3]); w.z = cvt_pk_bf16(v1[0], v1[1]); w.w = cvt_pk_bf16(v1[2], v1[3]);
                    *(u32x4*)(rowp + bj * HALF) = w; } }
    }
};
__device__ __forceinline__ float silu_f(float x) { return x * __builtin_amdgcn_rcpf(1.0f + __expf(-x)); }
struct EpiSwiGLU {
    static constexpr bool PERM = true, AFTER_DRAIN = false;
    bf16_t* O; int ldc;
    __device__ __forceinline__ void operator()(const f32x4 (&acc)[2][2][4][2], const Unit& u, int wr, int wc, int fr, int fq) const {
        const int row0 = u.pm * BM + wr * 64 + fr; const int col0 = u.pn * HALF + wc * 32 + 8 * fq;
#pragma unroll
        for (int ai = 0; ai < 2; ++ai)
#pragma unroll
            for (int m = 0; m < 4; ++m) { bf16_t* rowp = O + (size_t)(row0 + ai * HALF + m * 16) * ldc + col0;
                const f32x4 a0 = acc[ai][0][m][0], a1 = acc[ai][0][m][1], u0 = acc[ai][1][m][0], u1 = acc[ai][1][m][1];
                u32x4 w;
                w.x = cvt_pk_bf16(silu_f(a0[0]) * u0[0], silu_f(a0[1]) * u0[1]); w.y = cvt_pk_bf16(silu_f(a0[2]) * u0[2], silu_f(a0[3]) * u0[3]);
                w.z = cvt_pk_bf16(silu_f(a1[0]) * u1[0], silu_f(a1[1]) * u1[1]); w.w = cvt_pk_bf16(silu_f(a1[2]) * u1[2], silu_f(a1[3]) * u1[3]);
                *(u32x4*)rowp = w; }
    }
};
template <class Epi, class Sched, bool ALIGN_EPI = false, bool SP2 = false>
__device__ __forceinline__ void gemm_phase(PG8_LAS unsigned char* lds, const Gemm g, const Sched& S, const Epi& E) {
    int tid_l = threadIdx.x; asm volatile("" : "+v"(tid_l));
    const int tid = tid_l, wid = __builtin_amdgcn_readfirstlane(tid >> 6), lane = tid & 63, wr = wid >> 2, wc = wid & 3, fr = lane & 15, fq = lane >> 4;
    const int K = g.K, nt = K / BK;
    unsigned voffA[2], voffB[2];
#pragma unroll
    for (int i = 0; i < 2; ++i) { int R, C; stage_rc(tid * 16 + i * 8192, R, C); const int Rb = Epi::PERM ? ((R & ~31) + perm32(R & 31)) : R;
        voffA[i] = (unsigned)(R * K + C) * 2u; voffB[i] = (unsigned)(Rb * K + C) * 2u; }
    const size_t kstep = (size_t)(BK * 2);
    const size_t hstep = (size_t)HALF * K * 2;
    const size_t tstep = 2 * hstep;
    const unsigned ldsw = (unsigned)wid * 1024u;
    const int aoff = lds_byte(wr * 64 + fr, fq * 8), boff = lds_byte(wc * 32 + fr, fq * 8);
#define PG8_SA(b, h) (((b) * 2 + (h)) * HTB)
#define PG8_SB(b, h) ((4 + (b) * 2 + (h)) * HTB)
#define PG8_STAGE(bufoff, gbase, voff) do { _Pragma("unroll") for (int _i = 0; _i < 2; ++_i) \
        __builtin_amdgcn_global_load_lds((const unsigned*)((const char*)(gbase) + (voff)[_i]), (PG8_LAS unsigned*)(lds + (bufoff) + ldsw + _i * 8192), 16, 0, 0); } while (0)
#define PG8_LDA(dst, b, h) do { _Pragma("unroll") for (int m = 0; m < 4; ++m) _Pragma("unroll") for (int k = 0; k < 2; ++k) dst[m][k] = *(const PG8_LAS bf16x8*)(lds + PG8_SA(b, h) + aoff + m * 2048 + k * 1024); } while (0)
#define PG8_LDB(dst, b, h) do { _Pragma("unroll") for (int n = 0; n < 2; ++n) _Pragma("unroll") for (int k = 0; k < 2; ++k) dst[n][k] = *(const PG8_LAS bf16x8*)(lds + PG8_SB(b, h) + boff + n * 2048 + k * 1024); } while (0)
#define PG8_MMA(ai, bj, At, Bt) do { __builtin_amdgcn_s_setprio(1); _Pragma("unroll") for (int m = 0; m < 4; ++m) _Pragma("unroll") for (int n = 0; n < 2; ++n) _Pragma("unroll") for (int k = 0; k < 2; ++k) \
        acc[ai][bj][m][n] = __builtin_amdgcn_mfma_f32_16x16x32_bf16(Bt[n][k], At[m][k], acc[ai][bj][m][n], 0, 0, 0); __builtin_amdgcn_s_setprio(0); } while (0)
#define PG8_WAIT_V(n) asm volatile("s_waitcnt vmcnt(" #n ")" ::: "memory")
#define PG8_WAIT_L(n) asm volatile("s_waitcnt lgkmcnt(" #n ")" ::: "memory")
#define PG8_BAR __builtin_amdgcn_s_barrier()
#define PG8_SCHED __builtin_amdgcn_sched_barrier(0)
    Unit cur, nxt; int ui = 0;
    if (!S.next(0, cur)) return;
    f32x4 acc[2][2][4][2];
#pragma unroll
    for (int a = 0; a < 2; ++a)
#pragma unroll
        for (int b = 0; b < 2; ++b)
#pragma unroll
            for (int m = 0; m < 4; ++m)
#pragma unroll
                for (int n = 0; n < 2; ++n) acc[a][b][m][n] = (f32x4){0.f, 0.f, 0.f, 0.f};
    bf16x8 At[4][2], B0[2][2], B1[2][2];
    const char* cA = (const char*)g.A + (size_t)cur.pm * tstep; const char* cB = (const char*)g.Bt + (size_t)cur.pn * tstep;
    S.a_ready(cur);
    if constexpr (SP2) {
        PG8_STAGE(PG8_SB(0, 0), cB, voffB); PG8_STAGE(PG8_SB(0, 1), cB + hstep, voffB); PG8_STAGE(PG8_SA(0, 0), cA, voffA); PG8_STAGE(PG8_SA(0, 1), cA + hstep, voffA);
        if (wr == 1) PG8_BAR;
        PG8_WAIT_V(2); PG8_BAR;
        PG8_STAGE(PG8_SB(1, 0), cB + kstep, voffB); PG8_STAGE(PG8_SA(1, 0), cA + kstep, voffA); PG8_STAGE(PG8_SB(1, 1), cB + hstep + kstep, voffB);
        PG8_WAIT_V(6); PG8_BAR;
    } else {
        PG8_STAGE(PG8_SB(0, 0), cB, voffB); PG8_STAGE(PG8_SA(0, 0), cA, voffA); PG8_STAGE(PG8_SB(0, 1), cB + hstep, voffB); PG8_STAGE(PG8_SA(0, 1), cA + hstep, voffA);
        if (wr == 1) PG8_BAR;
        PG8_WAIT_V(4); PG8_BAR;
        PG8_STAGE(PG8_SB(1, 0), cB + kstep, voffB); PG8_STAGE(PG8_SA(1, 0), cA + kstep, voffA); PG8_STAGE(PG8_SB(1, 1), cB + hstep + kstep, voffB);
        PG8_WAIT_V(6); PG8_BAR;
    }
    for (;;) {
        const bool has_next = S.next(ui + 1, nxt);
        const char* nA = has_next ? (const char*)g.A + (size_t)nxt.pm * tstep : cA; const char* nB = has_next ? (const char*)g.Bt + (size_t)nxt.pn * tstep : cB;
        for (int t = 0; t < nt; t += 2) {
            const bool last = (t == nt - 2);
            const char* a1 = cA + (size_t)(t + 1) * kstep;
            const char* a2 = last ? nA : cA + (size_t)(t + 2) * kstep; const char* b2 = last ? nB : cB + (size_t)(t + 2) * kstep;
            const char* a3 = a2 + kstep; const char* b3 = b2 + kstep;
            if (last && has_next) S.a_ready(nxt);
            if constexpr (SP2) {
            PG8_LDB(B0, 0, 0); PG8_LDB(B1, 0, 1); PG8_SCHED; PG8_LDA(At, 0, 0); PG8_STAGE(PG8_SA(1, 1), a1 + hstep, voffA);
            PG8_WAIT_V(8); PG8_WAIT_L(0); PG8_BAR; PG8_MMA(0, 0, At, B0); PG8_MMA(0, 1, At, B1); PG8_BAR; PG8_SCHED;
            PG8_LDA(At, 0, 1); PG8_STAGE(PG8_SB(0, 0), b2, voffB); PG8_STAGE(PG8_SB(0, 1), b2 + hstep, voffB); PG8_STAGE(PG8_SA(0, 0), a2, voffA);
            PG8_WAIT_V(8); PG8_WAIT_L(0); PG8_BAR; PG8_MMA(1, 0, At, B0); PG8_MMA(1, 1, At, B1); PG8_BAR; PG8_SCHED;
            PG8_LDB(B0, 1, 0); PG8_LDB(B1, 1, 1); PG8_SCHED; PG8_LDA(At, 1, 0); PG8_STAGE(PG8_SA(0, 1), a2 + hstep, voffA);
            PG8_WAIT_V(8); PG8_WAIT_L(0); PG8_BAR; PG8_MMA(0, 0, At, B0); PG8_MMA(0, 1, At, B1); PG8_BAR; PG8_SCHED;
            PG8_LDA(At, 1, 1); PG8_STAGE(PG8_SB(1, 0), b3, voffB); PG8_STAGE(PG8_SB(1, 1), b3 + hstep, voffB); PG8_STAGE(PG8_SA(1, 0), a3, voffA);
            PG8_WAIT_V(8); PG8_WAIT_L(0); PG8_BAR; PG8_MMA(1, 0, At, B0); PG8_MMA(1, 1, At, B1); PG8_BAR; PG8_SCHED;
            } else {
            PG8_LDB(B0, 0, 0); PG8_SCHED; PG8_LDA(At, 0, 0); PG8_STAGE(PG8_SA(1, 1), a1 + hstep, voffA);
            PG8_WAIT_L(8); PG8_BAR; PG8_WAIT_L(0); PG8_MMA(0, 0, At, B0); PG8_BAR; PG8_SCHED;
            PG8_LDB(B1, 0, 1); PG8_STAGE(PG8_SB(0, 0), b2, voffB);
            PG8_BAR; PG8_WAIT_L(0); PG8_MMA(0, 1, At, B1); PG8_BAR;
            PG8_LDA(At, 0, 1); PG8_STAGE(PG8_SA(0, 0), a2, voffA);
            PG8_BAR; PG8_WAIT_L(0); PG8_MMA(1, 0, At, B0); PG8_BAR; PG8_SCHED;
            PG8_STAGE(PG8_SB(0, 1), b2 + hstep, voffB);
            PG8_WAIT_V(6); PG8_BAR; PG8_MMA(1, 1, At, B1); PG8_BAR;
            PG8_LDB(B0, 1, 0); PG8_SCHED; PG8_LDA(At, 1, 0); PG8_STAGE(PG8_SA(0, 1), a2 + hstep, voffA);
            PG8_WAIT_L(8); PG8_BAR; PG8_WAIT_L(0); PG8_MMA(0, 0, At, B0); PG8_BAR; PG8_SCHED;
            PG8_LDB(B1, 1, 1); PG8_STAGE(PG8_SB(1, 0), b3, voffB);
            PG8_BAR; PG8_WAIT_L(0); PG8_MMA(0, 1, At, B1); PG8_BAR;
            PG8_LDA(At, 1, 1); PG8_STAGE(PG8_SA(1, 0), a3, voffA);
            PG8_BAR; PG8_WAIT_L(0); PG8_MMA(1, 0, At, B0); PG8_BAR; PG8_SCHED;
            PG8_STAGE(PG8_SB(1, 1), b3 + hstep, voffB);
            PG8_WAIT_V(6); PG8_BAR; PG8_MMA(1, 1, At, B1); PG8_BAR;
            }
        }
        if constexpr (ALIGN_EPI) { if (wr == 0) PG8_BAR; }
        if constexpr (!Epi::AFTER_DRAIN) { E(acc, cur, wr, wc, fr, fq); S.done(cur); }
        if (!has_next) break;
#pragma unroll
        for (int a = 0; a < 2; ++a)
#pragma unroll
            for (int b = 0; b < 2; ++b)
#pragma unroll
                for (int m = 0; m < 4; ++m)
#pragma unroll
                    for (int n = 0; n < 2; ++n) acc[a][b][m][n] = (f32x4){0.f, 0.f, 0.f, 0.f};
        cur = nxt; cA = nA; cB = nB; ++ui;
        if constexpr (ALIGN_EPI) { if (wr == 1) PG8_BAR; }
    }
    PG8_WAIT_V(0);
    if constexpr (!ALIGN_EPI) { if (wr == 0) PG8_BAR; }
    PG8_BAR;
    if constexpr (Epi::AFTER_DRAIN) { E.fused(acc, cur, wr, wc, fr, fq, lds, wid, lane); S.done(cur); }
#undef PG8_SA
#undef PG8_SB
#undef PG8_STAGE
#undef PG8_LDA
#undef PG8_LDB
#undef PG8_MMA
#undef PG8_WAIT_V
#undef PG8_WAIT_L
#undef PG8_BAR
#undef PG8_SCHED
}
}

constexpr int NB = 8, SEQ = 4096, DM = 1024, NL = 2, CTXL = 256;
constexpr int NLAT = NB * SEQ, NCTX = NB * CTXL, NROW = NLAT + NCTX;
constexpr int DFF = 2816, NPJ = 2816, INW = 2824, NMODW = 9 * DM;
constexpr float LN_EPS = 1e-5f, ALPHA = 1.41421356237f;
constexpr int C_AQ = 0, C_AK = 256, C_AV = 384, C_BZ = 512, C_BX = 768, C_CQ = 1536, C_CK = 1792, C_CV = 1920, C_DQ = 2048, C_DK = 2304, C_DV = 2560;
constexpr int C_DTSRC = 1536;
constexpr size_t MiB = 1u << 20;
constexpr size_t WS_MOD = 0;
constexpr size_t WS_DT = 1 * MiB;
constexpr size_t WS_W = 4 * MiB, WS_WL = 41 * MiB;
constexpr size_t WO_W1A = 0, WO_W2A = 11 * MiB, WO_WIN = 16 * MiB + MiB / 2, WO_WOUT = 22 * MiB, WO_W1B = 24 * MiB, WO_W2B = 35 * MiB;
constexpr size_t WS_A = 86 * MiB;
constexpr size_t WS_ACT = 154 * MiB;
constexpr size_t WS_U = 341 * MiB;
constexpr size_t WS_O = 392 * MiB;
constexpr size_t WS_XC = 460 * MiB;
constexpr size_t WS_Y = 468 * MiB;
constexpr size_t WS_END = 512 * MiB;
constexpr int RING_BYTES = 131072, ROPE_OFF = RING_BYTES, LDS_BYTES = 147456;
constexpr int NWAVES = 8;
constexpr bool GEMM_SP2 = true;

#define LAS __attribute__((address_space(3)))
#define DI __device__ __forceinline__
typedef unsigned short bf16;
typedef unsigned v4u __attribute__((ext_vector_type(4)));
typedef unsigned v2u __attribute__((ext_vector_type(2)));
typedef float f32x4 __attribute__((ext_vector_type(4)));

DI float bf2f(unsigned b) { return __uint_as_float(b << 16); }
DI float bflo(unsigned w) { return __uint_as_float(w << 16); }
DI float bfhi(unsigned w) { return __uint_as_float(w & 0xffff0000u); }
DI unsigned f2bf(float f) { unsigned u = __float_as_uint(f); return (u + 0x7fffu + ((u >> 16) & 1u)) >> 16; }
DI unsigned pk2(float lo, float hi) { return f2bf(lo) | (f2bf(hi) << 16); }
typedef float f32x2_t __attribute__((ext_vector_type(2))); typedef __bf16 bf16x2_t __attribute__((ext_vector_type(2)));
DI unsigned cvtpk(float lo, float hi) { f32x2_t v = {lo, hi}; bf16x2_t b = __builtin_convertvector(v, bf16x2_t); return __builtin_bit_cast(unsigned, b); }
DI float wave_sum(float v) {
#pragma unroll
    for (int o = 1; o < 64; o <<= 1) v += __shfl_xor(v, o);
    return v;
}
DI float silu(float x) { return x / (1.0f + __expf(-x)); }

struct Args { const float* in[24]; float* out; unsigned char* ws; };
typedef const __attribute__((address_space(4))) Args* KArgs;
DI KArgs kargs() { KArgs p = (KArgs)__builtin_amdgcn_kernarg_segment_ptr(); asm volatile("" : "+s"(p)); return p; }

struct Frame {
    LAS unsigned char* lds;
    int tid, lane, wave, G, gw, ngw;
};
DI Frame mkframe() { Frame F; extern __shared__ __attribute__((aligned(16))) unsigned char lds_base[]; F.lds = (LAS unsigned char*)lds_base;
    int t = threadIdx.x; asm volatile("" : "+v"(t)); F.tid = t; F.lane = t & 63; F.wave = __builtin_amdgcn_readfirstlane(t >> 6);
    F.G = gridDim.x; F.gw = blockIdx.x * NWAVES + F.wave; F.ngw = F.G * NWAVES; return F; }
DI bf16* wbuf(KArgs KA, int l, size_t off) { return (bf16*)((KA->ws) + WS_W + (size_t)l * WS_WL + off); }

DI void transpose_item(const float* W, int ldw, int k0, int n0, bf16* WT, int ldt, int drow0, LAS float* scr, int lane) {
    float tv[32];
#pragma unroll
    for (int i = 0; i < 32; ++i) tv[i] = W[(size_t)(k0 + 2 * i + (lane >> 5)) * ldw + n0 + (lane & 31)];
#pragma unroll
    for (int i = 0; i < 32; ++i) scr[(2 * i + (lane >> 5)) * 33 + (lane & 31)] = tv[i];
    asm volatile("s_waitcnt lgkmcnt(0)" ::: "memory");
    const int c = lane & 7;
#pragma unroll
    for (int j = 0; j < 4; ++j) { const int n = (lane >> 3) + 8 * j; const LAS float* s = scr + (8 * c) * 33 + n;
        v4u o; o.x = pk2(s[0 * 33], s[1 * 33]); o.y = pk2(s[2 * 33], s[3 * 33]); o.z = pk2(s[4 * 33], s[5 * 33]); o.w = pk2(s[6 * 33], s[7 * 33]);
        *(v4u*)(WT + (size_t)(drow0 + n) * ldt + k0 + 8 * c) = o; }
    asm volatile("s_waitcnt lgkmcnt(0)" ::: "memory");
}
DI void p0a() {
    KArgs KA = kargs(); Frame F = mkframe();
    {
        LAS float* sv = (LAS float*)F.lds;
        for (int it = blockIdx.x; it < NL * 16 * 9; it += F.G) {
            const int l = it / 144, kc = (it % 144) / 9, cb = it % 9;
            __syncthreads();
            for (int i = F.tid; i < 576; i += 512) { const int r = i >> 6, kk = i & 63; const float v = r < 8 ? KA->in[1][r * DM + kc * 64 + kk] : KA->in[3][kc * 64 + kk]; sv[i] = silu(v); }
            __syncthreads();
            const int cg4 = F.tid & 255, kh = F.tid >> 8, col = cb * 1024 + 4 * cg4;
            f32x4 acc[9];
#pragma unroll
            for (int r = 0; r < 9; ++r) acc[r] = (f32x4){0.f, 0.f, 0.f, 0.f};
            const float* wp = KA->in[4] + ((size_t)l * DM + kc * 64 + kh * 32) * NMODW + col;
#pragma unroll 8
            for (int kk = 0; kk < 32; ++kk) { const f32x4 w = *(const f32x4*)(wp + (size_t)kk * NMODW);
#pragma unroll
                for (int r = 0; r < 9; ++r) acc[r] += w * sv[r * 64 + kh * 32 + kk]; }
#pragma unroll
            for (int r = 0; r < 9; ++r) *(f32x4*)(((float*)(KA->ws + WS_ACT)) + ((size_t)(l * 32 + kc * 2 + kh) * 9 + r) * NMODW + col) = acc[r];
        }
        __syncthreads();
    }
    LAS float* scr = (LAS float*)(F.lds + F.wave * 16384);
    constexpr int I1 = 16 * 176, I2 = 44 * 32, I3 = 16 * 88, I4 = 16 * 32, IL = 2 * I1 + 2 * I2 + I3 + I4;
    for (int it = F.gw; it < NL * IL; it += F.ngw) {
        const int l = it / IL; int r = it % IL;
        if (r < I1 || (r >= I1 + I2 + I3 + I4 && r < 2 * I1 + I2 + I3 + I4)) {
            const bool second = r >= I1; if (second) r -= I1 + I2 + I3 + I4;
            const int kb = r / 176, nb = r % 176, n0 = nb * 32;
            const int drow = n0 < DFF ? 256 * (n0 >> 7) + (n0 & 127) : 256 * ((n0 - DFF) >> 7) + 128 + ((n0 - DFF) & 127);
            transpose_item((second ? KA->in[22] : KA->in[8]) + (size_t)l * DM * 2 * DFF, 2 * DFF, kb * 64, n0, wbuf(KA, l, second ? WO_W1B : WO_W1A), DM, drow, scr, F.lane);
            continue; }
        r -= I1;
        if (r < I2) { const int kb = r / 32, nb = r % 32; transpose_item(KA->in[9] + (size_t)l * DFF * DM, DM, kb * 64, nb * 32, wbuf(KA, l, WO_W2A), DFF, nb * 32, scr, F.lane); continue; }
        r -= I2;
        if (r < I3) { const int kb = r / 88, nb = r % 88; const int n0 = nb < 48 ? nb * 32 : 1544 + (nb - 48) * 32;
            transpose_item(KA->in[10] + (size_t)l * DM * INW, INW, kb * 64, n0, wbuf(KA, l, WO_WIN), DM, nb * 32, scr, F.lane); continue; }
        r -= I3;
        if (r < I4) { const int kb = r / 32, nb = r % 32; transpose_item(KA->in[11] + (size_t)l * DM * DM, DM, kb * 64, nb * 32, wbuf(KA, l, WO_WOUT), DM, nb * 32, scr, F.lane); continue; }
        r -= I4 + I1;
        { const int kb = r / 32, nb = r % 32; transpose_item(KA->in[23] + (size_t)l * DFF * DM, DM, kb * 64, nb * 32, wbuf(KA, l, WO_W2B), DFF, nb * 32, scr, F.lane); }
    }
}
DI void p0b() {
    KArgs KA = kargs(); Frame F = mkframe();
    for (int i = blockIdx.x * 512 + F.tid; i < NL * 9 * NMODW; i += F.G * 512) {
        const int l = i / (9 * NMODW), rr = (i / NMODW) % 9, n = i % NMODW;
        float s = KA->in[5][l * NMODW + n];
        for (int p = 0; p < 32; ++p) s += ((float*)(KA->ws + WS_ACT))[((size_t)(l * 32 + p) * 9 + rr) * NMODW + n];
        ((float*)(KA->ws + WS_MOD))[i] = s;
    }
}
DI const float* modp(KArgs KA, int l, int mb, int idx) { return ((float*)(KA->ws + WS_MOD)) + ((size_t)(l * 9 + mb) * 9 + idx) * DM; }
DI void p0c() {
    KArgs KA = kargs(); Frame F = mkframe();
    for (int row = F.gw; row < NROW; row += F.ngw) {
        const int mb = row < NLAT ? (row >> 12) : 8;
        const float* src = row < NLAT ? KA->in[0] + (size_t)row * DM : KA->in[2] + (size_t)(row - NLAT) * DM;
        const float* sh = modp(KA, 0, mb, 0); const float* sc = modp(KA, 0, mb, 1);
#pragma unroll
        for (int j = 0; j < 4; ++j) { const int n = 4 * F.lane + 256 * j; const f32x4 v = *(const f32x4*)(src + n);
            const f32x4 a = v * (1.0f + *(const f32x4*)(sc + n)) + *(const f32x4*)(sh + n);
            v2u w; w.x = pk2(a.x, a.y); w.y = pk2(a.z, a.w); *(v2u*)(((bf16*)(KA->ws + WS_A)) + (size_t)row * DM + n) = w; }
    }
}
DI void ln_pass(int l, int gidx, float gmul, int lnidx, int nl, int nsh, int row0, int nrows, int wg0, int nwgs, const bool DTP) {
    KArgs KA = kargs(); Frame F = mkframe();
    F.gw = row0 + ((int)blockIdx.x - wg0) * NWAVES + F.wave; F.ngw = nwgs * NWAVES;
    LAS float* wdt = (LAS float*)F.lds;
    if (DTP) { __syncthreads(); for (int i = F.tid; i < 8192; i += 512) wdt[i] = KA->in[10][((size_t)l * DM + (i >> 3)) * INW + C_DTSRC + (i & 7)]; __syncthreads(); }
    const float* g = KA->in[6] + (l * 3 + lnidx) * DM; const float* bb = KA->in[7] + (l * 3 + lnidx) * DM;
    float* const xlat = KA->out; float* const xctx = (float*)(KA->ws + WS_XC); const bf16* const fbase = (const bf16*)(KA->ws + WS_O);
    const bool fromin = (l == 0 && lnidx == 0);
    const float* const slat = fromin ? KA->in[0] : (const float*)xlat; const float* const sctx = fromin ? KA->in[2] : (const float*)xctx;
    f32x4 xn[4]; v2u fn[4];
    if (F.gw < nrows) { const int row = F.gw; const float* xr = row < NLAT ? slat + (size_t)row * DM : sctx + (size_t)(row - NLAT) * DM;
#pragma unroll
        for (int j = 0; j < 4; ++j) { const int n = 4 * F.lane + 256 * j; xn[j] = *(const f32x4*)(xr + n); fn[j] = *(const v2u*)(fbase + (size_t)row * DM + n); } }
    for (int row = F.gw; row < nrows; row += F.ngw) {
        const int mb = row < NLAT ? (row >> 12) : 8;
        float* xrow = row < NLAT ? xlat + (size_t)row * DM : xctx + (size_t)(row - NLAT) * DM;
        const float* gate = modp(KA, l, mb, gidx);
        f32x4 v[4]; float s = 0.f;
#pragma unroll
        for (int j = 0; j < 4; ++j) { const int n = 4 * F.lane + 256 * j; const f32x4 gt = *(const f32x4*)(gate + n);
            const f32x4 fv = (f32x4){bflo(fn[j].x), bfhi(fn[j].x), bflo(fn[j].y), bfhi(fn[j].y)};
            v[j] = xn[j] * ALPHA + gt * fv * gmul; s += (v[j].x + v[j].y) + (v[j].z + v[j].w); }
        { const int nrow = row + F.ngw;
          if (nrow < nrows) { const float* xr = nrow < NLAT ? slat + (size_t)nrow * DM : sctx + (size_t)(nrow - NLAT) * DM;
#pragma unroll
            for (int j = 0; j < 4; ++j) { const int n = 4 * F.lane + 256 * j; xn[j] = *(const f32x4*)(xr + n); fn[j] = *(const v2u*)(fbase + (size_t)nrow * DM + n); } } }
        const float mean = wave_sum(s) * (1.f / DM); float s2 = 0.f;
#pragma unroll
        for (int j = 0; j < 4; ++j) { v[j] = v[j] - mean; s2 += (v[j].x * v[j].x + v[j].y * v[j].y) + (v[j].z * v[j].z + v[j].w * v[j].w); }
        const float rstd = 1.f / sqrtf(wave_sum(s2) * (1.f / DM) + LN_EPS);
        float dt[8];
#pragma unroll
        for (int q = 0; q < 8; ++q) dt[q] = 0.f;
#pragma unroll
        for (int j = 0; j < 4; ++j) { const int n = 4 * F.lane + 256 * j;
            const f32x4 y = v[j] * rstd * *(const f32x4*)(g + n) + *(const f32x4*)(bb + n);
            *(f32x4*)(xrow + n) = y;
            if (nsh >= 0) { const f32x4 a = y * (1.0f + *(const f32x4*)(modp(KA, nl, mb, nsh + 1) + n)) + *(const f32x4*)(modp(KA, nl, mb, nsh) + n);
                v2u w; w.x = cvtpk(a.x, a.y); w.y = cvtpk(a.z, a.w); *(v2u*)(((bf16*)(KA->ws + WS_A)) + (size_t)row * DM + n) = w;
                if (DTP) {
#pragma unroll
                    for (int e = 0; e < 4; ++e) { const f32x4 w0 = *(const LAS f32x4*)(wdt + (n + e) * 8), w1 = *(const LAS f32x4*)(wdt + (n + e) * 8 + 4); const float ae = a[e];
                        dt[0] += ae * w0.x; dt[1] += ae * w0.y; dt[2] += ae * w0.z; dt[3] += ae * w0.w; dt[4] += ae * w1.x; dt[5] += ae * w1.y; dt[6] += ae * w1.z; dt[7] += ae * w1.w; } } }
        }
        if (DTP) {
#pragma unroll
            for (int q = 0; q < 8; ++q) dt[q] = wave_sum(dt[q]);
            if (F.lane == 0) { *(f32x4*)(((float*)(KA->ws + WS_DT)) + (size_t)row * 8) = (f32x4){dt[0], dt[1], dt[2], dt[3]}; *(f32x4*)(((float*)(KA->ws + WS_DT)) + (size_t)row * 8 + 4) = (f32x4){dt[4], dt[5], dt[6], dt[7]}; }
        }
    }
}
DI void prep_pass(int l) {
    KArgs KA = kargs(); Frame F = mkframe();
    const LAS float* rc = (const LAS float*)(F.lds + ROPE_OFF); const LAS float* rsn = rc + 1024;
    bf16* P = (bf16*)(KA->ws + WS_ACT); bf16* U = (bf16*)(KA->ws + WS_U); float* DTB = (float*)(KA->ws + WS_DT);
    const int hv = F.lane >> 5, s = F.lane & 31, hsub = s >> 3, ra = (s >> 2) & 1, ig = s & 3, d1 = ra * 32 + 4 * ig, d2 = d1 + 16;
    constexpr int NBLK = NROW / 8;
    for (int item = F.gw; item < 4 * NBLK; item += F.ngw) {
        const int part = item / NBLK, rb = item - part * NBLK;
        const int row8 = rb * 8; const bool lat = row8 < NLAT;
        if (part == 0) {
#pragma unroll
        for (int rr = 0; rr < 4; ++rr) {
            const int row = row8 + 2 * rr + hv; const int t = row & 4095;
            const int pos = ra == 0 ? (t >> 6) : (t & 63);
            const f32x4 cs = *(const LAS f32x4*)(rc + pos * 16 + 4 * ig), sn = *(const LAS f32x4*)(rsn + pos * 16 + 4 * ig);
            bf16* pr = P + (size_t)row * NPJ;
#pragma unroll
            for (int it = 0; it < 3; ++it) {
                const int hh = it * 4 + hsub;
                const bool isc = hh >= 6; const int h6 = isc ? hh - 6 : hh;
                const int col = (isc ? (h6 < 4 ? C_CQ + h6 * 64 : C_CK + (h6 - 4) * 64) : (h6 < 4 ? C_AQ + h6 * 64 : C_AK + (h6 - 4) * 64));
                const v2u w1 = *(const v2u*)(pr + col + d1), w2 = *(const v2u*)(pr + col + d2);
                f32x4 x1 = (f32x4){bflo(w1.x), bfhi(w1.x), bflo(w1.y), bfhi(w1.y)}, x2 = (f32x4){bflo(w2.x), bfhi(w2.x), bflo(w2.y), bfhi(w2.y)};
                float ss = (x1.x * x1.x + x1.y * x1.y) + (x1.z * x1.z + x1.w * x1.w) + (x2.x * x2.x + x2.y * x2.y) + (x2.z * x2.z + x2.w * x2.w);
                ss += __shfl_xor(ss, 1); ss += __shfl_xor(ss, 2); ss += __shfl_xor(ss, 4);
                if (isc) { const float r = (h6 < 4 ? 0.125f * 1.4426950408889634f : 1.0f) / sqrtf(ss * (1.f / 64.f) + LN_EPS); const float* gn = (h6 < 4 ? KA->in[19] : KA->in[20]) + l * 64;
                    x1 = x1 * r * *(const f32x4*)(gn + d1); x2 = x2 * r * *(const f32x4*)(gn + d2); }
                if (lat) { const f32x4 y1 = x1 * cs - x2 * sn, y2 = x1 * sn + x2 * cs; x1 = y1; x2 = y2; }
                if (isc || lat) { v2u o1, o2; o1.x = cvtpk(x1.x, x1.y); o1.y = cvtpk(x1.z, x1.w); o2.x = cvtpk(x2.x, x2.y); o2.y = cvtpk(x2.z, x2.w);
                    *(v2u*)(pr + col + d1) = o1; *(v2u*)(pr + col + d2) = o2; }
            }
        }
        { const int row = row8 + (F.lane >> 3), q = F.lane & 7; const float v = DTB[(size_t)row * 8 + q] + KA->in[16][l * 8 + q]; DTB[(size_t)row * 8 + q] = fmaxf(v, 0.f) + log1pf(__expf(-fabsf(v))); }
        } else {
        const int Ls = lat ? SEQ : CTXL; const int tt0 = lat ? (row8 & 4095) : ((row8 - NLAT) & 255);
        { const int j = part - 1; const int ch = 4 * F.lane + 256 * j;
            const f32x4 bias = *(const f32x4*)(KA->in[15] + l * 768 + ch);
            f32x4 cw[5];
#pragma unroll
            for (int k = 0; k < 5; ++k) cw[k] = *(const f32x4*)(KA->in[14] + (l * 5 + k) * 768 + ch);
            f32x4 xw[12];
#pragma unroll
            for (int q = 0; q < 12; ++q) { const int t2 = tt0 + q - 2;
                if (t2 >= 0 && t2 < Ls) { const v2u w = *(const v2u*)(P + (size_t)(row8 + q - 2) * NPJ + C_BX + ch); xw[q] = (f32x4){bflo(w.x), bfhi(w.x), bflo(w.y), bfhi(w.y)}; }
                else xw[q] = (f32x4){0.f, 0.f, 0.f, 0.f}; }
#pragma unroll
            for (int q = 0; q < 8; ++q) { f32x4 acc = bias;
#pragma unroll
                for (int k = 0; k < 5; ++k) acc += cw[k] * xw[q + k];
                v2u o; o.x = cvtpk(silu(acc.x), silu(acc.y)); o.y = cvtpk(silu(acc.z), silu(acc.w)); *(v2u*)(U + (size_t)(row8 + q) * 768 + ch) = o; }
        }
        }
    }
}
DI void nkey(const float (&q)[64], float (&o)[64], float& m, float& l, const bf16* kr, const bf16* vr, float bias) {
    float s = bias;
#pragma unroll
    for (int c = 0; c < 8; ++c) { const v4u w = *(const v4u*)(kr + 8 * c);
        s += q[8 * c] * bflo(w.x) + q[8 * c + 1] * bfhi(w.x) + q[8 * c + 2] * bflo(w.y) + q[8 * c + 3] * bfhi(w.y) + q[8 * c + 4] * bflo(w.z) + q[8 * c + 5] * bfhi(w.z) + q[8 * c + 6] * bflo(w.w) + q[8 * c + 7] * bfhi(w.w); }
    const float mn = fmaxf(m, s), cf = __expf(m - mn), p = __expf(s - mn);
    l = l * cf + p; m = mn;
#pragma unroll
    for (int c = 0; c < 8; ++c) { const v4u w = *(const v4u*)(vr + 8 * c);
        o[8 * c] = o[8 * c] * cf + p * bflo(w.x); o[8 * c + 1] = o[8 * c + 1] * cf + p * bfhi(w.x); o[8 * c + 2] = o[8 * c + 2] * cf + p * bflo(w.y); o[8 * c + 3] = o[8 * c + 3] * cf + p * bfhi(w.y);
        o[8 * c + 4] = o[8 * c + 4] * cf + p * bflo(w.z); o[8 * c + 5] = o[8 * c + 5] * cf + p * bfhi(w.z); o[8 * c + 6] = o[8 * c + 6] * cf + p * bflo(w.w); o[8 * c + 7] = o[8 * c + 7] * cf + p * bfhi(w.w); }
}
template <int TYPE>
DI void naive_attn(int l, int row, int h, bool ctxq) {
    KArgs KA = kargs(); Frame F = mkframe();
    const bf16* P = ((bf16*)(KA->ws + WS_ACT));
    const int qcol = (TYPE == 0 ? C_AQ : TYPE == 1 ? C_CQ : C_DQ) + h * 64;
    const int kvh = TYPE == 2 ? h : (h >> 1);
    const int kcol = (TYPE == 0 ? C_AK : TYPE == 1 ? C_CK : C_DK) + kvh * 64, vcol = (TYPE == 0 ? C_AV : TYPE == 1 ? C_CV : C_DV) + kvh * 64;
    float q[64], o[64]; float m = -1e30f, ls = 0.f;
#pragma unroll
    for (int c = 0; c < 8; ++c) { const v4u w = *(const v4u*)(P + (size_t)row * NPJ + qcol + 8 * c);
        q[8 * c] = 0.125f * bflo(w.x); q[8 * c + 1] = 0.125f * bfhi(w.x); q[8 * c + 2] = 0.125f * bflo(w.y); q[8 * c + 3] = 0.125f * bfhi(w.y);
        q[8 * c + 4] = 0.125f * bflo(w.z); q[8 * c + 5] = 0.125f * bfhi(w.z); q[8 * c + 6] = 0.125f * bflo(w.w); q[8 * c + 7] = 0.125f * bfhi(w.w); }
#pragma unroll
    for (int d = 0; d < 64; ++d) o[d] = 0.f;
    int b;
    if (!ctxq) {
        b = row >> 12; const int t = row & 4095;
        if (TYPE == 0) { const int k0 = max(t - 128, 0), k1 = min(t + 128, SEQ - 1);
            for (int k = k0; k <= k1; ++k) { const bf16* kp = P + (size_t)(b * SEQ + k) * NPJ; nkey(q, o, m, ls, kp + kcol, kp + vcol, 0.f); } }
        else if (TYPE == 1) { for (int k = 0; k < SEQ; ++k) { const bf16* kp = P + (size_t)(b * SEQ + k) * NPJ; nkey(q, o, m, ls, kp + kcol, kp + vcol, 0.f); } }
        else { const int r = t >> 6, c = t & 63; const int rs = min(max(r - 4, 0), 56), cs = min(max(c - 8, 0), 48);
            for (int a = 0; a < 8; ++a) { const float* bp = KA->in[21] + ((size_t)(l * 4 + h) * 15 + (rs + a - r + 7)) * 31 + (cs - c + 15);
                for (int k = 0; k < 16; ++k) { const bf16* kp = P + (size_t)(b * SEQ + (rs + a) * 64 + cs + k) * NPJ; nkey(q, o, m, ls, kp + kcol, kp + vcol, bp[k]); } } }
    } else b = (row - NLAT) >> 8;
    for (int k = 0; k < CTXL; ++k) { const bf16* kp = P + (size_t)(NLAT + b * CTXL + k) * NPJ; nkey(q, o, m, ls, kp + kcol, kp + vcol, 0.f); }
    if (TYPE == 0) { const float sk = KA->in[13][l * 4 + h]; const float mn = fmaxf(m, sk), cf = __expf(m - mn); ls = ls * cf + __expf(sk - mn);
#pragma unroll
        for (int d = 0; d < 64; ++d) o[d] *= cf; }
    const float inv = 1.f / ls;
    bf16* op = ((bf16*)(KA->ws + WS_O)) + (size_t)row * DM + (TYPE == 0 ? 0 : TYPE == 1 ? 512 : 768) + h * 64;
#pragma unroll
    for (int c = 0; c < 8; ++c) { v4u w; w.x = pk2(o[8 * c] * inv, o[8 * c + 1] * inv); w.y = pk2(o[8 * c + 2] * inv, o[8 * c + 3] * inv); w.z = pk2(o[8 * c + 4] * inv, o[8 * c + 5] * inv); w.w = pk2(o[8 * c + 6] * inv, o[8 * c + 7] * inv);
        *(v4u*)(op + 8 * c) = w; }
}
DI void naive_ssd(int l, int item) {
    KArgs KA = kargs(); Frame F = mkframe();
    const int b = item >> 3, dir = (item >> 2) & 1, h = item & 3, g = h >> 1;
    const int p = F.tid >> 3, ng = F.tid & 7;
    const float A = -__expf(KA->in[17][l * 8 + dir * 4 + h]);
    bf16* Y = dir ? (((bf16*)(KA->ws + WS_Y) + (size_t)NROW * 256)) : ((bf16*)(KA->ws + WS_Y));
    float hs[16];
#pragma unroll
    for (int i = 0; i < 16; ++i) hs[i] = 0.f;
    for (int ph = 0; ph < 2; ++ph) {
        const int ns = ph ? SEQ : CTXL, base = ph ? b * SEQ : NLAT + b * CTXL;
#pragma unroll 4
        for (int s = 0; s < ns; ++s) {
            const int row = base + (dir ? ns - 1 - s : s);
            const float dt = ((float*)(KA->ws + WS_DT))[(size_t)row * 8 + dir * 4 + h];
            const bf16* ur = ((bf16*)(KA->ws + WS_U)) + (size_t)row * 768;
            const float xv = bf2f(ur[h * 64 + p]);
            const v4u b0 = *(const v4u*)(ur + 256 + g * 128 + ng * 16), b1 = *(const v4u*)(ur + 256 + g * 128 + ng * 16 + 8);
            const v4u c0 = *(const v4u*)(ur + 512 + g * 128 + ng * 16), c1 = *(const v4u*)(ur + 512 + g * 128 + ng * 16 + 8);
            const float dA = __expf(dt * A), dx = dt * xv;
            const unsigned bw[8] = {b0.x, b0.y, b0.z, b0.w, b1.x, b1.y, b1.z, b1.w}, cw[8] = {c0.x, c0.y, c0.z, c0.w, c1.x, c1.y, c1.z, c1.w};
            float y = 0.f;
#pragma unroll
            for (int i = 0; i < 8; ++i) { hs[2 * i] = hs[2 * i] * dA + dx * bflo(bw[i]); hs[2 * i + 1] = hs[2 * i + 1] * dA + dx * bfhi(bw[i]); y += bflo(cw[i]) * hs[2 * i] + bfhi(cw[i]) * hs[2 * i + 1]; }
            y += __shfl_xor(y, 1); y += __shfl_xor(y, 2); y += __shfl_xor(y, 4);
            if (ng == 0) Y[(size_t)row * 256 + h * 64 + p] = (bf16)f2bf(y);
        }
    }
}
DI void mixers_naive(int l, bool last) {
    Frame F = mkframe();
    const int nAttL = 64 * 12, nAttC = last ? 0 : 4 * 12, nItems = 64 + nAttL + nAttC;
    for (int it = blockIdx.x; it < nItems; it += F.G) {
        if (it < 64) { naive_ssd(l, it); continue; }
        int r = it - 64; bool cq = false; int rowbase;
        if (r >= nAttL) { r -= nAttL; cq = true; }
        const int rb = r / 12, ty = (r % 12) >> 2, h = r & 3;
        rowbase = cq ? NLAT + rb * 512 : rb * 512;
        const int row = rowbase + F.tid;
        if (ty == 0) naive_attn<0>(l, row, h, cq); else if (ty == 1) naive_attn<1>(l, row, h, cq); else naive_attn<2>(l, row, h, cq);
    }
}
typedef float f32x16 __attribute__((ext_vector_type(16)));
typedef short s16x4 __attribute__((ext_vector_type(4)));
typedef short bf16x8v __attribute__((ext_vector_type(8)));
typedef short v4i16_t __attribute__((ext_vector_type(4)));
DI s16x4 vtr(const LAS unsigned char* p) { return __builtin_bit_cast(s16x4, __builtin_amdgcn_ds_read_tr16_b64_v4i16((LAS v4i16_t*)p)); }
DI int crow16(int i, int h) { return (i & 3) + 8 * (i >> 2) + 4 * h; }
constexpr int AT_KRS = 144, AT_VRS = 192, AT_KB = 64 * AT_KRS, AT_BUF = AT_KB + 64 * AT_VRS, AT_RPB = 2 * AT_BUF;
constexpr float LOG2E = 1.4426950408889634f, AT_SC = 0.125f * LOG2E;
template <int TYPE>
DI void attn_unit(KArgs KA, const Frame& F, int l, int unit, bool ctxq) {
    const bf16* P = (const bf16*)(KA->ws + WS_ACT);
    const int L = F.lane, w = F.wave, r = L & 31, h2 = L >> 5, i16 = L & 15;
    int b, head, kvh, p0, qpos0, t0 = 0, nloc = 0;
    if (TYPE != 2) { int g, pb; if (!ctxq) { b = unit >> 6; g = (unit >> 5) & 1; pb = unit & 31; } else { b = unit >> 2; g = (unit >> 1) & 1; pb = unit & 1; }
        head = 2 * g + (w >> 2); kvh = g; p0 = pb * 128; qpos0 = p0 + 32 * (w & 3);
        if (!ctxq) { if (TYPE == 1) { t0 = 0; nloc = 64; } else { t0 = max(0, 2 * (pb - 1)); nloc = min(64, 2 * (pb + 2)) - t0; } } }
    else { int rb; if (!ctxq) { b = unit >> 6; head = (unit >> 4) & 3; rb = unit & 15; } else { b = unit >> 2; head = unit & 3; rb = 0; }
        kvh = head; p0 = rb * 256; qpos0 = p0 + 32 * w;
        if (!ctxq) { const int r0 = rb * 4; t0 = min(max(r0 - 4, 0), 56); nloc = min(max(r0 - 1, 0), 56) + 8 - t0; } }
    const int qcol = (TYPE == 0 ? C_AQ : TYPE == 1 ? C_CQ : C_DQ) + head * 64;
    const int kcol = (TYPE == 0 ? C_AK : TYPE == 1 ? C_CK : C_DK) + kvh * 64, vcol = (TYPE == 0 ? C_AV : TYPE == 1 ? C_CV : C_DV) + kvh * 64;
    const int qrow = (ctxq ? NLAT + b * CTXL : b * SEQ) + qpos0 + r;
    const int nt = nloc + 4;
    bf16x8v qf[4];
#pragma unroll
    for (int ks = 0; ks < 4; ++ks) qf[ks] = *(const bf16x8v*)(P + (size_t)qrow * NPJ + qcol + ks * 16 + 8 * h2);
    LAS unsigned char* lb = F.lds;
    if (TYPE == 2) { LAS float* rp = (LAS float*)(lb + AT_RPB); for (int i = F.tid; i < 465; i += 512) rp[i] = KA->in[21][(size_t)(l * 4 + head) * 465 + i] * 8.0f; }
    const int srow = F.tid >> 3, sch = F.tid & 7;
#define TILE_ROW0(i) ((i) < nloc ? b * SEQ + (t0 + (i)) * 64 : NLAT + b * CTXL + ((i) - nloc) * 64)
    v4u kreg, vreg;
    { const bf16* src = P + (size_t)(TILE_ROW0(0) + srow) * NPJ; kreg = *(const v4u*)(src + kcol + sch * 8); vreg = *(const v4u*)(src + vcol + sch * 8); }
    *(LAS v4u*)(lb + srow * AT_KRS + sch * 16) = kreg; *(LAS v4u*)(lb + AT_KB + srow * AT_VRS + sch * 16) = vreg;
    __syncthreads();
    f32x16 oacc[2];
#pragma unroll
    for (int i = 0; i < 16; ++i) { oacc[0][i] = 0.f; oacc[1][i] = 0.f; }
    float m = -1e30f, lsum = 0.f;
    if (TYPE == 1) {
        float gq = fabsf(KA->in[19][l * 64 + L]), gk = fabsf(KA->in[20][l * 64 + L]);
#pragma unroll
        for (int o = 1; o < 64; o <<= 1) { gq = fmaxf(gq, __shfl_xor(gq, o)); gk = fmaxf(gk, __shfl_xor(gk, o)); }
        m = 64.0f * 1.03f * gq * gk * AT_SC;
    }
    const int qpos = qpos0 + r;
    const int gr = qpos0 >> 6, rs = min(max(gr - 4, 0), 56), qc = qpos & 63, cs = min(max(qc - 8, 0), 48);
    for (int i = 0; i < nt; ++i) {
        const LAS unsigned char* kb_ = lb + (i & 1) * AT_BUF; const LAS unsigned char* vb_ = kb_ + AT_KB;
        if (i + 1 < nt) { const bf16* src = P + (size_t)(TILE_ROW0(i + 1) + srow) * NPJ; kreg = *(const v4u*)(src + kcol + sch * 8); vreg = *(const v4u*)(src + vcol + sch * 8); }
        const bool loc = i < nloc;
        bool skip = false;
        const int k0 = (t0 + i) * 64;
        if (loc && TYPE == 0) skip = (k0 + 63 < qpos0 - 128) || (k0 > qpos0 + 31 + 128);
        if (loc && TYPE == 2) skip = (t0 + i < rs) || (t0 + i >= rs + 8);
        if (!skip) {
            f32x16 sacc[2];
            bf16x8v kf[2][4], vf[2][2][2];
#pragma unroll
            for (int kb = 0; kb < 2; ++kb)
#pragma unroll
                for (int ks = 0; ks < 4; ++ks) kf[kb][ks] = *(const LAS bf16x8v*)(kb_ + (kb * 32 + r) * AT_KRS + ks * 32 + 16 * h2);
#pragma unroll
            for (int kb = 0; kb < 2; ++kb)
#pragma unroll
                for (int s = 0; s < 2; ++s)
#pragma unroll
                    for (int db = 0; db < 2; ++db) {
                        const LAS unsigned char* va = vb_ + (kb * 32 + 16 * s + 4 * h2 + (i16 >> 2)) * AT_VRS + (db * 32 + 16 * ((L >> 4) & 1) + 4 * (i16 & 3)) * 2;
                        const s16x4 lo = vtr(va), hi = vtr(va + 8 * AT_VRS);
                        vf[kb][s][db] = (bf16x8v){lo[0], lo[1], lo[2], lo[3], hi[0], hi[1], hi[2], hi[3]}; }
            __builtin_amdgcn_sched_barrier(0);
#pragma unroll
            for (int kb = 0; kb < 2; ++kb) {
#pragma unroll
                for (int q = 0; q < 16; ++q) sacc[kb][q] = (TYPE == 1) ? -m : 0.f;
#pragma unroll
                for (int ks = 0; ks < 4; ++ks) sacc[kb] = __builtin_amdgcn_mfma_f32_32x32x16_bf16(kf[kb][ks], qf[ks], sacc[kb], 0, 0, 0);
            }
            float tmax = -INFINITY;
            if ((TYPE == 0 || TYPE == 2) && loc) {
#pragma unroll
                for (int kb = 0; kb < 2; ++kb)
#pragma unroll
                    for (int q = 0; q < 16; ++q) { float s = sacc[kb][q]; const int kk = kb * 32 + crow16(q, h2);
                        if (TYPE == 0) { const int d = k0 + kk - qpos; if (d > 128 || d < -128) s = -INFINITY; }
                        if (TYPE == 2) { const int dc = kk - cs; const LAS float* rp = (const LAS float*)(lb + AT_RPB);
                            if (dc < 0 || dc >= 16) s = -INFINITY; else s += rp[(t0 + i - gr + 7) * 31 + (kk - qc + 15)]; }
                        sacc[kb][q] = s; }
            }
            if (TYPE != 1) {
#pragma unroll
                for (int kb = 0; kb < 2; ++kb)
#pragma unroll
                    for (int q = 0; q < 16; ++q) tmax = fmaxf(tmax, sacc[kb][q]);
                tmax = fmaxf(tmax, __shfl_xor(tmax, 32));
                const float mn = fmaxf(m, tmax);
                if (__any(mn > m)) {
                    const float alpha = __builtin_amdgcn_exp2f((m - mn) * AT_SC);
                    lsum *= alpha;
#pragma unroll
                    for (int q = 0; q < 16; ++q) { oacc[0][q] *= alpha; oacc[1][q] *= alpha; }
                }
                m = mn;
            }
            const float mns = -m * AT_SC;
            float psum = 0.f;
#pragma unroll
            for (int kb = 0; kb < 2; ++kb)
#pragma unroll
                for (int q = 0; q < 16; ++q) { const float p = (TYPE == 1) ? __builtin_amdgcn_exp2f(sacc[kb][q]) : __builtin_amdgcn_exp2f(__builtin_fmaf(sacc[kb][q], AT_SC, mns)); sacc[kb][q] = p; psum += p; }
            lsum += psum;
#pragma unroll
            for (int kb = 0; kb < 2; ++kb)
#pragma unroll
                for (int s = 0; s < 2; ++s) {
                    v4u pw; pw.x = cvtpk(sacc[kb][8 * s], sacc[kb][8 * s + 1]); pw.y = cvtpk(sacc[kb][8 * s + 2], sacc[kb][8 * s + 3]); pw.z = cvtpk(sacc[kb][8 * s + 4], sacc[kb][8 * s + 5]); pw.w = cvtpk(sacc[kb][8 * s + 6], sacc[kb][8 * s + 7]);
                    const bf16x8v pf = __builtin_bit_cast(bf16x8v, pw);
#pragma unroll
                    for (int db = 0; db < 2; ++db) oacc[db] = __builtin_amdgcn_mfma_f32_32x32x16_bf16(vf[kb][s][db], pf, oacc[db], 0, 0, 0);
                }
        }
        if (i + 1 < nt) { LAS unsigned char* nb = lb + ((i + 1) & 1) * AT_BUF; *(LAS v4u*)(nb + srow * AT_KRS + sch * 16) = kreg; *(LAS v4u*)(nb + AT_KB + srow * AT_VRS + sch * 16) = vreg; }
        __syncthreads();
    }
    lsum += __shfl_xor(lsum, 32);
    if (TYPE == 0) lsum += __builtin_amdgcn_exp2f(KA->in[13][l * 4 + head] * LOG2E - m * AT_SC);
    const float inv = 1.f / lsum;
    bf16* op = (bf16*)(KA->ws + WS_O) + (size_t)qrow * DM + (TYPE == 0 ? 0 : TYPE == 1 ? 512 : 768) + head * 64;
#pragma unroll
    for (int db = 0; db < 2; ++db)
#pragma unroll
        for (int q4 = 0; q4 < 4; ++q4) { v2u o; o.x = cvtpk(oacc[db][4 * q4] * inv, oacc[db][4 * q4 + 1] * inv); o.y = cvtpk(oacc[db][4 * q4 + 2] * inv, oacc[db][4 * q4 + 3] * inv);
            *(v2u*)(op + db * 32 + 8 * q4 + 4 * h2) = o; }
}
constexpr size_t WS_ST = WS_A;
constexpr size_t WS_DEC = 3 * MiB;
constexpr int SS_B = 0, SS_BRS = 272, SS_X = 34816, SS_XRS = 192, SS_X2 = 59392, SS_HF = 83968, SS_HB = 101376, SS_ARR = 118784;
DI int slot_row(int b, int slot) { return slot < 2 ? NLAT + b * CTXL + slot * 128 : b * SEQ + (slot - 2) * 128; }
DI void ssd_stage_dt(KArgs KA, const Frame& F, int l, int h, int rowbase, LAS float* arr) {
    const float* DTB = (const float*)(KA->ws + WS_DT);
    if (F.tid < 128) { const float df = DTB[(size_t)(rowbase + F.tid) * 8 + h], db = DTB[(size_t)(rowbase + F.tid) * 8 + 4 + h];
        const float Af = -__expf(KA->in[17][l * 8 + h]) * LOG2E, Ab = -__expf(KA->in[17][l * 8 + 4 + h]) * LOG2E;
        arr[F.tid] = df * Af; arr[128 + F.tid] = db * Ab; arr[256 + F.tid] = df; arr[384 + F.tid] = db; }
    __syncthreads();
    if (F.wave < 2) { const int L = F.lane; const bool rev = F.wave == 1;
        const float v0 = rev ? arr[128 + 127 - 2 * L] : arr[2 * L], v1 = rev ? arr[128 + 126 - 2 * L] : arr[2 * L + 1];
        float t = v0 + v1;
#pragma unroll
        for (int o = 1; o < 64; o <<= 1) { const float u = __shfl_up(t, o); if (L >= o) t += u; }
        if (rev) { arr[640 + 127 - 2 * L] = t - v1; arr[640 + 126 - 2 * L] = t; } else { arr[512 + 2 * L] = t - v1; arr[512 + 2 * L + 1] = t; } }
    __syncthreads();
}
struct BRegs { v4u v[4]; };
DI BRegs ssd_load_B(KArgs KA, const Frame& F, int g, int rowbase) {
    const bf16* U = (const bf16*)(KA->ws + WS_U);
    const int row = F.tid >> 2, pc = F.tid & 3; const bf16* src = U + (size_t)(rowbase + row) * 768 + 256 + g * 128 + pc * 32;
    BRegs b;
#pragma unroll
    for (int k = 0; k < 4; ++k) b.v[k] = *(const v4u*)(src + k * 8);
    return b;
}
DI void ssd_store_B(const Frame& F, const BRegs& b) {
    const int row = F.tid >> 2, pc = F.tid & 3;
#pragma unroll
    for (int k = 0; k < 4; ++k) *(LAS v4u*)(F.lds + SS_B + row * SS_BRS + pc * 64 + k * 16) = b.v[k];
}
DI v4u scale8(v4u w, float s) { v4u o; o.x = cvtpk(bflo(w.x) * s, bfhi(w.x) * s); o.y = cvtpk(bflo(w.y) * s, bfhi(w.y) * s); o.z = cvtpk(bflo(w.z) * s, bfhi(w.z) * s); o.w = cvtpk(bflo(w.w) * s, bfhi(w.w) * s); return o; }
DI void ssd_states(KArgs KA, const Frame& F, int l, int item) {
    const int slot = item % 34, bh = item / 34, b = bh >> 2, h = bh & 3, g = h >> 1, rowbase = slot_row(b, slot);
    const int L = F.lane, w = F.wave, r = L & 31, h2 = L >> 5, i16 = L & 15, grp = (L >> 4) & 1;
    LAS float* arr = (LAS float*)(F.lds + SS_ARR);
    const BRegs breg = ssd_load_B(KA, F, g, rowbase);
    v4u x0, x1;
    { const bf16* U = (const bf16*)(KA->ws + WS_U); const int row = F.tid >> 2, pc = F.tid & 3; const bf16* src = U + (size_t)(rowbase + row) * 768 + h * 64 + pc * 16; x0 = *(const v4u*)src; x1 = *(const v4u*)(src + 8); }
    ssd_stage_dt(KA, F, l, h, rowbase, arr);
    ssd_store_B(F, breg);
    { const int row = F.tid >> 2, pc = F.tid & 3;
      const float wf = __builtin_amdgcn_exp2f(arr[512 + 127] - arr[512 + row]) * arr[256 + row], wb = __builtin_amdgcn_exp2f(arr[640] - arr[640 + row]) * arr[384 + row];
      *(LAS v4u*)(F.lds + SS_X + row * SS_XRS + pc * 32) = scale8(x0, wf); *(LAS v4u*)(F.lds + SS_X + row * SS_XRS + pc * 32 + 16) = scale8(x1, wf);
      *(LAS v4u*)(F.lds + SS_X2 + row * SS_XRS + pc * 32) = scale8(x0, wb); *(LAS v4u*)(F.lds + SS_X2 + row * SS_XRS + pc * 32 + 16) = scale8(x1, wb); }
    __syncthreads();
    const int pblk = w >> 2, nblk = w & 3;
    bf16* ST = (bf16*)(KA->ws + WS_ST); float* DEC = (float*)(KA->ws + WS_DEC);
#pragma unroll
    for (int dir = 0; dir < 2; ++dir) {
        f32x16 acc;
#pragma unroll
        for (int q = 0; q < 16; ++q) acc[q] = 0.f;
        const LAS unsigned char* xb = F.lds + (dir ? SS_X2 : SS_X);
#pragma unroll
        for (int ks = 0; ks < 8; ++ks) {
            const LAS unsigned char* xa = xb + (ks * 16 + 8 * h2 + (i16 >> 2)) * SS_XRS + (pblk * 32 + 16 * grp + 4 * (i16 & 3)) * 2;
            const s16x4 xlo = vtr(xa), xhi = vtr(xa + 4 * SS_XRS);
            const LAS unsigned char* ba = F.lds + SS_B + (ks * 16 + 8 * h2 + (i16 >> 2)) * SS_BRS + (nblk * 32 + 16 * grp + 4 * (i16 & 3)) * 2;
            const s16x4 blo = vtr(ba), bhi_ = vtr(ba + 4 * SS_BRS);
            const bf16x8v xf = (bf16x8v){xlo[0], xlo[1], xlo[2], xlo[3], xhi[0], xhi[1], xhi[2], xhi[3]}, bfr = (bf16x8v){blo[0], blo[1], blo[2], blo[3], bhi_[0], bhi_[1], bhi_[2], bhi_[3]};
            acc = __builtin_amdgcn_mfma_f32_32x32x16_bf16(xf, bfr, acc, 0, 0, 0); }
        bf16* dst = ST + ((size_t)((bh * 2 + dir) * 34 + slot)) * 8192;
#pragma unroll
        for (int q = 0; q < 16; ++q) dst[(pblk * 32 + crow16(q, h2)) * 128 + nblk * 32 + r] = (bf16)(cvtpk(acc[q], 0.f) & 0xffffu);
        if (F.tid == 0) DEC[(bh * 2 + dir) * 34 + slot] = __builtin_amdgcn_exp2f(dir ? arr[640] : arr[512 + 127]);
    }
    __syncthreads();
}
DI void ssd_scan() {
    KArgs KA = kargs(); Frame F = mkframe();
    bf16* ST = (bf16*)(KA->ws + WS_ST); const float* DEC = (const float*)(KA->ws + WS_DEC);
    for (int gt = blockIdx.x * 512 + F.tid; gt < 64 * 2048; gt += F.G * 512) {
        const int chain = gt >> 11, e4 = gt & 2047, dir = chain & 1;
        bf16* base = ST + (size_t)chain * 34 * 8192 + e4 * 4;
        v2u tw[34]; float dc[34];
#pragma unroll
        for (int k = 0; k < 34; ++k) { const int slot = dir == 0 ? k : (k < 2 ? 1 - k : 35 - k); tw[k] = *(const v2u*)(base + (size_t)slot * 8192); dc[k] = DEC[chain * 34 + slot]; }
        f32x4 hc = (f32x4){0.f, 0.f, 0.f, 0.f};
#pragma unroll
        for (int k = 0; k < 34; ++k) { const int slot = dir == 0 ? k : (k < 2 ? 1 - k : 35 - k);
            const f32x4 t = (f32x4){bflo(tw[k].x), bfhi(tw[k].x), bflo(tw[k].y), bfhi(tw[k].y)};
            v2u ow; ow.x = cvtpk(hc.x, hc.y); ow.y = cvtpk(hc.z, hc.w); *(v2u*)(base + (size_t)slot * 8192) = ow; hc = hc * dc[k] + t; }
    }
}
DI void ssd_outputs(KArgs KA, const Frame& F, int l, int item) {
    const int slot = item % 34, bh = item / 34, b = bh >> 2, h = bh & 3, g = h >> 1, rowbase = slot_row(b, slot);
    const int L = F.lane, w = F.wave, r = L & 31, h2 = L >> 5, i16 = L & 15, grp = (L >> 4) & 1;
    LAS float* arr = (LAS float*)(F.lds + SS_ARR);
    const bf16* U = (const bf16*)(KA->ws + WS_U);
    const int ib = w & 3, pb = w >> 2, ipos = ib * 32 + r;
    bf16x8v cfq[8];
#pragma unroll
    for (int ks = 0; ks < 8; ++ks) cfq[ks] = *(const bf16x8v*)(U + (size_t)(rowbase + ipos) * 768 + 512 + g * 128 + ks * 16 + 8 * h2);
    const BRegs breg = ssd_load_B(KA, F, g, rowbase);
    v4u x0, x1, hf0, hf1, hb0, hb1;
    { const int row = F.tid >> 2, pc = F.tid & 3; const bf16* src = U + (size_t)(rowbase + row) * 768 + h * 64 + pc * 16; x0 = *(const v4u*)src; x1 = *(const v4u*)(src + 8); }
    { const bf16* ST = (const bf16*)(KA->ws + WS_ST); const int p = F.tid >> 3, pc = F.tid & 7;
      const bf16* sf = ST + ((size_t)((bh * 2 + 0) * 34 + slot)) * 8192 + p * 128 + pc * 16; const bf16* sb = ST + ((size_t)((bh * 2 + 1) * 34 + slot)) * 8192 + p * 128 + pc * 16;
      hf0 = *(const v4u*)sf; hf1 = *(const v4u*)(sf + 8); hb0 = *(const v4u*)sb; hb1 = *(const v4u*)(sb + 8); }
    ssd_stage_dt(KA, F, l, h, rowbase, arr);
    ssd_store_B(F, breg);
    { const int row = F.tid >> 2, pc = F.tid & 3; *(LAS v4u*)(F.lds + SS_X + row * SS_XRS + pc * 32) = x0; *(LAS v4u*)(F.lds + SS_X + row * SS_XRS + pc * 32 + 16) = x1; }
    { const int p = F.tid >> 3, pc = F.tid & 7; LAS unsigned char* d = F.lds + SS_HF + p * SS_BRS + pc * 32; *(LAS v4u*)d = hf0; *(LAS v4u*)(d + 16) = hf1;
      LAS unsigned char* e = F.lds + SS_HB + p * SS_BRS + pc * 32; *(LAS v4u*)e = hb0; *(LAS v4u*)(e + 16) = hb1; }
    __syncthreads();
    const float cfi = arr[512 + ipos], cbi = arr[640 + ipos];
    f32x16 yacc;
#pragma unroll
    for (int q = 0; q < 16; ++q) yacc[q] = 0.f;
#pragma unroll
    for (int jb = 0; jb < 4; ++jb) {
        f32x16 acc;
#pragma unroll
        for (int q = 0; q < 16; ++q) acc[q] = 0.f;
#pragma unroll
        for (int ks = 0; ks < 8; ++ks) { const bf16x8v bfr = *(const LAS bf16x8v*)(F.lds + SS_B + (jb * 32 + r) * SS_BRS + ks * 32 + 16 * h2);
            acc = __builtin_amdgcn_mfma_f32_32x32x16_bf16(bfr, cfq[ks], acc, 0, 0, 0); }
        if (jb < ib) {
#pragma unroll
            for (int q = 0; q < 16; ++q) { const int j = jb * 32 + crow16(q, h2); acc[q] *= __builtin_amdgcn_exp2f(cfi - arr[512 + j]) * arr[256 + j]; }
        } else if (jb > ib) {
#pragma unroll
            for (int q = 0; q < 16; ++q) { const int j = jb * 32 + crow16(q, h2); acc[q] *= __builtin_amdgcn_exp2f(cbi - arr[640 + j]) * arr[384 + j]; }
        } else {
            int rl = r; asm volatile("" : "+v"(rl));
#pragma unroll
            for (int q = 0; q < 16; ++q) { const int jl = crow16(q, h2), j = jb * 32 + jl;
                float wt = 0.f;
                if (jl <= rl) wt += __builtin_amdgcn_exp2f(cfi - arr[512 + j]) * arr[256 + j];
                if (jl >= rl) wt += __builtin_amdgcn_exp2f(cbi - arr[640 + j]) * arr[384 + j];
                acc[q] *= wt; }
        }
#pragma unroll
        for (int s = 0; s < 2; ++s) {
            v4u pw; pw.x = cvtpk(acc[8 * s], acc[8 * s + 1]); pw.y = cvtpk(acc[8 * s + 2], acc[8 * s + 3]); pw.z = cvtpk(acc[8 * s + 4], acc[8 * s + 5]); pw.w = cvtpk(acc[8 * s + 6], acc[8 * s + 7]);
            const bf16x8v pf = __builtin_bit_cast(bf16x8v, pw);
            const LAS unsigned char* xa = F.lds + SS_X + (jb * 32 + 16 * s + 4 * h2 + (i16 >> 2)) * SS_XRS + (pb * 32 + 16 * grp + 4 * (i16 & 3)) * 2;
            const s16x4 lo = vtr(xa), hi = vtr(xa + 8 * SS_XRS);
            const bf16x8v xf = (bf16x8v){lo[0], lo[1], lo[2], lo[3], hi[0], hi[1], hi[2], hi[3]};
            yacc = __builtin_amdgcn_mfma_f32_32x32x16_bf16(xf, pf, yacc, 0, 0, 0); }
    }
#pragma unroll
    for (int dir = 0; dir < 2; ++dir) {
        f32x16 tacc;
#pragma unroll
        for (int q = 0; q < 16; ++q) tacc[q] = 0.f;
#pragma unroll
        for (int ks = 0; ks < 8; ++ks) { const bf16x8v hfr = *(const LAS bf16x8v*)(F.lds + (dir ? SS_HB : SS_HF) + (pb * 32 + r) * SS_BRS + ks * 32 + 16 * h2);
            tacc = __builtin_amdgcn_mfma_f32_32x32x16_bf16(hfr, cfq[ks], tacc, 0, 0, 0); }
        const float sc = __builtin_amdgcn_exp2f(dir ? cbi : cfi);
#pragma unroll
        for (int q = 0; q < 16; ++q) yacc[q] += sc * tacc[q];
    }
    bf16* yp = (bf16*)(KA->ws + WS_Y) + (size_t)(rowbase + ipos) * 256 + h * 64 + pb * 32;
#pragma unroll
    for (int q4 = 0; q4 < 4; ++q4) { v2u o; o.x = cvtpk(yacc[4 * q4], yacc[4 * q4 + 1]); o.y = cvtpk(yacc[4 * q4 + 2], yacc[4 * q4 + 3]); *(v2u*)(yp + 8 * q4 + 4 * h2) = o; }
    __syncthreads();
}
DI void ssd_outputs_phase(int l, bool last) {
    KArgs KA = kargs(); Frame F = mkframe();
    for (int it = blockIdx.x; it < 32 * 34; it += F.G) { if (last && (it % 34) < 2) continue; ssd_outputs(KA, F, l, it); }
}
DI void mixers_flash(int l, bool last) {
    KArgs KA = kargs(); Frame F = mkframe();
    const int nS = 32 * 34, nL = 1536, nC = last ? 0 : 96, nItems = nS + nL + nC;
    for (int it = blockIdx.x; it < nItems; it += F.G) {
        if (it < nS) { ssd_states(KA, F, l, it); continue; }
        int u = it - nS; bool cq = false;
        if (u >= nL) { u -= nL; cq = true; }
        const int ty = u % 3, un = u / 3;
        if (ty == 0) attn_unit<1>(KA, F, l, un, cq); else if (ty == 1) attn_unit<0>(KA, F, l, un, cq); else attn_unit<2>(KA, F, l, un, cq);
    }
}
DI void merge_pass(int l, int nrows) {
    KArgs KA = kargs(); Frame F = mkframe();
    const bf16* P = (const bf16*)(KA->ws + WS_ACT); const bf16* O = (const bf16*)(KA->ws + WS_O); const bf16* Y = (const bf16*)(KA->ws + WS_Y); const bf16* U = (const bf16*)(KA->ws + WS_U);
    bf16* A = (bf16*)(KA->ws + WS_A);
    const int hh = F.lane >> 4, cn = 4 * F.lane;
    const float dsk = KA->in[18][l * 4 + hh];
    v2u o0, o2, o3, yw, xw, zw;
#define MERGE_LOAD(r_) do { o0 = *(const v2u*)(O + (size_t)(r_) * DM + cn); o2 = *(const v2u*)(O + (size_t)(r_) * DM + 512 + cn); o3 = *(const v2u*)(O + (size_t)(r_) * DM + 768 + cn); \
        yw = *(const v2u*)(Y + (size_t)(r_) * 256 + cn); xw = *(const v2u*)(U + (size_t)(r_) * 768 + cn); zw = *(const v2u*)(P + (size_t)(r_) * NPJ + C_BZ + cn); } while (0)
    if (F.gw < nrows) MERGE_LOAD(F.gw);
    for (int row = F.gw; row < nrows; row += F.ngw) {
        f32x4 v[4];
        v[0] = (f32x4){bflo(o0.x), bfhi(o0.x), bflo(o0.y), bfhi(o0.y)}; v[2] = (f32x4){bflo(o2.x), bfhi(o2.x), bflo(o2.y), bfhi(o2.y)}; v[3] = (f32x4){bflo(o3.x), bfhi(o3.x), bflo(o3.y), bfhi(o3.y)};
        { const f32x4 yf = (f32x4){bflo(yw.x), bfhi(yw.x), bflo(yw.y), bfhi(yw.y)}, xs = (f32x4){bflo(xw.x), bfhi(xw.x), bflo(xw.y), bfhi(xw.y)}, z = (f32x4){bflo(zw.x), bfhi(zw.x), bflo(zw.y), bfhi(zw.y)};
          const f32x4 y = yf + xs * dsk; v[1] = (f32x4){y.x * silu(z.x), y.y * silu(z.y), y.z * silu(z.z), y.w * silu(z.w)}; }
        if (row + F.ngw < nrows) MERGE_LOAD(row + F.ngw);
#pragma unroll
        for (int j = 0; j < 4; ++j) { const int n = 4 * F.lane + 256 * j;
            const float ss = wave_sum((v[j].x * v[j].x + v[j].y * v[j].y) + (v[j].z * v[j].z + v[j].w * v[j].w));
            const float r = 1.f / sqrtf(ss * (1.f / 256.f) + LN_EPS);
            const f32x4 a = v[j] * r * *(const f32x4*)(KA->in[12] + l * DM + n);
            v2u w; w.x = cvtpk(a.x, a.y); w.y = cvtpk(a.z, a.w); *(v2u*)(A + (size_t)row * DM + n) = w; }
    }
#undef MERGE_LOAD
}
constexpr size_t WS_CTL = 3 * MiB + 512 * 1024, CTL_BYTES = 16384;
constexpr int MISC_OFF = 139264;
#define XB_TMO      128
#define XB_XCNT(j)  (256  + 64 * (j))
#define XB_XSUB(j)  (1280 + 64 * (j))
#define XB_XGEN(j)  (2304 + 64 * (j))
#define XB_TOP      3328
#define XB_TOPGEN   3392
#define XCD_BAR_WORDS 3456
#define XB_SPIN_CAP (1u << 18)

__device__ __forceinline__ unsigned xb_ld(unsigned* p)              { return __hip_atomic_load(p, __ATOMIC_RELAXED, __HIP_MEMORY_SCOPE_AGENT); }
__device__ __forceinline__ unsigned xb_add(unsigned* p, unsigned v) { return __hip_atomic_fetch_add(p, v, __ATOMIC_RELAXED, __HIP_MEMORY_SCOPE_AGENT); }
__device__ __forceinline__ unsigned xb_xcc_id() { return (unsigned)__builtin_amdgcn_s_getreg((3 << 11) | 20) & 0xFu; }
#define XB_SPIN(cond, bar) do { unsigned _sp = 0; while (cond) { __builtin_amdgcn_s_sleep(1); \
    if ((++_sp & 255u) == 0u) { if (xb_ld(&(bar)[XB_TMO])) break; if (_sp > XB_SPIN_CAP) { atomicAdd(&(bar)[XB_TMO], 1u); break; } } } } while (0)

struct XcdBarrier {
    unsigned* bar; unsigned x;
    volatile LAS unsigned* st;
};

__device__ __forceinline__ XcdBarrier xcd_barrier_post(unsigned* bar, volatile LAS unsigned* st) {
    XcdBarrier b; b.bar = bar; b.x = xb_xcc_id(); b.st = st;
    if (threadIdx.x == 0) (void)xb_add(&bar[XB_XCNT(b.x)], 1u);
    return b;
}
__device__ __forceinline__ void xcd_barrier_complete(unsigned* bar, unsigned x, unsigned& nloc, unsigned& nx) {
    const unsigned G = gridDim.x * gridDim.y * gridDim.z;
    unsigned sum, cnt, mine, sp = 0u;
    for (;;) {
        sum = 0u; cnt = 0u; mine = 0u;
#pragma unroll
        for (unsigned j = 0; j < 16; ++j) { const unsigned c = xb_ld(&bar[XB_XCNT(j)]); sum += c; cnt += (c > 0u) ? 1u : 0u; mine = (j == x) ? c : mine; }
        if (sum == G) break;
        __builtin_amdgcn_s_sleep(1);
        if ((++sp & 255u) == 0u) { if (xb_ld(&bar[XB_TMO])) break; if (sp > XB_SPIN_CAP) { atomicAdd(&bar[XB_TMO], 1u); break; } }
    }
    nloc = mine > 0u ? mine : 1u; nx = cnt > 0u ? cnt : 1u;
}

__device__ __forceinline__ void xcd_barrier(const XcdBarrier& b) {
    asm volatile("s_waitcnt vmcnt(0)" ::: "memory");
    __syncthreads();
    if (threadIdx.x == 0) {
        unsigned* bar = b.bar;
        __builtin_amdgcn_s_waitcnt(0);
        unsigned nloc = b.st[0], nx = b.st[1];
        if (nloc == 0u) { xcd_barrier_complete(bar, b.x, nloc, nx); b.st[0] = nloc; b.st[1] = nx; }
        const unsigned old = xb_add(&bar[XB_XSUB(b.x)], 1u);
        const unsigned gen = old / nloc;
        if (old + 1u == (gen + 1u) * nloc) {
            __builtin_amdgcn_fence(__ATOMIC_RELEASE, "agent");
            asm volatile("s_waitcnt vmcnt(0)" ::: "memory");
            const unsigned og = xb_add(&bar[XB_TOP], 1u);
            const unsigned tg = og / nx;
            if (og + 1u == (tg + 1u) * nx) xb_add(&bar[XB_TOPGEN], 1u);
            else XB_SPIN(xb_ld(&bar[XB_TOPGEN]) == tg, bar);
            __builtin_amdgcn_fence(__ATOMIC_ACQUIRE, "agent");
            xb_add(&bar[XB_XGEN(b.x)], 1u);
            asm volatile("s_waitcnt vmcnt(0)" ::: "memory");
        } else {
            XB_SPIN(xb_ld(&bar[XB_XGEN(b.x)]) == gen, bar);
            __builtin_amdgcn_fence(__ATOMIC_ACQUIRE, "agent");
            asm volatile("s_waitcnt vmcnt(0)" ::: "memory");
        }
    }
    __syncthreads();
}

#define GRID_BAR() do { XcdBarrier b_; b_.bar = (unsigned*)(kargs()->ws + WS_CTL); b_.x = xb_xcc_id(); b_.st = (volatile LAS unsigned*)((LAS unsigned char*)lds + MISC_OFF); xcd_barrier(b_); } while (0)
#ifndef PROBE_GRP
#define PROBE_GRP 0
#endif
#define TIMED(grp, ...) do { unsigned long long t0_ = 0; if (PROBE_GRP == (grp)) t0_ = __builtin_amdgcn_s_memrealtime(); __VA_ARGS__; \
    if (PROBE_GRP == (grp) && blockIdx.x == 0) { const unsigned long long dt_ = __builtin_amdgcn_s_memrealtime() - t0_; const unsigned long long t1_ = __builtin_amdgcn_s_memrealtime(); \
        while (__builtin_amdgcn_s_memrealtime() - t1_ < 2 * dt_) __builtin_amdgcn_s_sleep(8); } } while (0)
__global__ void __launch_bounds__(NWAVES * 64, 2) mega_fwd(Args args) {
    extern __shared__ __attribute__((aligned(16))) unsigned char lds[];
    cg::grid_group grid = cg::this_grid();
    if (threadIdx.x < 2) ((volatile LAS unsigned*)((LAS unsigned char*)lds + MISC_OFF))[threadIdx.x] = 0u;
    __syncthreads();
    (void)xcd_barrier_post((unsigned*)(kargs()->ws + WS_CTL), (volatile LAS unsigned*)((LAS unsigned char*)lds + MISC_OFF));
    { LAS float* rc = (LAS float*)((LAS unsigned char*)lds + ROPE_OFF);
      for (int i = threadIdx.x; i < 1024; i += 512) { const int pos = i >> 4, fi = i & 15; const float inv = exp2f(-(float)fi * (13.287712379549449f / 16.f)); const float ang = (float)pos * inv; rc[i] = cosf(ang); rc[1024 + i] = sinf(ang); } }
    __syncthreads();

    if (args.ws == nullptr) grid.sync();
    p0a(); GRID_BAR(); p0b(); GRID_BAR(); p0c(); GRID_BAR();
    for (int l = 0; l < NL; ++l) {
        const bool last = (l == NL - 1); const int mrows = last ? NLAT : NROW;
        for (int s = 0; s < 3; ++s) {
            if (s != 1) {
                const bool second = (s == 2); const int rows = (second && last) ? NLAT : NROW;
                { KArgs KA = kargs(); pg8::Gemm g{((bf16*)(KA->ws + WS_A)), wbuf(KA, l, second ? WO_W1B : WO_W1A), rows, 2 * DFF, DM}; pg8::StaticOrder S; S.init(rows, 2 * DFF, (int)gridDim.x, (int)blockIdx.x); pg8::EpiSwiGLU E{((bf16*)(KA->ws + WS_ACT)), DFF};
                  pg8::gemm_phase<pg8::EpiSwiGLU, pg8::StaticOrder, true, GEMM_SP2>((LAS unsigned char*)lds, g, S, E); }
                GRID_BAR();
                { KArgs KA = kargs(); pg8::Gemm g{((bf16*)(KA->ws + WS_ACT)), wbuf(KA, l, second ? WO_W2B : WO_W2A), NLAT, DM, DFF}; pg8::StaticOrder S; S.init(NLAT, DM, (int)gridDim.x, (int)blockIdx.x); pg8::EpiBf16 E{((bf16*)(KA->ws + WS_O)), DM};
                  pg8::gemm_phase<pg8::EpiBf16, pg8::StaticOrder, true, GEMM_SP2>((LAS unsigned char*)lds, g, S, E); }
                GRID_BAR();
                const bool split = (rows == NROW);
                const int gidx = second ? 8 : 2, lnidx = second ? 2 : 0, nl = second ? l + 1 : l, nsh = second ? (last ? -1 : 0) : 3;
                if (split && blockIdx.x < 32) {
                    KArgs KA = kargs(); pg8::Gemm g{((bf16*)(KA->ws + WS_ACT)) + (size_t)NLAT * DFF, wbuf(KA, l, second ? WO_W2B : WO_W2A), NCTX, DM, DFF}; pg8::StaticOrder S; S.init(NCTX, DM, 32, (int)blockIdx.x);
                    pg8::EpiBf16 E{((bf16*)(KA->ws + WS_O)) + (size_t)NLAT * DM, DM};
                    pg8::gemm_phase<pg8::EpiBf16, pg8::StaticOrder, true, GEMM_SP2>((LAS unsigned char*)lds, g, S, E);
                } else ln_pass(l, gidx, 0.5f, lnidx, nl, nsh, 0, NLAT, split ? 32 : 0, split ? (int)gridDim.x - 32 : (int)gridDim.x, !second);
                if (split) { GRID_BAR(); ln_pass(l, gidx, 0.5f, lnidx, nl, nsh, NLAT, NROW, 0, (int)gridDim.x, !second); }
                if (!(second && last)) GRID_BAR();
            } else {
                { KArgs KA = kargs(); pg8::Gemm g{((bf16*)(KA->ws + WS_A)), wbuf(KA, l, WO_WIN), NROW, NPJ, DM}; pg8::StaticOrder S; S.init(NROW, NPJ, (int)gridDim.x, (int)blockIdx.x); pg8::EpiBf16 E{((bf16*)(KA->ws + WS_ACT)), NPJ};
                  pg8::gemm_phase<pg8::EpiBf16, pg8::StaticOrder, true, GEMM_SP2>((LAS unsigned char*)lds, g, S, E); }
                GRID_BAR();
                prep_pass(l); GRID_BAR();
                mixers_flash(l, last); GRID_BAR();
                ssd_scan(); GRID_BAR();
                ssd_outputs_phase(l, last); GRID_BAR();
                merge_pass(l, mrows); GRID_BAR();
                { KArgs KA = kargs(); pg8::Gemm g{((bf16*)(KA->ws + WS_A)), wbuf(KA, l, WO_WOUT), mrows, DM, DM}; pg8::StaticOrder S; S.init(mrows, DM, (int)gridDim.x, (int)blockIdx.x); pg8::EpiBf16 E{((bf16*)(KA->ws + WS_O)), DM};
                  pg8::gemm_phase<pg8::EpiBf16, pg8::StaticOrder, true, GEMM_SP2>((LAS unsigned char*)lds, g, S, E); }
                GRID_BAR();
                ln_pass(l, 5, 1.0f, 1, l, 6, 0, mrows, 0, (int)gridDim.x, false); GRID_BAR();
            }
        }
    }
}

extern "C" void kernel_launch(void* const* d_in, const int* in_sizes, int n_in, void* d_out, int out_size, void* d_ws, size_t ws_size, hipStream_t stream) {
    static int grid = 0;
    if (grid == 0) {
        if (n_in != 24 || out_size != NLAT * DM || ws_size < WS_END) { fprintf(stderr, "kernel_launch: unexpected shapes: n_in %d out %d ws %zu\n", n_in, out_size, ws_size); grid = -1; return; }
        int dev = 0, cus = 0, per_cu = 0;
        hipGetDevice(&dev); hipDeviceGetAttribute(&cus, hipDeviceAttributeMultiprocessorCount, dev);
        if (hipFuncSetAttribute((const void*)mega_fwd, hipFuncAttributeMaxDynamicSharedMemorySize, LDS_BYTES) != hipSuccess) { fprintf(stderr, "kernel_launch: hipFuncSetAttribute failed\n"); grid = -1; return; }
        if (hipOccupancyMaxActiveBlocksPerMultiprocessor(&per_cu, (const void*)mega_fwd, NWAVES * 64, LDS_BYTES) != hipSuccess || per_cu < 1) { fprintf(stderr, "kernel_launch: occupancy query says %d\n", per_cu); per_cu = 1; }
        (void)hipGetLastError();
        grid = cus;
    }
    if (grid < 0) return;
    if (hipMemsetAsync((char*)d_ws + WS_CTL, 0, CTL_BYTES, stream) != hipSuccess) { fprintf(stderr, "kernel_launch: memset of the barrier words failed\n"); return; }
    Args a{};
    for (int i = 0; i < 24; ++i) a.in[i] = (const float*)d_in[i];
    a.out = (float*)d_out; a.ws = (unsigned char*)d_ws;
    void* kargs[] = {&a};
    hipError_t e = hipLaunchCooperativeKernel((const void*)mega_fwd, dim3(grid), dim3(NWAVES * 64), kargs, LDS_BYTES, stream);
    if (e != hipSuccess) fprintf(stderr, "kernel_launch: cooperative launch failed: %s (grid %d)\n", hipGetErrorString(e), grid);
}
```

```cpp
#include <hip/hip_runtime.h>
#include <hip/hip_cooperative_groups.h>
#include <cstdio>
#include <cstdint>
namespace cg = cooperative_groups;
namespace pg8 {
#define PG8_LAS __attribute__((address_space(3)))
typedef unsigned short bf16_t;
typedef short bf16x8 __attribute__((ext_vector_type(8)));
typedef float f32x4 __attribute__((ext_vector_type(4)));
typedef unsigned u32x4 __attribute__((ext_vector_type(4)));
constexpr int BM = 256, BK = 64, HALF = 128, HTB = HALF * BK * 2  , STAGE_BYTES = 8 * HTB, NXCD = 8, WGM = 8;

__host__ __device__ __forceinline__ int lds_byte(int r, int c) { const int st = (r >> 4) * 2 + (c >> 5), rr = r & 15, cc = c & 31, ob = rr * 64 + cc * 2; return st * 1024 + (ob ^ (((ob >> 9) & 1) << 5)); }
__host__ __device__ __forceinline__ void stage_rc(int b, int& R, int& C) { const int st = b / 1024, sb = b % 1024, swz = sb ^ (((sb >> 9) & 1) << 5); R = (st >> 1) * 16 + swz / 64; C = (st & 1) * 32 + (swz % 64) / 2; }
__host__ __device__ __forceinline__ int perm32(int rho) { const int n = rho >> 4, i = rho & 15; return 8 * (i >> 2) + 4 * n + (i & 3); }

struct Unit { int pm, pn; };
struct Gemm { const bf16_t* A; const bf16_t* Bt; int M, N, K; };

struct StaticOrder {
    int nM, nN, nwg, G, c;
    __host__ __device__ void init(int M, int N, int G_, int c_) { nM = M / BM; nN = N / BM; nwg = nM * nN; G = G_; c = c_; }
    __host__ __device__ bool next(int i, Unit& u) const {
        const long L = (long)i * G + c; if (L >= nwg) return false;
        int wgid = (int)L; { const int q = nwg / NXCD, r = nwg % NXCD, xcd = wgid % NXCD, off = wgid / NXCD; wgid = (xcd < r ? xcd * (q + 1) : r * (q + 1) + (xcd - r) * q) + off; }
        const int nig = WGM * nN, gid = wgid / nig, fm = gid * WGM, gsz = (nM - fm) < WGM ? (nM - fm) : WGM;
        u.pm = fm + ((wgid % nig) % gsz); u.pn = (wgid % nig) / gsz; return true;
    }
    __device__ __forceinline__ void a_ready(const Unit&) const {}
    __device__ __forceinline__ void done(const Unit&) const {}
};

__device__ __forceinline__ unsigned cvt_pk_bf16(float lo, float hi) { unsigned r; asm volatile("v_cvt_pk_bf16_f32 %0, %1, %2" : "=v"(r) : "v"(lo), "v"(hi)); return r; }
struct EpiBf16 {
    static constexpr bool PERM = true, AFTER_DRAIN = false;
    bf16_t* O; int ldc;
    __device__ __forceinline__ void operator()(const f32x4 (&acc)[2][2][4][2], const Unit& u, int wr, int wc, int fr, int fq) const {
        const int row0 = u.pm * BM + wr * 64 + fr; const int col0 = u.pn * BM + wc * 32 + 8 * fq;
#pragma unroll
        for (int ai = 0; ai < 2; ++ai)
#pragma unroll
            for (int m = 0; m < 4; ++m) { bf16_t* rowp = O + (size_t)(row0 + ai * HALF + m * 16) * ldc + col0;
#pragma unroll
                for (int bj = 0; bj < 2; ++bj) { const f32x4 v0 = acc[ai][bj][m][0], v1 = acc[ai][bj][m][1];
                    u32x4 w; w.x = cvt_pk_bf16(v0[0], v0[1]); w.y = cvt_pk_bf16(v0[2], v0[3]); w.z = cvt_pk_bf16(v1[0], v1[1]); w.w = cvt_pk_bf16(v1[2], v1[3]);
                    *(u32x4*)(rowp + bj * HALF) = w; } }
    }
};
__device__ __forceinline__ float silu_f(float x) { return x * __builtin_amdgcn_rcpf(1.0f + __expf(-x)); }
struct EpiSwiGLU {
    static constexpr bool PERM = true, AFTER_DRAIN = false;
    bf16_t* O; int ldc;
    __device__ __forceinline__ void operator()(const f32x4 (&acc)[2][2][4][2], const Unit& u, int wr, int wc, int fr, int fq) const {
        const int row0 = u.pm * BM + wr * 64 + fr; const int col0 = u.pn * HALF + wc * 32 + 8 * fq;
#pragma unroll
        for (int ai = 0; ai < 2; ++ai)
#pragma unroll
            for (int m = 0; m < 4; ++m) { bf16_t* rowp = O + (size_t)(row0 + ai * HALF + m * 16) * ldc + col0;
                const f32x4 a0 = acc[ai][0][m][0], a1 = acc[ai][0][m][1], u0 = acc[ai][1][m][0], u1 = acc[ai][1][m][1];
                u32x4 w;
                w.x = cvt_pk_bf16(silu_f(a0[0]) * u0[0], silu_f(a0[1]) * u0[1]); w.y = cvt_pk_bf16(silu_f(a0[2]) * u0[2], silu_f(a0[3]) * u0[3]);
                w.z = cvt_pk_bf16(silu_f(a1[0]) * u1[0], silu_f(a1[1]) * u1[1]); w.w = cvt_pk_bf16(silu_f(a1[2]) * u1[2], silu_f(a1[3]) * u1[3]);
                *(u32x4*)rowp = w; }
    }
};
template <class Epi, class Sched, bool ALIGN_EPI = false, bool SP2 = false>
__device__ __forceinline__ void gemm_phase(PG8_LAS unsigned char* lds, const Gemm g, const Sched& S, const Epi& E) {
    int tid_l = threadIdx.x; asm volatile("" : "+v"(tid_l));
    const int tid = tid_l, wid = __builtin_amdgcn_readfirstlane(tid >> 6), lane = tid & 63, wr = wid >> 2, wc = wid & 3, fr = lane & 15, fq = lane >> 4;
    const int K = g.K, nt = K / BK;
    unsigned voffA[2], voffB[2];
#pragma unroll
    for (int i = 0; i < 2; ++i) { int R, C; stage_rc(tid * 16 + i * 8192, R, C); const int Rb = Epi::PERM ? ((R & ~31) + perm32(R & 31)) : R;
        voffA[i] = (unsigned)(R * K + C) * 2u; voffB[i] = (unsigned)(Rb * K + C) * 2u; }
    const size_t kstep = (size_t)(BK * 2);
    const size_t hstep = (size_t)HALF * K * 2;
    const size_t tstep = 2 * hstep;
    const unsigned ldsw = (unsigned)wid * 1024u;
    const int aoff = lds_byte(wr * 64 + fr, fq * 8), boff = lds_byte(wc * 32 + fr, fq * 8);
#define PG8_SA(b, h) (((b) * 2 + (h)) * HTB)
#define PG8_SB(b, h) ((4 + (b) * 2 + (h)) * HTB)
#define PG8_STAGE(bufoff, gbase, voff) do { _Pragma("unroll") for (int _i = 0; _i < 2; ++_i) \
        __builtin_amdgcn_global_load_lds((const unsigned*)((const char*)(gbase) + (voff)[_i]), (PG8_LAS unsigned*)(lds + (bufoff) + ldsw + _i * 8192), 16, 0, 0); } while (0)
#define PG8_LDA(dst, b, h) do { _Pragma("unroll") for (int m = 0; m < 4; ++m) _Pragma("unroll") for (int k = 0; k < 2; ++k) dst[m][k] = *(const PG8_LAS bf16x8*)(lds + PG8_SA(b, h) + aoff + m * 2048 + k * 1024); } while (0)
#define PG8_LDB(dst, b, h) do { _Pragma("unroll") for (int n = 0; n < 2; ++n) _Pragma("unroll") for (int k = 0; k < 2; ++k) dst[n][k] = *(const PG8_LAS bf16x8*)(lds + PG8_SB(b, h) + boff + n * 2048 + k * 1024); } while (0)
#define PG8_MMA(ai, bj, At, Bt) do { __builtin_amdgcn_s_setprio(1); _Pragma("unroll") for (int m = 0; m < 4; ++m) _Pragma("unroll") for (int n = 0; n < 2; ++n) _Pragma("unroll") for (int k = 0; k < 2; ++k) \
        acc[ai][bj][m][n] = __builtin_amdgcn_mfma_f32_16x16x32_bf16(Bt[n][k], At[m][k], acc[ai][bj][m][n], 0, 0, 0); __builtin_amdgcn_s_setprio(0); } while (0)
#define PG8_WAIT_V(n) asm volatile("s_waitcnt vmcnt(" #n ")" ::: "memory")
#define PG8_WAIT_L(n) asm volatile("s_waitcnt lgkmcnt(" #n ")" ::: "memory")
#define PG8_BAR __builtin_amdgcn_s_barrier()
#define PG8_SCHED __builtin_amdgcn_sched_barrier(0)
    Unit cur, nxt; int ui = 0;
    if (!S.next(0, cur)) return;
    f32x4 acc[2][2][4][2];
#pragma unroll
    for (int a = 0; a < 2; ++a)
#pragma unroll
        for (int b = 0; b < 2; ++b)
#pragma unroll
            for (int m = 0; m < 4; ++m)
#pragma unroll
                for (int n = 0; n < 2; ++n) acc[a][b][m][n] = (f32x4){0.f, 0.f, 0.f, 0.f};
    bf16x8 At[4][2], B0[2][2], B1[2][2];
    const char* cA = (const char*)g.A + (size_t)cur.pm * tstep; const char* cB = (const char*)g.Bt + (size_t)cur.pn * tstep;
    S.a_ready(cur);
    if constexpr (SP2) {
        PG8_STAGE(PG8_SB(0, 0), cB, voffB); PG8_STAGE(PG8_SB(0, 1), cB + hstep, voffB); PG8_STAGE(PG8_SA(0, 0), cA, voffA); PG8_STAGE(PG8_SA(0, 1), cA + hstep, voffA);
        if (wr == 1) PG8_BAR;
        PG8_WAIT_V(2); PG8_BAR;
        PG8_STAGE(PG8_SB(1, 0), cB + kstep, voffB); PG8_STAGE(PG8_SA(1, 0), cA + kstep, voffA); PG8_STAGE(PG8_SB(1, 1), cB + hstep + kstep, voffB);
        PG8_WAIT_V(6); PG8_BAR;
    } else {
        PG8_STAGE(PG8_SB(0, 0), cB, voffB); PG8_STAGE(PG8_SA(0, 0), cA, voffA); PG8_STAGE(PG8_SB(0, 1), cB + hstep, voffB); PG8_STAGE(PG8_SA(0, 1), cA + hstep, voffA);
        if (wr == 1) PG8_BAR;
        PG8_WAIT_V(4); PG8_BAR;
        PG8_STAGE(PG8_SB(1, 0), cB + kstep, voffB); PG8_STAGE(PG8_SA(1, 0), cA + kstep, voffA); PG8_STAGE(PG8_SB(1, 1), cB + hstep + kstep, voffB);
        PG8_WAIT_V(6); PG8_BAR;
    }
    for (;;) {
        const bool has_next = S.next(ui + 1, nxt);
        const char* nA = has_next ? (const char*)g.A + (size_t)nxt.pm * tstep : cA; const char* nB = has_next ? (const char*)g.Bt + (size_t)nxt.pn * tstep : cB;
        for (int t = 0; t < nt; t += 2) {
            const bool last = (t == nt - 2);
            const char* a1 = cA + (size_t)(t + 1) * kstep;
            const char* a2 = last ? nA : cA + (size_t)(t + 2) * kstep; const char* b2 = last ? nB : cB + (size_t)(t + 2) * kstep;
            const char* a3 = a2 + kstep; const char* b3 = b2 + kstep;
            if (last && has_next) S.a_ready(nxt);
            if constexpr (SP2) {
            PG8_LDB(B0, 0, 0); PG8_LDB(B1, 0, 1); PG8_SCHED; PG8_LDA(At, 0, 0); PG8_STAGE(PG8_SA(1, 1), a1 + hstep, voffA);
            PG8_WAIT_V(8); PG8_WAIT_L(0); PG8_BAR; PG8_MMA(0, 0, At, B0); PG8_MMA(0, 1, At, B1); PG8_BAR; PG8_SCHED;
            PG8_LDA(At, 0, 1); PG8_STAGE(PG8_SB(0, 0), b2, voffB); PG8_STAGE(PG8_SB(0, 1), b2 + hstep, voffB); PG8_STAGE(PG8_SA(0, 0), a2, voffA);
            PG8_WAIT_V(8); PG8_WAIT_L(0); PG8_BAR; PG8_MMA(1, 0, At, B0); PG8_MMA(1, 1, At, B1); PG8_BAR; PG8_SCHED;
            PG8_LDB(B0, 1, 0); PG8_LDB(B1, 1, 1); PG8_SCHED; PG8_LDA(At, 1, 0); PG8_STAGE(PG8_SA(0, 1), a2 + hstep, voffA);
            PG8_WAIT_V(8); PG8_WAIT_L(0); PG8_BAR; PG8_MMA(0, 0, At, B0); PG8_MMA(0, 1, At, B1); PG8_BAR; PG8_SCHED;
            PG8_LDA(At, 1, 1); PG8_STAGE(PG8_SB(1, 0), b3, voffB); PG8_STAGE(PG8_SB(1, 1), b3 + hstep, voffB); PG8_STAGE(PG8_SA(1, 0), a3, voffA);
            PG8_WAIT_V(8); PG8_WAIT_L(0); PG8_BAR; PG8_MMA(1, 0, At, B0); PG8_MMA(1, 1, At, B1); PG8_BAR; PG8_SCHED;
            } else {
            PG8_LDB(B0, 0, 0); PG8_SCHED; PG8_LDA(At, 0, 0); PG8_STAGE(PG8_SA(1, 1), a1 + hstep, voffA);
            PG8_WAIT_L(8); PG8_BAR; PG8_WAIT_L(0); PG8_MMA(0, 0, At, B0); PG8_BAR; PG8_SCHED;
            PG8_LDB(B1, 0, 1); PG8_STAGE(PG8_SB(0, 0), b2, voffB);
            PG8_BAR; PG8_WAIT_L(0); PG8_MMA(0, 1, At, B1); PG8_BAR;
            PG8_LDA(At, 0, 1); PG8_STAGE(PG8_SA(0, 0), a2, voffA);
            PG8_BAR; PG8_WAIT_L(0); PG8_MMA(1, 0, At, B0); PG8_BAR; PG8_SCHED;
            PG8_STAGE(PG8_SB(0, 1), b2 + hstep, voffB);
            PG8_WAIT_V(6); PG8_BAR; PG8_MMA(1, 1, At, B1); PG8_BAR;
            PG8_LDB(B0, 1, 0); PG8_SCHED; PG8_LDA(At, 1, 0); PG8_STAGE(PG8_SA(0, 1), a2 + hstep, voffA);
            PG8_WAIT_L(8); PG8_BAR; PG8_WAIT_L(0); PG8_MMA(0, 0, At, B0); PG8_BAR; PG8_SCHED;
            PG8_LDB(B1, 1, 1); PG8_STAGE(PG8_SB(1, 0), b3, voffB);
            PG8_BAR; PG8_WAIT_L(0); PG8_MMA(0, 1, At, B1); PG8_BAR;
            PG8_LDA(At, 1, 1); PG8_STAGE(PG8_SA(1, 0), a3, voffA);
            PG8_BAR; PG8_WAIT_L(0); PG8_MMA(1, 0, At, B0); PG8_BAR; PG8_SCHED;
            PG8_STAGE(PG8_SB(1, 1), b3 + hstep, voffB);
            PG8_WAIT_V(6); PG8_BAR; PG8_MMA(1, 1, At, B1); PG8_BAR;
            }
        }
        if constexpr (ALIGN_EPI) { if (wr == 0) PG8_BAR; }
        if constexpr (!Epi::AFTER_DRAIN) { E(acc, cur, wr, wc, fr, fq); S.done(cur); }
        if (!has_next) break;
#pragma unroll
        for (int a = 0; a < 2; ++a)
#pragma unroll
            for (int b = 0; b < 2; ++b)
#pragma unroll
                for (int m = 0; m < 4; ++m)
#pragma unroll
                    for (int n = 0; n < 2; ++n) acc[a][b][m][n] = (f32x4){0.f, 0.f, 0.f, 0.f};
        cur = nxt; cA = nA; cB = nB; ++ui;
        if constexpr (ALIGN_EPI) { if (wr == 1) PG8_BAR; }
    }
    PG8_WAIT_V(0);
    if constexpr (!ALIGN_EPI) { if (wr == 0) PG8_BAR; }
    PG8_BAR;
    if constexpr (Epi::AFTER_DRAIN) { E.fused(acc, cur, wr, wc, fr, fq, lds, wid, lane); S.done(cur); }
#undef PG8_SA
#undef PG8_SB
#undef PG8_STAGE
#undef PG8_LDA
#undef PG8_LDB
#undef PG8_MMA
#undef PG8_WAIT_V
#undef PG8_WAIT_L
#undef PG8_BAR
#undef PG8_SCHED
}
}

constexpr int NB = 8, SEQ = 4096, DM = 1024, NL = 2, CTXL = 256;
constexpr int NLAT = NB * SEQ, NCTX = NB * CTXL, NROW = NLAT + NCTX;
constexpr int DFF = 2816, NPJ = 2816, INW = 2824, NMODW = 9 * DM;
constexpr float LN_EPS = 1e-5f, ALPHA = 1.41421356237f;
constexpr int C_AQ = 0, C_AK = 256, C_AV = 384, C_BZ = 512, C_BX = 768, C_CQ = 1536, C_CK = 1792, C_CV = 1920, C_DQ = 2048, C_DK = 2304, C_DV = 2560;
constexpr int C_DTSRC = 1536;
constexpr size_t MiB = 1u << 20;
constexpr size_t WS_MOD = 0;
constexpr size_t WS_DT = 1 * MiB;
constexpr size_t WS_W = 4 * MiB, WS_WL = 41 * MiB;
constexpr size_t WO_W1A = 0, WO_W2A = 11 * MiB, WO_WIN = 16 * MiB + MiB / 2, WO_WOUT = 22 * MiB, WO_W1B = 24 * MiB, WO_W2B = 35 * MiB;
constexpr size_t WS_A = 86 * MiB;
constexpr size_t WS_ACT = 154 * MiB;
constexpr size_t WS_U = 341 * MiB;
constexpr size_t WS_O = 392 * MiB;
constexpr size_t WS_XC = 460 * MiB;
constexpr size_t WS_Y = 468 * MiB;
constexpr size_t WS_END = 512 * MiB;
constexpr int RING_BYTES = 131072, ROPE_OFF = RING_BYTES, LDS_BYTES = 147456;
constexpr int NWAVES = 8;
constexpr bool GEMM_SP2 = true;

#define LAS __attribute__((address_space(3)))
#define DI __device__ __forceinline__
typedef unsigned short bf16;
typedef unsigned v4u __attribute__((ext_vector_type(4)));
typedef unsigned v2u __attribute__((ext_vector_type(2)));
typedef float f32x4 __attribute__((ext_vector_type(4)));

DI float bf2f(unsigned b) { return __uint_as_float(b << 16); }
DI float bflo(unsigned w) { return __uint_as_float(w << 16); }
DI float bfhi(unsigned w) { return __uint_as_float(w & 0xffff0000u); }
DI unsigned f2bf(float f) { unsigned u = __float_as_uint(f); return (u + 0x7fffu + ((u >> 16) & 1u)) >> 16; }
DI unsigned pk2(float lo, float hi) { return f2bf(lo) | (f2bf(hi) << 16); }
typedef float f32x2_t __attribute__((ext_vector_type(2))); typedef __bf16 bf16x2_t __attribute__((ext_vector_type(2)));
DI unsigned cvtpk(float lo, float hi) { f32x2_t v = {lo, hi}; bf16x2_t b = __builtin_convertvector(v, bf16x2_t); return __builtin_bit_cast(unsigned, b); }
DI float wave_sum(float v) {
#pragma unroll
    for (int o = 1; o < 64; o <<= 1) v += __shfl_xor(v, o);
    return v;
}
DI float silu(float x) { return x * __builtin_amdgcn_rcpf(1.0f + __expf(-x)); }

struct Args { const float* in[24]; float* out; unsigned char* ws; };
typedef const __attribute__((address_space(4))) Args* KArgs;
DI KArgs kargs() { KArgs p = (KArgs)__builtin_amdgcn_kernarg_segment_ptr(); asm volatile("" : "+s"(p)); return p; }

struct Frame {
    LAS unsigned char* lds;
    int tid, lane, wave, G, gw, ngw;
};
DI Frame mkframe() { Frame F; extern __shared__ __attribute__((aligned(16))) unsigned char lds_base[]; F.lds = (LAS unsigned char*)lds_base;
    int t = threadIdx.x; asm volatile("" : "+v"(t)); F.tid = t; F.lane = t & 63; F.wave = __builtin_amdgcn_readfirstlane(t >> 6);
    F.G = gridDim.x; F.gw = blockIdx.x * NWAVES + F.wave; F.ngw = F.G * NWAVES; return F; }
DI bf16* wbuf(KArgs KA, int l, size_t off) { return (bf16*)((KA->ws) + WS_W + (size_t)l * WS_WL + off); }

DI void transpose_item(const float* W, int ldw, int k0, int n0, bf16* WT, int ldt, int drow0, LAS float* scr, int lane) {
    float tv[32];
#pragma unroll
    for (int i = 0; i < 32; ++i) tv[i] = W[(size_t)(k0 + 2 * i + (lane >> 5)) * ldw + n0 + (lane & 31)];
#pragma unroll
    for (int i = 0; i < 32; ++i) scr[(2 * i + (lane >> 5)) * 33 + (lane & 31)] = tv[i];
    asm volatile("s_waitcnt lgkmcnt(0)" ::: "memory");
    const int c = lane & 7;
#pragma unroll
    for (int j = 0; j < 4; ++j) { const int n = (lane >> 3) + 8 * j; const LAS float* s = scr + (8 * c) * 33 + n;
        v4u o; o.x = pk2(s[0 * 33], s[1 * 33]); o.y = pk2(s[2 * 33], s[3 * 33]); o.z = pk2(s[4 * 33], s[5 * 33]); o.w = pk2(s[6 * 33], s[7 * 33]);
        *(v4u*)(WT + (size_t)(drow0 + n) * ldt + k0 + 8 * c) = o; }
    asm volatile("s_waitcnt lgkmcnt(0)" ::: "memory");
}
DI void p0a() {
    KArgs KA = kargs(); Frame F = mkframe();
    {
        LAS float* sv = (LAS float*)F.lds;
        for (int it = blockIdx.x; it < NL * 16 * 9; it += F.G) {
            const int l = it / 144, kc = (it % 144) / 9, cb = it % 9;
            __syncthreads();
            for (int i = F.tid; i < 576; i += 512) { const int r = i >> 6, kk = i & 63; const float v = r < 8 ? KA->in[1][r * DM + kc * 64 + kk] : KA->in[3][kc * 64 + kk]; sv[i] = silu(v); }
            __syncthreads();
            const int cg4 = F.tid & 255, kh = F.tid >> 8, col = cb * 1024 + 4 * cg4;
            f32x4 acc[9];
#pragma unroll
            for (int r = 0; r < 9; ++r) acc[r] = (f32x4){0.f, 0.f, 0.f, 0.f};
            const float* wp = KA->in[4] + ((size_t)l * DM + kc * 64 + kh * 32) * NMODW + col;
#pragma unroll 8
            for (int kk = 0; kk < 32; ++kk) { const f32x4 w = *(const f32x4*)(wp + (size_t)kk * NMODW);
#pragma unroll
                for (int r = 0; r < 9; ++r) acc[r] += w * sv[r * 64 + kh * 32 + kk]; }
#pragma unroll
            for (int r = 0; r < 9; ++r) *(f32x4*)(((float*)(KA->ws + WS_ACT)) + ((size_t)(l * 32 + kc * 2 + kh) * 9 + r) * NMODW + col) = acc[r];
        }
        __syncthreads();
    }
    LAS float* scr = (LAS float*)(F.lds + F.wave * 16384);
    constexpr int I1 = 16 * 176, I2 = 44 * 32, I3 = 16 * 88, I4 = 16 * 32, IL = 2 * I1 + 2 * I2 + I3 + I4;
    for (int it = F.gw; it < NL * IL; it += F.ngw) {
        const int l = it / IL; int r = it % IL;
        if (r < I1 || (r >= I1 + I2 + I3 + I4 && r < 2 * I1 + I2 + I3 + I4)) {
            const bool second = r >= I1; if (second) r -= I1 + I2 + I3 + I4;
            const int kb = r / 176, nb = r % 176, n0 = nb * 32;
            const int drow = n0 < DFF ? 256 * (n0 >> 7) + (n0 & 127) : 256 * ((n0 - DFF) >> 7) + 128 + ((n0 - DFF) & 127);
            transpose_item((second ? KA->in[22] : KA->in[8]) + (size_t)l * DM * 2 * DFF, 2 * DFF, kb * 64, n0, wbuf(KA, l, second ? WO_W1B : WO_W1A), DM, drow, scr, F.lane);
            continue; }
        r -= I1;
        if (r < I2) { const int kb = r / 32, nb = r % 32; transpose_item(KA->in[9] + (size_t)l * DFF * DM, DM, kb * 64, nb * 32, wbuf(KA, l, WO_W2A), DFF, nb * 32, scr, F.lane); continue; }
        r -= I2;
        if (r < I3) { const int kb = r / 88, nb = r % 88; const int n0 = nb < 48 ? nb * 32 : 1544 + (nb - 48) * 32;
            transpose_item(KA->in[10] + (size_t)l * DM * INW, INW, kb * 64, n0, wbuf(KA, l, WO_WIN), DM, nb * 32, scr, F.lane); continue; }
        r -= I3;
        if (r < I4) { const int kb = r / 32, nb = r % 32; transpose_item(KA->in[11] + (size_t)l * DM * DM, DM, kb * 64, nb * 32, wbuf(KA, l, WO_WOUT), DM, nb * 32, scr, F.lane); continue; }
        r -= I4 + I1;
        { const int kb = r / 32, nb = r % 32; transpose_item(KA->in[23] + (size_t)l * DFF * DM, DM, kb * 64, nb * 32, wbuf(KA, l, WO_W2B), DFF, nb * 32, scr, F.lane); }
    }
}
DI void p0b() {
    KArgs KA = kargs(); Frame F = mkframe();
    for (int i = blockIdx.x * 512 + F.tid; i < NL * 9 * NMODW; i += F.G * 512) {
        const int l = i / (9 * NMODW), rr = (i / NMODW) % 9, n = i % NMODW;
        float s = KA->in[5][l * NMODW + n];
        for (int p = 0; p < 32; ++p) s += ((float*)(KA->ws + WS_ACT))[((size_t)(l * 32 + p) * 9 + rr) * NMODW + n];
        ((float*)(KA->ws + WS_MOD))[i] = s;
    }
}
DI const float* modp(KArgs KA, int l, int mb, int idx) { return ((float*)(KA->ws + WS_MOD)) + ((size_t)(l * 9 + mb) * 9 + idx) * DM; }
DI void p0c() {
    KArgs KA = kargs(); Frame F = mkframe();
    for (int row = F.gw; row < NROW; row += F.ngw) {
        const int mb = row < NLAT ? (row >> 12) : 8;
        const float* src = row < NLAT ? KA->in[0] + (size_t)row * DM : KA->in[2] + (size_t)(row - NLAT) * DM;
        const float* sh = modp(KA, 0, mb, 0); const float* sc = modp(KA, 0, mb, 1);
#pragma unroll
        for (int j = 0; j < 4; ++j) { const int n = 4 * F.lane + 256 * j; const f32x4 v = *(const f32x4*)(src + n);
            const f32x4 a = v * (1.0f + *(const f32x4*)(sc + n)) + *(const f32x4*)(sh + n);
            v2u w; w.x = pk2(a.x, a.y); w.y = pk2(a.z, a.w); *(v2u*)(((bf16*)(KA->ws + WS_A)) + (size_t)row * DM + n) = w; }
    }
}
DI void ln_pass(int l, int gidx, float gmul, int lnidx, int nl, int nsh, int row0, int nrows, int wg0, int nwgs, const bool DTP) {
    KArgs KA = kargs(); Frame F = mkframe();
    F.gw = row0 + ((int)blockIdx.x - wg0) * NWAVES + F.wave; F.ngw = nwgs * NWAVES;
    LAS float* wdt = (LAS float*)F.lds;
    if (DTP) { __syncthreads(); for (int i = F.tid; i < 8192; i += 512) wdt[i] = KA->in[10][((size_t)l * DM + (i >> 3)) * INW + C_DTSRC + (i & 7)]; __syncthreads(); }
    const float* g = KA->in[6] + (l * 3 + lnidx) * DM; const float* bb = KA->in[7] + (l * 3 + lnidx) * DM;
    float* const xlat = KA->out; float* const xctx = (float*)(KA->ws + WS_XC); const bf16* const fbase = (const bf16*)(KA->ws + WS_O);
    const bool fromin = (l == 0 && lnidx == 0);
    const float* const slat = fromin ? KA->in[0] : (const float*)xlat; const float* const sctx = fromin ? KA->in[2] : (const float*)xctx;
    f32x4 xn[4]; v2u fn[4];
    if (F.gw < nrows) { const int row = F.gw; const float* xr = row < NLAT ? slat + (size_t)row * DM : sctx + (size_t)(row - NLAT) * DM;
#pragma unroll
        for (int j = 0; j < 4; ++j) { const int n = 4 * F.lane + 256 * j; xn[j] = *(const f32x4*)(xr + n); fn[j] = *(const v2u*)(fbase + (size_t)row * DM + n); } }
    for (int row = F.gw; row < nrows; row += F.ngw) {
        const int mb = row < NLAT ? (row >> 12) : 8;
        float* xrow = row < NLAT ? xlat + (size_t)row * DM : xctx + (size_t)(row - NLAT) * DM;
        const float* gate = modp(KA, l, mb, gidx);
        f32x4 v[4]; float s = 0.f;
#pragma unroll
        for (int j = 0; j < 4; ++j) { const int n = 4 * F.lane + 256 * j; const f32x4 gt = *(const f32x4*)(gate + n);
            const f32x4 fv = (f32x4){bflo(fn[j].x), bfhi(fn[j].x), bflo(fn[j].y), bfhi(fn[j].y)};
            v[j] = xn[j] * ALPHA + gt * fv * gmul; s += (v[j].x + v[j].y) + (v[j].z + v[j].w); }
        { const int nrow = row + F.ngw;
          if (nrow < nrows) { const float* xr = nrow < NLAT ? slat + (size_t)nrow * DM : sctx + (size_t)(nrow - NLAT) * DM;
#pragma unroll
            for (int j = 0; j < 4; ++j) { const int n = 4 * F.lane + 256 * j; xn[j] = *(const f32x4*)(xr + n); fn[j] = *(const v2u*)(fbase + (size_t)nrow * DM + n); } } }
        const float mean = wave_sum(s) * (1.f / DM); float s2 = 0.f;
#pragma unroll
        for (int j = 0; j < 4; ++j) { v[j] = v[j] - mean; s2 += (v[j].x * v[j].x + v[j].y * v[j].y) + (v[j].z * v[j].z + v[j].w * v[j].w); }
        const float rstd = __builtin_amdgcn_rsqf(wave_sum(s2) * (1.f / DM) + LN_EPS);
        float dt[8];
#pragma unroll
        for (int q = 0; q < 8; ++q) dt[q] = 0.f;
#pragma unroll
        for (int j = 0; j < 4; ++j) { const int n = 4 * F.lane + 256 * j;
            const f32x4 y = v[j] * rstd * *(const f32x4*)(g + n) + *(const f32x4*)(bb + n);
            *(f32x4*)(xrow + n) = y;
            if (nsh >= 0) { const f32x4 a = y * (1.0f + *(const f32x4*)(modp(KA, nl, mb, nsh + 1) + n)) + *(const f32x4*)(modp(KA, nl, mb, nsh) + n);
                v2u w; w.x = cvtpk(a.x, a.y); w.y = cvtpk(a.z, a.w); *(v2u*)(((bf16*)(KA->ws + WS_A)) + (size_t)row * DM + n) = w;
                if (DTP) {
#pragma unroll
                    for (int e = 0; e < 4; ++e) { const f32x4 w0 = *(const LAS f32x4*)(wdt + (n + e) * 8), w1 = *(const LAS f32x4*)(wdt + (n + e) * 8 + 4); const float ae = a[e];
                        dt[0] += ae * w0.x; dt[1] += ae * w0.y; dt[2] += ae * w0.z; dt[3] += ae * w0.w; dt[4] += ae * w1.x; dt[5] += ae * w1.y; dt[6] += ae * w1.z; dt[7] += ae * w1.w; } } }
        }
        if (DTP) {
#pragma unroll
            for (int q = 0; q < 8; ++q) dt[q] = wave_sum(dt[q]);
            if (F.lane == 0) { *(f32x4*)(((float*)(KA->ws + WS_DT)) + (size_t)row * 8) = (f32x4){dt[0], dt[1], dt[2], dt[3]}; *(f32x4*)(((float*)(KA->ws + WS_DT)) + (size_t)row * 8 + 4) = (f32x4){dt[4], dt[5], dt[6], dt[7]}; }
        }
    }
}
DI void prep_pass(int l) {
    KArgs KA = kargs(); Frame F = mkframe();
    const LAS float* rc = (const LAS float*)(F.lds + ROPE_OFF); const LAS float* rsn = rc + 1024;
    bf16* P = (bf16*)(KA->ws + WS_ACT); bf16* U = (bf16*)(KA->ws + WS_U); float* DTB = (float*)(KA->ws + WS_DT);
    const int hv = F.lane >> 5, s = F.lane & 31, hsub = s >> 3, ra = (s >> 2) & 1, ig = s & 3, d1 = ra * 32 + 4 * ig, d2 = d1 + 16;
    constexpr int NBLK = NROW / 8;
    for (int item = F.gw; item < 4 * NBLK; item += F.ngw) {
        const int part = item / NBLK, rb = item - part * NBLK;
        const int row8 = rb * 8; const bool lat = row8 < NLAT;
        if (part == 0) {
#pragma unroll
        for (int rr = 0; rr < 4; ++rr) {
            const int row = row8 + 2 * rr + hv; const int t = row & 4095;
            const int pos = ra == 0 ? (t >> 6) : (t & 63);
            const f32x4 cs = *(const LAS f32x4*)(rc + pos * 16 + 4 * ig), sn = *(const LAS f32x4*)(rsn + pos * 16 + 4 * ig);
            bf16* pr = P + (size_t)row * NPJ;
#pragma unroll
            for (int it = 0; it < 3; ++it) {
                const int hh = it * 4 + hsub;
                const bool isc = hh >= 6; const int h6 = isc ? hh - 6 : hh;
                const int col = (isc ? (h6 < 4 ? C_CQ + h6 * 64 : C_CK + (h6 - 4) * 64) : (h6 < 4 ? C_AQ + h6 * 64 : C_AK + (h6 - 4) * 64));
                const v2u w1 = *(const v2u*)(pr + col + d1), w2 = *(const v2u*)(pr + col + d2);
                f32x4 x1 = (f32x4){bflo(w1.x), bfhi(w1.x), bflo(w1.y), bfhi(w1.y)}, x2 = (f32x4){bflo(w2.x), bfhi(w2.x), bflo(w2.y), bfhi(w2.y)};
                float ss = (x1.x * x1.x + x1.y * x1.y) + (x1.z * x1.z + x1.w * x1.w) + (x2.x * x2.x + x2.y * x2.y) + (x2.z * x2.z + x2.w * x2.w);
                ss += __shfl_xor(ss, 1); ss += __shfl_xor(ss, 2); ss += __shfl_xor(ss, 4);
                if (isc) { const float r = (h6 < 4 ? 0.125f * 1.4426950408889634f : 1.0f) * __builtin_amdgcn_rsqf(ss * (1.f / 64.f) + LN_EPS); const float* gn = (h6 < 4 ? KA->in[19] : KA->in[20]) + l * 64;
                    x1 = x1 * r * *(const f32x4*)(gn + d1); x2 = x2 * r * *(const f32x4*)(gn + d2); }
                if (lat) { const f32x4 y1 = x1 * cs - x2 * sn, y2 = x1 * sn + x2 * cs; x1 = y1; x2 = y2; }
                if (isc || lat) { v2u o1, o2; o1.x = cvtpk(x1.x, x1.y); o1.y = cvtpk(x1.z, x1.w); o2.x = cvtpk(x2.x, x2.y); o2.y = cvtpk(x2.z, x2.w);
                    *(v2u*)(pr + col + d1) = o1; *(v2u*)(pr + col + d2) = o2; }
            }
        }
        { const int row = row8 + (F.lane >> 3), q = F.lane & 7; const float v = DTB[(size_t)row * 8 + q] + KA->in[16][l * 8 + q]; DTB[(size_t)row * 8 + q] = fmaxf(v, 0.f) + log1pf(__expf(-fabsf(v))); }
        } else {
        const int Ls = lat ? SEQ : CTXL; const int tt0 = lat ? (row8 & 4095) : ((row8 - NLAT) & 255);
        { const int j = part - 1; const int ch = 4 * F.lane + 256 * j;
            const f32x4 bias = *(const f32x4*)(KA->in[15] + l * 768 + ch);
            f32x4 cw[5];
#pragma unroll
            for (int k = 0; k < 5; ++k) cw[k] = *(const f32x4*)(KA->in[14] + (l * 5 + k) * 768 + ch);
            f32x4 xw[12];
#pragma unroll
            for (int q = 0; q < 12; ++q) { const int t2 = tt0 + q - 2;
                if (t2 >= 0 && t2 < Ls) { const v2u w = *(const v2u*)(P + (size_t)(row8 + q - 2) * NPJ + C_BX + ch); xw[q] = (f32x4){bflo(w.x), bfhi(w.x), bflo(w.y), bfhi(w.y)}; }
                else xw[q] = (f32x4){0.f, 0.f, 0.f, 0.f}; }
#pragma unroll
            for (int q = 0; q < 8; ++q) { f32x4 acc = bias;
#pragma unroll
                for (int k = 0; k < 5; ++k) acc += cw[k] * xw[q + k];
                v2u o; o.x = cvtpk(silu(acc.x), silu(acc.y)); o.y = cvtpk(silu(acc.z), silu(acc.w)); *(v2u*)(U + (size_t)(row8 + q) * 768 + ch) = o; }
        }
        }
    }
}
DI void nkey(const float (&q)[64], float (&o)[64], float& m, float& l, const bf16* kr, const bf16* vr, float bias) {
    float s = bias;
#pragma unroll
    for (int c = 0; c < 8; ++c) { const v4u w = *(const v4u*)(kr + 8 * c);
        s += q[8 * c] * bflo(w.x) + q[8 * c + 1] * bfhi(w.x) + q[8 * c + 2] * bflo(w.y) + q[8 * c + 3] * bfhi(w.y) + q[8 * c + 4] * bflo(w.z) + q[8 * c + 5] * bfhi(w.z) + q[8 * c + 6] * bflo(w.w) + q[8 * c + 7] * bfhi(w.w); }
    const float mn = fmaxf(m, s), cf = __expf(m - mn), p = __expf(s - mn);
    l = l * cf + p; m = mn;
#pragma unroll
    for (int c = 0; c < 8; ++c) { const v4u w = *(const v4u*)(vr + 8 * c);
        o[8 * c] = o[8 * c] * cf + p * bflo(w.x); o[8 * c + 1] = o[8 * c + 1] * cf + p * bfhi(w.x); o[8 * c + 2] = o[8 * c + 2] * cf + p * bflo(w.y); o[8 * c + 3] = o[8 * c + 3] * cf + p * bfhi(w.y);
        o[8 * c + 4] = o[8 * c + 4] * cf + p * bflo(w.z); o[8 * c + 5] = o[8 * c + 5] * cf + p * bfhi(w.z); o[8 * c + 6] = o[8 * c + 6] * cf + p * bflo(w.w); o[8 * c + 7] = o[8 * c + 7] * cf + p * bfhi(w.w); }
}
template <int TYPE>
DI void naive_attn(int l, int row, int h, bool ctxq) {
    KArgs KA = kargs(); Frame F = mkframe();
    const bf16* P = ((bf16*)(KA->ws + WS_ACT));
    const int qcol = (TYPE == 0 ? C_AQ : TYPE == 1 ? C_CQ : C_DQ) + h * 64;
    const int kvh = TYPE == 2 ? h : (h >> 1);
    const int kcol = (TYPE == 0 ? C_AK : TYPE == 1 ? C_CK : C_DK) + kvh * 64, vcol = (TYPE == 0 ? C_AV : TYPE == 1 ? C_CV : C_DV) + kvh * 64;
    float q[64], o[64]; float m = -1e30f, ls = 0.f;
#pragma unroll
    for (int c = 0; c < 8; ++c) { const v4u w = *(const v4u*)(P + (size_t)row * NPJ + qcol + 8 * c);
        q[8 * c] = 0.125f * bflo(w.x); q[8 * c + 1] = 0.125f * bfhi(w.x); q[8 * c + 2] = 0.125f * bflo(w.y); q[8 * c + 3] = 0.125f * bfhi(w.y);
        q[8 * c + 4] = 0.125f * bflo(w.z); q[8 * c + 5] = 0.125f * bfhi(w.z); q[8 * c + 6] = 0.125f * bflo(w.w); q[8 * c + 7] = 0.125f * bfhi(w.w); }
#pragma unroll
    for (int d = 0; d < 64; ++d) o[d] = 0.f;
    int b;
    if (!ctxq) {
        b = row >> 12; const int t = row & 4095;
        if (TYPE == 0) { const int k0 = max(t - 128, 0), k1 = min(t + 128, SEQ - 1);
            for (int k = k0; k <= k1; ++k) { const bf16* kp = P + (size_t)(b * SEQ + k) * NPJ; nkey(q, o, m, ls, kp + kcol, kp + vcol, 0.f); } }
        else if (TYPE == 1) { for (int k = 0; k < SEQ; ++k) { const bf16* kp = P + (size_t)(b * SEQ + k) * NPJ; nkey(q, o, m, ls, kp + kcol, kp + vcol, 0.f); } }
        else { const int r = t >> 6, c = t & 63; const int rs = min(max(r - 4, 0), 56), cs = min(max(c - 8, 0), 48);
            for (int a = 0; a < 8; ++a) { const float* bp = KA->in[21] + ((size_t)(l * 4 + h) * 15 + (rs + a - r + 7)) * 31 + (cs - c + 15);
                for (int k = 0; k < 16; ++k) { const bf16* kp = P + (size_t)(b * SEQ + (rs + a) * 64 + cs + k) * NPJ; nkey(q, o, m, ls, kp + kcol, kp + vcol, bp[k]); } } }
    } else b = (row - NLAT) >> 8;
    for (int k = 0; k < CTXL; ++k) { const bf16* kp = P + (size_t)(NLAT + b * CTXL + k) * NPJ; nkey(q, o, m, ls, kp + kcol, kp + vcol, 0.f); }
    if (TYPE == 0) { const float sk = KA->in[13][l * 4 + h]; const float mn = fmaxf(m, sk), cf = __expf(m - mn); ls = ls * cf + __expf(sk - mn);
#pragma unroll
        for (int d = 0; d < 64; ++d) o[d] *= cf; }
    const float inv = 1.f / ls;
    bf16* op = ((bf16*)(KA->ws + WS_O)) + (size_t)row * DM + (TYPE == 0 ? 0 : TYPE == 1 ? 512 : 768) + h * 64;
#pragma unroll
    for (int c = 0; c < 8; ++c) { v4u w; w.x = pk2(o[8 * c] * inv, o[8 * c + 1] * inv); w.y = pk2(o[8 * c + 2] * inv, o[8 * c + 3] * inv); w.z = pk2(o[8 * c + 4] * inv, o[8 * c + 5] * inv); w.w = pk2(o[8 * c + 6] * inv, o[8 * c + 7] * inv);
        *(v4u*)(op + 8 * c) = w; }
}
DI void naive_ssd(int l, int item) {
    KArgs KA = kargs(); Frame F = mkframe();
    const int b = item >> 3, dir = (item >> 2) & 1, h = item & 3, g = h >> 1;
    const int p = F.tid >> 3, ng = F.tid & 7;
    const float A = -__expf(KA->in[17][l * 8 + dir * 4 + h]);
    bf16* Y = dir ? (((bf16*)(KA->ws + WS_Y) + (size_t)NROW * 256)) : ((bf16*)(KA->ws + WS_Y));
    float hs[16];
#pragma unroll
    for (int i = 0; i < 16; ++i) hs[i] = 0.f;
    for (int ph = 0; ph < 2; ++ph) {
        const int ns = ph ? SEQ : CTXL, base = ph ? b * SEQ : NLAT + b * CTXL;
#pragma unroll 4
        for (int s = 0; s < ns; ++s) {
            const int row = base + (dir ? ns - 1 - s : s);
            const float dt = ((float*)(KA->ws + WS_DT))[(size_t)row * 8 + dir * 4 + h];
            const bf16* ur = ((bf16*)(KA->ws + WS_U)) + (size_t)row * 768;
            const float xv = bf2f(ur[h * 64 + p]);
            const v4u b0 = *(const v4u*)(ur + 256 + g * 128 + ng * 16), b1 = *(const v4u*)(ur + 256 + g * 128 + ng * 16 + 8);
            const v4u c0 = *(const v4u*)(ur + 512 + g * 128 + ng * 16), c1 = *(const v4u*)(ur + 512 + g * 128 + ng * 16 + 8);
            const float dA = __expf(dt * A), dx = dt * xv;
            const unsigned bw[8] = {b0.x, b0.y, b0.z, b0.w, b1.x, b1.y, b1.z, b1.w}, cw[8] = {c0.x, c0.y, c0.z, c0.w, c1.x, c1.y, c1.z, c1.w};
            float y = 0.f;
#pragma unroll
            for (int i = 0; i < 8; ++i) { hs[2 * i] = hs[2 * i] * dA + dx * bflo(bw[i]); hs[2 * i + 1] = hs[2 * i + 1] * dA + dx * bfhi(bw[i]); y += bflo(cw[i]) * hs[2 * i] + bfhi(cw[i]) * hs[2 * i + 1]; }
            y += __shfl_xor(y, 1); y += __shfl_xor(y, 2); y += __shfl_xor(y, 4);
            if (ng == 0) Y[(size_t)row * 256 + h * 64 + p] = (bf16)f2bf(y);
        }
    }
}
DI void mixers_naive(int l, bool last) {
    Frame F = mkframe();
    const int nAttL = 64 * 12, nAttC = last ? 0 : 4 * 12, nItems = 64 + nAttL + nAttC;
    for (int it = blockIdx.x; it < nItems; it += F.G) {
        if (it < 64) { naive_ssd(l, it); continue; }
        int r = it - 64; bool cq = false; int rowbase;
        if (r >= nAttL) { r -= nAttL; cq = true; }
        const int rb = r / 12, ty = (r % 12) >> 2, h = r & 3;
        rowbase = cq ? NLAT + rb * 512 : rb * 512;
        const int row = rowbase + F.tid;
        if (ty == 0) naive_attn<0>(l, row, h, cq); else if (ty == 1) naive_attn<1>(l, row, h, cq); else naive_attn<2>(l, row, h, cq);
    }
}
typedef float f32x16 __attribute__((ext_vector_type(16)));
typedef short s16x4 __attribute__((ext_vector_type(4)));
typedef short bf16x8v __attribute__((ext_vector_type(8)));
typedef short v4i16_t __attribute__((ext_vector_type(4)));
DI s16x4 vtr(const LAS unsigned char* p) { return __builtin_bit_cast(s16x4, __builtin_amdgcn_ds_read_tr16_b64_v4i16((LAS v4i16_t*)p)); }
DI int crow16(int i, int h) { return (i & 3) + 8 * (i >> 2) + 4 * h; }
constexpr int AT_KRS = 144, AT_VRS = 192, AT_KB = 64 * AT_KRS, AT_BUF = AT_KB + 64 * AT_VRS, AT_RPB = 2 * AT_BUF;
constexpr float LOG2E = 1.4426950408889634f, AT_SC = 0.125f * LOG2E;
template <int TYPE>
DI void attn_unit(KArgs KA, const Frame& F, int l, int unit, bool ctxq) {
    const bf16* P = (const bf16*)(KA->ws + WS_ACT);
    const int L = F.lane, w = F.wave, r = L & 31, h2 = L >> 5, i16 = L & 15;
    int b, head, kvh, p0, qpos0, t0 = 0, nloc = 0;
    if (TYPE != 2) { int g, pb; if (!ctxq) { b = unit >> 6; g = (unit >> 5) & 1; pb = unit & 31; } else { b = unit >> 2; g = (unit >> 1) & 1; pb = unit & 1; }
        head = 2 * g + (w >> 2); kvh = g; p0 = pb * 128; qpos0 = p0 + 32 * (w & 3);
        if (!ctxq) { if (TYPE == 1) { t0 = 0; nloc = 64; } else { t0 = max(0, 2 * (pb - 1)); nloc = min(64, 2 * (pb + 2)) - t0; } } }
    else { int rb; if (!ctxq) { b = unit >> 6; head = (unit >> 4) & 3; rb = unit & 15; } else { b = unit >> 2; head = unit & 3; rb = 0; }
        kvh = head; p0 = rb * 256; qpos0 = p0 + 32 * w;
        if (!ctxq) { const int r0 = rb * 4; t0 = min(max(r0 - 4, 0), 56); nloc = min(max(r0 - 1, 0), 56) + 8 - t0; } }
    const int qcol = (TYPE == 0 ? C_AQ : TYPE == 1 ? C_CQ : C_DQ) + head * 64;
    const int kcol = (TYPE == 0 ? C_AK : TYPE == 1 ? C_CK : C_DK) + kvh * 64, vcol = (TYPE == 0 ? C_AV : TYPE == 1 ? C_CV : C_DV) + kvh * 64;
    const int qrow = (ctxq ? NLAT + b * CTXL : b * SEQ) + qpos0 + r;
    const int nt = nloc + 4;
    bf16x8v qf[4];
#pragma unroll
    for (int ks = 0; ks < 4; ++ks) qf[ks] = *(const bf16x8v*)(P + (size_t)qrow * NPJ + qcol + ks * 16 + 8 * h2);
    LAS unsigned char* lb = F.lds;
    if (TYPE == 2) { LAS float* rp = (LAS float*)(lb + AT_RPB); for (int i = F.tid; i < 465; i += 512) rp[i] = KA->in[21][(size_t)(l * 4 + head) * 465 + i] * 8.0f; }
    const int srow = F.tid >> 3, sch = F.tid & 7;
#define TILE_ROW0(i) ((i) < nloc ? b * SEQ + (t0 + (i)) * 64 : NLAT + b * CTXL + ((i) - nloc) * 64)
    v4u kreg, vreg;
    { const bf16* src = P + (size_t)(TILE_ROW0(0) + srow) * NPJ; kreg = *(const v4u*)(src + kcol + sch * 8); vreg = *(const v4u*)(src + vcol + sch * 8); }
    *(LAS v4u*)(lb + srow * AT_KRS + sch * 16) = kreg; *(LAS v4u*)(lb + AT_KB + srow * AT_VRS + sch * 16) = vreg;
    __syncthreads();
    f32x16 oacc[2];
#pragma unroll
    for (int i = 0; i < 16; ++i) { oacc[0][i] = 0.f; oacc[1][i] = 0.f; }
    float m = -1e30f, lsum = 0.f;
    if (TYPE == 1) {
        float gq = fabsf(KA->in[19][l * 64 + L]), gk = fabsf(KA->in[20][l * 64 + L]);
#pragma unroll
        for (int o = 1; o < 64; o <<= 1) { gq = fmaxf(gq, __shfl_xor(gq, o)); gk = fmaxf(gk, __shfl_xor(gk, o)); }
        m = 64.0f * 1.03f * gq * gk * AT_SC;
    }
    const int qpos = qpos0 + r;
    const int gr = qpos0 >> 6, rs = min(max(gr - 4, 0), 56), qc = qpos & 63, cs = min(max(qc - 8, 0), 48);
    for (int i = 0; i < nt; ++i) {
        const LAS unsigned char* kb_ = lb + (i & 1) * AT_BUF; const LAS unsigned char* vb_ = kb_ + AT_KB;
        if (i + 1 < nt) { const bf16* src = P + (size_t)(TILE_ROW0(i + 1) + srow) * NPJ; kreg = *(const v4u*)(src + kcol + sch * 8); vreg = *(const v4u*)(src + vcol + sch * 8); }
        const bool loc = i < nloc;
        bool skip = false;
        const int k0 = (t0 + i) * 64;
        if (loc && TYPE == 0) skip = (k0 + 63 < qpos0 - 128) || (k0 > qpos0 + 31 + 128);
        if (loc && TYPE == 2) skip = (t0 + i < rs) || (t0 + i >= rs + 8);
        if (!skip) {
            f32x16 sacc[2];
            bf16x8v kf[2][4], vf[2][2][2];
#pragma unroll
            for (int kb = 0; kb < 2; ++kb)
#pragma unroll
                for (int ks = 0; ks < 4; ++ks) kf[kb][ks] = *(const LAS bf16x8v*)(kb_ + (kb * 32 + r) * AT_KRS + ks * 32 + 16 * h2);
#pragma unroll
            for (int kb = 0; kb < 2; ++kb)
#pragma unroll
                for (int s = 0; s < 2; ++s)
#pragma unroll
                    for (int db = 0; db < 2; ++db) {
                        const LAS unsigned char* va = vb_ + (kb * 32 + 16 * s + 4 * h2 + (i16 >> 2)) * AT_VRS + (db * 32 + 16 * ((L >> 4) & 1) + 4 * (i16 & 3)) * 2;
                        const s16x4 lo = vtr(va), hi = vtr(va + 8 * AT_VRS);
                        vf[kb][s][db] = (bf16x8v){lo[0], lo[1], lo[2], lo[3], hi[0], hi[1], hi[2], hi[3]}; }
            __builtin_amdgcn_sched_barrier(0);
#pragma unroll
            for (int kb = 0; kb < 2; ++kb) {
#pragma unroll
                for (int q = 0; q < 16; ++q) sacc[kb][q] = (TYPE == 1) ? -m : 0.f;
#pragma unroll
                for (int ks = 0; ks < 4; ++ks) sacc[kb] = __builtin_amdgcn_mfma_f32_32x32x16_bf16(kf[kb][ks], qf[ks], sacc[kb], 0, 0, 0);
            }
            float tmax = -INFINITY;
            if ((TYPE == 0 || TYPE == 2) && loc) {
#pragma unroll
                for (int kb = 0; kb < 2; ++kb)
#pragma unroll
                    for (int q = 0; q < 16; ++q) { float s = sacc[kb][q]; const int kk = kb * 32 + crow16(q, h2);
                        if (TYPE == 0) { const int d = k0 + kk - qpos; if (d > 128 || d < -128) s = -INFINITY; }
                        if (TYPE == 2) { const int dc = kk - cs; const LAS float* rp = (const LAS float*)(lb + AT_RPB);
                            if (dc < 0 || dc >= 16) s = -INFINITY; else s += rp[(t0 + i - gr + 7) * 31 + (kk - qc + 15)]; }
                        sacc[kb][q] = s; }
            }
            if (TYPE != 1) {
#pragma unroll
                for (int kb = 0; kb < 2; ++kb)
#pragma unroll
                    for (int q = 0; q < 16; ++q) tmax = fmaxf(tmax, sacc[kb][q]);
                tmax = fmaxf(tmax, __shfl_xor(tmax, 32));
                const float mn = fmaxf(m, tmax);
                if (__any(mn > m)) {
                    const float alpha = __builtin_amdgcn_exp2f((m - mn) * AT_SC);
                    lsum *= alpha;
#pragma unroll
                    for (int q = 0; q < 16; ++q) { oacc[0][q] *= alpha; oacc[1][q] *= alpha; }
                }
                m = mn;
            }
            const float mns = -m * AT_SC;
            float psum = 0.f;
#pragma unroll
            for (int kb = 0; kb < 2; ++kb)
#pragma unroll
                for (int q = 0; q < 16; ++q) { const float p = (TYPE == 1) ? __builtin_amdgcn_exp2f(sacc[kb][q]) : __builtin_amdgcn_exp2f(__builtin_fmaf(sacc[kb][q], AT_SC, mns)); sacc[kb][q] = p; psum += p; }
            lsum += psum;
#pragma unroll
            for (int kb = 0; kb < 2; ++kb)
#pragma unroll
                for (int s = 0; s < 2; ++s) {
                    v4u pw; pw.x = cvtpk(sacc[kb][8 * s], sacc[kb][8 * s + 1]); pw.y = cvtpk(sacc[kb][8 * s + 2], sacc[kb][8 * s + 3]); pw.z = cvtpk(sacc[kb][8 * s + 4], sacc[kb][8 * s + 5]); pw.w = cvtpk(sacc[kb][8 * s + 6], sacc[kb][8 * s + 7]);
                    const bf16x8v pf = __builtin_bit_cast(bf16x8v, pw);
#pragma unroll
                    for (int db = 0; db < 2; ++db) oacc[db] = __builtin_amdgcn_mfma_f32_32x32x16_bf16(vf[kb][s][db], pf, oacc[db], 0, 0, 0);
                }
        }
        if (i + 1 < nt) { LAS unsigned char* nb = lb + ((i + 1) & 1) * AT_BUF; *(LAS v4u*)(nb + srow * AT_KRS + sch * 16) = kreg; *(LAS v4u*)(nb + AT_KB + srow * AT_VRS + sch * 16) = vreg; }
        __syncthreads();
    }
    lsum += __shfl_xor(lsum, 32);
    if (TYPE == 0) lsum += __builtin_amdgcn_exp2f(KA->in[13][l * 4 + head] * LOG2E - m * AT_SC);
    const float inv = __builtin_amdgcn_rcpf(lsum);
    bf16* op = (bf16*)(KA->ws + WS_O) + (size_t)qrow * DM + (TYPE == 0 ? 0 : TYPE == 1 ? 512 : 768) + head * 64;
#pragma unroll
    for (int db = 0; db < 2; ++db)
#pragma unroll
        for (int q4 = 0; q4 < 4; ++q4) { v2u o; o.x = cvtpk(oacc[db][4 * q4] * inv, oacc[db][4 * q4 + 1] * inv); o.y = cvtpk(oacc[db][4 * q4 + 2] * inv, oacc[db][4 * q4 + 3] * inv);
            *(v2u*)(op + db * 32 + 8 * q4 + 4 * h2) = o; }
}
constexpr size_t WS_ST = WS_A;
constexpr size_t WS_DEC = 3 * MiB;
constexpr int SS_B = 0, SS_BRS = 272, SS_X = 34816, SS_XRS = 192, SS_X2 = 59392, SS_HF = 83968, SS_HB = 101376, SS_ARR = 118784;
DI int slot_row(int b, int slot) { return slot < 2 ? NLAT + b * CTXL + slot * 128 : b * SEQ + (slot - 2) * 128; }
DI void ssd_stage_dt(KArgs KA, const Frame& F, int l, int h, int rowbase, LAS float* arr) {
    const float* DTB = (const float*)(KA->ws + WS_DT);
    if (F.tid < 128) { const float df = DTB[(size_t)(rowbase + F.tid) * 8 + h], db = DTB[(size_t)(rowbase + F.tid) * 8 + 4 + h];
        const float Af = -__expf(KA->in[17][l * 8 + h]) * LOG2E, Ab = -__expf(KA->in[17][l * 8 + 4 + h]) * LOG2E;
        arr[F.tid] = df * Af; arr[128 + F.tid] = db * Ab; arr[256 + F.tid] = df; arr[384 + F.tid] = db; }
    __syncthreads();
    if (F.wave < 2) { const int L = F.lane; const bool rev = F.wave == 1;
        const float v0 = rev ? arr[128 + 127 - 2 * L] : arr[2 * L], v1 = rev ? arr[128 + 126 - 2 * L] : arr[2 * L + 1];
        float t = v0 + v1;
#pragma unroll
        for (int o = 1; o < 64; o <<= 1) { const float u = __shfl_up(t, o); if (L >= o) t += u; }
        if (rev) { arr[640 + 127 - 2 * L] = t - v1; arr[640 + 126 - 2 * L] = t; } else { arr[512 + 2 * L] = t - v1; arr[512 + 2 * L + 1] = t; } }
    __syncthreads();
}
struct BRegs { v4u v[4]; };
DI BRegs ssd_load_B(KArgs KA, const Frame& F, int g, int rowbase) {
    const bf16* U = (const bf16*)(KA->ws + WS_U);
    const int row = F.tid >> 2, pc = F.tid & 3; const bf16* src = U + (size_t)(rowbase + row) * 768 + 256 + g * 128 + pc * 32;
    BRegs b;
#pragma unroll
    for (int k = 0; k < 4; ++k) b.v[k] = *(const v4u*)(src + k * 8);
    return b;
}
DI void ssd_store_B(const Frame& F, const BRegs& b) {
    const int row = F.tid >> 2, pc = F.tid & 3;
#pragma unroll
    for (int k = 0; k < 4; ++k) *(LAS v4u*)(F.lds + SS_B + row * SS_BRS + pc * 64 + k * 16) = b.v[k];
}
DI v4u scale8(v4u w, float s) { v4u o; o.x = cvtpk(bflo(w.x) * s, bfhi(w.x) * s); o.y = cvtpk(bflo(w.y) * s, bfhi(w.y) * s); o.z = cvtpk(bflo(w.z) * s, bfhi(w.z) * s); o.w = cvtpk(bflo(w.w) * s, bfhi(w.w) * s); return o; }
DI void ssd_states(KArgs KA, const Frame& F, int l, int item) {
    const int slot = item % 34, bh = item / 34, b = bh >> 2, h = bh & 3, g = h >> 1, rowbase = slot_row(b, slot);
    const int L = F.lane, w = F.wave, r = L & 31, h2 = L >> 5, i16 = L & 15, grp = (L >> 4) & 1;
    LAS float* arr = (LAS float*)(F.lds + SS_ARR);
    const BRegs breg = ssd_load_B(KA, F, g, rowbase);
    v4u x0, x1;
    { const bf16* U = (const bf16*)(KA->ws + WS_U); const int row = F.tid >> 2, pc = F.tid & 3; const bf16* src = U + (size_t)(rowbase + row) * 768 + h * 64 + pc * 16; x0 = *(const v4u*)src; x1 = *(const v4u*)(src + 8); }
    ssd_stage_dt(KA, F, l, h, rowbase, arr);
    ssd_store_B(F, breg);
    { const int row = F.tid >> 2, pc = F.tid & 3;
      const float wf = __builtin_amdgcn_exp2f(arr[512 + 127] - arr[512 + row]) * arr[256 + row], wb = __builtin_amdgcn_exp2f(arr[640] - arr[640 + row]) * arr[384 + row];
      *(LAS v4u*)(F.lds + SS_X + row * SS_XRS + pc * 32) = scale8(x0, wf); *(LAS v4u*)(F.lds + SS_X + row * SS_XRS + pc * 32 + 16) = scale8(x1, wf);
      *(LAS v4u*)(F.lds + SS_X2 + row * SS_XRS + pc * 32) = scale8(x0, wb); *(LAS v4u*)(F.lds + SS_X2 + row * SS_XRS + pc * 32 + 16) = scale8(x1, wb); }
    __syncthreads();
    const int pblk = w >> 2, nblk = w & 3;
    bf16* ST = (bf16*)(KA->ws + WS_ST); float* DEC = (float*)(KA->ws + WS_DEC);
#pragma unroll
    for (int dir = 0; dir < 2; ++dir) {
        f32x16 acc;
#pragma unroll
        for (int q = 0; q < 16; ++q) acc[q] = 0.f;
        const LAS unsigned char* xb = F.lds + (dir ? SS_X2 : SS_X);
#pragma unroll
        for (int ks = 0; ks < 8; ++ks) {
            const LAS unsigned char* xa = xb + (ks * 16 + 8 * h2 + (i16 >> 2)) * SS_XRS + (pblk * 32 + 16 * grp + 4 * (i16 & 3)) * 2;
            const s16x4 xlo = vtr(xa), xhi = vtr(xa + 4 * SS_XRS);
            const LAS unsigned char* ba = F.lds + SS_B + (ks * 16 + 8 * h2 + (i16 >> 2)) * SS_BRS + (nblk * 32 + 16 * grp + 4 * (i16 & 3)) * 2;
            const s16x4 blo = vtr(ba), bhi_ = vtr(ba + 4 * SS_BRS);
            const bf16x8v xf = (bf16x8v){xlo[0], xlo[1], xlo[2], xlo[3], xhi[0], xhi[1], xhi[2], xhi[3]}, bfr = (bf16x8v){blo[0], blo[1], blo[2], blo[3], bhi_[0], bhi_[1], bhi_[2], bhi_[3]};
            acc = __builtin_amdgcn_mfma_f32_32x32x16_bf16(xf, bfr, acc, 0, 0, 0); }
        bf16* dst = ST + ((size_t)((bh * 2 + dir) * 34 + slot)) * 8192;
#pragma unroll
        for (int q = 0; q < 16; ++q) dst[(pblk * 32 + crow16(q, h2)) * 128 + nblk * 32 + r] = (bf16)(cvtpk(acc[q], 0.f) & 0xffffu);
        if (F.tid == 0) DEC[(bh * 2 + dir) * 34 + slot] = __builtin_amdgcn_exp2f(dir ? arr[640] : arr[512 + 127]);
    }
    __syncthreads();
}
DI void ssd_scan() {
    KArgs KA = kargs(); Frame F = mkframe();
    bf16* ST = (bf16*)(KA->ws + WS_ST); const float* DEC = (const float*)(KA->ws + WS_DEC);
    for (int gt = blockIdx.x * 512 + F.tid; gt < 64 * 2048; gt += F.G * 512) {
        const int chain = gt >> 11, e4 = gt & 2047, dir = chain & 1;
        bf16* base = ST + (size_t)chain * 34 * 8192 + e4 * 4;
        v2u tw[34]; float dc[34];
#pragma unroll
        for (int k = 0; k < 34; ++k) { const int slot = dir == 0 ? k : (k < 2 ? 1 - k : 35 - k); tw[k] = *(const v2u*)(base + (size_t)slot * 8192); dc[k] = DEC[chain * 34 + slot]; }
        f32x4 hc = (f32x4){0.f, 0.f, 0.f, 0.f};
#pragma unroll
        for (int k = 0; k < 34; ++k) { const int slot = dir == 0 ? k : (k < 2 ? 1 - k : 35 - k);
            const f32x4 t = (f32x4){bflo(tw[k].x), bfhi(tw[k].x), bflo(tw[k].y), bfhi(tw[k].y)};
            v2u ow; ow.x = cvtpk(hc.x, hc.y); ow.y = cvtpk(hc.z, hc.w); *(v2u*)(base + (size_t)slot * 8192) = ow; hc = hc * dc[k] + t; }
    }
}
DI void ssd_outputs(KArgs KA, const Frame& F, int l, int item) {
    const int slot = item % 34, bh = item / 34, b = bh >> 2, h = bh & 3, g = h >> 1, rowbase = slot_row(b, slot);
    const int L = F.lane, w = F.wave, r = L & 31, h2 = L >> 5, i16 = L & 15, grp = (L >> 4) & 1;
    LAS float* arr = (LAS float*)(F.lds + SS_ARR);
    const bf16* U = (const bf16*)(KA->ws + WS_U);
    const int ib = w & 3, pb = w >> 2, ipos = ib * 32 + r;
    bf16x8v cfq[8];
#pragma unroll
    for (int ks = 0; ks < 8; ++ks) cfq[ks] = *(const bf16x8v*)(U + (size_t)(rowbase + ipos) * 768 + 512 + g * 128 + ks * 16 + 8 * h2);
    const BRegs breg = ssd_load_B(KA, F, g, rowbase);
    v4u x0, x1, hf0, hf1, hb0, hb1;
    { const int row = F.tid >> 2, pc = F.tid & 3; const bf16* src = U + (size_t)(rowbase + row) * 768 + h * 64 + pc * 16; x0 = *(const v4u*)src; x1 = *(const v4u*)(src + 8); }
    { const bf16* ST = (const bf16*)(KA->ws + WS_ST); const int p = F.tid >> 3, pc = F.tid & 7;
      const bf16* sf = ST + ((size_t)((bh * 2 + 0) * 34 + slot)) * 8192 + p * 128 + pc * 16; const bf16* sb = ST + ((size_t)((bh * 2 + 1) * 34 + slot)) * 8192 + p * 128 + pc * 16;
      hf0 = *(const v4u*)sf; hf1 = *(const v4u*)(sf + 8); hb0 = *(const v4u*)sb; hb1 = *(const v4u*)(sb + 8); }
    ssd_stage_dt(KA, F, l, h, rowbase, arr);
    ssd_store_B(F, breg);
    { const int row = F.tid >> 2, pc = F.tid & 3; *(LAS v4u*)(F.lds + SS_X + row * SS_XRS + pc * 32) = x0; *(LAS v4u*)(F.lds + SS_X + row * SS_XRS + pc * 32 + 16) = x1; }
    { const int p = F.tid >> 3, pc = F.tid & 7; LAS unsigned char* d = F.lds + SS_HF + p * SS_BRS + pc * 32; *(LAS v4u*)d = hf0; *(LAS v4u*)(d + 16) = hf1;
      LAS unsigned char* e = F.lds + SS_HB + p * SS_BRS + pc * 32; *(LAS v4u*)e = hb0; *(LAS v4u*)(e + 16) = hb1; }
    __syncthreads();
    const float cfi = arr[512 + ipos], cbi = arr[640 + ipos];
    f32x16 yacc;
#pragma unroll
    for (int q = 0; q < 16; ++q) yacc[q] = 0.f;
#pragma unroll
    for (int jb = 0; jb < 4; ++jb) {
        f32x16 acc;
#pragma unroll
        for (int q = 0; q < 16; ++q) acc[q] = 0.f;
#pragma unroll
        for (int ks = 0; ks < 8; ++ks) { const bf16x8v bfr = *(const LAS bf16x8v*)(F.lds + SS_B + (jb * 32 + r) * SS_BRS + ks * 32 + 16 * h2);
            acc = __builtin_amdgcn_mfma_f32_32x32x16_bf16(bfr, cfq[ks], acc, 0, 0, 0); }
        if (jb < ib) {
#pragma unroll
            for (int q = 0; q < 16; ++q) { const int j = jb * 32 + crow16(q, h2); acc[q] *= __builtin_amdgcn_exp2f(cfi - arr[512 + j]) * arr[256 + j]; }
        } else if (jb > ib) {
#pragma unroll
            for (int q = 0; q < 16; ++q) { const int j = jb * 32 + crow16(q, h2); acc[q] *= __builtin_amdgcn_exp2f(cbi - arr[640 + j]) * arr[384 + j]; }
        } else {
            int rl = r; asm volatile("" : "+v"(rl));
#pragma unroll
            for (int q = 0; q < 16; ++q) { const int jl = crow16(q, h2), j = jb * 32 + jl;
                float wt = 0.f;
                if (jl <= rl) wt += __builtin_amdgcn_exp2f(cfi - arr[512 + j]) * arr[256 + j];
                if (jl >= rl) wt += __builtin_amdgcn_exp2f(cbi - arr[640 + j]) * arr[384 + j];
                acc[q] *= wt; }
        }
#pragma unroll
        for (int s = 0; s < 2; ++s) {
            v4u pw; pw.x = cvtpk(acc[8 * s], acc[8 * s + 1]); pw.y = cvtpk(acc[8 * s + 2], acc[8 * s + 3]); pw.z = cvtpk(acc[8 * s + 4], acc[8 * s + 5]); pw.w = cvtpk(acc[8 * s + 6], acc[8 * s + 7]);
            const bf16x8v pf = __builtin_bit_cast(bf16x8v, pw);
            const LAS unsigned char* xa = F.lds + SS_X + (jb * 32 + 16 * s + 4 * h2 + (i16 >> 2)) * SS_XRS + (pb * 32 + 16 * grp + 4 * (i16 & 3)) * 2;
            const s16x4 lo = vtr(xa), hi = vtr(xa + 8 * SS_XRS);
            const bf16x8v xf = (bf16x8v){lo[0], lo[1], lo[2], lo[3], hi[0], hi[1], hi[2], hi[3]};
            yacc = __builtin_amdgcn_mfma_f32_32x32x16_bf16(xf, pf, yacc, 0, 0, 0); }
    }
#pragma unroll
    for (int dir = 0; dir < 2; ++dir) {
        f32x16 tacc;
#pragma unroll
        for (int q = 0; q < 16; ++q) tacc[q] = 0.f;
#pragma unroll
        for (int ks = 0; ks < 8; ++ks) { const bf16x8v hfr = *(const LAS bf16x8v*)(F.lds + (dir ? SS_HB : SS_HF) + (pb * 32 + r) * SS_BRS + ks * 32 + 16 * h2);
            tacc = __builtin_amdgcn_mfma_f32_32x32x16_bf16(hfr, cfq[ks], tacc, 0, 0, 0); }
        const float sc = __builtin_amdgcn_exp2f(dir ? cbi : cfi);
#pragma unroll
        for (int q = 0; q < 16; ++q) yacc[q] += sc * tacc[q];
    }
    bf16* yp = (bf16*)(KA->ws + WS_Y) + (size_t)(rowbase + ipos) * 256 + h * 64 + pb * 32;
#pragma unroll
    for (int q4 = 0; q4 < 4; ++q4) { v2u o; o.x = cvtpk(yacc[4 * q4], yacc[4 * q4 + 1]); o.y = cvtpk(yacc[4 * q4 + 2], yacc[4 * q4 + 3]); *(v2u*)(yp + 8 * q4 + 4 * h2) = o; }
    __syncthreads();
}
DI void ssd_outputs_phase(int l, bool last) {
    KArgs KA = kargs(); Frame F = mkframe();
    for (int it = blockIdx.x; it < 32 * 34; it += F.G) { if (last && (it % 34) < 2) continue; ssd_outputs(KA, F, l, it); }
}
DI void mixers_flash(int l, bool last) {
    KArgs KA = kargs(); Frame F = mkframe();
    const int nS = 32 * 34, nL = 1536, nC = last ? 0 : 96, nItems = nS + nL + nC;
    for (int it = blockIdx.x; it < nItems; it += F.G) {
        if (it < nS) { ssd_states(KA, F, l, it); continue; }
        int u = it - nS; bool cq = false;
        if (u >= nL) { u -= nL; cq = true; }
        const int ty = u % 3, un = u / 3;
        if (ty == 0) attn_unit<1>(KA, F, l, un, cq); else if (ty == 1) attn_unit<0>(KA, F, l, un, cq); else attn_unit<2>(KA, F, l, un, cq);
    }
}
DI void merge_pass(int l, int nrows) {
    KArgs KA = kargs(); Frame F = mkframe();
    const bf16* P = (const bf16*)(KA->ws + WS_ACT); const bf16* O = (const bf16*)(KA->ws + WS_O); const bf16* Y = (const bf16*)(KA->ws + WS_Y); const bf16* U = (const bf16*)(KA->ws + WS_U);
    bf16* A = (bf16*)(KA->ws + WS_A);
    const int hh = F.lane >> 4, cn = 4 * F.lane;
    const float dsk = KA->in[18][l * 4 + hh];
    v2u o0, o2, o3, yw, xw, zw;
#define MERGE_LOAD(r_) do { o0 = *(const v2u*)(O + (size_t)(r_) * DM + cn); o2 = *(const v2u*)(O + (size_t)(r_) * DM + 512 + cn); o3 = *(const v2u*)(O + (size_t)(r_) * DM + 768 + cn); \
        yw = *(const v2u*)(Y + (size_t)(r_) * 256 + cn); xw = *(const v2u*)(U + (size_t)(r_) * 768 + cn); zw = *(const v2u*)(P + (size_t)(r_) * NPJ + C_BZ + cn); } while (0)
    if (F.gw < nrows) MERGE_LOAD(F.gw);
    for (int row = F.gw; row < nrows; row += F.ngw) {
        f32x4 v[4];
        v[0] = (f32x4){bflo(o0.x), bfhi(o0.x), bflo(o0.y), bfhi(o0.y)}; v[2] = (f32x4){bflo(o2.x), bfhi(o2.x), bflo(o2.y), bfhi(o2.y)}; v[3] = (f32x4){bflo(o3.x), bfhi(o3.x), bflo(o3.y), bfhi(o3.y)};
        { const f32x4 yf = (f32x4){bflo(yw.x), bfhi(yw.x), bflo(yw.y), bfhi(yw.y)}, xs = (f32x4){bflo(xw.x), bfhi(xw.x), bflo(xw.y), bfhi(xw.y)}, z = (f32x4){bflo(zw.x), bfhi(zw.x), bflo(zw.y), bfhi(zw.y)};
          const f32x4 y = yf + xs * dsk; v[1] = (f32x4){y.x * silu(z.x), y.y * silu(z.y), y.z * silu(z.z), y.w * silu(z.w)}; }
        if (row + F.ngw < nrows) MERGE_LOAD(row + F.ngw);
#pragma unroll
        for (int j = 0; j < 4; ++j) { const int n = 4 * F.lane + 256 * j;
            const float ss = wave_sum((v[j].x * v[j].x + v[j].y * v[j].y) + (v[j].z * v[j].z + v[j].w * v[j].w));
            const float r = __builtin_amdgcn_rsqf(ss * (1.f / 256.f) + LN_EPS);
            const f32x4 a = v[j] * r * *(const f32x4*)(KA->in[12] + l * DM + n);
            v2u w; w.x = cvtpk(a.x, a.y); w.y = cvtpk(a.z, a.w); *(v2u*)(A + (size_t)row * DM + n) = w; }
    }
#undef MERGE_LOAD
}
constexpr size_t WS_CTL = 3 * MiB + 512 * 1024, CTL_BYTES = 16384;
constexpr int MISC_OFF = 139264;
#define XB_TMO      128
#define XB_XCNT(j)  (256  + 64 * (j))
#define XB_XSUB(j)  (1280 + 64 * (j))
#define XB_XGEN(j)  (2304 + 64 * (j))
#define XB_TOP      3328
#define XB_TOPGEN   3392
#define XCD_BAR_WORDS 3456
#define XB_SPIN_CAP (1u << 18)

__device__ __forceinline__ unsigned xb_ld(unsigned* p)              { return __hip_atomic_load(p, __ATOMIC_RELAXED, __HIP_MEMORY_SCOPE_AGENT); }
__device__ __forceinline__ unsigned xb_add(unsigned* p, unsigned v) { return __hip_atomic_fetch_add(p, v, __ATOMIC_RELAXED, __HIP_MEMORY_SCOPE_AGENT); }
__device__ __forceinline__ unsigned xb_xcc_id() { return (unsigned)__builtin_amdgcn_s_getreg((3 << 11) | 20) & 0xFu; }
#define XB_SPIN(cond, bar) do { unsigned _sp = 0; while (cond) { __builtin_amdgcn_s_sleep(1); \
    if ((++_sp & 255u) == 0u) { if (xb_ld(&(bar)[XB_TMO])) break; if (_sp > XB_SPIN_CAP) { atomicAdd(&(bar)[XB_TMO], 1u); break; } } } } while (0)

struct XcdBarrier {
    unsigned* bar; unsigned x;
    volatile LAS unsigned* st;
};

__device__ __forceinline__ XcdBarrier xcd_barrier_post(unsigned* bar, volatile LAS unsigned* st) {
    XcdBarrier b; b.bar = bar; b.x = xb_xcc_id(); b.st = st;
    if (threadIdx.x == 0) (void)xb_add(&bar[XB_XCNT(b.x)], 1u);
    return b;
}
__device__ __forceinline__ void xcd_barrier_complete(unsigned* bar, unsigned x, unsigned& nloc, unsigned& nx) {
    const unsigned G = gridDim.x * gridDim.y * gridDim.z;
    unsigned sum, cnt, mine, sp = 0u;
    for (;;) {
        sum = 0u; cnt = 0u; mine = 0u;
#pragma unroll
        for (unsigned j = 0; j < 16; ++j) { const unsigned c = xb_ld(&bar[XB_XCNT(j)]); sum += c; cnt += (c > 0u) ? 1u : 0u; mine = (j == x) ? c : mine; }
        if (sum == G) break;
        __builtin_amdgcn_s_sleep(1);
        if ((++sp & 255u) == 0u) { if (xb_ld(&bar[XB_TMO])) break; if (sp > XB_SPIN_CAP) { atomicAdd(&bar[XB_TMO], 1u); break; } }
    }
    nloc = mine > 0u ? mine : 1u; nx = cnt > 0u ? cnt : 1u;
}

__device__ __forceinline__ void xcd_barrier(const XcdBarrier& b) {
    asm volatile("s_waitcnt vmcnt(0)" ::: "memory");
    __syncthreads();
    if (threadIdx.x == 0) {
        unsigned* bar = b.bar;
        __builtin_amdgcn_s_waitcnt(0);
        unsigned nloc = b.st[0], nx = b.st[1];
        if (nloc == 0u) { xcd_barrier_complete(bar, b.x, nloc, nx); b.st[0] = nloc; b.st[1] = nx; }
        const unsigned old = xb_add(&bar[XB_XSUB(b.x)], 1u);
        const unsigned gen = old / nloc;
        if (old + 1u == (gen + 1u) * nloc) {
            __builtin_amdgcn_fence(__ATOMIC_RELEASE, "agent");
            asm volatile("s_waitcnt vmcnt(0)" ::: "memory");
            const unsigned og = xb_add(&bar[XB_TOP], 1u);
            const unsigned tg = og / nx;
            if (og + 1u == (tg + 1u) * nx) xb_add(&bar[XB_TOPGEN], 1u);
            else XB_SPIN(xb_ld(&bar[XB_TOPGEN]) == tg, bar);
            __builtin_amdgcn_fence(__ATOMIC_ACQUIRE, "agent");
            xb_add(&bar[XB_XGEN(b.x)], 1u);
            asm volatile("s_waitcnt vmcnt(0)" ::: "memory");
        } else {
            XB_SPIN(xb_ld(&bar[XB_XGEN(b.x)]) == gen, bar);
            __builtin_amdgcn_fence(__ATOMIC_ACQUIRE, "agent");
            asm volatile("s_waitcnt vmcnt(0)" ::: "memory");
        }
    }
    __syncthreads();
}

#define GRID_BAR() do { XcdBarrier b_; b_.bar = (unsigned*)(kargs()->ws + WS_CTL); b_.x = xb_xcc_id(); b_.st = (volatile LAS unsigned*)((LAS unsigned char*)lds + MISC_OFF); xcd_barrier(b_); } while (0)
#ifndef PROBE_GRP
#define PROBE_GRP 0
#endif
#define TIMED(grp, ...) do { unsigned long long t0_ = 0; if (PROBE_GRP == (grp)) t0_ = __builtin_amdgcn_s_memrealtime(); __VA_ARGS__; \
    if (PROBE_GRP == (grp) && blockIdx.x == 0) { const unsigned long long dt_ = __builtin_amdgcn_s_memrealtime() - t0_; const unsigned long long t1_ = __builtin_amdgcn_s_memrealtime(); \
        while (__builtin_amdgcn_s_memrealtime() - t1_ < 2 * dt_) __builtin_amdgcn_s_sleep(8); } } while (0)
__global__ void __launch_bounds__(NWAVES * 64, 2) mega_fwd(Args args) {
    extern __shared__ __attribute__((aligned(16))) unsigned char lds[];
    cg::grid_group grid = cg::this_grid();
    if (threadIdx.x < 2) ((volatile LAS unsigned*)((LAS unsigned char*)lds + MISC_OFF))[threadIdx.x] = 0u;
    __syncthreads();
    (void)xcd_barrier_post((unsigned*)(kargs()->ws + WS_CTL), (volatile LAS unsigned*)((LAS unsigned char*)lds + MISC_OFF));
    { LAS float* rc = (LAS float*)((LAS unsigned char*)lds + ROPE_OFF);
      for (int i = threadIdx.x; i < 1024; i += 512) { const int pos = i >> 4, fi = i & 15; const float inv = exp2f(-(float)fi * (13.287712379549449f / 16.f)); const float ang = (float)pos * inv; rc[i] = cosf(ang); rc[1024 + i] = sinf(ang); } }
    __syncthreads();

    if (args.ws == nullptr) grid.sync();
    p0a(); GRID_BAR(); p0b(); GRID_BAR(); p0c(); GRID_BAR();
    for (int l = 0; l < NL; ++l) {
        const bool last = (l == NL - 1); const int mrows = last ? NLAT : NROW;
        for (int s = 0; s < 3; ++s) {
            if (s != 1) {
                const bool second = (s == 2); const int rows = (second && last) ? NLAT : NROW;
                { KArgs KA = kargs(); pg8::Gemm g{((bf16*)(KA->ws + WS_A)), wbuf(KA, l, second ? WO_W1B : WO_W1A), rows, 2 * DFF, DM}; pg8::StaticOrder S; S.init(rows, 2 * DFF, (int)gridDim.x, (int)blockIdx.x); pg8::EpiSwiGLU E{((bf16*)(KA->ws + WS_ACT)), DFF};
                  pg8::gemm_phase<pg8::EpiSwiGLU, pg8::StaticOrder, true, GEMM_SP2>((LAS unsigned char*)lds, g, S, E); }
                GRID_BAR();
                { KArgs KA = kargs(); pg8::Gemm g{((bf16*)(KA->ws + WS_ACT)), wbuf(KA, l, second ? WO_W2B : WO_W2A), NLAT, DM, DFF}; pg8::StaticOrder S; S.init(NLAT, DM, (int)gridDim.x, (int)blockIdx.x); pg8::EpiBf16 E{((bf16*)(KA->ws + WS_O)), DM};
                  pg8::gemm_phase<pg8::EpiBf16, pg8::StaticOrder, true, GEMM_SP2>((LAS unsigned char*)lds, g, S, E); }
                GRID_BAR();
                const bool split = (rows == NROW);
                const int gidx = second ? 8 : 2, lnidx = second ? 2 : 0, nl = second ? l + 1 : l, nsh = second ? (last ? -1 : 0) : 3;
                if (split && blockIdx.x < 32) {
                    KArgs KA = kargs(); pg8::Gemm g{((bf16*)(KA->ws + WS_ACT)) + (size_t)NLAT * DFF, wbuf(KA, l, second ? WO_W2B : WO_W2A), NCTX, DM, DFF}; pg8::StaticOrder S; S.init(NCTX, DM, 32, (int)blockIdx.x);
                    pg8::EpiBf16 E{((bf16*)(KA->ws + WS_O)) + (size_t)NLAT * DM, DM};
                    pg8::gemm_phase<pg8::EpiBf16, pg8::StaticOrder, true, GEMM_SP2>((LAS unsigned char*)lds, g, S, E);
                } else ln_pass(l, gidx, 0.5f, lnidx, nl, nsh, 0, NLAT, split ? 32 : 0, split ? (int)gridDim.x - 32 : (int)gridDim.x, !second);
                if (split) { GRID_BAR(); ln_pass(l, gidx, 0.5f, lnidx, nl, nsh, NLAT, NROW, 0, (int)gridDim.x, !second); }
                if (!(second && last)) GRID_BAR();
            } else {
                { KArgs KA = kargs(); pg8::Gemm g{((bf16*)(KA->ws + WS_A)), wbuf(KA, l, WO_WIN), NROW, NPJ, DM}; pg8::StaticOrder S; S.init(NROW, NPJ, (int)gridDim.x, (int)blockIdx.x); pg8::EpiBf16 E{((bf16*)(KA->ws + WS_ACT)), NPJ};
                  pg8::gemm_phase<pg8::EpiBf16, pg8::StaticOrder, true, GEMM_SP2>((LAS unsigned char*)lds, g, S, E); }
                GRID_BAR();
                prep_pass(l); GRID_BAR();
                mixers_flash(l, last); GRID_BAR();
                ssd_scan(); GRID_BAR();
                ssd_outputs_phase(l, last); GRID_BAR();
                merge_pass(l, mrows); GRID_BAR();
                { KArgs KA = kargs(); pg8::Gemm g{((bf16*)(KA->ws + WS_A)), wbuf(KA, l, WO_WOUT), mrows, DM, DM}; pg8::StaticOrder S; S.init(mrows, DM, (int)gridDim.x, (int)blockIdx.x); pg8::EpiBf16 E{((bf16*)(KA->ws + WS_O)), DM};
                  pg8::gemm_phase<pg8::EpiBf16, pg8::StaticOrder, true, GEMM_SP2>((LAS unsigned char*)lds, g, S, E); }
                GRID_BAR();
                ln_pass(l, 5, 1.0f, 1, l, 6, 0, mrows, 0, (int)gridDim.x, false); GRID_BAR();
            }
        }
    }
}

extern "C" void kernel_launch(void* const* d_in, const int* in_sizes, int n_in, void* d_out, int out_size, void* d_ws, size_t ws_size, hipStream_t stream) {
    static int grid = 0;
    if (grid == 0) {
        if (n_in != 24 || out_size != NLAT * DM || ws_size < WS_END) { fprintf(stderr, "kernel_launch: unexpected shapes: n_in %d out %d ws %zu\n", n_in, out_size, ws_size); grid = -1; return; }
        int dev = 0, cus = 0, per_cu = 0;
        hipGetDevice(&dev); hipDeviceGetAttribute(&cus, hipDeviceAttributeMultiprocessorCount, dev);
        if (hipFuncSetAttribute((const void*)mega_fwd, hipFuncAttributeMaxDynamicSharedMemorySize, LDS_BYTES) != hipSuccess) { fprintf(stderr, "kernel_launch: hipFuncSetAttribute failed\n"); grid = -1; return; }
        if (hipOccupancyMaxActiveBlocksPerMultiprocessor(&per_cu, (const void*)mega_fwd, NWAVES * 64, LDS_BYTES) != hipSuccess || per_cu < 1) { fprintf(stderr, "kernel_launch: occupancy query says %d\n", per_cu); per_cu = 1; }
        (void)hipGetLastError();
        grid = cus;
    }
    if (grid < 0) return;
    if (hipMemsetAsync((char*)d_ws + WS_CTL, 0, CTL_BYTES, stream) != hipSuccess) { fprintf(stderr, "kernel_launch: memset of the barrier words failed\n"); return; }
    Args a{};
    for (int i = 0; i < 24; ++i) a.in[i] = (const float*)d_in[i];
    a.out = (float*)d_out; a.ws = (unsigned char*)d_ws;
    void* kargs[] = {&a};
    hipError_t e = hipLaunchCooperativeKernel((const void*)mega_fwd, dim3(grid), dim3(NWAVES * 64), kargs, LDS_BYTES, stream);
    if (e != hipSuccess) fprintf(stderr, "kernel_launch: cooperative launch failed: %s (grid %d)\n", hipGetErrorString(e), grid);
}
```

```cpp
#include <hip/hip_runtime.h>
#include <hip/hip_cooperative_groups.h>
#include <cstdio>
#include <cstdint>
namespace cg = cooperative_groups;
namespace pg8 {
#define PG8_LAS __attribute__((address_space(3)))
typedef unsigned short bf16_t;
typedef short bf16x8 __attribute__((ext_vector_type(8)));
typedef float f32x4 __attribute__((ext_vector_type(4)));
typedef unsigned u32x4 __attribute__((ext_vector_type(4)));
constexpr int BM = 256, BK = 64, HALF = 128, HTB = HALF * BK * 2  , STAGE_BYTES = 8 * HTB, NXCD = 8, WGM = 8;

__host__ __device__ __forceinline__ int lds_byte(int r, int c) { const int st = (r >> 4) * 2 + (c >> 5), rr = r & 15, cc = c & 31, ob = rr * 64 + cc * 2; return st * 1024 + (ob ^ (((ob >> 9) & 1) << 5)); }
__host__ __device__ __forceinline__ void stage_rc(int b, int& R, int& C) { const int st = b / 1024, sb = b % 1024, swz = sb ^ (((sb >> 9) & 1) << 5); R = (st >> 1) * 16 + swz / 64; C = (st & 1) * 32 + (swz % 64) / 2; }
__host__ __device__ __forceinline__ int perm32(int rho) { const int n = rho >> 4, i = rho & 15; return 8 * (i >> 2) + 4 * n + (i & 3); }

struct Unit { int pm, pn; };
struct Gemm { const bf16_t* A; const bf16_t* Bt; int M, N, K; };

struct StaticOrder {
    int nM, nN, nwg, G, c;
    __host__ __device__ void init(int M, int N, int G_, int c_) { nM = M / BM; nN = N / BM; nwg = nM * nN; G = G_; c = c_; }
    __host__ __device__ bool next(int i, Unit& u) const {
        const long L = (long)i * G + c; if (L >= nwg) return false;
        int wgid = (int)L; { const int q = nwg / NXCD, r = nwg % NXCD, xcd = wgid % NXCD, off = wgid / NXCD; wgid = (xcd < r ? xcd * (q + 1) : r * (q + 1) + (xcd - r) * q) + off; }
        const int nig = WGM * nN, gid = wgid / nig, fm = gid * WGM, gsz = (nM - fm) < WGM ? (nM - fm) : WGM;
        u.pm = fm + ((wgid % nig) % gsz); u.pn = (wgid % nig) / gsz; return true;
    }
    __device__ __forceinline__ void a_ready(const Unit&) const {}
    __device__ __forceinline__ void done(const Unit&) const {}
};

__device__ __forceinline__ unsigned cvt_pk_bf16(float lo, float hi) { unsigned r; asm volatile("v_cvt_pk_bf16_f32 %0, %1, %2" : "=v"(r) : "v"(lo), "v"(hi)); return r; }
struct EpiBf16 {
    static constexpr bool PERM = true, AFTER_DRAIN = false;
    bf16_t* O; int ldc;
    __device__ __forceinline__ void operator()(const f32x4 (&acc)[2][2][4][2], const Unit& u, int wr, int wc, int fr, int fq) const {
        const int row0 = u.pm * BM + wr * 64 + fr; const int col0 = u.pn * BM + wc * 32 + 8 * fq;
#pragma unroll
        for (int ai = 0; ai < 2; ++ai)
#pragma unroll
            for (int m = 0; m < 4; ++m) { bf16_t* rowp = O + (size_t)(row0 + ai * HALF + m * 16) * ldc + col0;
#pragma unroll
                for (int bj = 0; bj < 2; ++bj) { const f32x4 v0 = acc[ai][bj][m][0], v1 = acc[ai][bj][m][1];
                    u32x4 w; w.x = cvt_pk_bf16(v0[0], v0[1]); w.y = cvt_pk_bf16(v0[2], v0[3]); w.z = cvt_pk_bf16(v1[0], v1[1]); w.w = cvt_pk_bf16(v1[2], v1[3]);
                    *(u32x4*)(rowp + bj * HALF) = w; } }
    }
};
__device__ __forceinline__ float silu_f(float x) { return x * __builtin_amdgcn_rcpf(1.0f + __expf(-x)); }
struct EpiSwiGLU {
    static constexpr bool PERM = true, AFTER_DRAIN = false;
    bf16_t* O; int ldc;
    __device__ __forceinline__ void operator()(const f32x4 (&acc)[2][2][4][2], const Unit& u, int wr, int wc, int fr, int fq) const {
        const int row0 = u.pm * BM + wr * 64 + fr; const int col0 = u.pn * HALF + wc * 32 + 8 * fq;
#pragma unroll
        for (int ai = 0; ai < 2; ++ai)
#pragma unroll
            for (int m = 0; m < 4; ++m) { bf16_t* rowp = O + (size_t)(row0 + ai * HALF + m * 16) * ldc + col0;
                const f32x4 a0 = acc[ai][0][m][0], a1 = acc[ai][0][m][1], u0 = acc[ai][1][m][0], u1 = acc[ai][1][m][1];
                u32x4 w;
                w.x = cvt_pk_bf16(silu_f(a0[0]) * u0[0], silu_f(a0[1]) * u0[1]); w.y = cvt_pk_bf16(silu_f(a0[2]) * u0[2], silu_f(a0[3]) * u0[3]);
                w.z = cvt_pk_bf16(silu_f(a1[0]) * u1[0], silu_f(a1[1]) * u1[1]); w.w = cvt_pk_bf16(silu_f(a1[2]) * u1[2], silu_f(a1[3]) * u1[3]);
                *(u32x4*)rowp = w; }
    }
};
template <class Epi, class Sched, bool ALIGN_EPI = false, bool SP2 = false>
__device__ __forceinline__ void gemm_phase(PG8_LAS unsigned char* lds, const Gemm g, const Sched& S, const Epi& E) {
    int tid_l = threadIdx.x; asm volatile("" : "+v"(tid_l));
    const int tid = tid_l, wid = __builtin_amdgcn_readfirstlane(tid >> 6), lane = tid & 63, wr = wid >> 2, wc = wid & 3, fr = lane & 15, fq = lane >> 4;
    const int K = g.K, nt = K / BK;
    unsigned voffA[2], voffB[2];
#pragma unroll
    for (int i = 0; i < 2; ++i) { int R, C; stage_rc(tid * 16 + i * 8192, R, C); const int Rb = Epi::PERM ? ((R & ~31) + perm32(R & 31)) : R;
        voffA[i] = (unsigned)(R * K + C) * 2u; voffB[i] = (unsigned)(Rb * K + C) * 2u; }
    const size_t kstep = (size_t)(BK * 2);
    const size_t hstep = (size_t)HALF * K * 2;
    const size_t tstep = 2 * hstep;
    const unsigned ldsw = (unsigned)wid * 1024u;
    const int aoff = lds_byte(wr * 64 + fr, fq * 8), boff = lds_byte(wc * 32 + fr, fq * 8);
#define PG8_SA(b, h) (((b) * 2 + (h)) * HTB)
#define PG8_SB(b, h) ((4 + (b) * 2 + (h)) * HTB)
#define PG8_STAGE(bufoff, gbase, voff) do { _Pragma("unroll") for (int _i = 0; _i < 2; ++_i) \
        __builtin_amdgcn_global_load_lds((const unsigned*)((const char*)(gbase) + (voff)[_i]), (PG8_LAS unsigned*)(lds + (bufoff) + ldsw + _i * 8192), 16, 0, 0); } while (0)
#define PG8_LDA(dst, b, h) do { _Pragma("unroll") for (int m = 0; m < 4; ++m) _Pragma("unroll") for (int k = 0; k < 2; ++k) dst[m][k] = *(const PG8_LAS bf16x8*)(lds + PG8_SA(b, h) + aoff + m * 2048 + k * 1024); } while (0)
#define PG8_LDB(dst, b, h) do { _Pragma("unroll") for (int n = 0; n < 2; ++n) _Pragma("unroll") for (int k = 0; k < 2; ++k) dst[n][k] = *(const PG8_LAS bf16x8*)(lds + PG8_SB(b, h) + boff + n * 2048 + k * 1024); } while (0)
#define PG8_MMA(ai, bj, At, Bt) do { __builtin_amdgcn_s_setprio(1); _Pragma("unroll") for (int m = 0; m < 4; ++m) _Pragma("unroll") for (int n = 0; n < 2; ++n) _Pragma("unroll") for (int k = 0; k < 2; ++k) \
        acc[ai][bj][m][n] = __builtin_amdgcn_mfma_f32_16x16x32_bf16(Bt[n][k], At[m][k], acc[ai][bj][m][n], 0, 0, 0); __builtin_amdgcn_s_setprio(0); } while (0)
#define PG8_WAIT_V(n) asm volatile("s_waitcnt vmcnt(" #n ")" ::: "memory")
#define PG8_WAIT_L(n) asm volatile("s_waitcnt lgkmcnt(" #n ")" ::: "memory")
#define PG8_BAR __builtin_amdgcn_s_barrier()
#define PG8_SCHED __builtin_amdgcn_sched_barrier(0)
    Unit cur, nxt; int ui = 0;
    if (!S.next(0, cur)) return;
    f32x4 acc[2][2][4][2];
#pragma unroll
    for (int a = 0; a < 2; ++a)
#pragma unroll
        for (int b = 0; b < 2; ++b)
#pragma unroll
            for (int m = 0; m < 4; ++m)
#pragma unroll
                for (int n = 0; n < 2; ++n) acc[a][b][m][n] = (f32x4){0.f, 0.f, 0.f, 0.f};
    bf16x8 At[4][2], B0[2][2], B1[2][2];
    const char* cA = (const char*)g.A + (size_t)cur.pm * tstep; const char* cB = (const char*)g.Bt + (size_t)cur.pn * tstep;
    S.a_ready(cur);
    if constexpr (SP2) {
        PG8_STAGE(PG8_SB(0, 0), cB, voffB); PG8_STAGE(PG8_SB(0, 1), cB + hstep, voffB); PG8_STAGE(PG8_SA(0, 0), cA, voffA); PG8_STAGE(PG8_SA(0, 1), cA + hstep, voffA);
        if (wr == 1) PG8_BAR;
        PG8_WAIT_V(2); PG8_BAR;
        PG8_STAGE(PG8_SB(1, 0), cB + kstep, voffB); PG8_STAGE(PG8_SA(1, 0), cA + kstep, voffA); PG8_STAGE(PG8_SB(1, 1), cB + hstep + kstep, voffB);
        PG8_WAIT_V(6); PG8_BAR;
    } else {
        PG8_STAGE(PG8_SB(0, 0), cB, voffB); PG8_STAGE(PG8_SA(0, 0), cA, voffA); PG8_STAGE(PG8_SB(0, 1), cB + hstep, voffB); PG8_STAGE(PG8_SA(0, 1), cA + hstep, voffA);
        if (wr == 1) PG8_BAR;
        PG8_WAIT_V(4); PG8_BAR;
        PG8_STAGE(PG8_SB(1, 0), cB + kstep, voffB); PG8_STAGE(PG8_SA(1, 0), cA + kstep, voffA); PG8_STAGE(PG8_SB(1, 1), cB + hstep + kstep, voffB);
        PG8_WAIT_V(6); PG8_BAR;
    }
    for (;;) {
        const bool has_next = S.next(ui + 1, nxt);
        const char* nA = has_next ? (const char*)g.A + (size_t)nxt.pm * tstep : cA; const char* nB = has_next ? (const char*)g.Bt + (size_t)nxt.pn * tstep : cB;
        for (int t = 0; t < nt; t += 2) {
            const bool last = (t == nt - 2);
            const char* a1 = cA + (size_t)(t + 1) * kstep;
            const char* a2 = last ? nA : cA + (size_t)(t + 2) * kstep; const char* b2 = last ? nB : cB + (size_t)(t + 2) * kstep;
            const char* a3 = a2 + kstep; const char* b3 = b2 + kstep;
            if (last && has_next) S.a_ready(nxt);
            if constexpr (SP2) {
            PG8_LDB(B0, 0, 0); PG8_LDB(B1, 0, 1); PG8_SCHED; PG8_LDA(At, 0, 0); PG8_STAGE(PG8_SA(1, 1), a1 + hstep, voffA);
            PG8_WAIT_V(8); PG8_WAIT_L(0); PG8_BAR; PG8_MMA(0, 0, At, B0); PG8_MMA(0, 1, At, B1); PG8_BAR; PG8_SCHED;
            PG8_LDA(At, 0, 1); PG8_STAGE(PG8_SB(0, 0), b2, voffB); PG8_STAGE(PG8_SB(0, 1), b2 + hstep, voffB); PG8_STAGE(PG8_SA(0, 0), a2, voffA);
            PG8_WAIT_V(8); PG8_WAIT_L(0); PG8_BAR; PG8_MMA(1, 0, At, B0); PG8_MMA(1, 1, At, B1); PG8_BAR; PG8_SCHED;
            PG8_LDB(B0, 1, 0); PG8_LDB(B1, 1, 1); PG8_SCHED; PG8_LDA(At, 1, 0); PG8_STAGE(PG8_SA(0, 1), a2 + hstep, voffA);
            PG8_WAIT_V(8); PG8_WAIT_L(0); PG8_BAR; PG8_MMA(0, 0, At, B0); PG8_MMA(0, 1, At, B1); PG8_BAR; PG8_SCHED;
            PG8_LDA(At, 1, 1); PG8_STAGE(PG8_SB(1, 0), b3, voffB); PG8_STAGE(PG8_SB(1, 1), b3 + hstep, voffB); PG8_STAGE(PG8_SA(1, 0), a3, voffA);
            PG8_WAIT_V(8); PG8_WAIT_L(0); PG8_BAR; PG8_MMA(1, 0, At, B0); PG8_MMA(1, 1, At, B1); PG8_BAR; PG8_SCHED;
            } else {
            PG8_LDB(B0, 0, 0); PG8_SCHED; PG8_LDA(At, 0, 0); PG8_STAGE(PG8_SA(1, 1), a1 + hstep, voffA);
            PG8_WAIT_L(8); PG8_BAR; PG8_WAIT_L(0); PG8_MMA(0, 0, At, B0); PG8_BAR; PG8_SCHED;
            PG8_LDB(B1, 0, 1); PG8_STAGE(PG8_SB(0, 0), b2, voffB);
            PG8_BAR; PG8_WAIT_L(0); PG8_MMA(0, 1, At, B1); PG8_BAR;
            PG8_LDA(At, 0, 1); PG8_STAGE(PG8_SA(0, 0), a2, voffA);
            PG8_BAR; PG8_WAIT_L(0); PG8_MMA(1, 0, At, B0); PG8_BAR; PG8_SCHED;
            PG8_STAGE(PG8_SB(0, 1), b2 + hstep, voffB);
            PG8_WAIT_V(6); PG8_BAR; PG8_MMA(1, 1, At, B1); PG8_BAR;
            PG8_LDB(B0, 1, 0); PG8_SCHED; PG8_LDA(At, 1, 0); PG8_STAGE(PG8_SA(0, 1), a2 + hstep, voffA);
            PG8_WAIT_L(8); PG8_BAR; PG8_WAIT_L(0); PG8_MMA(0, 0, At, B0); PG8_BAR; PG8_SCHED;
            PG8_LDB(B1, 1, 1); PG8_STAGE(PG8_SB(1, 0), b3, voffB);
            PG8_BAR; PG8_WAIT_L(0); PG8_MMA(0, 1, At, B1); PG8_BAR;
            PG8_LDA(At, 1, 1); PG8_STAGE(PG8_SA(1, 0), a3, voffA);
            PG8_BAR; PG8_WAIT_L(0); PG8_MMA(1, 0, At, B0); PG8_BAR; PG8_SCHED;
            PG8_STAGE(PG8_SB(1, 1), b3 + hstep, voffB);
            PG8_WAIT_V(6); PG8_BAR; PG8_MMA(1, 1, At, B1); PG8_BAR;
            }
        }
        if constexpr (ALIGN_EPI) { if (wr == 0) PG8_BAR; }
        if constexpr (!Epi::AFTER_DRAIN) { E(acc, cur, wr, wc, fr, fq); S.done(cur); }
        if (!has_next) break;
#pragma unroll
        for (int a = 0; a < 2; ++a)
#pragma unroll
            for (int b = 0; b < 2; ++b)
#pragma unroll
                for (int m = 0; m < 4; ++m)
#pragma unroll
                    for (int n = 0; n < 2; ++n) acc[a][b][m][n] = (f32x4){0.f, 0.f, 0.f, 0.f};
        cur = nxt; cA = nA; cB = nB; ++ui;
        if constexpr (ALIGN_EPI) { if (wr == 1) PG8_BAR; }
    }
    PG8_WAIT_V(0);
    if constexpr (!ALIGN_EPI) { if (wr == 0) PG8_BAR; }
    PG8_BAR;
    if constexpr (Epi::AFTER_DRAIN) { E.fused(acc, cur, wr, wc, fr, fq, lds, wid, lane); S.done(cur); }
#undef PG8_SA
#undef PG8_SB
#undef PG8_STAGE
#undef PG8_LDA
#undef PG8_LDB
#undef PG8_MMA
#undef PG8_WAIT_V
#undef PG8_WAIT_L
#undef PG8_BAR
#undef PG8_SCHED
}
}

constexpr int NB = 8, SEQ = 4096, DM = 1024, NL = 2, CTXL = 256;
constexpr int NLAT = NB * SEQ, NCTX = NB * CTXL, NROW = NLAT + NCTX;
constexpr int DFF = 2816, NPJ = 2816, INW = 2824, NMODW = 9 * DM;
constexpr float LN_EPS = 1e-5f, ALPHA = 1.41421356237f;
constexpr int C_AQ = 0, C_AK = 256, C_AV = 384, C_BZ = 512, C_BX = 768, C_CQ = 1536, C_CK = 1792, C_CV = 1920, C_DQ = 2048, C_DK = 2304, C_DV = 2560;
constexpr int C_DTSRC = 1536;
constexpr size_t MiB = 1u << 20;
constexpr size_t WS_MOD = 0;
constexpr size_t WS_DT = 1 * MiB;
constexpr size_t WS_W = 4 * MiB, WS_WL = 41 * MiB;
constexpr size_t WO_W1A = 0, WO_W2A = 11 * MiB, WO_WIN = 16 * MiB + MiB / 2, WO_WOUT = 22 * MiB, WO_W1B = 24 * MiB, WO_W2B = 35 * MiB;
constexpr size_t WS_A = 86 * MiB;
constexpr size_t WS_ACT = 154 * MiB;
constexpr size_t WS_U = 341 * MiB;
constexpr size_t WS_O = 392 * MiB;
constexpr size_t WS_XC = 460 * MiB;
constexpr size_t WS_Y = 468 * MiB;
constexpr size_t WS_END = 512 * MiB;
constexpr int RING_BYTES = 131072, ROPE_OFF = RING_BYTES, LDS_BYTES = 147456;
constexpr int NWAVES = 8;
constexpr bool GEMM_SP2 = true;

#define LAS __attribute__((address_space(3)))
#define DI __device__ __forceinline__
typedef unsigned short bf16;
typedef unsigned v4u __attribute__((ext_vector_type(4)));
typedef unsigned v2u __attribute__((ext_vector_type(2)));
typedef float f32x4 __attribute__((ext_vector_type(4)));

DI float bf2f(unsigned b) { return __uint_as_float(b << 16); }
DI float bflo(unsigned w) { return __uint_as_float(w << 16); }
DI float bfhi(unsigned w) { return __uint_as_float(w & 0xffff0000u); }
DI unsigned f2bf(float f) { unsigned u = __float_as_uint(f); return (u + 0x7fffu + ((u >> 16) & 1u)) >> 16; }
DI unsigned pk2(float lo, float hi) { return f2bf(lo) | (f2bf(hi) << 16); }
typedef float f32x2_t __attribute__((ext_vector_type(2))); typedef __bf16 bf16x2_t __attribute__((ext_vector_type(2)));
DI unsigned cvtpk(float lo, float hi) { f32x2_t v = {lo, hi}; bf16x2_t b = __builtin_convertvector(v, bf16x2_t); return __builtin_bit_cast(unsigned, b); }
DI float dpp_f(float v, const int ctrl_unused) { return v; }
#define DPP_ADD(v_, ctrl_) ((v_) + __builtin_bit_cast(float, __builtin_amdgcn_update_dpp(0, __builtin_bit_cast(int, (v_)), (ctrl_), 0xf, 0xf, false)))
DI float wave_sum(float v) {
    v = DPP_ADD(v, 0xB1);
    v = DPP_ADD(v, 0x4E);
    v = DPP_ADD(v, 0x141);
    v = DPP_ADD(v, 0x140);
    const int vi = __builtin_bit_cast(int, v);
    const float r0 = __builtin_bit_cast(float, __builtin_amdgcn_readlane(vi, 0)), r1 = __builtin_bit_cast(float, __builtin_amdgcn_readlane(vi, 16));
    const float r2 = __builtin_bit_cast(float, __builtin_amdgcn_readlane(vi, 32)), r3 = __builtin_bit_cast(float, __builtin_amdgcn_readlane(vi, 48));
    return (r0 + r1) + (r2 + r3);
}
DI float silu(float x) { return x * __builtin_amdgcn_rcpf(1.0f + __expf(-x)); }

struct Args { const float* in[24]; float* out; unsigned char* ws; };
typedef const __attribute__((address_space(4))) Args* KArgs;
DI KArgs kargs() { KArgs p = (KArgs)__builtin_amdgcn_kernarg_segment_ptr(); asm volatile("" : "+s"(p)); return p; }

struct Frame {
    LAS unsigned char* lds;
    int tid, lane, wave, G, gw, ngw;
};
DI Frame mkframe() { Frame F; extern __shared__ __attribute__((aligned(16))) unsigned char lds_base[]; F.lds = (LAS unsigned char*)lds_base;
    int t = threadIdx.x; asm volatile("" : "+v"(t)); F.tid = t; F.lane = t & 63; F.wave = __builtin_amdgcn_readfirstlane(t >> 6);
    F.G = gridDim.x; F.gw = blockIdx.x * NWAVES + F.wave; F.ngw = F.G * NWAVES; return F; }
DI bf16* wbuf(KArgs KA, int l, size_t off) { return (bf16*)((KA->ws) + WS_W + (size_t)l * WS_WL + off); }

DI void transpose_item(const float* W, int ldw, int k0, int n0, bf16* WT, int ldt, int drow0, LAS float* scr, int lane) {
    float tv[32];
#pragma unroll
    for (int i = 0; i < 32; ++i) tv[i] = W[(size_t)(k0 + 2 * i + (lane >> 5)) * ldw + n0 + (lane & 31)];
#pragma unroll
    for (int i = 0; i < 32; ++i) scr[(2 * i + (lane >> 5)) * 33 + (lane & 31)] = tv[i];
    asm volatile("s_waitcnt lgkmcnt(0)" ::: "memory");
    const int c = lane & 7;
#pragma unroll
    for (int j = 0; j < 4; ++j) { const int n = (lane >> 3) + 8 * j; const LAS float* s = scr + (8 * c) * 33 + n;
        v4u o; o.x = pk2(s[0 * 33], s[1 * 33]); o.y = pk2(s[2 * 33], s[3 * 33]); o.z = pk2(s[4 * 33], s[5 * 33]); o.w = pk2(s[6 * 33], s[7 * 33]);
        *(v4u*)(WT + (size_t)(drow0 + n) * ldt + k0 + 8 * c) = o; }
    asm volatile("s_waitcnt lgkmcnt(0)" ::: "memory");
}
DI void p0a() {
    KArgs KA = kargs(); Frame F = mkframe();
    {
        LAS float* sv = (LAS float*)F.lds;
        for (int it = blockIdx.x; it < NL * 16 * 9; it += F.G) {
            const int l = it / 144, kc = (it % 144) / 9, cb = it % 9;
            __syncthreads();
            for (int i = F.tid; i < 576; i += 512) { const int r = i >> 6, kk = i & 63; const float v = r < 8 ? KA->in[1][r * DM + kc * 64 + kk] : KA->in[3][kc * 64 + kk]; sv[i] = silu(v); }
            __syncthreads();
            const int cg4 = F.tid & 255, kh = F.tid >> 8, col = cb * 1024 + 4 * cg4;
            f32x4 acc[9];
#pragma unroll
            for (int r = 0; r < 9; ++r) acc[r] = (f32x4){0.f, 0.f, 0.f, 0.f};
            const float* wp = KA->in[4] + ((size_t)l * DM + kc * 64 + kh * 32) * NMODW + col;
#pragma unroll 8
            for (int kk = 0; kk < 32; ++kk) { const f32x4 w = *(const f32x4*)(wp + (size_t)kk * NMODW);
#pragma unroll
                for (int r = 0; r < 9; ++r) acc[r] += w * sv[r * 64 + kh * 32 + kk]; }
#pragma unroll
            for (int r = 0; r < 9; ++r) *(f32x4*)(((float*)(KA->ws + WS_ACT)) + ((size_t)(l * 32 + kc * 2 + kh) * 9 + r) * NMODW + col) = acc[r];
        }
        __syncthreads();
    }
    LAS float* scr = (LAS float*)(F.lds + F.wave * 16384);
    constexpr int I1 = 16 * 176, I2 = 44 * 32, I3 = 16 * 88, I4 = 16 * 32, IL = 2 * I1 + 2 * I2 + I3 + I4;
    for (int it = F.gw; it < NL * IL; it += F.ngw) {
        const int l = it / IL; int r = it % IL;
        if (r < I1 || (r >= I1 + I2 + I3 + I4 && r < 2 * I1 + I2 + I3 + I4)) {
            const bool second = r >= I1; if (second) r -= I1 + I2 + I3 + I4;
            const int kb = r / 176, nb = r % 176, n0 = nb * 32;
            const int drow = n0 < DFF ? 256 * (n0 >> 7) + (n0 & 127) : 256 * ((n0 - DFF) >> 7) + 128 + ((n0 - DFF) & 127);
            transpose_item((second ? KA->in[22] : KA->in[8]) + (size_t)l * DM * 2 * DFF, 2 * DFF, kb * 64, n0, wbuf(KA, l, second ? WO_W1B : WO_W1A), DM, drow, scr, F.lane);
            continue; }
        r -= I1;
        if (r < I2) { const int kb = r / 32, nb = r % 32; transpose_item(KA->in[9] + (size_t)l * DFF * DM, DM, kb * 64, nb * 32, wbuf(KA, l, WO_W2A), DFF, nb * 32, scr, F.lane); continue; }
        r -= I2;
        if (r < I3) { const int kb = r / 88, nb = r % 88; const int n0 = nb < 48 ? nb * 32 : 1544 + (nb - 48) * 32;
            transpose_item(KA->in[10] + (size_t)l * DM * INW, INW, kb * 64, n0, wbuf(KA, l, WO_WIN), DM, nb * 32, scr, F.lane); continue; }
        r -= I3;
        if (r < I4) { const int kb = r / 32, nb = r % 32; transpose_item(KA->in[11] + (size_t)l * DM * DM, DM, kb * 64, nb * 32, wbuf(KA, l, WO_WOUT), DM, nb * 32, scr, F.lane); continue; }
        r -= I4 + I1;
        { const int kb = r / 32, nb = r % 32; transpose_item(KA->in[23] + (size_t)l * DFF * DM, DM, kb * 64, nb * 32, wbuf(KA, l, WO_W2B), DFF, nb * 32, scr, F.lane); }
    }
}
DI void p0b() {
    KArgs KA = kargs(); Frame F = mkframe();
    for (int i = blockIdx.x * 512 + F.tid; i < NL * 9 * NMODW; i += F.G * 512) {
        const int l = i / (9 * NMODW), rr = (i / NMODW) % 9, n = i % NMODW;
        float s = KA->in[5][l * NMODW + n];
        for (int p = 0; p < 32; ++p) s += ((float*)(KA->ws + WS_ACT))[((size_t)(l * 32 + p) * 9 + rr) * NMODW + n];
        ((float*)(KA->ws + WS_MOD))[i] = s;
    }
}
DI const float* modp(KArgs KA, int l, int mb, int idx) { return ((float*)(KA->ws + WS_MOD)) + ((size_t)(l * 9 + mb) * 9 + idx) * DM; }
DI void p0c() {
    KArgs KA = kargs(); Frame F = mkframe();
    for (int row = F.gw; row < NROW; row += F.ngw) {
        const int mb = row < NLAT ? (row >> 12) : 8;
        const float* src = row < NLAT ? KA->in[0] + (size_t)row * DM : KA->in[2] + (size_t)(row - NLAT) * DM;
        const float* sh = modp(KA, 0, mb, 0); const float* sc = modp(KA, 0, mb, 1);
#pragma unroll
        for (int j = 0; j < 4; ++j) { const int n = 4 * F.lane + 256 * j; const f32x4 v = *(const f32x4*)(src + n);
            const f32x4 a = v * (1.0f + *(const f32x4*)(sc + n)) + *(const f32x4*)(sh + n);
            v2u w; w.x = pk2(a.x, a.y); w.y = pk2(a.z, a.w); *(v2u*)(((bf16*)(KA->ws + WS_A)) + (size_t)row * DM + n) = w; }
    }
}
DI void ln_pass(int l, int gidx, float gmul, int lnidx, int nl, int nsh, int row0, int nrows, int wg0, int nwgs, const bool DTP) {
    KArgs KA = kargs(); Frame F = mkframe();
    F.gw = row0 + ((int)blockIdx.x - wg0) * NWAVES + F.wave; F.ngw = nwgs * NWAVES;
    LAS float* wdt = (LAS float*)F.lds;
    if (DTP) { __syncthreads(); for (int i = F.tid; i < 8192; i += 512) wdt[i] = KA->in[10][((size_t)l * DM + (i >> 3)) * INW + C_DTSRC + (i & 7)]; __syncthreads(); }
    const float* g = KA->in[6] + (l * 3 + lnidx) * DM; const float* bb = KA->in[7] + (l * 3 + lnidx) * DM;
    float* const xlat = KA->out; float* const xctx = (float*)(KA->ws + WS_XC); const bf16* const fbase = (const bf16*)(KA->ws + WS_O);
    const bool fromin = (l == 0 && lnidx == 0);
    const float* const slat = fromin ? KA->in[0] : (const float*)xlat; const float* const sctx = fromin ? KA->in[2] : (const float*)xctx;
    f32x4 xn[4]; v2u fn[4];
    if (F.gw < nrows) { const int row = F.gw; const float* xr = row < NLAT ? slat + (size_t)row * DM : sctx + (size_t)(row - NLAT) * DM;
#pragma unroll
        for (int j = 0; j < 4; ++j) { const int n = 4 * F.lane + 256 * j; xn[j] = *(const f32x4*)(xr + n); fn[j] = *(const v2u*)(fbase + (size_t)row * DM + n); } }
    for (int row = F.gw; row < nrows; row += F.ngw) {
        const int mb = row < NLAT ? (row >> 12) : 8;
        float* xrow = row < NLAT ? xlat + (size_t)row * DM : xctx + (size_t)(row - NLAT) * DM;
        const float* gate = modp(KA, l, mb, gidx);
        f32x4 v[4]; float s = 0.f;
#pragma unroll
        for (int j = 0; j < 4; ++j) { const int n = 4 * F.lane + 256 * j; const f32x4 gt = *(const f32x4*)(gate + n);
            const f32x4 fv = (f32x4){bflo(fn[j].x), bfhi(fn[j].x), bflo(fn[j].y), bfhi(fn[j].y)};
            v[j] = xn[j] * ALPHA + gt * fv * gmul; s += (v[j].x + v[j].y) + (v[j].z + v[j].w); }
        { const int nrow = row + F.ngw;
          if (nrow < nrows) { const float* xr = nrow < NLAT ? slat + (size_t)nrow * DM : sctx + (size_t)(nrow - NLAT) * DM;
#pragma unroll
            for (int j = 0; j < 4; ++j) { const int n = 4 * F.lane + 256 * j; xn[j] = *(const f32x4*)(xr + n); fn[j] = *(const v2u*)(fbase + (size_t)nrow * DM + n); } } }
        const float mean = wave_sum(s) * (1.f / DM); float s2 = 0.f;
#pragma unroll
        for (int j = 0; j < 4; ++j) { v[j] = v[j] - mean; s2 += (v[j].x * v[j].x + v[j].y * v[j].y) + (v[j].z * v[j].z + v[j].w * v[j].w); }
        const float rstd = __builtin_amdgcn_rsqf(wave_sum(s2) * (1.f / DM) + LN_EPS);
        float dt[8];
#pragma unroll
        for (int q = 0; q < 8; ++q) dt[q] = 0.f;
#pragma unroll
        for (int j = 0; j < 4; ++j) { const int n = 4 * F.lane + 256 * j;
            const f32x4 y = v[j] * rstd * *(const f32x4*)(g + n) + *(const f32x4*)(bb + n);
            *(f32x4*)(xrow + n) = y;
            if (nsh >= 0) { const f32x4 a = y * (1.0f + *(const f32x4*)(modp(KA, nl, mb, nsh + 1) + n)) + *(const f32x4*)(modp(KA, nl, mb, nsh) + n);
                v2u w; w.x = cvtpk(a.x, a.y); w.y = cvtpk(a.z, a.w); *(v2u*)(((bf16*)(KA->ws + WS_A)) + (size_t)row * DM + n) = w;
                if (DTP) {
#pragma unroll
                    for (int e = 0; e < 4; ++e) { const f32x4 w0 = *(const LAS f32x4*)(wdt + (n + e) * 8), w1 = *(const LAS f32x4*)(wdt + (n + e) * 8 + 4); const float ae = a[e];
                        dt[0] += ae * w0.x; dt[1] += ae * w0.y; dt[2] += ae * w0.z; dt[3] += ae * w0.w; dt[4] += ae * w1.x; dt[5] += ae * w1.y; dt[6] += ae * w1.z; dt[7] += ae * w1.w; } } }
        }
        if (DTP) {
#pragma unroll
            for (int q = 0; q < 8; ++q) dt[q] = wave_sum(dt[q]);
            if (F.lane == 0) { *(f32x4*)(((float*)(KA->ws + WS_DT)) + (size_t)row * 8) = (f32x4){dt[0], dt[1], dt[2], dt[3]}; *(f32x4*)(((float*)(KA->ws + WS_DT)) + (size_t)row * 8 + 4) = (f32x4){dt[4], dt[5], dt[6], dt[7]}; }
        }
    }
}
DI void prep_pass(int l) {
    KArgs KA = kargs(); Frame F = mkframe();
    const LAS float* rc = (const LAS float*)(F.lds + ROPE_OFF); const LAS float* rsn = rc + 1024;
    bf16* P = (bf16*)(KA->ws + WS_ACT); bf16* U = (bf16*)(KA->ws + WS_U); float* DTB = (float*)(KA->ws + WS_DT);
    const int hv = F.lane >> 5, s = F.lane & 31, hsub = s >> 3, ra = (s >> 2) & 1, ig = s & 3, d1 = ra * 32 + 4 * ig, d2 = d1 + 16;
    constexpr int NBLK = NROW / 8;
    for (int item = F.gw; item < 4 * NBLK; item += F.ngw) {
        const int part = item / NBLK, rb = item - part * NBLK;
        const int row8 = rb * 8; const bool lat = row8 < NLAT;
        if (part == 0) {
#pragma unroll
        for (int rr = 0; rr < 4; ++rr) {
            const int row = row8 + 2 * rr + hv; const int t = row & 4095;
            const int pos = ra == 0 ? (t >> 6) : (t & 63);
            const f32x4 cs = *(const LAS f32x4*)(rc + pos * 16 + 4 * ig), sn = *(const LAS f32x4*)(rsn + pos * 16 + 4 * ig);
            bf16* pr = P + (size_t)row * NPJ;
#pragma unroll
            for (int it = 0; it < 3; ++it) {
                const int hh = it * 4 + hsub;
                const bool isc = hh >= 6; const int h6 = isc ? hh - 6 : hh;
                const int col = (isc ? (h6 < 4 ? C_CQ + h6 * 64 : C_CK + (h6 - 4) * 64) : (h6 < 4 ? C_AQ + h6 * 64 : C_AK + (h6 - 4) * 64));
                const v2u w1 = *(const v2u*)(pr + col + d1), w2 = *(const v2u*)(pr + col + d2);
                f32x4 x1 = (f32x4){bflo(w1.x), bfhi(w1.x), bflo(w1.y), bfhi(w1.y)}, x2 = (f32x4){bflo(w2.x), bfhi(w2.x), bflo(w2.y), bfhi(w2.y)};
                float ss = (x1.x * x1.x + x1.y * x1.y) + (x1.z * x1.z + x1.w * x1.w) + (x2.x * x2.x + x2.y * x2.y) + (x2.z * x2.z + x2.w * x2.w);
                ss += __shfl_xor(ss, 1); ss += __shfl_xor(ss, 2); ss += __shfl_xor(ss, 4);
                if (isc) { const float r = (h6 < 4 ? 0.125f * 1.4426950408889634f : 1.0f) * __builtin_amdgcn_rsqf(ss * (1.f / 64.f) + LN_EPS); const float* gn = (h6 < 4 ? KA->in[19] : KA->in[20]) + l * 64;
                    x1 = x1 * r * *(const f32x4*)(gn + d1); x2 = x2 * r * *(const f32x4*)(gn + d2); }
                if (lat) { const f32x4 y1 = x1 * cs - x2 * sn, y2 = x1 * sn + x2 * cs; x1 = y1; x2 = y2; }
                if (isc || lat) { v2u o1, o2; o1.x = cvtpk(x1.x, x1.y); o1.y = cvtpk(x1.z, x1.w); o2.x = cvtpk(x2.x, x2.y); o2.y = cvtpk(x2.z, x2.w);
                    *(v2u*)(pr + col + d1) = o1; *(v2u*)(pr + col + d2) = o2; }
            }
        }
        { const int row = row8 + (F.lane >> 3), q = F.lane & 7; const float v = DTB[(size_t)row * 8 + q] + KA->in[16][l * 8 + q]; DTB[(size_t)row * 8 + q] = fmaxf(v, 0.f) + log1pf(__expf(-fabsf(v))); }
        } else {
        const int Ls = lat ? SEQ : CTXL; const int tt0 = lat ? (row8 & 4095) : ((row8 - NLAT) & 255);
        { const int j = part - 1; const int ch = 4 * F.lane + 256 * j;
            const f32x4 bias = *(const f32x4*)(KA->in[15] + l * 768 + ch);
            f32x4 cw[5];
#pragma unroll
            for (int k = 0; k < 5; ++k) cw[k] = *(const f32x4*)(KA->in[14] + (l * 5 + k) * 768 + ch);
            f32x4 xw[12];
#pragma unroll
            for (int q = 0; q < 12; ++q) { const int t2 = tt0 + q - 2;
                if (t2 >= 0 && t2 < Ls) { const v2u w = *(const v2u*)(P + (size_t)(row8 + q - 2) * NPJ + C_BX + ch); xw[q] = (f32x4){bflo(w.x), bfhi(w.x), bflo(w.y), bfhi(w.y)}; }
                else xw[q] = (f32x4){0.f, 0.f, 0.f, 0.f}; }
#pragma unroll
            for (int q = 0; q < 8; ++q) { f32x4 acc = bias;
#pragma unroll
                for (int k = 0; k < 5; ++k) acc += cw[k] * xw[q + k];
                v2u o; o.x = cvtpk(silu(acc.x), silu(acc.y)); o.y = cvtpk(silu(acc.z), silu(acc.w)); *(v2u*)(U + (size_t)(row8 + q) * 768 + ch) = o; }
        }
        }
    }
}
DI void nkey(const float (&q)[64], float (&o)[64], float& m, float& l, const bf16* kr, const bf16* vr, float bias) {
    float s = bias;
#pragma unroll
    for (int c = 0; c < 8; ++c) { const v4u w = *(const v4u*)(kr + 8 * c);
        s += q[8 * c] * bflo(w.x) + q[8 * c + 1] * bfhi(w.x) + q[8 * c + 2] * bflo(w.y) + q[8 * c + 3] * bfhi(w.y) + q[8 * c + 4] * bflo(w.z) + q[8 * c + 5] * bfhi(w.z) + q[8 * c + 6] * bflo(w.w) + q[8 * c + 7] * bfhi(w.w); }
    const float mn = fmaxf(m, s), cf = __expf(m - mn), p = __expf(s - mn);
    l = l * cf + p; m = mn;
#pragma unroll
    for (int c = 0; c < 8; ++c) { const v4u w = *(const v4u*)(vr + 8 * c);
        o[8 * c] = o[8 * c] * cf + p * bflo(w.x); o[8 * c + 1] = o[8 * c + 1] * cf + p * bfhi(w.x); o[8 * c + 2] = o[8 * c + 2] * cf + p * bflo(w.y); o[8 * c + 3] = o[8 * c + 3] * cf + p * bfhi(w.y);
        o[8 * c + 4] = o[8 * c + 4] * cf + p * bflo(w.z); o[8 * c + 5] = o[8 * c + 5] * cf + p * bfhi(w.z); o[8 * c + 6] = o[8 * c + 6] * cf + p * bflo(w.w); o[8 * c + 7] = o[8 * c + 7] * cf + p * bfhi(w.w); }
}
template <int TYPE>
DI void naive_attn(int l, int row, int h, bool ctxq) {
    KArgs KA = kargs(); Frame F = mkframe();
    const bf16* P = ((bf16*)(KA->ws + WS_ACT));
    const int qcol = (TYPE == 0 ? C_AQ : TYPE == 1 ? C_CQ : C_DQ) + h * 64;
    const int kvh = TYPE == 2 ? h : (h >> 1);
    const int kcol = (TYPE == 0 ? C_AK : TYPE == 1 ? C_CK : C_DK) + kvh * 64, vcol = (TYPE == 0 ? C_AV : TYPE == 1 ? C_CV : C_DV) + kvh * 64;
    float q[64], o[64]; float m = -1e30f, ls = 0.f;
#pragma unroll
    for (int c = 0; c < 8; ++c) { const v4u w = *(const v4u*)(P + (size_t)row * NPJ + qcol + 8 * c);
        q[8 * c] = 0.125f * bflo(w.x); q[8 * c + 1] = 0.125f * bfhi(w.x); q[8 * c + 2] = 0.125f * bflo(w.y); q[8 * c + 3] = 0.125f * bfhi(w.y);
        q[8 * c + 4] = 0.125f * bflo(w.z); q[8 * c + 5] = 0.125f * bfhi(w.z); q[8 * c + 6] = 0.125f * bflo(w.w); q[8 * c + 7] = 0.125f * bfhi(w.w); }
#pragma unroll
    for (int d = 0; d < 64; ++d) o[d] = 0.f;
    int b;
    if (!ctxq) {
        b = row >> 12; const int t = row & 4095;
        if (TYPE == 0) { const int k0 = max(t - 128, 0), k1 = min(t + 128, SEQ - 1);
            for (int k = k0; k <= k1; ++k) { const bf16* kp = P + (size_t)(b * SEQ + k) * NPJ; nkey(q, o, m, ls, kp + kcol, kp + vcol, 0.f); } }
        else if (TYPE == 1) { for (int k = 0; k < SEQ; ++k) { const bf16* kp = P + (size_t)(b * SEQ + k) * NPJ; nkey(q, o, m, ls, kp + kcol, kp + vcol, 0.f); } }
        else { const int r = t >> 6, c = t & 63; const int rs = min(max(r - 4, 0), 56), cs = min(max(c - 8, 0), 48);
            for (int a = 0; a < 8; ++a) { const float* bp = KA->in[21] + ((size_t)(l * 4 + h) * 15 + (rs + a - r + 7)) * 31 + (cs - c + 15);
                for (int k = 0; k < 16; ++k) { const bf16* kp = P + (size_t)(b * SEQ + (rs + a) * 64 + cs + k) * NPJ; nkey(q, o, m, ls, kp + kcol, kp + vcol, bp[k]); } } }
    } else b = (row - NLAT) >> 8;
    for (int k = 0; k < CTXL; ++k) { const bf16* kp = P + (size_t)(NLAT + b * CTXL + k) * NPJ; nkey(q, o, m, ls, kp + kcol, kp + vcol, 0.f); }
    if (TYPE == 0) { const float sk = KA->in[13][l * 4 + h]; const float mn = fmaxf(m, sk), cf = __expf(m - mn); ls = ls * cf + __expf(sk - mn);
#pragma unroll
        for (int d = 0; d < 64; ++d) o[d] *= cf; }
    const float inv = 1.f / ls;
    bf16* op = ((bf16*)(KA->ws + WS_O)) + (size_t)row * DM + (TYPE == 0 ? 0 : TYPE == 1 ? 512 : 768) + h * 64;
#pragma unroll
    for (int c = 0; c < 8; ++c) { v4u w; w.x = pk2(o[8 * c] * inv, o[8 * c + 1] * inv); w.y = pk2(o[8 * c + 2] * inv, o[8 * c + 3] * inv); w.z = pk2(o[8 * c + 4] * inv, o[8 * c + 5] * inv); w.w = pk2(o[8 * c + 6] * inv, o[8 * c + 7] * inv);
        *(v4u*)(op + 8 * c) = w; }
}
DI void naive_ssd(int l, int item) {
    KArgs KA = kargs(); Frame F = mkframe();
    const int b = item >> 3, dir = (item >> 2) & 1, h = item & 3, g = h >> 1;
    const int p = F.tid >> 3, ng = F.tid & 7;
    const float A = -__expf(KA->in[17][l * 8 + dir * 4 + h]);
    bf16* Y = dir ? (((bf16*)(KA->ws + WS_Y) + (size_t)NROW * 256)) : ((bf16*)(KA->ws + WS_Y));
    float hs[16];
#pragma unroll
    for (int i = 0; i < 16; ++i) hs[i] = 0.f;
    for (int ph = 0; ph < 2; ++ph) {
        const int ns = ph ? SEQ : CTXL, base = ph ? b * SEQ : NLAT + b * CTXL;
#pragma unroll 4
        for (int s = 0; s < ns; ++s) {
            const int row = base + (dir ? ns - 1 - s : s);
            const float dt = ((float*)(KA->ws + WS_DT))[(size_t)row * 8 + dir * 4 + h];
            const bf16* ur = ((bf16*)(KA->ws + WS_U)) + (size_t)row * 768;
            const float xv = bf2f(ur[h * 64 + p]);
            const v4u b0 = *(const v4u*)(ur + 256 + g * 128 + ng * 16), b1 = *(const v4u*)(ur + 256 + g * 128 + ng * 16 + 8);
            const v4u c0 = *(const v4u*)(ur + 512 + g * 128 + ng * 16), c1 = *(const v4u*)(ur + 512 + g * 128 + ng * 16 + 8);
            const float dA = __expf(dt * A), dx = dt * xv;
            const unsigned bw[8] = {b0.x, b0.y, b0.z, b0.w, b1.x, b1.y, b1.z, b1.w}, cw[8] = {c0.x, c0.y, c0.z, c0.w, c1.x, c1.y, c1.z, c1.w};
            float y = 0.f;
#pragma unroll
            for (int i = 0; i < 8; ++i) { hs[2 * i] = hs[2 * i] * dA + dx * bflo(bw[i]); hs[2 * i + 1] = hs[2 * i + 1] * dA + dx * bfhi(bw[i]); y += bflo(cw[i]) * hs[2 * i] + bfhi(cw[i]) * hs[2 * i + 1]; }
            y += __shfl_xor(y, 1); y += __shfl_xor(y, 2); y += __shfl_xor(y, 4);
            if (ng == 0) Y[(size_t)row * 256 + h * 64 + p] = (bf16)f2bf(y);
        }
    }
}
DI void mixers_naive(int l, bool last) {
    Frame F = mkframe();
    const int nAttL = 64 * 12, nAttC = last ? 0 : 4 * 12, nItems = 64 + nAttL + nAttC;
    for (int it = blockIdx.x; it < nItems; it += F.G) {
        if (it < 64) { naive_ssd(l, it); continue; }
        int r = it - 64; bool cq = false; int rowbase;
        if (r >= nAttL) { r -= nAttL; cq = true; }
        const int rb = r / 12, ty = (r % 12) >> 2, h = r & 3;
        rowbase = cq ? NLAT + rb * 512 : rb * 512;
        const int row = rowbase + F.tid;
        if (ty == 0) naive_attn<0>(l, row, h, cq); else if (ty == 1) naive_attn<1>(l, row, h, cq); else naive_attn<2>(l, row, h, cq);
    }
}
typedef float f32x16 __attribute__((ext_vector_type(16)));
typedef short s16x4 __attribute__((ext_vector_type(4)));
typedef short bf16x8v __attribute__((ext_vector_type(8)));
typedef short v4i16_t __attribute__((ext_vector_type(4)));
DI s16x4 vtr(const LAS unsigned char* p) { return __builtin_bit_cast(s16x4, __builtin_amdgcn_ds_read_tr16_b64_v4i16((LAS v4i16_t*)p)); }
DI int crow16(int i, int h) { return (i & 3) + 8 * (i >> 2) + 4 * h; }
constexpr int AT_KRS = 144, AT_VRS = 192, AT_KB = 64 * AT_KRS, AT_BUF = AT_KB + 64 * AT_VRS, AT_RPB = 2 * AT_BUF;
constexpr float LOG2E = 1.4426950408889634f, AT_SC = 0.125f * LOG2E;
template <int TYPE>
DI void attn_unit(KArgs KA, const Frame& F, int l, int unit, bool ctxq) {
    const bf16* P = (const bf16*)(KA->ws + WS_ACT);
    const int L = F.lane, w = F.wave, r = L & 31, h2 = L >> 5, i16 = L & 15;
    int b, head, kvh, p0, qpos0, t0 = 0, nloc = 0;
    if (TYPE != 2) { int g, pb; if (!ctxq) { b = unit >> 6; g = (unit >> 5) & 1; pb = unit & 31; } else { b = unit >> 2; g = (unit >> 1) & 1; pb = unit & 1; }
        head = 2 * g + (w >> 2); kvh = g; p0 = pb * 128; qpos0 = p0 + 32 * (w & 3);
        if (!ctxq) { if (TYPE == 1) { t0 = 0; nloc = 64; } else { t0 = max(0, 2 * (pb - 1)); nloc = min(64, 2 * (pb + 2)) - t0; } } }
    else { int rb; if (!ctxq) { b = unit >> 6; head = (unit >> 4) & 3; rb = unit & 15; } else { b = unit >> 2; head = unit & 3; rb = 0; }
        kvh = head; p0 = rb * 256; qpos0 = p0 + 32 * w;
        if (!ctxq) { const int r0 = rb * 4; t0 = min(max(r0 - 4, 0), 56); nloc = min(max(r0 - 1, 0), 56) + 8 - t0; } }
    const int qcol = (TYPE == 0 ? C_AQ : TYPE == 1 ? C_CQ : C_DQ) + head * 64;
    const int kcol = (TYPE == 0 ? C_AK : TYPE == 1 ? C_CK : C_DK) + kvh * 64, vcol = (TYPE == 0 ? C_AV : TYPE == 1 ? C_CV : C_DV) + kvh * 64;
    const int qrow = (ctxq ? NLAT + b * CTXL : b * SEQ) + qpos0 + r;
    const int nt = nloc + 4;
    bf16x8v qf[4];
#pragma unroll
    for (int ks = 0; ks < 4; ++ks) qf[ks] = *(const bf16x8v*)(P + (size_t)qrow * NPJ + qcol + ks * 16 + 8 * h2);
    LAS unsigned char* lb = F.lds;
    if (TYPE == 2) { LAS float* rp = (LAS float*)(lb + AT_RPB); for (int i = F.tid; i < 465; i += 512) rp[i] = KA->in[21][(size_t)(l * 4 + head) * 465 + i] * 8.0f; }
    const int srow = F.tid >> 3, sch = F.tid & 7;
#define TILE_ROW0(i) ((i) < nloc ? b * SEQ + (t0 + (i)) * 64 : NLAT + b * CTXL + ((i) - nloc) * 64)
    v4u kreg, vreg;
    { const bf16* src = P + (size_t)(TILE_ROW0(0) + srow) * NPJ; kreg = *(const v4u*)(src + kcol + sch * 8); vreg = *(const v4u*)(src + vcol + sch * 8); }
    *(LAS v4u*)(lb + srow * AT_KRS + sch * 16) = kreg; *(LAS v4u*)(lb + AT_KB + srow * AT_VRS + sch * 16) = vreg;
    __syncthreads();
    f32x16 oacc[2];
#pragma unroll
    for (int i = 0; i < 16; ++i) { oacc[0][i] = 0.f; oacc[1][i] = 0.f; }
    float m = -1e30f, lsum = 0.f;
    if (TYPE == 1) {
        float gq = fabsf(KA->in[19][l * 64 + L]), gk = fabsf(KA->in[20][l * 64 + L]);
#pragma unroll
        for (int o = 1; o < 64; o <<= 1) { gq = fmaxf(gq, __shfl_xor(gq, o)); gk = fmaxf(gk, __shfl_xor(gk, o)); }
        m = 64.0f * 1.03f * gq * gk * AT_SC;
    }
    const int qpos = qpos0 + r;
    const int gr = qpos0 >> 6, rs = min(max(gr - 4, 0), 56), qc = qpos & 63, cs = min(max(qc - 8, 0), 48);
    for (int i = 0; i < nt; ++i) {
        const LAS unsigned char* kb_ = lb + (i & 1) * AT_BUF; const LAS unsigned char* vb_ = kb_ + AT_KB;
        if (i + 1 < nt) { const bf16* src = P + (size_t)(TILE_ROW0(i + 1) + srow) * NPJ; kreg = *(const v4u*)(src + kcol + sch * 8); vreg = *(const v4u*)(src + vcol + sch * 8); }
        const bool loc = i < nloc;
        bool skip = false;
        const int k0 = (t0 + i) * 64;
        if (loc && TYPE == 0) skip = (k0 + 63 < qpos0 - 128) || (k0 > qpos0 + 31 + 128);
        if (loc && TYPE == 2) skip = (t0 + i < rs) || (t0 + i >= rs + 8);
        if (!skip) {
            f32x16 sacc[2];
            bf16x8v kf[2][4], vf[2][2][2];
#pragma unroll
            for (int kb = 0; kb < 2; ++kb)
#pragma unroll
                for (int ks = 0; ks < 4; ++ks) kf[kb][ks] = *(const LAS bf16x8v*)(kb_ + (kb * 32 + r) * AT_KRS + ks * 32 + 16 * h2);
#pragma unroll
            for (int kb = 0; kb < 2; ++kb)
#pragma unroll
                for (int s = 0; s < 2; ++s)
#pragma unroll
                    for (int db = 0; db < 2; ++db) {
                        const LAS unsigned char* va = vb_ + (kb * 32 + 16 * s + 4 * h2 + (i16 >> 2)) * AT_VRS + (db * 32 + 16 * ((L >> 4) & 1) + 4 * (i16 & 3)) * 2;
                        const s16x4 lo = vtr(va), hi = vtr(va + 8 * AT_VRS);
                        vf[kb][s][db] = (bf16x8v){lo[0], lo[1], lo[2], lo[3], hi[0], hi[1], hi[2], hi[3]}; }
            __builtin_amdgcn_sched_barrier(0);
#pragma unroll
            for (int kb = 0; kb < 2; ++kb) {
#pragma unroll
                for (int q = 0; q < 16; ++q) sacc[kb][q] = (TYPE == 1) ? -m : 0.f;
#pragma unroll
                for (int ks = 0; ks < 4; ++ks) sacc[kb] = __builtin_amdgcn_mfma_f32_32x32x16_bf16(kf[kb][ks], qf[ks], sacc[kb], 0, 0, 0);
            }
            float tmax = -INFINITY;
            if ((TYPE == 0 || TYPE == 2) && loc) {
#pragma unroll
                for (int kb = 0; kb < 2; ++kb)
#pragma unroll
                    for (int q = 0; q < 16; ++q) { float s = sacc[kb][q]; const int kk = kb * 32 + crow16(q, h2);
                        if (TYPE == 0) { const int d = k0 + kk - qpos; if (d > 128 || d < -128) s = -INFINITY; }
                        if (TYPE == 2) { const int dc = kk - cs; const LAS float* rp = (const LAS float*)(lb + AT_RPB);
                            if (dc < 0 || dc >= 16) s = -INFINITY; else s += rp[(t0 + i - gr + 7) * 31 + (kk - qc + 15)]; }
                        sacc[kb][q] = s; }
            }
            if (TYPE != 1) {
#pragma unroll
                for (int kb = 0; kb < 2; ++kb)
#pragma unroll
                    for (int q = 0; q < 16; ++q) tmax = fmaxf(tmax, sacc[kb][q]);
                tmax = fmaxf(tmax, __shfl_xor(tmax, 32));
                const float mn = fmaxf(m, tmax);
                if (__any(mn > m)) {
                    const float alpha = __builtin_amdgcn_exp2f((m - mn) * AT_SC);
                    lsum *= alpha;
#pragma unroll
                    for (int q = 0; q < 16; ++q) { oacc[0][q] *= alpha; oacc[1][q] *= alpha; }
                }
                m = mn;
            }
            const float mns = -m * AT_SC;
            float psum = 0.f;
#pragma unroll
            for (int kb = 0; kb < 2; ++kb)
#pragma unroll
                for (int q = 0; q < 16; ++q) { const float p = (TYPE == 1) ? __builtin_amdgcn_exp2f(sacc[kb][q]) : __builtin_amdgcn_exp2f(__builtin_fmaf(sacc[kb][q], AT_SC, mns)); sacc[kb][q] = p; psum += p; }
            lsum += psum;
#pragma unroll
            for (int kb = 0; kb < 2; ++kb)
#pragma unroll
                for (int s = 0; s < 2; ++s) {
                    v4u pw; pw.x = cvtpk(sacc[kb][8 * s], sacc[kb][8 * s + 1]); pw.y = cvtpk(sacc[kb][8 * s + 2], sacc[kb][8 * s + 3]); pw.z = cvtpk(sacc[kb][8 * s + 4], sacc[kb][8 * s + 5]); pw.w = cvtpk(sacc[kb][8 * s + 6], sacc[kb][8 * s + 7]);
                    const bf16x8v pf = __builtin_bit_cast(bf16x8v, pw);
#pragma unroll
                    for (int db = 0; db < 2; ++db) oacc[db] = __builtin_amdgcn_mfma_f32_32x32x16_bf16(vf[kb][s][db], pf, oacc[db], 0, 0, 0);
                }
        }
        if (i + 1 < nt) { LAS unsigned char* nb = lb + ((i + 1) & 1) * AT_BUF; *(LAS v4u*)(nb + srow * AT_KRS + sch * 16) = kreg; *(LAS v4u*)(nb + AT_KB + srow * AT_VRS + sch * 16) = vreg; }
        __syncthreads();
    }
    lsum += __shfl_xor(lsum, 32);
    if (TYPE == 0) lsum += __builtin_amdgcn_exp2f(KA->in[13][l * 4 + head] * LOG2E - m * AT_SC);
    const float inv = __builtin_amdgcn_rcpf(lsum);
    bf16* op = (bf16*)(KA->ws + WS_O) + (size_t)qrow * DM + (TYPE == 0 ? 0 : TYPE == 1 ? 512 : 768) + head * 64;
#pragma unroll
    for (int db = 0; db < 2; ++db)
#pragma unroll
        for (int q4 = 0; q4 < 4; ++q4) { v2u o; o.x = cvtpk(oacc[db][4 * q4] * inv, oacc[db][4 * q4 + 1] * inv); o.y = cvtpk(oacc[db][4 * q4 + 2] * inv, oacc[db][4 * q4 + 3] * inv);
            *(v2u*)(op + db * 32 + 8 * q4 + 4 * h2) = o; }
}
constexpr size_t WS_ST = WS_A;
constexpr size_t WS_DEC = 3 * MiB;
constexpr int SS_B = 0, SS_BRS = 272, SS_X = 34816, SS_XRS = 192, SS_X2 = 59392, SS_HF = 83968, SS_HB = 101376, SS_ARR = 118784;
DI int slot_row(int b, int slot) { return slot < 2 ? NLAT + b * CTXL + slot * 128 : b * SEQ + (slot - 2) * 128; }
DI void ssd_stage_dt(KArgs KA, const Frame& F, int l, int h, int rowbase, LAS float* arr) {
    const float* DTB = (const float*)(KA->ws + WS_DT);
    if (F.tid < 128) { const float df = DTB[(size_t)(rowbase + F.tid) * 8 + h], db = DTB[(size_t)(rowbase + F.tid) * 8 + 4 + h];
        const float Af = -__expf(KA->in[17][l * 8 + h]) * LOG2E, Ab = -__expf(KA->in[17][l * 8 + 4 + h]) * LOG2E;
        arr[F.tid] = df * Af; arr[128 + F.tid] = db * Ab; arr[256 + F.tid] = df; arr[384 + F.tid] = db; }
    __syncthreads();
    if (F.wave < 2) { const int L = F.lane; const bool rev = F.wave == 1;
        const float v0 = rev ? arr[128 + 127 - 2 * L] : arr[2 * L], v1 = rev ? arr[128 + 126 - 2 * L] : arr[2 * L + 1];
        float t = v0 + v1;
#pragma unroll
        for (int o = 1; o < 64; o <<= 1) { const float u = __shfl_up(t, o); if (L >= o) t += u; }
        if (rev) { arr[640 + 127 - 2 * L] = t - v1; arr[640 + 126 - 2 * L] = t; } else { arr[512 + 2 * L] = t - v1; arr[512 + 2 * L + 1] = t; } }
    __syncthreads();
}
struct BRegs { v4u v[4]; };
DI BRegs ssd_load_B(KArgs KA, const Frame& F, int g, int rowbase) {
    const bf16* U = (const bf16*)(KA->ws + WS_U);
    const int row = F.tid >> 2, pc = F.tid & 3; const bf16* src = U + (size_t)(rowbase + row) * 768 + 256 + g * 128 + pc * 32;
    BRegs b;
#pragma unroll
    for (int k = 0; k < 4; ++k) b.v[k] = *(const v4u*)(src + k * 8);
    return b;
}
DI void ssd_store_B(const Frame& F, const BRegs& b) {
    const int row = F.tid >> 2, pc = F.tid & 3;
#pragma unroll
    for (int k = 0; k < 4; ++k) *(LAS v4u*)(F.lds + SS_B + row * SS_BRS + pc * 64 + k * 16) = b.v[k];
}
DI v4u scale8(v4u w, float s) { v4u o; o.x = cvtpk(bflo(w.x) * s, bfhi(w.x) * s); o.y = cvtpk(bflo(w.y) * s, bfhi(w.y) * s); o.z = cvtpk(bflo(w.z) * s, bfhi(w.z) * s); o.w = cvtpk(bflo(w.w) * s, bfhi(w.w) * s); return o; }
DI void ssd_states(KArgs KA, const Frame& F, int l, int item) {
    const int slot = item % 34, bh = item / 34, b = bh >> 2, h = bh & 3, g = h >> 1, rowbase = slot_row(b, slot);
    const int L = F.lane, w = F.wave, r = L & 31, h2 = L >> 5, i16 = L & 15, grp = (L >> 4) & 1;
    LAS float* arr = (LAS float*)(F.lds + SS_ARR);
    const BRegs breg = ssd_load_B(KA, F, g, rowbase);
    v4u x0, x1;
    { const bf16* U = (const bf16*)(KA->ws + WS_U); const int row = F.tid >> 2, pc = F.tid & 3; const bf16* src = U + (size_t)(rowbase + row) * 768 + h * 64 + pc * 16; x0 = *(const v4u*)src; x1 = *(const v4u*)(src + 8); }
    ssd_stage_dt(KA, F, l, h, rowbase, arr);
    ssd_store_B(F, breg);
    { const int row = F.tid >> 2, pc = F.tid & 3;
      const float wf = __builtin_amdgcn_exp2f(arr[512 + 127] - arr[512 + row]) * arr[256 + row], wb = __builtin_amdgcn_exp2f(arr[640] - arr[640 + row]) * arr[384 + row];
      *(LAS v4u*)(F.lds + SS_X + row * SS_XRS + pc * 32) = scale8(x0, wf); *(LAS v4u*)(F.lds + SS_X + row * SS_XRS + pc * 32 + 16) = scale8(x1, wf);
      *(LAS v4u*)(F.lds + SS_X2 + row * SS_XRS + pc * 32) = scale8(x0, wb); *(LAS v4u*)(F.lds + SS_X2 + row * SS_XRS + pc * 32 + 16) = scale8(x1, wb); }
    __syncthreads();
    const int pblk = w >> 2, nblk = w & 3;
    bf16* ST = (bf16*)(KA->ws + WS_ST); float* DEC = (float*)(KA->ws + WS_DEC);
#pragma unroll
    for (int dir = 0; dir < 2; ++dir) {
        f32x16 acc;
#pragma unroll
        for (int q = 0; q < 16; ++q) acc[q] = 0.f;
        const LAS unsigned char* xb = F.lds + (dir ? SS_X2 : SS_X);
#pragma unroll
        for (int ks = 0; ks < 8; ++ks) {
            const LAS unsigned char* xa = xb + (ks * 16 + 8 * h2 + (i16 >> 2)) * SS_XRS + (pblk * 32 + 16 * grp + 4 * (i16 & 3)) * 2;
            const s16x4 xlo = vtr(xa), xhi = vtr(xa + 4 * SS_XRS);
            const LAS unsigned char* ba = F.lds + SS_B + (ks * 16 + 8 * h2 + (i16 >> 2)) * SS_BRS + (nblk * 32 + 16 * grp + 4 * (i16 & 3)) * 2;
            const s16x4 blo = vtr(ba), bhi_ = vtr(ba + 4 * SS_BRS);
            const bf16x8v xf = (bf16x8v){xlo[0], xlo[1], xlo[2], xlo[3], xhi[0], xhi[1], xhi[2], xhi[3]}, bfr = (bf16x8v){blo[0], blo[1], blo[2], blo[3], bhi_[0], bhi_[1], bhi_[2], bhi_[3]};
            acc = __builtin_amdgcn_mfma_f32_32x32x16_bf16(xf, bfr, acc, 0, 0, 0); }
        bf16* dst = ST + ((size_t)((bh * 2 + dir) * 34 + slot)) * 8192;
#pragma unroll
        for (int q = 0; q < 16; ++q) dst[(pblk * 32 + crow16(q, h2)) * 128 + nblk * 32 + r] = (bf16)(cvtpk(acc[q], 0.f) & 0xffffu);
        if (F.tid == 0) DEC[(bh * 2 + dir) * 34 + slot] = __builtin_amdgcn_exp2f(dir ? arr[640] : arr[512 + 127]);
    }
    __syncthreads();
}
DI void ssd_scan() {
    KArgs KA = kargs(); Frame F = mkframe();
    bf16* ST = (bf16*)(KA->ws + WS_ST); const float* DEC = (const float*)(KA->ws + WS_DEC);
    for (int gt = blockIdx.x * 512 + F.tid; gt < 64 * 2048; gt += F.G * 512) {
        const int chain = gt >> 11, e4 = gt & 2047, dir = chain & 1;
        bf16* base = ST + (size_t)chain * 34 * 8192 + e4 * 4;
        v2u tw[34]; float dc[34];
#pragma unroll
        for (int k = 0; k < 34; ++k) { const int slot = dir == 0 ? k : (k < 2 ? 1 - k : 35 - k); tw[k] = *(const v2u*)(base + (size_t)slot * 8192); dc[k] = DEC[chain * 34 + slot]; }
        f32x4 hc = (f32x4){0.f, 0.f, 0.f, 0.f};
#pragma unroll
        for (int k = 0; k < 34; ++k) { const int slot = dir == 0 ? k : (k < 2 ? 1 - k : 35 - k);
            const f32x4 t = (f32x4){bflo(tw[k].x), bfhi(tw[k].x), bflo(tw[k].y), bfhi(tw[k].y)};
            v2u ow; ow.x = cvtpk(hc.x, hc.y); ow.y = cvtpk(hc.z, hc.w); *(v2u*)(base + (size_t)slot * 8192) = ow; hc = hc * dc[k] + t; }
    }
}
DI void ssd_outputs(KArgs KA, const Frame& F, int l, int item) {
    const int slot = item % 34, bh = item / 34, b = bh >> 2, h = bh & 3, g = h >> 1, rowbase = slot_row(b, slot);
    const int L = F.lane, w = F.wave, r = L & 31, h2 = L >> 5, i16 = L & 15, grp = (L >> 4) & 1;
    LAS float* arr = (LAS float*)(F.lds + SS_ARR);
    const bf16* U = (const bf16*)(KA->ws + WS_U);
    const int ib = w & 3, pb = w >> 2, ipos = ib * 32 + r;
    bf16x8v cfq[8];
#pragma unroll
    for (int ks = 0; ks < 8; ++ks) cfq[ks] = *(const bf16x8v*)(U + (size_t)(rowbase + ipos) * 768 + 512 + g * 128 + ks * 16 + 8 * h2);
    const BRegs breg = ssd_load_B(KA, F, g, rowbase);
    v4u x0, x1, hf0, hf1, hb0, hb1;
    { const int row = F.tid >> 2, pc = F.tid & 3; const bf16* src = U + (size_t)(rowbase + row) * 768 + h * 64 + pc * 16; x0 = *(const v4u*)src; x1 = *(const v4u*)(src + 8); }
    { const bf16* ST = (const bf16*)(KA->ws + WS_ST); const int p = F.tid >> 3, pc = F.tid & 7;
      const bf16* sf = ST + ((size_t)((bh * 2 + 0) * 34 + slot)) * 8192 + p * 128 + pc * 16; const bf16* sb = ST + ((size_t)((bh * 2 + 1) * 34 + slot)) * 8192 + p * 128 + pc * 16;
      hf0 = *(const v4u*)sf; hf1 = *(const v4u*)(sf + 8); hb0 = *(const v4u*)sb; hb1 = *(const v4u*)(sb + 8); }
    ssd_stage_dt(KA, F, l, h, rowbase, arr);
    ssd_store_B(F, breg);
    { const int row = F.tid >> 2, pc = F.tid & 3; *(LAS v4u*)(F.lds + SS_X + row * SS_XRS + pc * 32) = x0; *(LAS v4u*)(F.lds + SS_X + row * SS_XRS + pc * 32 + 16) = x1; }
    { const int p = F.tid >> 3, pc = F.tid & 7; LAS unsigned char* d = F.lds + SS_HF + p * SS_BRS + pc * 32; *(LAS v4u*)d = hf0; *(LAS v4u*)(d + 16) = hf1;
      LAS unsigned char* e = F.lds + SS_HB + p * SS_BRS + pc * 32; *(LAS v4u*)e = hb0; *(LAS v4u*)(e + 16) = hb1; }
    __syncthreads();
    const float cfi = arr[512 + ipos], cbi = arr[640 + ipos];
    f32x16 yacc;
#pragma unroll
    for (int q = 0; q < 16; ++q) yacc[q] = 0.f;
#pragma unroll
    for (int jb = 0; jb < 4; ++jb) {
        f32x16 acc;
#pragma unroll
        for (int q = 0; q < 16; ++q) acc[q] = 0.f;
#pragma unroll
        for (int ks = 0; ks < 8; ++ks) { const bf16x8v bfr = *(const LAS bf16x8v*)(F.lds + SS_B + (jb * 32 + r) * SS_BRS + ks * 32 + 16 * h2);
            acc = __builtin_amdgcn_mfma_f32_32x32x16_bf16(bfr, cfq[ks], acc, 0, 0, 0); }
        if (jb < ib) {
#pragma unroll
            for (int q = 0; q < 16; ++q) { const int j = jb * 32 + crow16(q, h2); acc[q] *= __builtin_amdgcn_exp2f(cfi - arr[512 + j]) * arr[256 + j]; }
        } else if (jb > ib) {
#pragma unroll
            for (int q = 0; q < 16; ++q) { const int j = jb * 32 + crow16(q, h2); acc[q] *= __builtin_amdgcn_exp2f(cbi - arr[640 + j]) * arr[384 + j]; }
        } else {
            int rl = r; asm volatile("" : "+v"(rl));
#pragma unroll
            for (int q = 0; q < 16; ++q) { const int jl = crow16(q, h2), j = jb * 32 + jl;
                float wt = 0.f;
                if (jl <= rl) wt += __builtin_amdgcn_exp2f(cfi - arr[512 + j]) * arr[256 + j];
                if (jl >= rl) wt += __builtin_amdgcn_exp2f(cbi - arr[640 + j]) * arr[384 + j];
                acc[q] *= wt; }
        }
#pragma unroll
        for (int s = 0; s < 2; ++s) {
            v4u pw; pw.x = cvtpk(acc[8 * s], acc[8 * s + 1]); pw.y = cvtpk(acc[8 * s + 2], acc[8 * s + 3]); pw.z = cvtpk(acc[8 * s + 4], acc[8 * s + 5]); pw.w = cvtpk(acc[8 * s + 6], acc[8 * s + 7]);
            const bf16x8v pf = __builtin_bit_cast(bf16x8v, pw);
            const LAS unsigned char* xa = F.lds + SS_X + (jb * 32 + 16 * s + 4 * h2 + (i16 >> 2)) * SS_XRS + (pb * 32 + 16 * grp + 4 * (i16 & 3)) * 2;
            const s16x4 lo = vtr(xa), hi = vtr(xa + 8 * SS_XRS);
            const bf16x8v xf = (bf16x8v){lo[0], lo[1], lo[2], lo[3], hi[0], hi[1], hi[2], hi[3]};
            yacc = __builtin_amdgcn_mfma_f32_32x32x16_bf16(xf, pf, yacc, 0, 0, 0); }
    }
#pragma unroll
    for (int dir = 0; dir < 2; ++dir) {
        f32x16 tacc;
#pragma unroll
        for (int q = 0; q < 16; ++q) tacc[q] = 0.f;
#pragma unroll
        for (int ks = 0; ks < 8; ++ks) { const bf16x8v hfr = *(const LAS bf16x8v*)(F.lds + (dir ? SS_HB : SS_HF) + (pb * 32 + r) * SS_BRS + ks * 32 + 16 * h2);
            tacc = __builtin_amdgcn_mfma_f32_32x32x16_bf16(hfr, cfq[ks], tacc, 0, 0, 0); }
        const float sc = __builtin_amdgcn_exp2f(dir ? cbi : cfi);
#pragma unroll
        for (int q = 0; q < 16; ++q) yacc[q] += sc * tacc[q];
    }
    bf16* yp = (bf16*)(KA->ws + WS_Y) + (size_t)(rowbase + ipos) * 256 + h * 64 + pb * 32;
#pragma unroll
    for (int q4 = 0; q4 < 4; ++q4) { v2u o; o.x = cvtpk(yacc[4 * q4], yacc[4 * q4 + 1]); o.y = cvtpk(yacc[4 * q4 + 2], yacc[4 * q4 + 3]); *(v2u*)(yp + 8 * q4 + 4 * h2) = o; }
    __syncthreads();
}
DI void ssd_outputs_phase(int l, bool last) {
    KArgs KA = kargs(); Frame F = mkframe();
    for (int it = blockIdx.x; it < 32 * 34; it += F.G) { if (last && (it % 34) < 2) continue; ssd_outputs(KA, F, l, it); }
}
DI void mixers_flash(int l, bool last) {
    KArgs KA = kargs(); Frame F = mkframe();
    const int nS = 32 * 34, nL = 1536, nC = last ? 0 : 96, nItems = nS + nL + nC;
    for (int it = blockIdx.x; it < nItems; it += F.G) {
        if (it < nS) { ssd_states(KA, F, l, it); continue; }
        int u = it - nS; bool cq = false;
        if (u >= nL) { u -= nL; cq = true; }
        const int ty = u % 3, un = u / 3;
        if (ty == 0) attn_unit<1>(KA, F, l, un, cq); else if (ty == 1) attn_unit<0>(KA, F, l, un, cq); else attn_unit<2>(KA, F, l, un, cq);
    }
}
DI void merge_pass(int l, int nrows) {
    KArgs KA = kargs(); Frame F = mkframe();
    const bf16* P = (const bf16*)(KA->ws + WS_ACT); const bf16* O = (const bf16*)(KA->ws + WS_O); const bf16* Y = (const bf16*)(KA->ws + WS_Y); const bf16* U = (const bf16*)(KA->ws + WS_U);
    bf16* A = (bf16*)(KA->ws + WS_A);
    const int hh = F.lane >> 4, cn = 4 * F.lane;
    const float dsk = KA->in[18][l * 4 + hh];
    v2u o0, o2, o3, yw, xw, zw;
#define MERGE_LOAD(r_) do { o0 = *(const v2u*)(O + (size_t)(r_) * DM + cn); o2 = *(const v2u*)(O + (size_t)(r_) * DM + 512 + cn); o3 = *(const v2u*)(O + (size_t)(r_) * DM + 768 + cn); \
        yw = *(const v2u*)(Y + (size_t)(r_) * 256 + cn); xw = *(const v2u*)(U + (size_t)(r_) * 768 + cn); zw = *(const v2u*)(P + (size_t)(r_) * NPJ + C_BZ + cn); } while (0)
    if (F.gw < nrows) MERGE_LOAD(F.gw);
    for (int row = F.gw; row < nrows; row += F.ngw) {
        f32x4 v[4];
        v[0] = (f32x4){bflo(o0.x), bfhi(o0.x), bflo(o0.y), bfhi(o0.y)}; v[2] = (f32x4){bflo(o2.x), bfhi(o2.x), bflo(o2.y), bfhi(o2.y)}; v[3] = (f32x4){bflo(o3.x), bfhi(o3.x), bflo(o3.y), bfhi(o3.y)};
        { const f32x4 yf = (f32x4){bflo(yw.x), bfhi(yw.x), bflo(yw.y), bfhi(yw.y)}, xs = (f32x4){bflo(xw.x), bfhi(xw.x), bflo(xw.y), bfhi(xw.y)}, z = (f32x4){bflo(zw.x), bfhi(zw.x), bflo(zw.y), bfhi(zw.y)};
          const f32x4 y = yf + xs * dsk; v[1] = (f32x4){y.x * silu(z.x), y.y * silu(z.y), y.z * silu(z.z), y.w * silu(z.w)}; }
        if (row + F.ngw < nrows) MERGE_LOAD(row + F.ngw);
#pragma unroll
        for (int j = 0; j < 4; ++j) { const int n = 4 * F.lane + 256 * j;
            const float ss = wave_sum((v[j].x * v[j].x + v[j].y * v[j].y) + (v[j].z * v[j].z + v[j].w * v[j].w));
            const float r = __builtin_amdgcn_rsqf(ss * (1.f / 256.f) + LN_EPS);
            const f32x4 a = v[j] * r * *(const f32x4*)(KA->in[12] + l * DM + n);
            v2u w; w.x = cvtpk(a.x, a.y); w.y = cvtpk(a.z, a.w); *(v2u*)(A + (size_t)row * DM + n) = w; }
    }
#undef MERGE_LOAD
}
constexpr size_t WS_CTL = 3 * MiB + 512 * 1024, CTL_BYTES = 16384;
constexpr int MISC_OFF = 139264;
#define XB_TMO      128
#define XB_XCNT(j)  (256  + 64 * (j))
#define XB_XSUB(j)  (1280 + 64 * (j))
#define XB_XGEN(j)  (2304 + 64 * (j))
#define XB_TOP      3328
#define XB_TOPGEN   3392
#define XCD_BAR_WORDS 3456
#define XB_SPIN_CAP (1u << 18)

__device__ __forceinline__ unsigned xb_ld(unsigned* p)              { return __hip_atomic_load(p, __ATOMIC_RELAXED, __HIP_MEMORY_SCOPE_AGENT); }
__device__ __forceinline__ unsigned xb_add(unsigned* p, unsigned v) { return __hip_atomic_fetch_add(p, v, __ATOMIC_RELAXED, __HIP_MEMORY_SCOPE_AGENT); }
__device__ __forceinline__ unsigned xb_xcc_id() { return (unsigned)__builtin_amdgcn_s_getreg((3 << 11) | 20) & 0xFu; }
#define XB_SPIN(cond, bar) do { unsigned _sp = 0; while (cond) { __builtin_amdgcn_s_sleep(1); \
    if ((++_sp & 255u) == 0u) { if (xb_ld(&(bar)[XB_TMO])) break; if (_sp > XB_SPIN_CAP) { atomicAdd(&(bar)[XB_TMO], 1u); break; } } } } while (0)

struct XcdBarrier {
    unsigned* bar; unsigned x;
    volatile LAS unsigned* st;
};

__device__ __forceinline__ XcdBarrier xcd_barrier_post(unsigned* bar, volatile LAS unsigned* st) {
    XcdBarrier b; b.bar = bar; b.x = xb_xcc_id(); b.st = st;
    if (threadIdx.x == 0) (void)xb_add(&bar[XB_XCNT(b.x)], 1u);
    return b;
}
__device__ __forceinline__ void xcd_barrier_complete(unsigned* bar, unsigned x, unsigned& nloc, unsigned& nx) {
    const unsigned G = gridDim.x * gridDim.y * gridDim.z;
    unsigned sum, cnt, mine, sp = 0u;
    for (;;) {
        sum = 0u; cnt = 0u; mine = 0u;
#pragma unroll
        for (unsigned j = 0; j < 16; ++j) { const unsigned c = xb_ld(&bar[XB_XCNT(j)]); sum += c; cnt += (c > 0u) ? 1u : 0u; mine = (j == x) ? c : mine; }
        if (sum == G) break;
        __builtin_amdgcn_s_sleep(1);
        if ((++sp & 255u) == 0u) { if (xb_ld(&bar[XB_TMO])) break; if (sp > XB_SPIN_CAP) { atomicAdd(&bar[XB_TMO], 1u); break; } }
    }
    nloc = mine > 0u ? mine : 1u; nx = cnt > 0u ? cnt : 1u;
}

__device__ __forceinline__ void xcd_barrier(const XcdBarrier& b) {
    asm volatile("s_waitcnt vmcnt(0)" ::: "memory");
    __syncthreads();
    if (threadIdx.x == 0) {
        unsigned* bar = b.bar;
        __builtin_amdgcn_s_waitcnt(0);
        unsigned nloc = b.st[0], nx = b.st[1];
        if (nloc == 0u) { xcd_barrier_complete(bar, b.x, nloc, nx); b.st[0] = nloc; b.st[1] = nx; }
        const unsigned old = xb_add(&bar[XB_XSUB(b.x)], 1u);
        const unsigned gen = old / nloc;
        if (old + 1u == (gen + 1u) * nloc) {
            __builtin_amdgcn_fence(__ATOMIC_RELEASE, "agent");
            asm volatile("s_waitcnt vmcnt(0)" ::: "memory");
            const unsigned og = xb_add(&bar[XB_TOP], 1u);
            const unsigned tg = og / nx;
            if (og + 1u == (tg + 1u) * nx) xb_add(&bar[XB_TOPGEN], 1u);
            else XB_SPIN(xb_ld(&bar[XB_TOPGEN]) == tg, bar);
            __builtin_amdgcn_fence(__ATOMIC_ACQUIRE, "agent");
            xb_add(&bar[XB_XGEN(b.x)], 1u);
            asm volatile("s_waitcnt vmcnt(0)" ::: "memory");
        } else {
            XB_SPIN(xb_ld(&bar[XB_XGEN(b.x)]) == gen, bar);
            __builtin_amdgcn_fence(__ATOMIC_ACQUIRE, "agent");
            asm volatile("s_waitcnt vmcnt(0)" ::: "memory");
        }
    }
    __syncthreads();
}

#define GRID_BAR() do { XcdBarrier b_; b_.bar = (unsigned*)(kargs()->ws + WS_CTL); b_.x = xb_xcc_id(); b_.st = (volatile LAS unsigned*)((LAS unsigned char*)lds + MISC_OFF); xcd_barrier(b_); } while (0)
#ifndef PROBE_GRP
#define PROBE_GRP 0
#endif
#define TIMED(grp, ...) do { unsigned long long t0_ = 0; if (PROBE_GRP == (grp)) t0_ = __builtin_amdgcn_s_memrealtime(); __VA_ARGS__; \
    if (PROBE_GRP == (grp) && blockIdx.x == 0) { const unsigned long long dt_ = __builtin_amdgcn_s_memrealtime() - t0_; const unsigned long long t1_ = __builtin_amdgcn_s_memrealtime(); \
        while (__builtin_amdgcn_s_memrealtime() - t1_ < 2 * dt_) __builtin_amdgcn_s_sleep(8); } } while (0)
__global__ void __launch_bounds__(NWAVES * 64, 2) mega_fwd(Args args) {
    extern __shared__ __attribute__((aligned(16))) unsigned char lds[];
    cg::grid_group grid = cg::this_grid();
    if (threadIdx.x < 2) ((volatile LAS unsigned*)((LAS unsigned char*)lds + MISC_OFF))[threadIdx.x] = 0u;
    __syncthreads();
    (void)xcd_barrier_post((unsigned*)(kargs()->ws + WS_CTL), (volatile LAS unsigned*)((LAS unsigned char*)lds + MISC_OFF));
    { LAS float* rc = (LAS float*)((LAS unsigned char*)lds + ROPE_OFF);
      for (int i = threadIdx.x; i < 1024; i += 512) { const int pos = i >> 4, fi = i & 15; const float inv = exp2f(-(float)fi * (13.287712379549449f / 16.f)); const float ang = (float)pos * inv; rc[i] = cosf(ang); rc[1024 + i] = sinf(ang); } }
    __syncthreads();

    if (args.ws == nullptr) grid.sync();
    p0a(); GRID_BAR(); p0b(); GRID_BAR(); p0c(); GRID_BAR();
    for (int l = 0; l < NL; ++l) {
        const bool last = (l == NL - 1); const int mrows = last ? NLAT : NROW;
        for (int s = 0; s < 3; ++s) {
            if (s != 1) {
                const bool second = (s == 2); const int rows = (second && last) ? NLAT : NROW;
                { KArgs KA = kargs(); pg8::Gemm g{((bf16*)(KA->ws + WS_A)), wbuf(KA, l, second ? WO_W1B : WO_W1A), rows, 2 * DFF, DM}; pg8::StaticOrder S; S.init(rows, 2 * DFF, (int)gridDim.x, (int)blockIdx.x); pg8::EpiSwiGLU E{((bf16*)(KA->ws + WS_ACT)), DFF};
                  pg8::gemm_phase<pg8::EpiSwiGLU, pg8::StaticOrder, true, GEMM_SP2>((LAS unsigned char*)lds, g, S, E); }
                GRID_BAR();
                { KArgs KA = kargs(); pg8::Gemm g{((bf16*)(KA->ws + WS_ACT)), wbuf(KA, l, second ? WO_W2B : WO_W2A), NLAT, DM, DFF}; pg8::StaticOrder S; S.init(NLAT, DM, (int)gridDim.x, (int)blockIdx.x); pg8::EpiBf16 E{((bf16*)(KA->ws + WS_O)), DM};
                  pg8::gemm_phase<pg8::EpiBf16, pg8::StaticOrder, true, GEMM_SP2>((LAS unsigned char*)lds, g, S, E); }
                GRID_BAR();
                const bool split = (rows == NROW);
                const int gidx = second ? 8 : 2, lnidx = second ? 2 : 0, nl = second ? l + 1 : l, nsh = second ? (last ? -1 : 0) : 3;
                if (split && blockIdx.x < 32) {
                    KArgs KA = kargs(); pg8::Gemm g{((bf16*)(KA->ws + WS_ACT)) + (size_t)NLAT * DFF, wbuf(KA, l, second ? WO_W2B : WO_W2A), NCTX, DM, DFF}; pg8::StaticOrder S; S.init(NCTX, DM, 32, (int)blockIdx.x);
                    pg8::EpiBf16 E{((bf16*)(KA->ws + WS_O)) + (size_t)NLAT * DM, DM};
                    pg8::gemm_phase<pg8::EpiBf16, pg8::StaticOrder, true, GEMM_SP2>((LAS unsigned char*)lds, g, S, E);
                } else ln_pass(l, gidx, 0.5f, lnidx, nl, nsh, 0, NLAT, split ? 32 : 0, split ? (int)gridDim.x - 32 : (int)gridDim.x, !second);
                if (split) { GRID_BAR(); ln_pass(l, gidx, 0.5f, lnidx, nl, nsh, NLAT, NROW, 0, (int)gridDim.x, !second); }
                if (!(second && last)) GRID_BAR();
            } else {
                { KArgs KA = kargs(); pg8::Gemm g{((bf16*)(KA->ws + WS_A)), wbuf(KA, l, WO_WIN), NROW, NPJ, DM}; pg8::StaticOrder S; S.init(NROW, NPJ, (int)gridDim.x, (int)blockIdx.x); pg8::EpiBf16 E{((bf16*)(KA->ws + WS_ACT)), NPJ};
                  pg8::gemm_phase<pg8::EpiBf16, pg8::StaticOrder, true, GEMM_SP2>((LAS unsigned char*)lds, g, S, E); }
                GRID_BAR();
                prep_pass(l); GRID_BAR();
                mixers_flash(l, last); GRID_BAR();
                ssd_scan(); GRID_BAR();
                ssd_outputs_phase(l, last); GRID_BAR();
                merge_pass(l, mrows); GRID_BAR();
                { KArgs KA = kargs(); pg8::Gemm g{((bf16*)(KA->ws + WS_A)), wbuf(KA, l, WO_WOUT), mrows, DM, DM}; pg8::StaticOrder S; S.init(mrows, DM, (int)gridDim.x, (int)blockIdx.x); pg8::EpiBf16 E{((bf16*)(KA->ws + WS_O)), DM};
                  pg8::gemm_phase<pg8::EpiBf16, pg8::StaticOrder, true, GEMM_SP2>((LAS unsigned char*)lds, g, S, E); }
                GRID_BAR();
                ln_pass(l, 5, 1.0f, 1, l, 6, 0, mrows, 0, (int)gridDim.x, false); GRID_BAR();
            }
        }
    }
}

extern "C" void kernel_launch(void* const* d_in, const int* in_sizes, int n_in, void* d_out, int out_size, void* d_ws, size_t ws_size, hipStream_t stream) {
    static int grid = 0;
    if (grid == 0) {
        if (n_in != 24 || out_size != NLAT * DM || ws_size < WS_END) { fprintf(stderr, "kernel_launch: unexpected shapes: n_in %d out %d ws %zu\n", n_in, out_size, ws_size); grid = -1; return; }
        int dev = 0, cus = 0, per_cu = 0;
        hipGetDevice(&dev); hipDeviceGetAttribute(&cus, hipDeviceAttributeMultiprocessorCount, dev);
        if (hipFuncSetAttribute((const void*)mega_fwd, hipFuncAttributeMaxDynamicSharedMemorySize, LDS_BYTES) != hipSuccess) { fprintf(stderr, "kernel_launch: hipFuncSetAttribute failed\n"); grid = -1; return; }
        if (hipOccupancyMaxActiveBlocksPerMultiprocessor(&per_cu, (const void*)mega_fwd, NWAVES * 64, LDS_BYTES) != hipSuccess || per_cu < 1) { fprintf(stderr, "kernel_launch: occupancy query says %d\n", per_cu); per_cu = 1; }
        (void)hipGetLastError();
        grid = cus;
    }
    if (grid < 0) return;
    if (hipMemsetAsync((char*)d_ws + WS_CTL, 0, CTL_BYTES, stream) != hipSuccess) { fprintf(stderr, "kernel_launch: memset of the barrier words failed\n"); return; }
    Args a{};
    for (int i = 0; i < 24; ++i) a.in[i] = (const float*)d_in[i];
    a.out = (float*)d_out; a.ws = (unsigned char*)d_ws;
    void* kargs[] = {&a};
    hipError_t e = hipLaunchCooperativeKernel((const void*)mega_fwd, dim3(grid), dim3(NWAVES * 64), kargs, LDS_BYTES, stream);
    if (e != hipSuccess) fprintf(stderr, "kernel_launch: cooperative launch failed: %s (grid %d)\n", hipGetErrorString(e), grid);
}
```

```cpp
#include <hip/hip_runtime.h>
#include <hip/hip_cooperative_groups.h>
#include <cstdio>
#include <cstdint>
namespace cg = cooperative_groups;
namespace pg8 {
#define PG8_LAS __attribute__((address_space(3)))
typedef unsigned short bf16_t;
typedef short bf16x8 __attribute__((ext_vector_type(8)));
typedef float f32x4 __attribute__((ext_vector_type(4)));
typedef unsigned u32x4 __attribute__((ext_vector_type(4)));
constexpr int BM = 256, BK = 64, HALF = 128, HTB = HALF * BK * 2  , STAGE_BYTES = 8 * HTB, NXCD = 8, WGM = 8;

__host__ __device__ __forceinline__ int lds_byte(int r, int c) { const int st = (r >> 4) * 2 + (c >> 5), rr = r & 15, cc = c & 31, ob = rr * 64 + cc * 2; return st * 1024 + (ob ^ (((ob >> 9) & 1) << 5)); }
__host__ __device__ __forceinline__ void stage_rc(int b, int& R, int& C) { const int st = b / 1024, sb = b % 1024, swz = sb ^ (((sb >> 9) & 1) << 5); R = (st >> 1) * 16 + swz / 64; C = (st & 1) * 32 + (swz % 64) / 2; }
__host__ __device__ __forceinline__ int perm32(int rho) { const int n = rho >> 4, i = rho & 15; return 8 * (i >> 2) + 4 * n + (i & 3); }

struct Unit { int pm, pn; };
struct Gemm { const bf16_t* A; const bf16_t* Bt; int M, N, K; };

struct StaticOrder {
    int nM, nN, nwg, G, c;
    __host__ __device__ void init(int M, int N, int G_, int c_) { nM = M / BM; nN = N / BM; nwg = nM * nN; G = G_; c = c_; }
    __host__ __device__ bool next(int i, Unit& u) const {
        const long L = (long)i * G + c; if (L >= nwg) return false;
        int wgid = (int)L; { const int q = nwg / NXCD, r = nwg % NXCD, xcd = wgid % NXCD, off = wgid / NXCD; wgid = (xcd < r ? xcd * (q + 1) : r * (q + 1) + (xcd - r) * q) + off; }
        const int nig = WGM * nN, gid = wgid / nig, fm = gid * WGM, gsz = (nM - fm) < WGM ? (nM - fm) : WGM;
        u.pm = fm + ((wgid % nig) % gsz); u.pn = (wgid % nig) / gsz; return true;
    }
    __device__ __forceinline__ void a_ready(const Unit&) const {}
    __device__ __forceinline__ void done(const Unit&) const {}
};

__device__ __forceinline__ unsigned cvt_pk_bf16(float lo, float hi) { unsigned r; asm volatile("v_cvt_pk_bf16_f32 %0, %1, %2" : "=v"(r) : "v"(lo), "v"(hi)); return r; }
struct EpiBf16 {
    static constexpr bool PERM = true, AFTER_DRAIN = false;
    bf16_t* O; int ldc;
    __device__ __forceinline__ void operator()(const f32x4 (&acc)[2][2][4][2], const Unit& u, int wr, int wc, int fr, int fq) const {
        const int row0 = u.pm * BM + wr * 64 + fr; const int col0 = u.pn * BM + wc * 32 + 8 * fq;
#pragma unroll
        for (int ai = 0; ai < 2; ++ai)
#pragma unroll
            for (int m = 0; m < 4; ++m) { bf16_t* rowp = O + (size_t)(row0 + ai * HALF + m * 16) * ldc + col0;
#pragma unroll
                for (int bj = 0; bj < 2; ++bj) { const f32x4 v0 = acc[ai][bj][m][0], v1 = acc[ai][bj][m][1];
                    u32x4 w; w.x = cvt_pk_bf16(v0[0], v0[1]); w.y = cvt_pk_bf16(v0[2], v0[3]); w.z = cvt_pk_bf16(v1[0], v1[1]); w.w = cvt_pk_bf16(v1[2], v1[3]);
                    *(u32x4*)(rowp + bj * HALF) = w; } }
    }
};
__device__ __forceinline__ float silu_f(float x) { return x * __builtin_amdgcn_rcpf(1.0f + __expf(-x)); }
struct EpiSwiGLU {
    static constexpr bool PERM = true, AFTER_DRAIN = false;
    bf16_t* O; int ldc;
    __device__ __forceinline__ void operator()(const f32x4 (&acc)[2][2][4][2], const Unit& u, int wr, int wc, int fr, int fq) const {
        const int row0 = u.pm * BM + wr * 64 + fr; const int col0 = u.pn * HALF + wc * 32 + 8 * fq;
#pragma unroll
        for (int ai = 0; ai < 2; ++ai)
#pragma unroll
            for (int m = 0; m < 4; ++m) { bf16_t* rowp = O + (size_t)(row0 + ai * HALF + m * 16) * ldc + col0;
                const f32x4 a0 = acc[ai][0][m][0], a1 = acc[ai][0][m][1], u0 = acc[ai][1][m][0], u1 = acc[ai][1][m][1];
                u32x4 w;
                w.x = cvt_pk_bf16(silu_f(a0[0]) * u0[0], silu_f(a0[1]) * u0[1]); w.y = cvt_pk_bf16(silu_f(a0[2]) * u0[2], silu_f(a0[3]) * u0[3]);
                w.z = cvt_pk_bf16(silu_f(a1[0]) * u1[0], silu_f(a1[1]) * u1[1]); w.w = cvt_pk_bf16(silu_f(a1[2]) * u1[2], silu_f(a1[3]) * u1[3]);
                *(u32x4*)rowp = w; }
    }
};
template <class Epi, class Sched, bool ALIGN_EPI = false, bool SP2 = false>
__device__ __forceinline__ void gemm_phase(PG8_LAS unsigned char* lds, const Gemm g, const Sched& S, const Epi& E) {
    int tid_l = threadIdx.x; asm volatile("" : "+v"(tid_l));
    const int tid = tid_l, wid = __builtin_amdgcn_readfirstlane(tid >> 6), lane = tid & 63, wr = wid >> 2, wc = wid & 3, fr = lane & 15, fq = lane >> 4;
    const int K = g.K, nt = K / BK;
    unsigned voffA[2], voffB[2];
#pragma unroll
    for (int i = 0; i < 2; ++i) { int R, C; stage_rc(tid * 16 + i * 8192, R, C); const int Rb = Epi::PERM ? ((R & ~31) + perm32(R & 31)) : R;
        voffA[i] = (unsigned)(R * K + C) * 2u; voffB[i] = (unsigned)(Rb * K + C) * 2u; }
    const size_t kstep = (size_t)(BK * 2);
    const size_t hstep = (size_t)HALF * K * 2;
    const size_t tstep = 2 * hstep;
    const unsigned ldsw = (unsigned)wid * 1024u;
    const int aoff = lds_byte(wr * 64 + fr, fq * 8), boff = lds_byte(wc * 32 + fr, fq * 8);
#define PG8_SA(b, h) (((b) * 2 + (h)) * HTB)
#define PG8_SB(b, h) ((4 + (b) * 2 + (h)) * HTB)
#define PG8_STAGE(bufoff, gbase, voff) do { _Pragma("unroll") for (int _i = 0; _i < 2; ++_i) \
        __builtin_amdgcn_global_load_lds((const unsigned*)((const char*)(gbase) + (voff)[_i]), (PG8_LAS unsigned*)(lds + (bufoff) + ldsw + _i * 8192), 16, 0, 0); } while (0)
#define PG8_LDA(dst, b, h) do { _Pragma("unroll") for (int m = 0; m < 4; ++m) _Pragma("unroll") for (int k = 0; k < 2; ++k) dst[m][k] = *(const PG8_LAS bf16x8*)(lds + PG8_SA(b, h) + aoff + m * 2048 + k * 1024); } while (0)
#define PG8_LDB(dst, b, h) do { _Pragma("unroll") for (int n = 0; n < 2; ++n) _Pragma("unroll") for (int k = 0; k < 2; ++k) dst[n][k] = *(const PG8_LAS bf16x8*)(lds + PG8_SB(b, h) + boff + n * 2048 + k * 1024); } while (0)
#define PG8_MMA(ai, bj, At, Bt) do { __builtin_amdgcn_s_setprio(1); _Pragma("unroll") for (int m = 0; m < 4; ++m) _Pragma("unroll") for (int n = 0; n < 2; ++n) _Pragma("unroll") for (int k = 0; k < 2; ++k) \
        acc[ai][bj][m][n] = __builtin_amdgcn_mfma_f32_16x16x32_bf16(Bt[n][k], At[m][k], acc[ai][bj][m][n], 0, 0, 0); __builtin_amdgcn_s_setprio(0); } while (0)
#define PG8_WAIT_V(n) asm volatile("s_waitcnt vmcnt(" #n ")" ::: "memory")
#define PG8_WAIT_L(n) asm volatile("s_waitcnt lgkmcnt(" #n ")" ::: "memory")
#define PG8_BAR __builtin_amdgcn_s_barrier()
#define PG8_SCHED __builtin_amdgcn_sched_barrier(0)
    Unit cur, nxt; int ui = 0;
    if (!S.next(0, cur)) return;
    f32x4 acc[2][2][4][2];
#pragma unroll
    for (int a = 0; a < 2; ++a)
#pragma unroll
        for (int b = 0; b < 2; ++b)
#pragma unroll
            for (int m = 0; m < 4; ++m)
#pragma unroll
                for (int n = 0; n < 2; ++n) acc[a][b][m][n] = (f32x4){0.f, 0.f, 0.f, 0.f};
    bf16x8 At[4][2], B0[2][2], B1[2][2];
    const char* cA = (const char*)g.A + (size_t)cur.pm * tstep; const char* cB = (const char*)g.Bt + (size_t)cur.pn * tstep;
    S.a_ready(cur);
    if constexpr (SP2) {
        PG8_STAGE(PG8_SB(0, 0), cB, voffB); PG8_STAGE(PG8_SB(0, 1), cB + hstep, voffB); PG8_STAGE(PG8_SA(0, 0), cA, voffA); PG8_STAGE(PG8_SA(0, 1), cA + hstep, voffA);
        if (wr == 1) PG8_BAR;
        PG8_WAIT_V(2); PG8_BAR;
        PG8_STAGE(PG8_SB(1, 0), cB + kstep, voffB); PG8_STAGE(PG8_SA(1, 0), cA + kstep, voffA); PG8_STAGE(PG8_SB(1, 1), cB + hstep + kstep, voffB);
        PG8_WAIT_V(6); PG8_BAR;
    } else {
        PG8_STAGE(PG8_SB(0, 0), cB, voffB); PG8_STAGE(PG8_SA(0, 0), cA, voffA); PG8_STAGE(PG8_SB(0, 1), cB + hstep, voffB); PG8_STAGE(PG8_SA(0, 1), cA + hstep, voffA);
        if (wr == 1) PG8_BAR;
        PG8_WAIT_V(4); PG8_BAR;
        PG8_STAGE(PG8_SB(1, 0), cB + kstep, voffB); PG8_STAGE(PG8_SA(1, 0), cA + kstep, voffA); PG8_STAGE(PG8_SB(1, 1), cB + hstep + kstep, voffB);
        PG8_WAIT_V(6); PG8_BAR;
    }
    for (;;) {
        const bool has_next = S.next(ui + 1, nxt);
        const char* nA = has_next ? (const char*)g.A + (size_t)nxt.pm * tstep : cA; const char* nB = has_next ? (const char*)g.Bt + (size_t)nxt.pn * tstep : cB;
        for (int t = 0; t < nt; t += 2) {
            const bool last = (t == nt - 2);
            const char* a1 = cA + (size_t)(t + 1) * kstep;
            const char* a2 = last ? nA : cA + (size_t)(t + 2) * kstep; const char* b2 = last ? nB : cB + (size_t)(t + 2) * kstep;
            const char* a3 = a2 + kstep; const char* b3 = b2 + kstep;
            if (last && has_next) S.a_ready(nxt);
            if constexpr (SP2) {
            PG8_LDB(B0, 0, 0); PG8_LDB(B1, 0, 1); PG8_SCHED; PG8_LDA(At, 0, 0); PG8_STAGE(PG8_SA(1, 1), a1 + hstep, voffA);
            PG8_WAIT_V(8); PG8_WAIT_L(0); PG8_BAR; PG8_MMA(0, 0, At, B0); PG8_MMA(0, 1, At, B1); PG8_BAR; PG8_SCHED;
            PG8_LDA(At, 0, 1); PG8_STAGE(PG8_SB(0, 0), b2, voffB); PG8_STAGE(PG8_SB(0, 1), b2 + hstep, voffB); PG8_STAGE(PG8_SA(0, 0), a2, voffA);
            PG8_WAIT_V(8); PG8_WAIT_L(0); PG8_BAR; PG8_MMA(1, 0, At, B0); PG8_MMA(1, 1, At, B1); PG8_BAR; PG8_SCHED;
            PG8_LDB(B0, 1, 0); PG8_LDB(B1, 1, 1); PG8_SCHED; PG8_LDA(At, 1, 0); PG8_STAGE(PG8_SA(0, 1), a2 + hstep, voffA);
            PG8_WAIT_V(8); PG8_WAIT_L(0); PG8_BAR; PG8_MMA(0, 0, At, B0); PG8_MMA(0, 1, At, B1); PG8_BAR; PG8_SCHED;
            PG8_LDA(At, 1, 1); PG8_STAGE(PG8_SB(1, 0), b3, voffB); PG8_STAGE(PG8_SB(1, 1), b3 + hstep, voffB); PG8_STAGE(PG8_SA(1, 0), a3, voffA);
            PG8_WAIT_V(8); PG8_WAIT_L(0); PG8_BAR; PG8_MMA(1, 0, At, B0); PG8_MMA(1, 1, At, B1); PG8_BAR; PG8_SCHED;
            } else {
            PG8_LDB(B0, 0, 0); PG8_SCHED; PG8_LDA(At, 0, 0); PG8_STAGE(PG8_SA(1, 1), a1 + hstep, voffA);
            PG8_WAIT_L(8); PG8_BAR; PG8_WAIT_L(0); PG8_MMA(0, 0, At, B0); PG8_BAR; PG8_SCHED;
            PG8_LDB(B1, 0, 1); PG8_STAGE(PG8_SB(0, 0), b2, voffB);
            PG8_BAR; PG8_WAIT_L(0); PG8_MMA(0, 1, At, B1); PG8_BAR;
            PG8_LDA(At, 0, 1); PG8_STAGE(PG8_SA(0, 0), a2, voffA);
            PG8_BAR; PG8_WAIT_L(0); PG8_MMA(1, 0, At, B0); PG8_BAR; PG8_SCHED;
            PG8_STAGE(PG8_SB(0, 1), b2 + hstep, voffB);
            PG8_WAIT_V(6); PG8_BAR; PG8_MMA(1, 1, At, B1); PG8_BAR;
            PG8_LDB(B0, 1, 0); PG8_SCHED; PG8_LDA(At, 1, 0); PG8_STAGE(PG8_SA(0, 1), a2 + hstep, voffA);
            PG8_WAIT_L(8); PG8_BAR; PG8_WAIT_L(0); PG8_MMA(0, 0, At, B0); PG8_BAR; PG8_SCHED;
            PG8_LDB(B1, 1, 1); PG8_STAGE(PG8_SB(1, 0), b3, voffB);
            PG8_BAR; PG8_WAIT_L(0); PG8_MMA(0, 1, At, B1); PG8_BAR;
            PG8_LDA(At, 1, 1); PG8_STAGE(PG8_SA(1, 0), a3, voffA);
            PG8_BAR; PG8_WAIT_L(0); PG8_MMA(1, 0, At, B0); PG8_BAR; PG8_SCHED;
            PG8_STAGE(PG8_SB(1, 1), b3 + hstep, voffB);
            PG8_WAIT_V(6); PG8_BAR; PG8_MMA(1, 1, At, B1); PG8_BAR;
            }
        }
        if constexpr (ALIGN_EPI) { if (wr == 0) PG8_BAR; }
        if constexpr (!Epi::AFTER_DRAIN) { E(acc, cur, wr, wc, fr, fq); S.done(cur); }
        if (!has_next) break;
#pragma unroll
        for (int a = 0; a < 2; ++a)
#pragma unroll
            for (int b = 0; b < 2; ++b)
#pragma unroll
                for (int m = 0; m < 4; ++m)
#pragma unroll
                    for (int n = 0; n < 2; ++n) acc[a][b][m][n] = (f32x4){0.f, 0.f, 0.f, 0.f};
        cur = nxt; cA = nA; cB = nB; ++ui;
        if constexpr (ALIGN_EPI) { if (wr == 1) PG8_BAR; }
    }
    PG8_WAIT_V(0);
    if constexpr (!ALIGN_EPI) { if (wr == 0) PG8_BAR; }
    PG8_BAR;
    if constexpr (Epi::AFTER_DRAIN) { E.fused(acc, cur, wr, wc, fr, fq, lds, wid, lane); S.done(cur); }
#undef PG8_SA
#undef PG8_SB
#undef PG8_STAGE
#undef PG8_LDA
#undef PG8_LDB
#undef PG8_MMA
#undef PG8_WAIT_V
#undef PG8_WAIT_L
#undef PG8_BAR
#undef PG8_SCHED
}
}

constexpr int NB = 8, SEQ = 4096, DM = 1024, NL = 2, CTXL = 256;
constexpr int NLAT = NB * SEQ, NCTX = NB * CTXL, NROW = NLAT + NCTX;
constexpr int DFF = 2816, NPJ = 2816, INW = 2824, NMODW = 9 * DM;
constexpr float LN_EPS = 1e-5f, ALPHA = 1.41421356237f;
constexpr int C_AQ = 0, C_AK = 256, C_AV = 384, C_BZ = 512, C_BX = 768, C_CQ = 1536, C_CK = 1792, C_CV = 1920, C_DQ = 2048, C_DK = 2304, C_DV = 2560;
constexpr int C_DTSRC = 1536;
constexpr size_t MiB = 1u << 20;
constexpr size_t WS_MOD = 0;
constexpr size_t WS_DT = 1 * MiB;
constexpr size_t WS_W = 4 * MiB, WS_WL = 41 * MiB;
constexpr size_t WO_W1A = 0, WO_W2A = 11 * MiB, WO_WIN = 16 * MiB + MiB / 2, WO_WOUT = 22 * MiB, WO_W1B = 24 * MiB, WO_W2B = 35 * MiB;
constexpr size_t WS_A = 86 * MiB;
constexpr size_t WS_ACT = 154 * MiB;
constexpr size_t WS_U = 341 * MiB;
constexpr size_t WS_O = 392 * MiB;
constexpr size_t WS_XC = 460 * MiB;
constexpr size_t WS_Y = 468 * MiB;
constexpr size_t WS_END = 512 * MiB;
constexpr int RING_BYTES = 131072, ROPE_OFF = RING_BYTES, LDS_BYTES = 147456;
constexpr int NWAVES = 8;
constexpr bool GEMM_SP2 = true;

#define LAS __attribute__((address_space(3)))
#define DI __device__ __forceinline__
typedef unsigned short bf16;
typedef unsigned v4u __attribute__((ext_vector_type(4)));
typedef unsigned v2u __attribute__((ext_vector_type(2)));
typedef float f32x4 __attribute__((ext_vector_type(4)));

DI float bf2f(unsigned b) { return __uint_as_float(b << 16); }
DI float bflo(unsigned w) { return __uint_as_float(w << 16); }
DI float bfhi(unsigned w) { return __uint_as_float(w & 0xffff0000u); }
DI unsigned f2bf(float f) { unsigned u = __float_as_uint(f); return (u + 0x7fffu + ((u >> 16) & 1u)) >> 16; }
DI unsigned pk2(float lo, float hi) { return f2bf(lo) | (f2bf(hi) << 16); }
typedef float f32x2_t __attribute__((ext_vector_type(2))); typedef __bf16 bf16x2_t __attribute__((ext_vector_type(2)));
DI unsigned cvtpk(float lo, float hi) { f32x2_t v = {lo, hi}; bf16x2_t b = __builtin_convertvector(v, bf16x2_t); return __builtin_bit_cast(unsigned, b); }
DI float dpp_f(float v, const int ctrl_unused) { return v; }
#define DPP_ADD(v_, ctrl_) ((v_) + __builtin_bit_cast(float, __builtin_amdgcn_update_dpp(0, __builtin_bit_cast(int, (v_)), (ctrl_), 0xf, 0xf, false)))
DI float wave_sum(float v) {
    v = DPP_ADD(v, 0xB1);
    v = DPP_ADD(v, 0x4E);
    v = DPP_ADD(v, 0x141);
    v = DPP_ADD(v, 0x140);
    const int vi = __builtin_bit_cast(int, v);
    const float r0 = __builtin_bit_cast(float, __builtin_amdgcn_readlane(vi, 0)), r1 = __builtin_bit_cast(float, __builtin_amdgcn_readlane(vi, 16));
    const float r2 = __builtin_bit_cast(float, __builtin_amdgcn_readlane(vi, 32)), r3 = __builtin_bit_cast(float, __builtin_amdgcn_readlane(vi, 48));
    return (r0 + r1) + (r2 + r3);
}
DI float silu(float x) { return x * __builtin_amdgcn_rcpf(1.0f + __expf(-x)); }

struct Args { const float* in[24]; float* out; unsigned char* ws; };
typedef const __attribute__((address_space(4))) Args* KArgs;
DI KArgs kargs() { KArgs p = (KArgs)__builtin_amdgcn_kernarg_segment_ptr(); asm volatile("" : "+s"(p)); return p; }

struct Frame {
    LAS unsigned char* lds;
    int tid, lane, wave, G, gw, ngw;
};
DI Frame mkframe() { Frame F; extern __shared__ __attribute__((aligned(16))) unsigned char lds_base[]; F.lds = (LAS unsigned char*)lds_base;
    int t = threadIdx.x; asm volatile("" : "+v"(t)); F.tid = t; F.lane = t & 63; F.wave = __builtin_amdgcn_readfirstlane(t >> 6);
    F.G = gridDim.x; F.gw = blockIdx.x * NWAVES + F.wave; F.ngw = F.G * NWAVES; return F; }
DI bf16* wbuf(KArgs KA, int l, size_t off) { return (bf16*)((KA->ws) + WS_W + (size_t)l * WS_WL + off); }

DI void transpose_item(const float* W, int ldw, int k0, int n0, bf16* WT, int ldt, int drow0, LAS float* scr, int lane) {
    float tv[32];
#pragma unroll
    for (int i = 0; i < 32; ++i) tv[i] = W[(size_t)(k0 + 2 * i + (lane >> 5)) * ldw + n0 + (lane & 31)];
#pragma unroll
    for (int i = 0; i < 32; ++i) scr[(2 * i + (lane >> 5)) * 33 + (lane & 31)] = tv[i];
    asm volatile("s_waitcnt lgkmcnt(0)" ::: "memory");
    const int c = lane & 7;
#pragma unroll
    for (int j = 0; j < 4; ++j) { const int n = (lane >> 3) + 8 * j; const LAS float* s = scr + (8 * c) * 33 + n;
        v4u o; o.x = pk2(s[0 * 33], s[1 * 33]); o.y = pk2(s[2 * 33], s[3 * 33]); o.z = pk2(s[4 * 33], s[5 * 33]); o.w = pk2(s[6 * 33], s[7 * 33]);
        *(v4u*)(WT + (size_t)(drow0 + n) * ldt + k0 + 8 * c) = o; }
    asm volatile("s_waitcnt lgkmcnt(0)" ::: "memory");
}
DI void p0a() {
    KArgs KA = kargs(); Frame F = mkframe();
    {
        LAS float* sv = (LAS float*)F.lds;
        for (int it = blockIdx.x; it < NL * 16 * 9; it += F.G) {
            const int l = it / 144, kc = (it % 144) / 9, cb = it % 9;
            __syncthreads();
            for (int i = F.tid; i < 576; i += 512) { const int r = i >> 6, kk = i & 63; const float v = r < 8 ? KA->in[1][r * DM + kc * 64 + kk] : KA->in[3][kc * 64 + kk]; sv[i] = silu(v); }
            __syncthreads();
            const int cg4 = F.tid & 255, kh = F.tid >> 8, col = cb * 1024 + 4 * cg4;
            f32x4 acc[9];
#pragma unroll
            for (int r = 0; r < 9; ++r) acc[r] = (f32x4){0.f, 0.f, 0.f, 0.f};
            const float* wp = KA->in[4] + ((size_t)l * DM + kc * 64 + kh * 32) * NMODW + col;
#pragma unroll 8
            for (int kk = 0; kk < 32; ++kk) { const f32x4 w = *(const f32x4*)(wp + (size_t)kk * NMODW);
#pragma unroll
                for (int r = 0; r < 9; ++r) acc[r] += w * sv[r * 64 + kh * 32 + kk]; }
#pragma unroll
            for (int r = 0; r < 9; ++r) *(f32x4*)(((float*)(KA->ws + WS_ACT)) + ((size_t)(l * 32 + kc * 2 + kh) * 9 + r) * NMODW + col) = acc[r];
        }
        __syncthreads();
    }
    LAS float* scr = (LAS float*)(F.lds + F.wave * 16384);
    constexpr int I1 = 16 * 176, I2 = 44 * 32, I3 = 16 * 88, I4 = 16 * 32, IL = 2 * I1 + 2 * I2 + I3 + I4;
    for (int it = F.gw; it < NL * IL; it += F.ngw) {
        const int l = it / IL; int r = it % IL;
        if (r < I1 || (r >= I1 + I2 + I3 + I4 && r < 2 * I1 + I2 + I3 + I4)) {
            const bool second = r >= I1; if (second) r -= I1 + I2 + I3 + I4;
            const int kb = r / 176, nb = r % 176, n0 = nb * 32;
            const int drow = n0 < DFF ? 256 * (n0 >> 7) + (n0 & 127) : 256 * ((n0 - DFF) >> 7) + 128 + ((n0 - DFF) & 127);
            transpose_item((second ? KA->in[22] : KA->in[8]) + (size_t)l * DM * 2 * DFF, 2 * DFF, kb * 64, n0, wbuf(KA, l, second ? WO_W1B : WO_W1A), DM, drow, scr, F.lane);
            continue; }
        r -= I1;
        if (r < I2) { const int kb = r / 32, nb = r % 32; transpose_item(KA->in[9] + (size_t)l * DFF * DM, DM, kb * 64, nb * 32, wbuf(KA, l, WO_W2A), DFF, nb * 32, scr, F.lane); continue; }
        r -= I2;
        if (r < I3) { const int kb = r / 88, nb = r % 88; const int n0 = nb < 48 ? nb * 32 : 1544 + (nb - 48) * 32;
            transpose_item(KA->in[10] + (size_t)l * DM * INW, INW, kb * 64, n0, wbuf(KA, l, WO_WIN), DM, nb * 32, scr, F.lane); continue; }
        r -= I3;
        if (r < I4) { const int kb = r / 32, nb = r % 32; transpose_item(KA->in[11] + (size_t)l * DM * DM, DM, kb * 64, nb * 32, wbuf(KA, l, WO_WOUT), DM, nb * 32, scr, F.lane); continue; }
        r -= I4 + I1;
        { const int kb = r / 32, nb = r % 32; transpose_item(KA->in[23] + (size_t)l * DFF * DM, DM, kb * 64, nb * 32, wbuf(KA, l, WO_W2B), DFF, nb * 32, scr, F.lane); }
    }
}
DI void p0b() {
    KArgs KA = kargs(); Frame F = mkframe();
    for (int i = blockIdx.x * 512 + F.tid; i < NL * 9 * NMODW; i += F.G * 512) {
        const int l = i / (9 * NMODW), rr = (i / NMODW) % 9, n = i % NMODW;
        float s = KA->in[5][l * NMODW + n];
        for (int p = 0; p < 32; ++p) s += ((float*)(KA->ws + WS_ACT))[((size_t)(l * 32 + p) * 9 + rr) * NMODW + n];
        ((float*)(KA->ws + WS_MOD))[i] = s;
    }
}
DI const float* modp(KArgs KA, int l, int mb, int idx) { return ((float*)(KA->ws + WS_MOD)) + ((size_t)(l * 9 + mb) * 9 + idx) * DM; }
DI void p0c() {
    KArgs KA = kargs(); Frame F = mkframe();
    for (int row = F.gw; row < NROW; row += F.ngw) {
        const int mb = row < NLAT ? (row >> 12) : 8;
        const float* src = row < NLAT ? KA->in[0] + (size_t)row * DM : KA->in[2] + (size_t)(row - NLAT) * DM;
        const float* sh = modp(KA, 0, mb, 0); const float* sc = modp(KA, 0, mb, 1);
#pragma unroll
        for (int j = 0; j < 4; ++j) { const int n = 4 * F.lane + 256 * j; const f32x4 v = *(const f32x4*)(src + n);
            const f32x4 a = v * (1.0f + *(const f32x4*)(sc + n)) + *(const f32x4*)(sh + n);
            v2u w; w.x = pk2(a.x, a.y); w.y = pk2(a.z, a.w); *(v2u*)(((bf16*)(KA->ws + WS_A)) + (size_t)row * DM + n) = w; }
    }
}
DI void ln_pass(int l, int gidx, float gmul, int lnidx, int nl, int nsh, int row0, int nrows, int wg0, int nwgs, const bool DTP) {
    KArgs KA = kargs(); Frame F = mkframe();
    const int nwv_ = nwgs * NWAVES, per_ = (nrows - row0 + nwv_ - 1) / nwv_;
    F.gw = row0 + (((int)blockIdx.x - wg0) * NWAVES + F.wave) * per_; F.ngw = 1;
    const int rend = min(F.gw + per_, nrows);
    LAS float* wdt = (LAS float*)F.lds;
    if (DTP) { __syncthreads(); for (int i = F.tid; i < 8192; i += 512) wdt[i] = KA->in[10][((size_t)l * DM + (i >> 3)) * INW + C_DTSRC + (i & 7)]; __syncthreads(); }
    const float* g = KA->in[6] + (l * 3 + lnidx) * DM; const float* bb = KA->in[7] + (l * 3 + lnidx) * DM;
    float* const xlat = KA->out; float* const xctx = (float*)(KA->ws + WS_XC); const bf16* const fbase = (const bf16*)(KA->ws + WS_O);
    const bool fromin = (l == 0 && lnidx == 0);
    const float* const slat = fromin ? KA->in[0] : (const float*)xlat; const float* const sctx = fromin ? KA->in[2] : (const float*)xctx;
    f32x4 g4[4], b4[4];
#pragma unroll
    for (int j = 0; j < 4; ++j) { g4[j] = *(const f32x4*)(g + 4 * F.lane + 256 * j); b4[j] = *(const f32x4*)(bb + 4 * F.lane + 256 * j); }
    f32x4 xn[4]; v2u fn[4];
    if (F.gw < rend) { const int row = F.gw; const float* xr = row < NLAT ? slat + (size_t)row * DM : sctx + (size_t)(row - NLAT) * DM;
#pragma unroll
        for (int j = 0; j < 4; ++j) { const int n = 4 * F.lane + 256 * j; xn[j] = *(const f32x4*)(xr + n); fn[j] = *(const v2u*)(fbase + (size_t)row * DM + n); } }
    f32x4 gt4[4], sh4[4], sc4[4]; int cur_mb = -1;
    for (int row = F.gw; row < rend; row += F.ngw) {
        const int mb = row < NLAT ? (row >> 12) : 8;
        if (mb != cur_mb) { cur_mb = mb;
#pragma unroll
            for (int j = 0; j < 4; ++j) { const int n = 4 * F.lane + 256 * j; gt4[j] = *(const f32x4*)(modp(KA, l, mb, gidx) + n) * gmul;
                if (nsh >= 0) { sc4[j] = 1.0f + *(const f32x4*)(modp(KA, nl, mb, nsh + 1) + n); sh4[j] = *(const f32x4*)(modp(KA, nl, mb, nsh) + n); } } }
        float* xrow = row < NLAT ? xlat + (size_t)row * DM : xctx + (size_t)(row - NLAT) * DM;
        f32x4 v[4]; float s = 0.f;
#pragma unroll
        for (int j = 0; j < 4; ++j) { const f32x4 fv = (f32x4){bflo(fn[j].x), bfhi(fn[j].x), bflo(fn[j].y), bfhi(fn[j].y)};
            v[j] = xn[j] * ALPHA + gt4[j] * fv; s += (v[j].x + v[j].y) + (v[j].z + v[j].w); }
        { const int nrow = row + F.ngw;
          if (nrow < rend) { const float* xr = nrow < NLAT ? slat + (size_t)nrow * DM : sctx + (size_t)(nrow - NLAT) * DM;
#pragma unroll
            for (int j = 0; j < 4; ++j) { const int n = 4 * F.lane + 256 * j; xn[j] = *(const f32x4*)(xr + n); fn[j] = *(const v2u*)(fbase + (size_t)nrow * DM + n); } } }
        const float mean = wave_sum(s) * (1.f / DM); float s2 = 0.f;
#pragma unroll
        for (int j = 0; j < 4; ++j) { v[j] = v[j] - mean; s2 += (v[j].x * v[j].x + v[j].y * v[j].y) + (v[j].z * v[j].z + v[j].w * v[j].w); }
        const float rstd = __builtin_amdgcn_rsqf(wave_sum(s2) * (1.f / DM) + LN_EPS);
        float dt[8];
#pragma unroll
        for (int q = 0; q < 8; ++q) dt[q] = 0.f;
#pragma unroll
        for (int j = 0; j < 4; ++j) { const int n = 4 * F.lane + 256 * j;
            const f32x4 y = v[j] * rstd * g4[j] + b4[j];
            *(f32x4*)(xrow + n) = y;
            if (nsh >= 0) { const f32x4 a = y * sc4[j] + sh4[j];
                v2u w; w.x = cvtpk(a.x, a.y); w.y = cvtpk(a.z, a.w); *(v2u*)(((bf16*)(KA->ws + WS_A)) + (size_t)row * DM + n) = w;
                if (DTP) {
#pragma unroll
                    for (int e = 0; e < 4; ++e) { const f32x4 w0 = *(const LAS f32x4*)(wdt + (n + e) * 8), w1 = *(const LAS f32x4*)(wdt + (n + e) * 8 + 4); const float ae = a[e];
                        dt[0] += ae * w0.x; dt[1] += ae * w0.y; dt[2] += ae * w0.z; dt[3] += ae * w0.w; dt[4] += ae * w1.x; dt[5] += ae * w1.y; dt[6] += ae * w1.z; dt[7] += ae * w1.w; } } }
        }
        if (DTP) {
#pragma unroll
            for (int q = 0; q < 8; ++q) dt[q] = wave_sum(dt[q]);
            if (F.lane == 0) { *(f32x4*)(((float*)(KA->ws + WS_DT)) + (size_t)row * 8) = (f32x4){dt[0], dt[1], dt[2], dt[3]}; *(f32x4*)(((float*)(KA->ws + WS_DT)) + (size_t)row * 8 + 4) = (f32x4){dt[4], dt[5], dt[6], dt[7]}; }
        }
    }
}
DI void prep_pass(int l) {
    KArgs KA = kargs(); Frame F = mkframe();
    const LAS float* rc = (const LAS float*)(F.lds + ROPE_OFF); const LAS float* rsn = rc + 1024;
    bf16* P = (bf16*)(KA->ws + WS_ACT); bf16* U = (bf16*)(KA->ws + WS_U); float* DTB = (float*)(KA->ws + WS_DT);
    const int hv = F.lane >> 5, s = F.lane & 31, hsub = s >> 3, ra = (s >> 2) & 1, ig = s & 3, d1 = ra * 32 + 4 * ig, d2 = d1 + 16;
    constexpr int NBLK = NROW / 8;
    for (int item = F.gw; item < 4 * NBLK; item += F.ngw) {
        const int part = item / NBLK, rb = item - part * NBLK;
        const int row8 = rb * 8; const bool lat = row8 < NLAT;
        if (part == 0) {
#pragma unroll
        for (int rr = 0; rr < 4; ++rr) {
            const int row = row8 + 2 * rr + hv; const int t = row & 4095;
            const int pos = ra == 0 ? (t >> 6) : (t & 63);
            const f32x4 cs = *(const LAS f32x4*)(rc + pos * 16 + 4 * ig), sn = *(const LAS f32x4*)(rsn + pos * 16 + 4 * ig);
            bf16* pr = P + (size_t)row * NPJ;
#pragma unroll
            for (int it = 0; it < 3; ++it) {
                const int hh = it * 4 + hsub;
                const bool isc = hh >= 6; const int h6 = isc ? hh - 6 : hh;
                const int col = (isc ? (h6 < 4 ? C_CQ + h6 * 64 : C_CK + (h6 - 4) * 64) : (h6 < 4 ? C_AQ + h6 * 64 : C_AK + (h6 - 4) * 64));
                const v2u w1 = *(const v2u*)(pr + col + d1), w2 = *(const v2u*)(pr + col + d2);
                f32x4 x1 = (f32x4){bflo(w1.x), bfhi(w1.x), bflo(w1.y), bfhi(w1.y)}, x2 = (f32x4){bflo(w2.x), bfhi(w2.x), bflo(w2.y), bfhi(w2.y)};
                float ss = (x1.x * x1.x + x1.y * x1.y) + (x1.z * x1.z + x1.w * x1.w) + (x2.x * x2.x + x2.y * x2.y) + (x2.z * x2.z + x2.w * x2.w);
                ss = DPP_ADD(ss, 0xB1); ss = DPP_ADD(ss, 0x4E); ss = DPP_ADD(ss, 0x141);
                if (isc) { const float r = (h6 < 4 ? 0.125f * 1.4426950408889634f : 1.0f) * __builtin_amdgcn_rsqf(ss * (1.f / 64.f) + LN_EPS); const float* gn = (h6 < 4 ? KA->in[19] : KA->in[20]) + l * 64;
                    x1 = x1 * r * *(const f32x4*)(gn + d1); x2 = x2 * r * *(const f32x4*)(gn + d2); }
                if (lat) { const f32x4 y1 = x1 * cs - x2 * sn, y2 = x1 * sn + x2 * cs; x1 = y1; x2 = y2; }
                if (isc || lat) { v2u o1, o2; o1.x = cvtpk(x1.x, x1.y); o1.y = cvtpk(x1.z, x1.w); o2.x = cvtpk(x2.x, x2.y); o2.y = cvtpk(x2.z, x2.w);
                    *(v2u*)(pr + col + d1) = o1; *(v2u*)(pr + col + d2) = o2; }
            }
        }
        { const int row = row8 + (F.lane >> 3), q = F.lane & 7; const float v = DTB[(size_t)row * 8 + q] + KA->in[16][l * 8 + q]; DTB[(size_t)row * 8 + q] = fmaxf(v, 0.f) + log1pf(__expf(-fabsf(v))); }
        } else {
        const int Ls = lat ? SEQ : CTXL; const int tt0 = lat ? (row8 & 4095) : ((row8 - NLAT) & 255);
        { const int j = part - 1; const int ch = 4 * F.lane + 256 * j;
            const f32x4 bias = *(const f32x4*)(KA->in[15] + l * 768 + ch);
            f32x4 cw[5];
#pragma unroll
            for (int k = 0; k < 5; ++k) cw[k] = *(const f32x4*)(KA->in[14] + (l * 5 + k) * 768 + ch);
            f32x4 xw[12];
#pragma unroll
            for (int q = 0; q < 12; ++q) { const int t2 = tt0 + q - 2;
                if (t2 >= 0 && t2 < Ls) { const v2u w = *(const v2u*)(P + (size_t)(row8 + q - 2) * NPJ + C_BX + ch); xw[q] = (f32x4){bflo(w.x), bfhi(w.x), bflo(w.y), bfhi(w.y)}; }
                else xw[q] = (f32x4){0.f, 0.f, 0.f, 0.f}; }
#pragma unroll
            for (int q = 0; q < 8; ++q) { f32x4 acc = bias;
#pragma unroll
                for (int k = 0; k < 5; ++k) acc += cw[k] * xw[q + k];
                v2u o; o.x = cvtpk(silu(acc.x), silu(acc.y)); o.y = cvtpk(silu(acc.z), silu(acc.w)); *(v2u*)(U + (size_t)(row8 + q) * 768 + ch) = o; }
        }
        }
    }
}
DI void nkey(const float (&q)[64], float (&o)[64], float& m, float& l, const bf16* kr, const bf16* vr, float bias) {
    float s = bias;
#pragma unroll
    for (int c = 0; c < 8; ++c) { const v4u w = *(const v4u*)(kr + 8 * c);
        s += q[8 * c] * bflo(w.x) + q[8 * c + 1] * bfhi(w.x) + q[8 * c + 2] * bflo(w.y) + q[8 * c + 3] * bfhi(w.y) + q[8 * c + 4] * bflo(w.z) + q[8 * c + 5] * bfhi(w.z) + q[8 * c + 6] * bflo(w.w) + q[8 * c + 7] * bfhi(w.w); }
    const float mn = fmaxf(m, s), cf = __expf(m - mn), p = __expf(s - mn);
    l = l * cf + p; m = mn;
#pragma unroll
    for (int c = 0; c < 8; ++c) { const v4u w = *(const v4u*)(vr + 8 * c);
        o[8 * c] = o[8 * c] * cf + p * bflo(w.x); o[8 * c + 1] = o[8 * c + 1] * cf + p * bfhi(w.x); o[8 * c + 2] = o[8 * c + 2] * cf + p * bflo(w.y); o[8 * c + 3] = o[8 * c + 3] * cf + p * bfhi(w.y);
        o[8 * c + 4] = o[8 * c + 4] * cf + p * bflo(w.z); o[8 * c + 5] = o[8 * c + 5] * cf + p * bfhi(w.z); o[8 * c + 6] = o[8 * c + 6] * cf + p * bflo(w.w); o[8 * c + 7] = o[8 * c + 7] * cf + p * bfhi(w.w); }
}
template <int TYPE>
DI void naive_attn(int l, int row, int h, bool ctxq) {
    KArgs KA = kargs(); Frame F = mkframe();
    const bf16* P = ((bf16*)(KA->ws + WS_ACT));
    const int qcol = (TYPE == 0 ? C_AQ : TYPE == 1 ? C_CQ : C_DQ) + h * 64;
    const int kvh = TYPE == 2 ? h : (h >> 1);
    const int kcol = (TYPE == 0 ? C_AK : TYPE == 1 ? C_CK : C_DK) + kvh * 64, vcol = (TYPE == 0 ? C_AV : TYPE == 1 ? C_CV : C_DV) + kvh * 64;
    float q[64], o[64]; float m = -1e30f, ls = 0.f;
#pragma unroll
    for (int c = 0; c < 8; ++c) { const v4u w = *(const v4u*)(P + (size_t)row * NPJ + qcol + 8 * c);
        q[8 * c] = 0.125f * bflo(w.x); q[8 * c + 1] = 0.125f * bfhi(w.x); q[8 * c + 2] = 0.125f * bflo(w.y); q[8 * c + 3] = 0.125f * bfhi(w.y);
        q[8 * c + 4] = 0.125f * bflo(w.z); q[8 * c + 5] = 0.125f * bfhi(w.z); q[8 * c + 6] = 0.125f * bflo(w.w); q[8 * c + 7] = 0.125f * bfhi(w.w); }
#pragma unroll
    for (int d = 0; d < 64; ++d) o[d] = 0.f;
    int b;
    if (!ctxq) {
        b = row >> 12; const int t = row & 4095;
        if (TYPE == 0) { const int k0 = max(t - 128, 0), k1 = min(t + 128, SEQ - 1);
            for (int k = k0; k <= k1; ++k) { const bf16* kp = P + (size_t)(b * SEQ + k) * NPJ; nkey(q, o, m, ls, kp + kcol, kp + vcol, 0.f); } }
        else if (TYPE == 1) { for (int k = 0; k < SEQ; ++k) { const bf16* kp = P + (size_t)(b * SEQ + k) * NPJ; nkey(q, o, m, ls, kp + kcol, kp + vcol, 0.f); } }
        else { const int r = t >> 6, c = t & 63; const int rs = min(max(r - 4, 0), 56), cs = min(max(c - 8, 0), 48);
            for (int a = 0; a < 8; ++a) { const float* bp = KA->in[21] + ((size_t)(l * 4 + h) * 15 + (rs + a - r + 7)) * 31 + (cs - c + 15);
                for (int k = 0; k < 16; ++k) { const bf16* kp = P + (size_t)(b * SEQ + (rs + a) * 64 + cs + k) * NPJ; nkey(q, o, m, ls, kp + kcol, kp + vcol, bp[k]); } } }
    } else b = (row - NLAT) >> 8;
    for (int k = 0; k < CTXL; ++k) { const bf16* kp = P + (size_t)(NLAT + b * CTXL + k) * NPJ; nkey(q, o, m, ls, kp + kcol, kp + vcol, 0.f); }
    if (TYPE == 0) { const float sk = KA->in[13][l * 4 + h]; const float mn = fmaxf(m, sk), cf = __expf(m - mn); ls = ls * cf + __expf(sk - mn);
#pragma unroll
        for (int d = 0; d < 64; ++d) o[d] *= cf; }
    const float inv = 1.f / ls;
    bf16* op = ((bf16*)(KA->ws + WS_O)) + (size_t)row * DM + (TYPE == 0 ? 0 : TYPE == 1 ? 512 : 768) + h * 64;
#pragma unroll
    for (int c = 0; c < 8; ++c) { v4u w; w.x = pk2(o[8 * c] * inv, o[8 * c + 1] * inv); w.y = pk2(o[8 * c + 2] * inv, o[8 * c + 3] * inv); w.z = pk2(o[8 * c + 4] * inv, o[8 * c + 5] * inv); w.w = pk2(o[8 * c + 6] * inv, o[8 * c + 7] * inv);
        *(v4u*)(op + 8 * c) = w; }
}
DI void naive_ssd(int l, int item) {
    KArgs KA = kargs(); Frame F = mkframe();
    const int b = item >> 3, dir = (item >> 2) & 1, h = item & 3, g = h >> 1;
    const int p = F.tid >> 3, ng = F.tid & 7;
    const float A = -__expf(KA->in[17][l * 8 + dir * 4 + h]);
    bf16* Y = dir ? (((bf16*)(KA->ws + WS_Y) + (size_t)NROW * 256)) : ((bf16*)(KA->ws + WS_Y));
    float hs[16];
#pragma unroll
    for (int i = 0; i < 16; ++i) hs[i] = 0.f;
    for (int ph = 0; ph < 2; ++ph) {
        const int ns = ph ? SEQ : CTXL, base = ph ? b * SEQ : NLAT + b * CTXL;
#pragma unroll 4
        for (int s = 0; s < ns; ++s) {
            const int row = base + (dir ? ns - 1 - s : s);
            const float dt = ((float*)(KA->ws + WS_DT))[(size_t)row * 8 + dir * 4 + h];
            const bf16* ur = ((bf16*)(KA->ws + WS_U)) + (size_t)row * 768;
            const float xv = bf2f(ur[h * 64 + p]);
            const v4u b0 = *(const v4u*)(ur + 256 + g * 128 + ng * 16), b1 = *(const v4u*)(ur + 256 + g * 128 + ng * 16 + 8);
            const v4u c0 = *(const v4u*)(ur + 512 + g * 128 + ng * 16), c1 = *(const v4u*)(ur + 512 + g * 128 + ng * 16 + 8);
            const float dA = __expf(dt * A), dx = dt * xv;
            const unsigned bw[8] = {b0.x, b0.y, b0.z, b0.w, b1.x, b1.y, b1.z, b1.w}, cw[8] = {c0.x, c0.y, c0.z, c0.w, c1.x, c1.y, c1.z, c1.w};
            float y = 0.f;
#pragma unroll
            for (int i = 0; i < 8; ++i) { hs[2 * i] = hs[2 * i] * dA + dx * bflo(bw[i]); hs[2 * i + 1] = hs[2 * i + 1] * dA + dx * bfhi(bw[i]); y += bflo(cw[i]) * hs[2 * i] + bfhi(cw[i]) * hs[2 * i + 1]; }
            y += __shfl_xor(y, 1); y += __shfl_xor(y, 2); y += __shfl_xor(y, 4);
            if (ng == 0) Y[(size_t)row * 256 + h * 64 + p] = (bf16)f2bf(y);
        }
    }
}
DI void mixers_naive(int l, bool last) {
    Frame F = mkframe();
    const int nAttL = 64 * 12, nAttC = last ? 0 : 4 * 12, nItems = 64 + nAttL + nAttC;
    for (int it = blockIdx.x; it < nItems; it += F.G) {
        if (it < 64) { naive_ssd(l, it); continue; }
        int r = it - 64; bool cq = false; int rowbase;
        if (r >= nAttL) { r -= nAttL; cq = true; }
        const int rb = r / 12, ty = (r % 12) >> 2, h = r & 3;
        rowbase = cq ? NLAT + rb * 512 : rb * 512;
        const int row = rowbase + F.tid;
        if (ty == 0) naive_attn<0>(l, row, h, cq); else if (ty == 1) naive_attn<1>(l, row, h, cq); else naive_attn<2>(l, row, h, cq);
    }
}
typedef float f32x16 __attribute__((ext_vector_type(16)));
typedef short s16x4 __attribute__((ext_vector_type(4)));
typedef short bf16x8v __attribute__((ext_vector_type(8)));
typedef short v4i16_t __attribute__((ext_vector_type(4)));
DI s16x4 vtr(const LAS unsigned char* p) { return __builtin_bit_cast(s16x4, __builtin_amdgcn_ds_read_tr16_b64_v4i16((LAS v4i16_t*)p)); }
DI int crow16(int i, int h) { return (i & 3) + 8 * (i >> 2) + 4 * h; }
constexpr int AT_KRS = 144, AT_VRS = 192, AT_KB = 64 * AT_KRS, AT_BUF = AT_KB + 64 * AT_VRS, AT_RPB = 2 * AT_BUF;
constexpr float LOG2E = 1.4426950408889634f, AT_SC = 0.125f * LOG2E;
template <int TYPE>
DI void attn_unit(KArgs KA, const Frame& F, int l, int unit, bool ctxq) {
    const bf16* P = (const bf16*)(KA->ws + WS_ACT);
    const int L = F.lane, w = F.wave, r = L & 31, h2 = L >> 5, i16 = L & 15;
    int b, head, kvh, p0, qpos0, t0 = 0, nloc = 0;
    if (TYPE != 2) { int g, pb; if (!ctxq) { b = unit >> 6; g = (unit >> 5) & 1; pb = unit & 31; } else { b = unit >> 2; g = (unit >> 1) & 1; pb = unit & 1; }
        head = 2 * g + (w >> 2); kvh = g; p0 = pb * 128; qpos0 = p0 + 32 * (w & 3);
        if (!ctxq) { if (TYPE == 1) { t0 = 0; nloc = 64; } else { t0 = max(0, 2 * (pb - 1)); nloc = min(64, 2 * (pb + 2)) - t0; } } }
    else { int rb; if (!ctxq) { b = unit >> 6; head = (unit >> 4) & 3; rb = unit & 15; } else { b = unit >> 2; head = unit & 3; rb = 0; }
        kvh = head; p0 = rb * 256; qpos0 = p0 + 32 * w;
        if (!ctxq) { const int r0 = rb * 4; t0 = min(max(r0 - 4, 0), 56); nloc = min(max(r0 - 1, 0), 56) + 8 - t0; } }
    const int qcol = (TYPE == 0 ? C_AQ : TYPE == 1 ? C_CQ : C_DQ) + head * 64;
    const int kcol = (TYPE == 0 ? C_AK : TYPE == 1 ? C_CK : C_DK) + kvh * 64, vcol = (TYPE == 0 ? C_AV : TYPE == 1 ? C_CV : C_DV) + kvh * 64;
    const int qrow = (ctxq ? NLAT + b * CTXL : b * SEQ) + qpos0 + r;
    const int nt = nloc + 4;
    bf16x8v qf[4];
#pragma unroll
    for (int ks = 0; ks < 4; ++ks) qf[ks] = *(const bf16x8v*)(P + (size_t)qrow * NPJ + qcol + ks * 16 + 8 * h2);
    LAS unsigned char* lb = F.lds;
    if (TYPE == 2) { LAS float* rp = (LAS float*)(lb + AT_RPB); for (int i = F.tid; i < 465; i += 512) rp[i] = KA->in[21][(size_t)(l * 4 + head) * 465 + i] * 8.0f; }
    const int srow = F.tid >> 3, sch = F.tid & 7;
#define TILE_ROW0(i) ((i) < nloc ? b * SEQ + (t0 + (i)) * 64 : NLAT + b * CTXL + ((i) - nloc) * 64)
    v4u kreg, vreg;
    { const bf16* src = P + (size_t)(TILE_ROW0(0) + srow) * NPJ; kreg = *(const v4u*)(src + kcol + sch * 8); vreg = *(const v4u*)(src + vcol + sch * 8); }
    *(LAS v4u*)(lb + srow * AT_KRS + sch * 16) = kreg; *(LAS v4u*)(lb + AT_KB + srow * AT_VRS + sch * 16) = vreg;
    __syncthreads();
    f32x16 oacc[2];
#pragma unroll
    for (int i = 0; i < 16; ++i) { oacc[0][i] = 0.f; oacc[1][i] = 0.f; }
    float m = -1e30f, lsum = 0.f;
    if (TYPE == 1) {
        float gq = fabsf(KA->in[19][l * 64 + L]), gk = fabsf(KA->in[20][l * 64 + L]);
#pragma unroll
        for (int o = 1; o < 64; o <<= 1) { gq = fmaxf(gq, __shfl_xor(gq, o)); gk = fmaxf(gk, __shfl_xor(gk, o)); }
        m = 64.0f * 1.03f * gq * gk * AT_SC;
    }
    const int qpos = qpos0 + r;
    const int gr = qpos0 >> 6, rs = min(max(gr - 4, 0), 56), qc = qpos & 63, cs = min(max(qc - 8, 0), 48);
    for (int i = 0; i < nt; ++i) {
        const LAS unsigned char* kb_ = lb + (i & 1) * AT_BUF; const LAS unsigned char* vb_ = kb_ + AT_KB;
        if (i + 1 < nt) { const bf16* src = P + (size_t)(TILE_ROW0(i + 1) + srow) * NPJ; kreg = *(const v4u*)(src + kcol + sch * 8); vreg = *(const v4u*)(src + vcol + sch * 8); }
        const bool loc = i < nloc;
        bool skip = false;
        const int k0 = (t0 + i) * 64;
        if (loc && TYPE == 0) skip = (k0 + 63 < qpos0 - 128) || (k0 > qpos0 + 31 + 128);
        if (loc && TYPE == 2) skip = (t0 + i < rs) || (t0 + i >= rs + 8);
        if (!skip) {
            f32x16 sacc[2];
            bf16x8v kf[2][4], vf[2][2][2];
#pragma unroll
            for (int kb = 0; kb < 2; ++kb)
#pragma unroll
                for (int ks = 0; ks < 4; ++ks) kf[kb][ks] = *(const LAS bf16x8v*)(kb_ + (kb * 32 + r) * AT_KRS + ks * 32 + 16 * h2);
#pragma unroll
            for (int kb = 0; kb < 2; ++kb)
#pragma unroll
                for (int s = 0; s < 2; ++s)
#pragma unroll
                    for (int db = 0; db < 2; ++db) {
                        const LAS unsigned char* va = vb_ + (kb * 32 + 16 * s + 4 * h2 + (i16 >> 2)) * AT_VRS + (db * 32 + 16 * ((L >> 4) & 1) + 4 * (i16 & 3)) * 2;
                        const s16x4 lo = vtr(va), hi = vtr(va + 8 * AT_VRS);
                        vf[kb][s][db] = (bf16x8v){lo[0], lo[1], lo[2], lo[3], hi[0], hi[1], hi[2], hi[3]}; }
            __builtin_amdgcn_sched_barrier(0);
#pragma unroll
            for (int kb = 0; kb < 2; ++kb) {
#pragma unroll
                for (int q = 0; q < 16; ++q) sacc[kb][q] = (TYPE == 1) ? -m : 0.f;
#pragma unroll
                for (int ks = 0; ks < 4; ++ks) sacc[kb] = __builtin_amdgcn_mfma_f32_32x32x16_bf16(kf[kb][ks], qf[ks], sacc[kb], 0, 0, 0);
            }
            float tmax = -INFINITY;
            if ((TYPE == 0 || TYPE == 2) && loc) {
#pragma unroll
                for (int kb = 0; kb < 2; ++kb)
#pragma unroll
                    for (int q = 0; q < 16; ++q) { float s = sacc[kb][q]; const int kk = kb * 32 + crow16(q, h2);
                        if (TYPE == 0) { const int d = k0 + kk - qpos; if (d > 128 || d < -128) s = -INFINITY; }
                        if (TYPE == 2) { const int dc = kk - cs; const LAS float* rp = (const LAS float*)(lb + AT_RPB);
                            if (dc < 0 || dc >= 16) s = -INFINITY; else s += rp[(t0 + i - gr + 7) * 31 + (kk - qc + 15)]; }
                        sacc[kb][q] = s; }
            }
            if (TYPE != 1) {
#pragma unroll
                for (int kb = 0; kb < 2; ++kb)
#pragma unroll
                    for (int q = 0; q < 16; ++q) tmax = fmaxf(tmax, sacc[kb][q]);
                tmax = fmaxf(tmax, __shfl_xor(tmax, 32));
                const float mn = fmaxf(m, tmax);
                if (__any(mn > m)) {
                    const float alpha = __builtin_amdgcn_exp2f((m - mn) * AT_SC);
                    lsum *= alpha;
#pragma unroll
                    for (int q = 0; q < 16; ++q) { oacc[0][q] *= alpha; oacc[1][q] *= alpha; }
                }
                m = mn;
            }
            const float mns = -m * AT_SC;
            float psum = 0.f;
#pragma unroll
            for (int kb = 0; kb < 2; ++kb)
#pragma unroll
                for (int q = 0; q < 16; ++q) { const float p = (TYPE == 1) ? __builtin_amdgcn_exp2f(sacc[kb][q]) : __builtin_amdgcn_exp2f(__builtin_fmaf(sacc[kb][q], AT_SC, mns)); sacc[kb][q] = p; psum += p; }
            lsum += psum;
#pragma unroll
            for (int kb = 0; kb < 2; ++kb)
#pragma unroll
                for (int s = 0; s < 2; ++s) {
                    v4u pw; pw.x = cvtpk(sacc[kb][8 * s], sacc[kb][8 * s + 1]); pw.y = cvtpk(sacc[kb][8 * s + 2], sacc[kb][8 * s + 3]); pw.z = cvtpk(sacc[kb][8 * s + 4], sacc[kb][8 * s + 5]); pw.w = cvtpk(sacc[kb][8 * s + 6], sacc[kb][8 * s + 7]);
                    const bf16x8v pf = __builtin_bit_cast(bf16x8v, pw);
#pragma unroll
                    for (int db = 0; db < 2; ++db) oacc[db] = __builtin_amdgcn_mfma_f32_32x32x16_bf16(vf[kb][s][db], pf, oacc[db], 0, 0, 0);
                }
        }
        if (i + 1 < nt) { LAS unsigned char* nb = lb + ((i + 1) & 1) * AT_BUF; *(LAS v4u*)(nb + srow * AT_KRS + sch * 16) = kreg; *(LAS v4u*)(nb + AT_KB + srow * AT_VRS + sch * 16) = vreg; }
        __syncthreads();
    }
    lsum += __shfl_xor(lsum, 32);
    if (TYPE == 0) lsum += __builtin_amdgcn_exp2f(KA->in[13][l * 4 + head] * LOG2E - m * AT_SC);
    const float inv = __builtin_amdgcn_rcpf(lsum);
    bf16* op = (bf16*)(KA->ws + WS_O) + (size_t)qrow * DM + (TYPE == 0 ? 0 : TYPE == 1 ? 512 : 768) + head * 64;
#pragma unroll
    for (int db = 0; db < 2; ++db)
#pragma unroll
        for (int q4 = 0; q4 < 4; ++q4) { v2u o; o.x = cvtpk(oacc[db][4 * q4] * inv, oacc[db][4 * q4 + 1] * inv); o.y = cvtpk(oacc[db][4 * q4 + 2] * inv, oacc[db][4 * q4 + 3] * inv);
            *(v2u*)(op + db * 32 + 8 * q4 + 4 * h2) = o; }
}
constexpr size_t WS_ST = WS_A;
constexpr size_t WS_DEC = 3 * MiB;
constexpr int SS_B = 0, SS_BRS = 272, SS_X = 34816, SS_XRS = 192, SS_X2 = 59392, SS_HF = 83968, SS_HB = 101376, SS_ARR = 118784;
DI int slot_row(int b, int slot) { return slot < 2 ? NLAT + b * CTXL + slot * 128 : b * SEQ + (slot - 2) * 128; }
DI void ssd_stage_dt(KArgs KA, const Frame& F, int l, int h, int rowbase, LAS float* arr) {
    const float* DTB = (const float*)(KA->ws + WS_DT);
    if (F.tid < 128) { const float df = DTB[(size_t)(rowbase + F.tid) * 8 + h], db = DTB[(size_t)(rowbase + F.tid) * 8 + 4 + h];
        const float Af = -__expf(KA->in[17][l * 8 + h]) * LOG2E, Ab = -__expf(KA->in[17][l * 8 + 4 + h]) * LOG2E;
        arr[F.tid] = df * Af; arr[128 + F.tid] = db * Ab; arr[256 + F.tid] = df; arr[384 + F.tid] = db; }
    __syncthreads();
    if (F.wave < 2) { const int L = F.lane; const bool rev = F.wave == 1;
        const float v0 = rev ? arr[128 + 127 - 2 * L] : arr[2 * L], v1 = rev ? arr[128 + 126 - 2 * L] : arr[2 * L + 1];
        float t = v0 + v1;
#pragma unroll
        for (int o = 1; o < 64; o <<= 1) { const float u = __shfl_up(t, o); if (L >= o) t += u; }
        if (rev) { arr[640 + 127 - 2 * L] = t - v1; arr[640 + 126 - 2 * L] = t; } else { arr[512 + 2 * L] = t - v1; arr[512 + 2 * L + 1] = t; } }
    __syncthreads();
}
struct BRegs { v4u v[4]; };
DI BRegs ssd_load_B(KArgs KA, const Frame& F, int g, int rowbase) {
    const bf16* U = (const bf16*)(KA->ws + WS_U);
    const int row = F.tid >> 2, pc = F.tid & 3; const bf16* src = U + (size_t)(rowbase + row) * 768 + 256 + g * 128 + pc * 32;
    BRegs b;
#pragma unroll
    for (int k = 0; k < 4; ++k) b.v[k] = *(const v4u*)(src + k * 8);
    return b;
}
DI void ssd_store_B(const Frame& F, const BRegs& b) {
    const int row = F.tid >> 2, pc = F.tid & 3;
#pragma unroll
    for (int k = 0; k < 4; ++k) *(LAS v4u*)(F.lds + SS_B + row * SS_BRS + pc * 64 + k * 16) = b.v[k];
}
DI v4u scale8(v4u w, float s) { v4u o; o.x = cvtpk(bflo(w.x) * s, bfhi(w.x) * s); o.y = cvtpk(bflo(w.y) * s, bfhi(w.y) * s); o.z = cvtpk(bflo(w.z) * s, bfhi(w.z) * s); o.w = cvtpk(bflo(w.w) * s, bfhi(w.w) * s); return o; }
DI void ssd_states(KArgs KA, const Frame& F, int l, int item) {
    const int slot = item % 34, bh = item / 34, b = bh >> 2, h = bh & 3, g = h >> 1, rowbase = slot_row(b, slot);
    const int L = F.lane, w = F.wave, r = L & 31, h2 = L >> 5, i16 = L & 15, grp = (L >> 4) & 1;
    LAS float* arr = (LAS float*)(F.lds + SS_ARR);
    const BRegs breg = ssd_load_B(KA, F, g, rowbase);
    v4u x0, x1;
    { const bf16* U = (const bf16*)(KA->ws + WS_U); const int row = F.tid >> 2, pc = F.tid & 3; const bf16* src = U + (size_t)(rowbase + row) * 768 + h * 64 + pc * 16; x0 = *(const v4u*)src; x1 = *(const v4u*)(src + 8); }
    ssd_stage_dt(KA, F, l, h, rowbase, arr);
    ssd_store_B(F, breg);
    { const int row = F.tid >> 2, pc = F.tid & 3;
      const float wf = __builtin_amdgcn_exp2f(arr[512 + 127] - arr[512 + row]) * arr[256 + row], wb = __builtin_amdgcn_exp2f(arr[640] - arr[640 + row]) * arr[384 + row];
      *(LAS v4u*)(F.lds + SS_X + row * SS_XRS + pc * 32) = scale8(x0, wf); *(LAS v4u*)(F.lds + SS_X + row * SS_XRS + pc * 32 + 16) = scale8(x1, wf);
      *(LAS v4u*)(F.lds + SS_X2 + row * SS_XRS + pc * 32) = scale8(x0, wb); *(LAS v4u*)(F.lds + SS_X2 + row * SS_XRS + pc * 32 + 16) = scale8(x1, wb); }
    __syncthreads();
    const int pblk = w >> 2, nblk = w & 3;
    bf16* ST = (bf16*)(KA->ws + WS_ST); float* DEC = (float*)(KA->ws + WS_DEC);
#pragma unroll
    for (int dir = 0; dir < 2; ++dir) {
        f32x16 acc;
#pragma unroll
        for (int q = 0; q < 16; ++q) acc[q] = 0.f;
        const LAS unsigned char* xb = F.lds + (dir ? SS_X2 : SS_X);
#pragma unroll
        for (int ks = 0; ks < 8; ++ks) {
            const LAS unsigned char* xa = xb + (ks * 16 + 8 * h2 + (i16 >> 2)) * SS_XRS + (pblk * 32 + 16 * grp + 4 * (i16 & 3)) * 2;
            const s16x4 xlo = vtr(xa), xhi = vtr(xa + 4 * SS_XRS);
            const LAS unsigned char* ba = F.lds + SS_B + (ks * 16 + 8 * h2 + (i16 >> 2)) * SS_BRS + (nblk * 32 + 16 * grp + 4 * (i16 & 3)) * 2;
            const s16x4 blo = vtr(ba), bhi_ = vtr(ba + 4 * SS_BRS);
            const bf16x8v xf = (bf16x8v){xlo[0], xlo[1], xlo[2], xlo[3], xhi[0], xhi[1], xhi[2], xhi[3]}, bfr = (bf16x8v){blo[0], blo[1], blo[2], blo[3], bhi_[0], bhi_[1], bhi_[2], bhi_[3]};
            acc = __builtin_amdgcn_mfma_f32_32x32x16_bf16(xf, bfr, acc, 0, 0, 0); }
        bf16* dst = ST + ((size_t)((bh * 2 + dir) * 34 + slot)) * 8192;
#pragma unroll
        for (int q = 0; q < 16; ++q) dst[(pblk * 32 + crow16(q, h2)) * 128 + nblk * 32 + r] = (bf16)(cvtpk(acc[q], 0.f) & 0xffffu);
        if (F.tid == 0) DEC[(bh * 2 + dir) * 34 + slot] = __builtin_amdgcn_exp2f(dir ? arr[640] : arr[512 + 127]);
    }
    __syncthreads();
}
DI void ssd_scan() {
    KArgs KA = kargs(); Frame F = mkframe();
    bf16* ST = (bf16*)(KA->ws + WS_ST); const float* DEC = (const float*)(KA->ws + WS_DEC);
    for (int gt = blockIdx.x * 512 + F.tid; gt < 64 * 2048; gt += F.G * 512) {
        const int chain = gt >> 11, e4 = gt & 2047, dir = chain & 1;
        bf16* base = ST + (size_t)chain * 34 * 8192 + e4 * 4;
        v2u tw[34]; float dc[34];
#pragma unroll
        for (int k = 0; k < 34; ++k) { const int slot = dir == 0 ? k : (k < 2 ? 1 - k : 35 - k); tw[k] = *(const v2u*)(base + (size_t)slot * 8192); dc[k] = DEC[chain * 34 + slot]; }
        f32x4 hc = (f32x4){0.f, 0.f, 0.f, 0.f};
#pragma unroll
        for (int k = 0; k < 34; ++k) { const int slot = dir == 0 ? k : (k < 2 ? 1 - k : 35 - k);
            const f32x4 t = (f32x4){bflo(tw[k].x), bfhi(tw[k].x), bflo(tw[k].y), bfhi(tw[k].y)};
            v2u ow; ow.x = cvtpk(hc.x, hc.y); ow.y = cvtpk(hc.z, hc.w); *(v2u*)(base + (size_t)slot * 8192) = ow; hc = hc * dc[k] + t; }
    }
}
DI void ssd_outputs(KArgs KA, const Frame& F, int l, int item) {
    const int slot = item % 34, bh = item / 34, b = bh >> 2, h = bh & 3, g = h >> 1, rowbase = slot_row(b, slot);
    const int L = F.lane, w = F.wave, r = L & 31, h2 = L >> 5, i16 = L & 15, grp = (L >> 4) & 1;
    LAS float* arr = (LAS float*)(F.lds + SS_ARR);
    const bf16* U = (const bf16*)(KA->ws + WS_U);
    const int ib = w & 3, pb = w >> 2, ipos = ib * 32 + r;
    bf16x8v cfq[8];
#pragma unroll
    for (int ks = 0; ks < 8; ++ks) cfq[ks] = *(const bf16x8v*)(U + (size_t)(rowbase + ipos) * 768 + 512 + g * 128 + ks * 16 + 8 * h2);
    const BRegs breg = ssd_load_B(KA, F, g, rowbase);
    v4u x0, x1, hf0, hf1, hb0, hb1;
    { const int row = F.tid >> 2, pc = F.tid & 3; const bf16* src = U + (size_t)(rowbase + row) * 768 + h * 64 + pc * 16; x0 = *(const v4u*)src; x1 = *(const v4u*)(src + 8); }
    { const bf16* ST = (const bf16*)(KA->ws + WS_ST); const int p = F.tid >> 3, pc = F.tid & 7;
      const bf16* sf = ST + ((size_t)((bh * 2 + 0) * 34 + slot)) * 8192 + p * 128 + pc * 16; const bf16* sb = ST + ((size_t)((bh * 2 + 1) * 34 + slot)) * 8192 + p * 128 + pc * 16;
      hf0 = *(const v4u*)sf; hf1 = *(const v4u*)(sf + 8); hb0 = *(const v4u*)sb; hb1 = *(const v4u*)(sb + 8); }
    ssd_stage_dt(KA, F, l, h, rowbase, arr);
    ssd_store_B(F, breg);
    { const int row = F.tid >> 2, pc = F.tid & 3; *(LAS v4u*)(F.lds + SS_X + row * SS_XRS + pc * 32) = x0; *(LAS v4u*)(F.lds + SS_X + row * SS_XRS + pc * 32 + 16) = x1; }
    { const int p = F.tid >> 3, pc = F.tid & 7; LAS unsigned char* d = F.lds + SS_HF + p * SS_BRS + pc * 32; *(LAS v4u*)d = hf0; *(LAS v4u*)(d + 16) = hf1;
      LAS unsigned char* e = F.lds + SS_HB + p * SS_BRS + pc * 32; *(LAS v4u*)e = hb0; *(LAS v4u*)(e + 16) = hb1; }
    __syncthreads();
    const float cfi = arr[512 + ipos], cbi = arr[640 + ipos];
    f32x16 yacc;
#pragma unroll
    for (int q = 0; q < 16; ++q) yacc[q] = 0.f;
#pragma unroll
    for (int jb = 0; jb < 4; ++jb) {
        f32x16 acc;
#pragma unroll
        for (int q = 0; q < 16; ++q) acc[q] = 0.f;
#pragma unroll
        for (int ks = 0; ks < 8; ++ks) { const bf16x8v bfr = *(const LAS bf16x8v*)(F.lds + SS_B + (jb * 32 + r) * SS_BRS + ks * 32 + 16 * h2);
            acc = __builtin_amdgcn_mfma_f32_32x32x16_bf16(bfr, cfq[ks], acc, 0, 0, 0); }
        if (jb < ib) {
#pragma unroll
            for (int q = 0; q < 16; ++q) { const int j = jb * 32 + crow16(q, h2); acc[q] *= __builtin_amdgcn_exp2f(cfi - arr[512 + j]) * arr[256 + j]; }
        } else if (jb > ib) {
#pragma unroll
            for (int q = 0; q < 16; ++q) { const int j = jb * 32 + crow16(q, h2); acc[q] *= __builtin_amdgcn_exp2f(cbi - arr[640 + j]) * arr[384 + j]; }
        } else {
            int rl = r; asm volatile("" : "+v"(rl));
#pragma unroll
            for (int q = 0; q < 16; ++q) { const int jl = crow16(q, h2), j = jb * 32 + jl;
                float wt = 0.f;
                if (jl <= rl) wt += __builtin_amdgcn_exp2f(cfi - arr[512 + j]) * arr[256 + j];
                if (jl >= rl) wt += __builtin_amdgcn_exp2f(cbi - arr[640 + j]) * arr[384 + j];
                acc[q] *= wt; }
        }
#pragma unroll
        for (int s = 0; s < 2; ++s) {
            v4u pw; pw.x = cvtpk(acc[8 * s], acc[8 * s + 1]); pw.y = cvtpk(acc[8 * s + 2], acc[8 * s + 3]); pw.z = cvtpk(acc[8 * s + 4], acc[8 * s + 5]); pw.w = cvtpk(acc[8 * s + 6], acc[8 * s + 7]);
            const bf16x8v pf = __builtin_bit_cast(bf16x8v, pw);
            const LAS unsigned char* xa = F.lds + SS_X + (jb * 32 + 16 * s + 4 * h2 + (i16 >> 2)) * SS_XRS + (pb * 32 + 16 * grp + 4 * (i16 & 3)) * 2;
            const s16x4 lo = vtr(xa), hi = vtr(xa + 8 * SS_XRS);
            const bf16x8v xf = (bf16x8v){lo[0], lo[1], lo[2], lo[3], hi[0], hi[1], hi[2], hi[3]};
            yacc = __builtin_amdgcn_mfma_f32_32x32x16_bf16(xf, pf, yacc, 0, 0, 0); }
    }
#pragma unroll
    for (int dir = 0; dir < 2; ++dir) {
        f32x16 tacc;
#pragma unroll
        for (int q = 0; q < 16; ++q) tacc[q] = 0.f;
#pragma unroll
        for (int ks = 0; ks < 8; ++ks) { const bf16x8v hfr = *(const LAS bf16x8v*)(F.lds + (dir ? SS_HB : SS_HF) + (pb * 32 + r) * SS_BRS + ks * 32 + 16 * h2);
            tacc = __builtin_amdgcn_mfma_f32_32x32x16_bf16(hfr, cfq[ks], tacc, 0, 0, 0); }
        const float sc = __builtin_amdgcn_exp2f(dir ? cbi : cfi);
#pragma unroll
        for (int q = 0; q < 16; ++q) yacc[q] += sc * tacc[q];
    }
    bf16* yp = (bf16*)(KA->ws + WS_Y) + (size_t)(rowbase + ipos) * 256 + h * 64 + pb * 32;
#pragma unroll
    for (int q4 = 0; q4 < 4; ++q4) { v2u o; o.x = cvtpk(yacc[4 * q4], yacc[4 * q4 + 1]); o.y = cvtpk(yacc[4 * q4 + 2], yacc[4 * q4 + 3]); *(v2u*)(yp + 8 * q4 + 4 * h2) = o; }
    __syncthreads();
}
DI void ssd_outputs_phase(int l, bool last) {
    KArgs KA = kargs(); Frame F = mkframe();
    for (int it = blockIdx.x; it < 32 * 34; it += F.G) { if (last && (it % 34) < 2) continue; ssd_outputs(KA, F, l, it); }
}
DI void mixers_flash(int l, bool last) {
    KArgs KA = kargs(); Frame F = mkframe();
    const int nS = 32 * 34, nL = 1536, nC = last ? 0 : 96, nItems = nS + nL + nC;
    for (int it = blockIdx.x; it < nItems; it += F.G) {
        if (it < nS) { ssd_states(KA, F, l, it); continue; }
        int u = it - nS; bool cq = false;
        if (u >= nL) { u -= nL; cq = true; }
        const int ty = u % 3, un = u / 3;
        if (ty == 0) attn_unit<1>(KA, F, l, un, cq); else if (ty == 1) attn_unit<0>(KA, F, l, un, cq); else attn_unit<2>(KA, F, l, un, cq);
    }
}
DI void merge_pass(int l, int nrows) {
    KArgs KA = kargs(); Frame F = mkframe();
    const bf16* P = (const bf16*)(KA->ws + WS_ACT); const bf16* O = (const bf16*)(KA->ws + WS_O); const bf16* Y = (const bf16*)(KA->ws + WS_Y); const bf16* U = (const bf16*)(KA->ws + WS_U);
    bf16* A = (bf16*)(KA->ws + WS_A);
    const int hh = F.lane >> 4, cn = 4 * F.lane;
    const float dsk = KA->in[18][l * 4 + hh];
    f32x4 mg[4];
#pragma unroll
    for (int j = 0; j < 4; ++j) mg[j] = *(const f32x4*)(KA->in[12] + l * DM + 4 * F.lane + 256 * j);
    v2u o0, o2, o3, yw, xw, zw;
#define MERGE_LOAD(r_) do { o0 = *(const v2u*)(O + (size_t)(r_) * DM + cn); o2 = *(const v2u*)(O + (size_t)(r_) * DM + 512 + cn); o3 = *(const v2u*)(O + (size_t)(r_) * DM + 768 + cn); \
        yw = *(const v2u*)(Y + (size_t)(r_) * 256 + cn); xw = *(const v2u*)(U + (size_t)(r_) * 768 + cn); zw = *(const v2u*)(P + (size_t)(r_) * NPJ + C_BZ + cn); } while (0)
    if (F.gw < nrows) MERGE_LOAD(F.gw);
    for (int row = F.gw; row < nrows; row += F.ngw) {
        f32x4 v[4];
        v[0] = (f32x4){bflo(o0.x), bfhi(o0.x), bflo(o0.y), bfhi(o0.y)}; v[2] = (f32x4){bflo(o2.x), bfhi(o2.x), bflo(o2.y), bfhi(o2.y)}; v[3] = (f32x4){bflo(o3.x), bfhi(o3.x), bflo(o3.y), bfhi(o3.y)};
        { const f32x4 yf = (f32x4){bflo(yw.x), bfhi(yw.x), bflo(yw.y), bfhi(yw.y)}, xs = (f32x4){bflo(xw.x), bfhi(xw.x), bflo(xw.y), bfhi(xw.y)}, z = (f32x4){bflo(zw.x), bfhi(zw.x), bflo(zw.y), bfhi(zw.y)};
          const f32x4 y = yf + xs * dsk; v[1] = (f32x4){y.x * silu(z.x), y.y * silu(z.y), y.z * silu(z.z), y.w * silu(z.w)}; }
        if (row + F.ngw < nrows) MERGE_LOAD(row + F.ngw);
#pragma unroll
        for (int j = 0; j < 4; ++j) { const int n = 4 * F.lane + 256 * j;
            const float ss = wave_sum((v[j].x * v[j].x + v[j].y * v[j].y) + (v[j].z * v[j].z + v[j].w * v[j].w));
            const float r = __builtin_amdgcn_rsqf(ss * (1.f / 256.f) + LN_EPS);
            const f32x4 a = v[j] * r * mg[j];
            v2u w; w.x = cvtpk(a.x, a.y); w.y = cvtpk(a.z, a.w); *(v2u*)(A + (size_t)row * DM + n) = w; }
    }
#undef MERGE_LOAD
}
constexpr size_t WS_CTL = 3 * MiB + 512 * 1024, CTL_BYTES = 16384;
constexpr int MISC_OFF = 139264;
#define XB_TMO      128
#define XB_XCNT(j)  (256  + 64 * (j))
#define XB_XSUB(j)  (1280 + 64 * (j))
#define XB_XGEN(j)  (2304 + 64 * (j))
#define XB_TOP      3328
#define XB_TOPGEN   3392
#define XCD_BAR_WORDS 3456
#define XB_SPIN_CAP (1u << 18)

__device__ __forceinline__ unsigned xb_ld(unsigned* p)              { return __hip_atomic_load(p, __ATOMIC_RELAXED, __HIP_MEMORY_SCOPE_AGENT); }
__device__ __forceinline__ unsigned xb_add(unsigned* p, unsigned v) { return __hip_atomic_fetch_add(p, v, __ATOMIC_RELAXED, __HIP_MEMORY_SCOPE_AGENT); }
__device__ __forceinline__ unsigned xb_xcc_id() { return (unsigned)__builtin_amdgcn_s_getreg((3 << 11) | 20) & 0xFu; }
#define XB_SPIN(cond, bar) do { unsigned _sp = 0; while (cond) { __builtin_amdgcn_s_sleep(1); \
    if ((++_sp & 255u) == 0u) { if (xb_ld(&(bar)[XB_TMO])) break; if (_sp > XB_SPIN_CAP) { atomicAdd(&(bar)[XB_TMO], 1u); break; } } } } while (0)

struct XcdBarrier {
    unsigned* bar; unsigned x;
    volatile LAS unsigned* st;
};

__device__ __forceinline__ XcdBarrier xcd_barrier_post(unsigned* bar, volatile LAS unsigned* st) {
    XcdBarrier b; b.bar = bar; b.x = xb_xcc_id(); b.st = st;
    if (threadIdx.x == 0) (void)xb_add(&bar[XB_XCNT(b.x)], 1u);
    return b;
}
__device__ __forceinline__ void xcd_barrier_complete(unsigned* bar, unsigned x, unsigned& nloc, unsigned& nx) {
    const unsigned G = gridDim.x * gridDim.y * gridDim.z;
    unsigned sum, cnt, mine, sp = 0u;
    for (;;) {
        sum = 0u; cnt = 0u; mine = 0u;
#pragma unroll
        for (unsigned j = 0; j < 16; ++j) { const unsigned c = xb_ld(&bar[XB_XCNT(j)]); sum += c; cnt += (c > 0u) ? 1u : 0u; mine = (j == x) ? c : mine; }
        if (sum == G) break;
        __builtin_amdgcn_s_sleep(1);
        if ((++sp & 255u) == 0u) { if (xb_ld(&bar[XB_TMO])) break; if (sp > XB_SPIN_CAP) { atomicAdd(&bar[XB_TMO], 1u); break; } }
    }
    nloc = mine > 0u ? mine : 1u; nx = cnt > 0u ? cnt : 1u;
}

__device__ __forceinline__ void xcd_barrier(const XcdBarrier& b) {
    asm volatile("s_waitcnt vmcnt(0)" ::: "memory");
    __syncthreads();
    if (threadIdx.x == 0) {
        unsigned* bar = b.bar;
        __builtin_amdgcn_s_waitcnt(0);
        unsigned nloc = b.st[0], nx = b.st[1];
        if (nloc == 0u) { xcd_barrier_complete(bar, b.x, nloc, nx); b.st[0] = nloc; b.st[1] = nx; }
        const unsigned old = xb_add(&bar[XB_XSUB(b.x)], 1u);
        const unsigned gen = old / nloc;
        if (old + 1u == (gen + 1u) * nloc) {
            __builtin_amdgcn_fence(__ATOMIC_RELEASE, "agent");
            asm volatile("s_waitcnt vmcnt(0)" ::: "memory");
            const unsigned og = xb_add(&bar[XB_TOP], 1u);
            const unsigned tg = og / nx;
            if (og + 1u == (tg + 1u) * nx) xb_add(&bar[XB_TOPGEN], 1u);
            else XB_SPIN(xb_ld(&bar[XB_TOPGEN]) == tg, bar);
            __builtin_amdgcn_fence(__ATOMIC_ACQUIRE, "agent");
            xb_add(&bar[XB_XGEN(b.x)], 1u);
            asm volatile("s_waitcnt vmcnt(0)" ::: "memory");
        } else {
            XB_SPIN(xb_ld(&bar[XB_XGEN(b.x)]) == gen, bar);
            __builtin_amdgcn_fence(__ATOMIC_ACQUIRE, "agent");
            asm volatile("s_waitcnt vmcnt(0)" ::: "memory");
        }
    }
    __syncthreads();
}

#define GRID_BAR() do { XcdBarrier b_; b_.bar = (unsigned*)(kargs()->ws + WS_CTL); b_.x = xb_xcc_id(); b_.st = (volatile LAS unsigned*)((LAS unsigned char*)lds + MISC_OFF); xcd_barrier(b_); } while (0)
#ifndef PROBE_GRP
#define PROBE_GRP 0
#endif
#define TIMED(grp, ...) do { unsigned long long t0_ = 0; if (PROBE_GRP == (grp)) t0_ = __builtin_amdgcn_s_memrealtime(); __VA_ARGS__; \
    if (PROBE_GRP == (grp) && blockIdx.x == 0) { const unsigned long long dt_ = __builtin_amdgcn_s_memrealtime() - t0_; const unsigned long long t1_ = __builtin_amdgcn_s_memrealtime(); \
        while (__builtin_amdgcn_s_memrealtime() - t1_ < 2 * dt_) __builtin_amdgcn_s_sleep(8); } } while (0)
__global__ void __launch_bounds__(NWAVES * 64, 2) mega_fwd(Args args) {
    extern __shared__ __attribute__((aligned(16))) unsigned char lds[];
    cg::grid_group grid = cg::this_grid();
    if (threadIdx.x < 2) ((volatile LAS unsigned*)((LAS unsigned char*)lds + MISC_OFF))[threadIdx.x] = 0u;
    __syncthreads();
    (void)xcd_barrier_post((unsigned*)(kargs()->ws + WS_CTL), (volatile LAS unsigned*)((LAS unsigned char*)lds + MISC_OFF));
    { LAS float* rc = (LAS float*)((LAS unsigned char*)lds + ROPE_OFF);
      for (int i = threadIdx.x; i < 1024; i += 512) { const int pos = i >> 4, fi = i & 15; const float inv = exp2f(-(float)fi * (13.287712379549449f / 16.f)); const float ang = (float)pos * inv; rc[i] = cosf(ang); rc[1024 + i] = sinf(ang); } }
    __syncthreads();

    if (args.ws == nullptr) grid.sync();
    p0a(); GRID_BAR(); p0b(); GRID_BAR(); p0c(); GRID_BAR();
    for (int l = 0; l < NL; ++l) {
        const bool last = (l == NL - 1); const int mrows = last ? NLAT : NROW;
        for (int s = 0; s < 3; ++s) {
            if (s != 1) {
                const bool second = (s == 2); const int rows = (second && last) ? NLAT : NROW;
                { KArgs KA = kargs(); pg8::Gemm g{((bf16*)(KA->ws + WS_A)), wbuf(KA, l, second ? WO_W1B : WO_W1A), rows, 2 * DFF, DM}; pg8::StaticOrder S; S.init(rows, 2 * DFF, (int)gridDim.x, (int)blockIdx.x); pg8::EpiSwiGLU E{((bf16*)(KA->ws + WS_ACT)), DFF};
                  pg8::gemm_phase<pg8::EpiSwiGLU, pg8::StaticOrder, true, GEMM_SP2>((LAS unsigned char*)lds, g, S, E); }
                GRID_BAR();
                { KArgs KA = kargs(); pg8::Gemm g{((bf16*)(KA->ws + WS_ACT)), wbuf(KA, l, second ? WO_W2B : WO_W2A), NLAT, DM, DFF}; pg8::StaticOrder S; S.init(NLAT, DM, (int)gridDim.x, (int)blockIdx.x); pg8::EpiBf16 E{((bf16*)(KA->ws + WS_O)), DM};
                  pg8::gemm_phase<pg8::EpiBf16, pg8::StaticOrder, true, GEMM_SP2>((LAS unsigned char*)lds, g, S, E); }
                GRID_BAR();
                const bool split = (rows == NROW);
                const int gidx = second ? 8 : 2, lnidx = second ? 2 : 0, nl = second ? l + 1 : l, nsh = second ? (last ? -1 : 0) : 3;
                if (split && blockIdx.x < 32) {
                    KArgs KA = kargs(); pg8::Gemm g{((bf16*)(KA->ws + WS_ACT)) + (size_t)NLAT * DFF, wbuf(KA, l, second ? WO_W2B : WO_W2A), NCTX, DM, DFF}; pg8::StaticOrder S; S.init(NCTX, DM, 32, (int)blockIdx.x);
                    pg8::EpiBf16 E{((bf16*)(KA->ws + WS_O)) + (size_t)NLAT * DM, DM};
                    pg8::gemm_phase<pg8::EpiBf16, pg8::StaticOrder, true, GEMM_SP2>((LAS unsigned char*)lds, g, S, E);
                } else ln_pass(l, gidx, 0.5f, lnidx, nl, nsh, 0, NLAT, split ? 32 : 0, split ? (int)gridDim.x - 32 : (int)gridDim.x, !second);
                if (split) { GRID_BAR(); ln_pass(l, gidx, 0.5f, lnidx, nl, nsh, NLAT, NROW, 0, (int)gridDim.x, !second); }
                if (!(second && last)) GRID_BAR();
            } else {
                { KArgs KA = kargs(); pg8::Gemm g{((bf16*)(KA->ws + WS_A)), wbuf(KA, l, WO_WIN), NROW, NPJ, DM}; pg8::StaticOrder S; S.init(NROW, NPJ, (int)gridDim.x, (int)blockIdx.x); pg8::EpiBf16 E{((bf16*)(KA->ws + WS_ACT)), NPJ};
                  pg8::gemm_phase<pg8::EpiBf16, pg8::StaticOrder, true, GEMM_SP2>((LAS unsigned char*)lds, g, S, E); }
                GRID_BAR();
                prep_pass(l); GRID_BAR();
                mixers_flash(l, last); GRID_BAR();
                ssd_scan(); GRID_BAR();
                ssd_outputs_phase(l, last); GRID_BAR();
                merge_pass(l, mrows); GRID_BAR();
                { KArgs KA = kargs(); pg8::Gemm g{((bf16*)(KA->ws + WS_A)), wbuf(KA, l, WO_WOUT), mrows, DM, DM}; pg8::StaticOrder S; S.init(mrows, DM, (int)gridDim.x, (int)blockIdx.x); pg8::EpiBf16 E{((bf16*)(KA->ws + WS_O)), DM};
                  pg8::gemm_phase<pg8::EpiBf16, pg8::StaticOrder, true, GEMM_SP2>((LAS unsigned char*)lds, g, S, E); }
                GRID_BAR();
                ln_pass(l, 5, 1.0f, 1, l, 6, 0, mrows, 0, (int)gridDim.x, false); GRID_BAR();
            }
        }
    }
}

extern "C" void kernel_launch(void* const* d_in, const int* in_sizes, int n_in, void* d_out, int out_size, void* d_ws, size_t ws_size, hipStream_t stream) {
    static int grid = 0;
    if (grid == 0) {
        if (n_in != 24 || out_size != NLAT * DM || ws_size < WS_END) { fprintf(stderr, "kernel_launch: unexpected shapes: n_in %d out %d ws %zu\n", n_in, out_size, ws_size); grid = -1; return; }
        int dev = 0, cus = 0, per_cu = 0;
        hipGetDevice(&dev); hipDeviceGetAttribute(&cus, hipDeviceAttributeMultiprocessorCount, dev);
        if (hipFuncSetAttribute((const void*)mega_fwd, hipFuncAttributeMaxDynamicSharedMemorySize, LDS_BYTES) != hipSuccess) { fprintf(stderr, "kernel_launch: hipFuncSetAttribute failed\n"); grid = -1; return; }
        if (hipOccupancyMaxActiveBlocksPerMultiprocessor(&per_cu, (const void*)mega_fwd, NWAVES * 64, LDS_BYTES) != hipSuccess || per_cu < 1) { fprintf(stderr, "kernel_launch: occupancy query says %d\n", per_cu); per_cu = 1; }
        (void)hipGetLastError();
        grid = cus;
    }
    if (grid < 0) return;
    if (hipMemsetAsync((char*)d_ws + WS_CTL, 0, CTL_BYTES, stream) != hipSuccess) { fprintf(stderr, "kernel_launch: memset of the barrier words failed\n"); return; }
    Args a{};
    for (int i = 0; i < 24; ++i) a.in[i] = (const float*)d_in[i];
    a.out = (float*)d_out; a.ws = (unsigned char*)d_ws;
    void* kargs[] = {&a};
    hipError_t e = hipLaunchCooperativeKernel((const void*)mega_fwd, dim3(grid), dim3(NWAVES * 64), kargs, LDS_BYTES, stream);
    if (e != hipSuccess) fprintf(stderr, "kernel_launch: cooperative launch failed: %s (grid %d)\n", hipGetErrorString(e), grid);
}
```

```cpp
#include <hip/hip_runtime.h>
#include <hip/hip_cooperative_groups.h>
#include <cstdio>
#include <cstdint>
namespace cg = cooperative_groups;
namespace pg8 {
#define PG8_LAS __attribute__((address_space(3)))
typedef unsigned short bf16_t;
typedef short bf16x8 __attribute__((ext_vector_type(8)));
typedef float f32x4 __attribute__((ext_vector_type(4)));
typedef unsigned u32x4 __attribute__((ext_vector_type(4)));
constexpr int BM = 256, BK = 64, HALF = 128, HTB = HALF * BK * 2  , STAGE_BYTES = 8 * HTB, NXCD = 8, WGM = 8;

__host__ __device__ __forceinline__ int lds_byte(int r, int c) { const int st = (r >> 4) * 2 + (c >> 5), rr = r & 15, cc = c & 31, ob = rr * 64 + cc * 2; return st * 1024 + (ob ^ (((ob >> 9) & 1) << 5)); }
__host__ __device__ __forceinline__ void stage_rc(int b, int& R, int& C) { const int st = b / 1024, sb = b % 1024, swz = sb ^ (((sb >> 9) & 1) << 5); R = (st >> 1) * 16 + swz / 64; C = (st & 1) * 32 + (swz % 64) / 2; }
__host__ __device__ __forceinline__ int perm32(int rho) { const int n = rho >> 4, i = rho & 15; return 8 * (i >> 2) + 4 * n + (i & 3); }

struct Unit { int pm, pn; };
struct Gemm { const bf16_t* A; const bf16_t* Bt; int M, N, K; };

struct StaticOrder {
    int nM, nN, nwg, G, c;
    __host__ __device__ void init(int M, int N, int G_, int c_) { nM = M / BM; nN = N / BM; nwg = nM * nN; G = G_; c = c_; }
    __host__ __device__ bool next(int i, Unit& u) const {
        const long L = (long)i * G + c; if (L >= nwg) return false;
        int wgid = (int)L; { const int q = nwg / NXCD, r = nwg % NXCD, xcd = wgid % NXCD, off = wgid / NXCD; wgid = (xcd < r ? xcd * (q + 1) : r * (q + 1) + (xcd - r) * q) + off; }
        const int nig = WGM * nN, gid = wgid / nig, fm = gid * WGM, gsz = (nM - fm) < WGM ? (nM - fm) : WGM;
        u.pm = fm + ((wgid % nig) % gsz); u.pn = (wgid % nig) / gsz; return true;
    }
    __device__ __forceinline__ void a_ready(const Unit&) const {}
    __device__ __forceinline__ void done(const Unit&) const {}
};

__device__ __forceinline__ unsigned cvt_pk_bf16(float lo, float hi) { unsigned r; asm volatile("v_cvt_pk_bf16_f32 %0, %1, %2" : "=v"(r) : "v"(lo), "v"(hi)); return r; }
struct EpiBf16 {
    static constexpr bool PERM = true, AFTER_DRAIN = false;
    bf16_t* O; int ldc;
    __device__ __forceinline__ void operator()(const f32x4 (&acc)[2][2][4][2], const Unit& u, int wr, int wc, int fr, int fq) const {
        const int row0 = u.pm * BM + wr * 64 + fr; const int col0 = u.pn * BM + wc * 32 + 8 * fq;
#pragma unroll
        for (int ai = 0; ai < 2; ++ai)
#pragma unroll
            for (int m = 0; m < 4; ++m) { bf16_t* rowp = O + (size_t)(row0 + ai * HALF + m * 16) * ldc + col0;
#pragma unroll
                for (int bj = 0; bj < 2; ++bj) { const f32x4 v0 = acc[ai][bj][m][0], v1 = acc[ai][bj][m][1];
                    u32x4 w; w.x = cvt_pk_bf16(v0[0], v0[1]); w.y = cvt_pk_bf16(v0[2], v0[3]); w.z = cvt_pk_bf16(v1[0], v1[1]); w.w = cvt_pk_bf16(v1[2], v1[3]);
                    *(u32x4*)(rowp + bj * HALF) = w; } }
    }
};
__device__ __forceinline__ float silu_f(float x) { return x * __builtin_amdgcn_rcpf(1.0f + __expf(-x)); }
struct EpiSwiGLU {
    static constexpr bool PERM = true, AFTER_DRAIN = false;
    bf16_t* O; int ldc;
    __device__ __forceinline__ void operator()(const f32x4 (&acc)[2][2][4][2], const Unit& u, int wr, int wc, int fr, int fq) const {
        const int row0 = u.pm * BM + wr * 64 + fr; const int col0 = u.pn * HALF + wc * 32 + 8 * fq;
#pragma unroll
        for (int ai = 0; ai < 2; ++ai)
#pragma unroll
            for (int m = 0; m < 4; ++m) { bf16_t* rowp = O + (size_t)(row0 + ai * HALF + m * 16) * ldc + col0;
                const f32x4 a0 = acc[ai][0][m][0], a1 = acc[ai][0][m][1], u0 = acc[ai][1][m][0], u1 = acc[ai][1][m][1];
                u32x4 w;
                w.x = cvt_pk_bf16(silu_f(a0[0]) * u0[0], silu_f(a0[1]) * u0[1]); w.y = cvt_pk_bf16(silu_f(a0[2]) * u0[2], silu_f(a0[3]) * u0[3]);
                w.z = cvt_pk_bf16(silu_f(a1[0]) * u1[0], silu_f(a1[1]) * u1[1]); w.w = cvt_pk_bf16(silu_f(a1[2]) * u1[2], silu_f(a1[3]) * u1[3]);
                *(u32x4*)rowp = w; }
    }
};
template <class Epi, class Sched, bool ALIGN_EPI = false, bool SP2 = false>
__device__ __forceinline__ void gemm_phase(PG8_LAS unsigned char* lds, const Gemm g, const Sched& S, const Epi& E) {
    int tid_l = threadIdx.x; asm volatile("" : "+v"(tid_l));
    const int tid = tid_l, wid = __builtin_amdgcn_readfirstlane(tid >> 6), lane = tid & 63, wr = wid >> 2, wc = wid & 3, fr = lane & 15, fq = lane >> 4;
    const int K = g.K, nt = K / BK;
    unsigned voffA[2], voffB[2];
#pragma unroll
    for (int i = 0; i < 2; ++i) { int R, C; stage_rc(tid * 16 + i * 8192, R, C); const int Rb = Epi::PERM ? ((R & ~31) + perm32(R & 31)) : R;
        voffA[i] = (unsigned)(R * K + C) * 2u; voffB[i] = (unsigned)(Rb * K + C) * 2u; }
    const size_t kstep = (size_t)(BK * 2);
    const size_t hstep = (size_t)HALF * K * 2;
    const size_t tstep = 2 * hstep;
    const unsigned ldsw = (unsigned)wid * 1024u;
    const int aoff = lds_byte(wr * 64 + fr, fq * 8), boff = lds_byte(wc * 32 + fr, fq * 8);
#define PG8_SA(b, h) (((b) * 2 + (h)) * HTB)
#define PG8_SB(b, h) ((4 + (b) * 2 + (h)) * HTB)
#define PG8_STAGE(bufoff, gbase, voff) do { _Pragma("unroll") for (int _i = 0; _i < 2; ++_i) \
        __builtin_amdgcn_global_load_lds((const unsigned*)((const char*)(gbase) + (voff)[_i]), (PG8_LAS unsigned*)(lds + (bufoff) + ldsw + _i * 8192), 16, 0, 0); } while (0)
#define PG8_LDA(dst, b, h) do { _Pragma("unroll") for (int m = 0; m < 4; ++m) _Pragma("unroll") for (int k = 0; k < 2; ++k) dst[m][k] = *(const PG8_LAS bf16x8*)(lds + PG8_SA(b, h) + aoff + m * 2048 + k * 1024); } while (0)
#define PG8_LDB(dst, b, h) do { _Pragma("unroll") for (int n = 0; n < 2; ++n) _Pragma("unroll") for (int k = 0; k < 2; ++k) dst[n][k] = *(const PG8_LAS bf16x8*)(lds + PG8_SB(b, h) + boff + n * 2048 + k * 1024); } while (0)
#define PG8_MMA(ai, bj, At, Bt) do { __builtin_amdgcn_s_setprio(1); _Pragma("unroll") for (int m = 0; m < 4; ++m) _Pragma("unroll") for (int n = 0; n < 2; ++n) _Pragma("unroll") for (int k = 0; k < 2; ++k) \
        acc[ai][bj][m][n] = __builtin_amdgcn_mfma_f32_16x16x32_bf16(Bt[n][k], At[m][k], acc[ai][bj][m][n], 0, 0, 0); __builtin_amdgcn_s_setprio(0); } while (0)
#define PG8_WAIT_V(n) asm volatile("s_waitcnt vmcnt(" #n ")" ::: "memory")
#define PG8_WAIT_L(n) asm volatile("s_waitcnt lgkmcnt(" #n ")" ::: "memory")
#define PG8_BAR __builtin_amdgcn_s_barrier()
#define PG8_SCHED __builtin_amdgcn_sched_barrier(0)
    Unit cur, nxt; int ui = 0;
    if (!S.next(0, cur)) return;
    f32x4 acc[2][2][4][2];
#pragma unroll
    for (int a = 0; a < 2; ++a)
#pragma unroll
        for (int b = 0; b < 2; ++b)
#pragma unroll
            for (int m = 0; m < 4; ++m)
#pragma unroll
                for (int n = 0; n < 2; ++n) acc[a][b][m][n] = (f32x4){0.f, 0.f, 0.f, 0.f};
    bf16x8 At[4][2], B0[2][2], B1[2][2];
    const char* cA = (const char*)g.A + (size_t)cur.pm * tstep; const char* cB = (const char*)g.Bt + (size_t)cur.pn * tstep;
    S.a_ready(cur);
    if constexpr (SP2) {
        PG8_STAGE(PG8_SB(0, 0), cB, voffB); PG8_STAGE(PG8_SB(0, 1), cB + hstep, voffB); PG8_STAGE(PG8_SA(0, 0), cA, voffA); PG8_STAGE(PG8_SA(0, 1), cA + hstep, voffA);
        if (wr == 1) PG8_BAR;
        PG8_WAIT_V(2); PG8_BAR;
        PG8_STAGE(PG8_SB(1, 0), cB + kstep, voffB); PG8_STAGE(PG8_SA(1, 0), cA + kstep, voffA); PG8_STAGE(PG8_SB(1, 1), cB + hstep + kstep, voffB);
        PG8_WAIT_V(6); PG8_BAR;
    } else {
        PG8_STAGE(PG8_SB(0, 0), cB, voffB); PG8_STAGE(PG8_SA(0, 0), cA, voffA); PG8_STAGE(PG8_SB(0, 1), cB + hstep, voffB); PG8_STAGE(PG8_SA(0, 1), cA + hstep, voffA);
        if (wr == 1) PG8_BAR;
        PG8_WAIT_V(4); PG8_BAR;
        PG8_STAGE(PG8_SB(1, 0), cB + kstep, voffB); PG8_STAGE(PG8_SA(1, 0), cA + kstep, voffA); PG8_STAGE(PG8_SB(1, 1), cB + hstep + kstep, voffB);
        PG8_WAIT_V(6); PG8_BAR;
    }
    for (;;) {
        const bool has_next = S.next(ui + 1, nxt);
        const char* nA = has_next ? (const char*)g.A + (size_t)nxt.pm * tstep : cA; const char* nB = has_next ? (const char*)g.Bt + (size_t)nxt.pn * tstep : cB;
        for (int t = 0; t < nt; t += 2) {
            const bool last = (t == nt - 2);
            const char* a1 = cA + (size_t)(t + 1) * kstep;
            const char* a2 = last ? nA : cA + (size_t)(t + 2) * kstep; const char* b2 = last ? nB : cB + (size_t)(t + 2) * kstep;
            const char* a3 = a2 + kstep; const char* b3 = b2 + kstep;
            if (last && has_next) S.a_ready(nxt);
            if constexpr (SP2) {
            PG8_LDB(B0, 0, 0); PG8_LDB(B1, 0, 1); PG8_SCHED; PG8_LDA(At, 0, 0); PG8_STAGE(PG8_SA(1, 1), a1 + hstep, voffA);
            PG8_WAIT_V(8); PG8_WAIT_L(0); PG8_BAR; PG8_MMA(0, 0, At, B0); PG8_MMA(0, 1, At, B1); PG8_BAR; PG8_SCHED;
            PG8_LDA(At, 0, 1); PG8_STAGE(PG8_SB(0, 0), b2, voffB); PG8_STAGE(PG8_SB(0, 1), b2 + hstep, voffB); PG8_STAGE(PG8_SA(0, 0), a2, voffA);
            PG8_WAIT_V(8); PG8_WAIT_L(0); PG8_BAR; PG8_MMA(1, 0, At, B0); PG8_MMA(1, 1, At, B1); PG8_BAR; PG8_SCHED;
            PG8_LDB(B0, 1, 0); PG8_LDB(B1, 1, 1); PG8_SCHED; PG8_LDA(At, 1, 0); PG8_STAGE(PG8_SA(0, 1), a2 + hstep, voffA);
            PG8_WAIT_V(8); PG8_WAIT_L(0); PG8_BAR; PG8_MMA(0, 0, At, B0); PG8_MMA(0, 1, At, B1); PG8_BAR; PG8_SCHED;
            PG8_LDA(At, 1, 1); PG8_STAGE(PG8_SB(1, 0), b3, voffB); PG8_STAGE(PG8_SB(1, 1), b3 + hstep, voffB); PG8_STAGE(PG8_SA(1, 0), a3, voffA);
            PG8_WAIT_V(8); PG8_WAIT_L(0); PG8_BAR; PG8_MMA(1, 0, At, B0); PG8_MMA(1, 1, At, B1); PG8_BAR; PG8_SCHED;
            } else {
            PG8_LDB(B0, 0, 0); PG8_SCHED; PG8_LDA(At, 0, 0); PG8_STAGE(PG8_SA(1, 1), a1 + hstep, voffA);
            PG8_WAIT_L(8); PG8_BAR; PG8_WAIT_L(0); PG8_MMA(0, 0, At, B0); PG8_BAR; PG8_SCHED;
            PG8_LDB(B1, 0, 1); PG8_STAGE(PG8_SB(0, 0), b2, voffB);
            PG8_BAR; PG8_WAIT_L(0); PG8_MMA(0, 1, At, B1); PG8_BAR;
            PG8_LDA(At, 0, 1); PG8_STAGE(PG8_SA(0, 0), a2, voffA);
            PG8_BAR; PG8_WAIT_L(0); PG8_MMA(1, 0, At, B0); PG8_BAR; PG8_SCHED;
            PG8_STAGE(PG8_SB(0, 1), b2 + hstep, voffB);
            PG8_WAIT_V(6); PG8_BAR; PG8_MMA(1, 1, At, B1); PG8_BAR;
            PG8_LDB(B0, 1, 0); PG8_SCHED; PG8_LDA(At, 1, 0); PG8_STAGE(PG8_SA(0, 1), a2 + hstep, voffA);
            PG8_WAIT_L(8); PG8_BAR; PG8_WAIT_L(0); PG8_MMA(0, 0, At, B0); PG8_BAR; PG8_SCHED;
            PG8_LDB(B1, 1, 1); PG8_STAGE(PG8_SB(1, 0), b3, voffB);
            PG8_BAR; PG8_WAIT_L(0); PG8_MMA(0, 1, At, B1); PG8_BAR;
            PG8_LDA(At, 1, 1); PG8_STAGE(PG8_SA(1, 0), a3, voffA);
            PG8_BAR; PG8_WAIT_L(0); PG8_MMA(1, 0, At, B0); PG8_BAR; PG8_SCHED;
            PG8_STAGE(PG8_SB(1, 1), b3 + hstep, voffB);
            PG8_WAIT_V(6); PG8_BAR; PG8_MMA(1, 1, At, B1); PG8_BAR;
            }
        }
        if constexpr (ALIGN_EPI) { if (wr == 0) PG8_BAR; }
        if constexpr (!Epi::AFTER_DRAIN) { E(acc, cur, wr, wc, fr, fq); S.done(cur); }
        if (!has_next) break;
#pragma unroll
        for (int a = 0; a < 2; ++a)
#pragma unroll
            for (int b = 0; b < 2; ++b)
#pragma unroll
                for (int m = 0; m < 4; ++m)
#pragma unroll
                    for (int n = 0; n < 2; ++n) acc[a][b][m][n] = (f32x4){0.f, 0.f, 0.f, 0.f};
        cur = nxt; cA = nA; cB = nB; ++ui;
        if constexpr (ALIGN_EPI) { if (wr == 1) PG8_BAR; }
    }
    PG8_WAIT_V(0);
    if constexpr (!ALIGN_EPI) { if (wr == 0) PG8_BAR; }
    PG8_BAR;
    if constexpr (Epi::AFTER_DRAIN) { E.fused(acc, cur, wr, wc, fr, fq, lds, wid, lane); S.done(cur); }
#undef PG8_SA
#undef PG8_SB
#undef PG8_STAGE
#undef PG8_LDA
#undef PG8_LDB
#undef PG8_MMA
#undef PG8_WAIT_V
#undef PG8_WAIT_L
#undef PG8_BAR
#undef PG8_SCHED
}
}

constexpr int NB = 8, SEQ = 4096, DM = 1024, NL = 2, CTXL = 256;
constexpr int NLAT = NB * SEQ, NCTX = NB * CTXL, NROW = NLAT + NCTX;
constexpr int DFF = 2816, NPJ = 2816, INW = 2824, NMODW = 9 * DM;
constexpr float LN_EPS = 1e-5f, ALPHA = 1.41421356237f;
constexpr int C_AQ = 0, C_AK = 256, C_AV = 384, C_BZ = 512, C_BX = 768, C_CQ = 1536, C_CK = 1792, C_CV = 1920, C_DQ = 2048, C_DK = 2304, C_DV = 2560;
constexpr int C_DTSRC = 1536;
constexpr size_t MiB = 1u << 20;
constexpr size_t WS_MOD = 0;
constexpr size_t WS_DT = 1 * MiB;
constexpr size_t WS_W = 4 * MiB, WS_WL = 41 * MiB;
constexpr size_t WO_W1A = 0, WO_W2A = 11 * MiB, WO_WIN = 16 * MiB + MiB / 2, WO_WOUT = 22 * MiB, WO_W1B = 24 * MiB, WO_W2B = 35 * MiB;
constexpr size_t WS_A = 86 * MiB;
constexpr size_t WS_ACT = 154 * MiB;
constexpr size_t WS_U = 341 * MiB;
constexpr size_t WS_O = 392 * MiB;
constexpr size_t WS_XC = 460 * MiB;
constexpr size_t WS_Y = 468 * MiB;
constexpr size_t WS_END = 512 * MiB;
constexpr int RING_BYTES = 131072, ROPE_OFF = RING_BYTES, LDS_BYTES = 147456;
constexpr int NWAVES = 8;
constexpr bool GEMM_SP2 = true;

#define LAS __attribute__((address_space(3)))
#define DI __device__ __forceinline__
typedef unsigned short bf16;
typedef unsigned v4u __attribute__((ext_vector_type(4)));
typedef unsigned v2u __attribute__((ext_vector_type(2)));
typedef float f32x4 __attribute__((ext_vector_type(4)));

DI float bf2f(unsigned b) { return __uint_as_float(b << 16); }
DI float bflo(unsigned w) { return __uint_as_float(w << 16); }
DI float bfhi(unsigned w) { return __uint_as_float(w & 0xffff0000u); }
DI unsigned f2bf(float f) { unsigned u = __float_as_uint(f); return (u + 0x7fffu + ((u >> 16) & 1u)) >> 16; }
DI unsigned pk2(float lo, float hi) { return f2bf(lo) | (f2bf(hi) << 16); }
typedef float f32x2_t __attribute__((ext_vector_type(2))); typedef __bf16 bf16x2_t __attribute__((ext_vector_type(2)));
DI unsigned cvtpk(float lo, float hi) { f32x2_t v = {lo, hi}; bf16x2_t b = __builtin_convertvector(v, bf16x2_t); return __builtin_bit_cast(unsigned, b); }
DI float dpp_f(float v, const int ctrl_unused) { return v; }
#define DPP_ADD(v_, ctrl_) ((v_) + __builtin_bit_cast(float, __builtin_amdgcn_update_dpp(0, __builtin_bit_cast(int, (v_)), (ctrl_), 0xf, 0xf, false)))
DI float wave_sum(float v) {
    v = DPP_ADD(v, 0xB1);
    v = DPP_ADD(v, 0x4E);
    v = DPP_ADD(v, 0x141);
    v = DPP_ADD(v, 0x140);
    const int vi = __builtin_bit_cast(int, v);
    const float r0 = __builtin_bit_cast(float, __builtin_amdgcn_readlane(vi, 0)), r1 = __builtin_bit_cast(float, __builtin_amdgcn_readlane(vi, 16));
    const float r2 = __builtin_bit_cast(float, __builtin_amdgcn_readlane(vi, 32)), r3 = __builtin_bit_cast(float, __builtin_amdgcn_readlane(vi, 48));
    return (r0 + r1) + (r2 + r3);
}
DI float silu(float x) { return x * __builtin_amdgcn_rcpf(1.0f + __expf(-x)); }

struct Args { const float* in[24]; float* out; unsigned char* ws; };
typedef const __attribute__((address_space(4))) Args* KArgs;
DI KArgs kargs() { KArgs p = (KArgs)__builtin_amdgcn_kernarg_segment_ptr(); asm volatile("" : "+s"(p)); return p; }

struct Frame {
    LAS unsigned char* lds;
    int tid, lane, wave, G, gw, ngw;
};
DI Frame mkframe() { Frame F; extern __shared__ __attribute__((aligned(16))) unsigned char lds_base[]; F.lds = (LAS unsigned char*)lds_base;
    int t = threadIdx.x; asm volatile("" : "+v"(t)); F.tid = t; F.lane = t & 63; F.wave = __builtin_amdgcn_readfirstlane(t >> 6);
    F.G = gridDim.x; F.gw = blockIdx.x * NWAVES + F.wave; F.ngw = F.G * NWAVES; return F; }
DI bf16* wbuf(KArgs KA, int l, size_t off) { return (bf16*)((KA->ws) + WS_W + (size_t)l * WS_WL + off); }

DI void transpose_item(const float* W, int ldw, int k0, int n0, bf16* WT, int ldt, int drow0, LAS float* scr, int lane) {
    float tv[32];
#pragma unroll
    for (int i = 0; i < 32; ++i) tv[i] = W[(size_t)(k0 + 2 * i + (lane >> 5)) * ldw + n0 + (lane & 31)];
#pragma unroll
    for (int i = 0; i < 32; ++i) scr[(2 * i + (lane >> 5)) * 33 + (lane & 31)] = tv[i];
    asm volatile("s_waitcnt lgkmcnt(0)" ::: "memory");
    const int c = lane & 7;
#pragma unroll
    for (int j = 0; j < 4; ++j) { const int n = (lane >> 3) + 8 * j; const LAS float* s = scr + (8 * c) * 33 + n;
        v4u o; o.x = pk2(s[0 * 33], s[1 * 33]); o.y = pk2(s[2 * 33], s[3 * 33]); o.z = pk2(s[4 * 33], s[5 * 33]); o.w = pk2(s[6 * 33], s[7 * 33]);
        *(v4u*)(WT + (size_t)(drow0 + n) * ldt + k0 + 8 * c) = o; }
    asm volatile("s_waitcnt lgkmcnt(0)" ::: "memory");
}
DI void p0a() {
    KArgs KA = kargs(); Frame F = mkframe();
    {
        LAS float* sv = (LAS float*)F.lds;
        for (int it = blockIdx.x; it < NL * 16 * 9; it += F.G) {
            const int l = it / 144, kc = (it % 144) / 9, cb = it % 9;
            __syncthreads();
            for (int i = F.tid; i < 576; i += 512) { const int r = i >> 6, kk = i & 63; const float v = r < 8 ? KA->in[1][r * DM + kc * 64 + kk] : KA->in[3][kc * 64 + kk]; sv[i] = silu(v); }
            __syncthreads();
            const int cg4 = F.tid & 255, kh = F.tid >> 8, col = cb * 1024 + 4 * cg4;
            f32x4 acc[9];
#pragma unroll
            for (int r = 0; r < 9; ++r) acc[r] = (f32x4){0.f, 0.f, 0.f, 0.f};
            const float* wp = KA->in[4] + ((size_t)l * DM + kc * 64 + kh * 32) * NMODW + col;
#pragma unroll 8
            for (int kk = 0; kk < 32; ++kk) { const f32x4 w = *(const f32x4*)(wp + (size_t)kk * NMODW);
#pragma unroll
                for (int r = 0; r < 9; ++r) acc[r] += w * sv[r * 64 + kh * 32 + kk]; }
#pragma unroll
            for (int r = 0; r < 9; ++r) *(f32x4*)(((float*)(KA->ws + WS_ACT)) + ((size_t)(l * 32 + kc * 2 + kh) * 9 + r) * NMODW + col) = acc[r];
        }
        __syncthreads();
    }
    LAS float* scr = (LAS float*)(F.lds + F.wave * 16384);
    constexpr int I1 = 16 * 176, I2 = 44 * 32, I3 = 16 * 88, I4 = 16 * 32, IL = 2 * I1 + 2 * I2 + I3 + I4;
    for (int it = F.gw; it < NL * IL; it += F.ngw) {
        const int l = it / IL; int r = it % IL;
        if (r < I1 || (r >= I1 + I2 + I3 + I4 && r < 2 * I1 + I2 + I3 + I4)) {
            const bool second = r >= I1; if (second) r -= I1 + I2 + I3 + I4;
            const int kb = r / 176, nb = r % 176, n0 = nb * 32;
            const int drow = n0 < DFF ? 256 * (n0 >> 7) + (n0 & 127) : 256 * ((n0 - DFF) >> 7) + 128 + ((n0 - DFF) & 127);
            transpose_item((second ? KA->in[22] : KA->in[8]) + (size_t)l * DM * 2 * DFF, 2 * DFF, kb * 64, n0, wbuf(KA, l, second ? WO_W1B : WO_W1A), DM, drow, scr, F.lane);
            continue; }
        r -= I1;
        if (r < I2) { const int kb = r / 32, nb = r % 32; transpose_item(KA->in[9] + (size_t)l * DFF * DM, DM, kb * 64, nb * 32, wbuf(KA, l, WO_W2A), DFF, nb * 32, scr, F.lane); continue; }
        r -= I2;
        if (r < I3) { const int kb = r / 88, nb = r % 88; const int n0 = nb < 48 ? nb * 32 : 1544 + (nb - 48) * 32;
            transpose_item(KA->in[10] + (size_t)l * DM * INW, INW, kb * 64, n0, wbuf(KA, l, WO_WIN), DM, nb * 32, scr, F.lane); continue; }
        r -= I3;
        if (r < I4) { const int kb = r / 32, nb = r % 32; transpose_item(KA->in[11] + (size_t)l * DM * DM, DM, kb * 64, nb * 32, wbuf(KA, l, WO_WOUT), DM, nb * 32, scr, F.lane); continue; }
        r -= I4 + I1;
        { const int kb = r / 32, nb = r % 32; transpose_item(KA->in[23] + (size_t)l * DFF * DM, DM, kb * 64, nb * 32, wbuf(KA, l, WO_W2B), DFF, nb * 32, scr, F.lane); }
    }
}
DI void p0b() {
    KArgs KA = kargs(); Frame F = mkframe();
    for (int i = blockIdx.x * 512 + F.tid; i < NL * 9 * NMODW; i += F.G * 512) {
        const int l = i / (9 * NMODW), rr = (i / NMODW) % 9, n = i % NMODW;
        float s = KA->in[5][l * NMODW + n];
        for (int p = 0; p < 32; ++p) s += ((float*)(KA->ws + WS_ACT))[((size_t)(l * 32 + p) * 9 + rr) * NMODW + n];
        ((float*)(KA->ws + WS_MOD))[i] = s;
    }
}
DI const float* modp(KArgs KA, int l, int mb, int idx) { return ((float*)(KA->ws + WS_MOD)) + ((size_t)(l * 9 + mb) * 9 + idx) * DM; }
DI void p0c() {
    KArgs KA = kargs(); Frame F = mkframe();
    for (int row = F.gw; row < NROW; row += F.ngw) {
        const int mb = row < NLAT ? (row >> 12) : 8;
        const float* src = row < NLAT ? KA->in[0] + (size_t)row * DM : KA->in[2] + (size_t)(row - NLAT) * DM;
        const float* sh = modp(KA, 0, mb, 0); const float* sc = modp(KA, 0, mb, 1);
#pragma unroll
        for (int j = 0; j < 4; ++j) { const int n = 4 * F.lane + 256 * j; const f32x4 v = *(const f32x4*)(src + n);
            const f32x4 a = v * (1.0f + *(const f32x4*)(sc + n)) + *(const f32x4*)(sh + n);
            v2u w; w.x = pk2(a.x, a.y); w.y = pk2(a.z, a.w); *(v2u*)(((bf16*)(KA->ws + WS_A)) + (size_t)row * DM + n) = w; }
    }
}
DI void ln_pass(int l, int gidx, float gmul, int lnidx, int nl, int nsh, int row0, int nrows, int wg0, int nwgs, const bool DTP) {
    KArgs KA = kargs(); Frame F = mkframe();
    const int nwv_ = nwgs * NWAVES, per_ = (nrows - row0 + nwv_ - 1) / nwv_;
    F.gw = row0 + (((int)blockIdx.x - wg0) * NWAVES + F.wave) * per_; F.ngw = 1;
    const int rend = min(F.gw + per_, nrows);
    LAS float* wdt = (LAS float*)F.lds;
    if (DTP) { __syncthreads(); for (int i = F.tid; i < 8192; i += 512) wdt[i] = KA->in[10][((size_t)l * DM + (i >> 3)) * INW + C_DTSRC + (i & 7)]; __syncthreads(); }
    const float* g = KA->in[6] + (l * 3 + lnidx) * DM; const float* bb = KA->in[7] + (l * 3 + lnidx) * DM;
    float* const xlat = KA->out; float* const xctx = (float*)(KA->ws + WS_XC); const bf16* const fbase = (const bf16*)(KA->ws + WS_O);
    const bool fromin = (l == 0 && lnidx == 0);
    const float* const slat = fromin ? KA->in[0] : (const float*)xlat; const float* const sctx = fromin ? KA->in[2] : (const float*)xctx;
    f32x4 g4[4], b4[4];
#pragma unroll
    for (int j = 0; j < 4; ++j) { g4[j] = *(const f32x4*)(g + 4 * F.lane + 256 * j); b4[j] = *(const f32x4*)(bb + 4 * F.lane + 256 * j); }
    f32x4 xn[4]; v2u fn[4];
    if (F.gw < rend) { const int row = F.gw; const float* xr = row < NLAT ? slat + (size_t)row * DM : sctx + (size_t)(row - NLAT) * DM;
#pragma unroll
        for (int j = 0; j < 4; ++j) { const int n = 4 * F.lane + 256 * j; xn[j] = *(const f32x4*)(xr + n); fn[j] = *(const v2u*)(fbase + (size_t)row * DM + n); } }
    f32x4 gt4[4], sh4[4], sc4[4]; int cur_mb = -1;
    for (int row = F.gw; row < rend; row += F.ngw) {
        const int mb = row < NLAT ? (row >> 12) : 8;
        if (mb != cur_mb) { cur_mb = mb;
#pragma unroll
            for (int j = 0; j < 4; ++j) { const int n = 4 * F.lane + 256 * j; gt4[j] = *(const f32x4*)(modp(KA, l, mb, gidx) + n) * gmul;
                if (nsh >= 0) { sc4[j] = 1.0f + *(const f32x4*)(modp(KA, nl, mb, nsh + 1) + n); sh4[j] = *(const f32x4*)(modp(KA, nl, mb, nsh) + n); } } }
        float* xrow = row < NLAT ? xlat + (size_t)row * DM : xctx + (size_t)(row - NLAT) * DM;
        f32x4 v[4]; float s = 0.f;
#pragma unroll
        for (int j = 0; j < 4; ++j) { const f32x4 fv = (f32x4){bflo(fn[j].x), bfhi(fn[j].x), bflo(fn[j].y), bfhi(fn[j].y)};
            v[j] = xn[j] * ALPHA + gt4[j] * fv; s += (v[j].x + v[j].y) + (v[j].z + v[j].w); }
        { const int nrow = row + F.ngw;
          if (nrow < rend) { const float* xr = nrow < NLAT ? slat + (size_t)nrow * DM : sctx + (size_t)(nrow - NLAT) * DM;
#pragma unroll
            for (int j = 0; j < 4; ++j) { const int n = 4 * F.lane + 256 * j; xn[j] = *(const f32x4*)(xr + n); fn[j] = *(const v2u*)(fbase + (size_t)nrow * DM + n); } } }
        const float mean = wave_sum(s) * (1.f / DM); float s2 = 0.f;
#pragma unroll
        for (int j = 0; j < 4; ++j) { v[j] = v[j] - mean; s2 += (v[j].x * v[j].x + v[j].y * v[j].y) + (v[j].z * v[j].z + v[j].w * v[j].w); }
        const float rstd = __builtin_amdgcn_rsqf(wave_sum(s2) * (1.f / DM) + LN_EPS);
        float dt[8];
#pragma unroll
        for (int q = 0; q < 8; ++q) dt[q] = 0.f;
#pragma unroll
        for (int j = 0; j < 4; ++j) { const int n = 4 * F.lane + 256 * j;
            const f32x4 y = v[j] * rstd * g4[j] + b4[j];
            *(f32x4*)(xrow + n) = y;
            if (nsh >= 0) { const f32x4 a = y * sc4[j] + sh4[j];
                v2u w; w.x = cvtpk(a.x, a.y); w.y = cvtpk(a.z, a.w); *(v2u*)(((bf16*)(KA->ws + WS_A)) + (size_t)row * DM + n) = w;
                if (DTP) {
#pragma unroll
                    for (int e = 0; e < 4; ++e) { const f32x4 w0 = *(const LAS f32x4*)(wdt + (n + e) * 8), w1 = *(const LAS f32x4*)(wdt + (n + e) * 8 + 4); const float ae = a[e];
                        dt[0] += ae * w0.x; dt[1] += ae * w0.y; dt[2] += ae * w0.z; dt[3] += ae * w0.w; dt[4] += ae * w1.x; dt[5] += ae * w1.y; dt[6] += ae * w1.z; dt[7] += ae * w1.w; } } }
        }
        if (DTP) {
#pragma unroll
            for (int q = 0; q < 8; ++q) dt[q] = wave_sum(dt[q]);
            if (F.lane == 0) { *(f32x4*)(((float*)(KA->ws + WS_DT)) + (size_t)row * 8) = (f32x4){dt[0], dt[1], dt[2], dt[3]}; *(f32x4*)(((float*)(KA->ws + WS_DT)) + (size_t)row * 8 + 4) = (f32x4){dt[4], dt[5], dt[6], dt[7]}; }
        }
    }
}
DI void prep_pass(int l) {
    KArgs KA = kargs(); Frame F = mkframe();
    const LAS float* rc = (const LAS float*)(F.lds + ROPE_OFF); const LAS float* rsn = rc + 1024;
    bf16* P = (bf16*)(KA->ws + WS_ACT); bf16* U = (bf16*)(KA->ws + WS_U); float* DTB = (float*)(KA->ws + WS_DT);
    const int hv = F.lane >> 5, s = F.lane & 31, hsub = s >> 3, ra = (s >> 2) & 1, ig = s & 3, d1 = ra * 32 + 4 * ig, d2 = d1 + 16;
    constexpr int NBLK = NROW / 8;
    for (int item = F.gw; item < 4 * NBLK; item += F.ngw) {
        const int part = item / NBLK, rb = item - part * NBLK;
        const int row8 = rb * 8; const bool lat = row8 < NLAT;
        if (part == 0) {
#pragma unroll
        for (int rr = 0; rr < 4; ++rr) {
            const int row = row8 + 2 * rr + hv; const int t = row & 4095;
            const int pos = ra == 0 ? (t >> 6) : (t & 63);
            const f32x4 cs = *(const LAS f32x4*)(rc + pos * 16 + 4 * ig), sn = *(const LAS f32x4*)(rsn + pos * 16 + 4 * ig);
            bf16* pr = P + (size_t)row * NPJ;
#pragma unroll
            for (int it = 0; it < 3; ++it) {
                const int hh = it * 4 + hsub;
                const bool isc = hh >= 6; const int h6 = isc ? hh - 6 : hh;
                const int col = (isc ? (h6 < 4 ? C_CQ + h6 * 64 : C_CK + (h6 - 4) * 64) : (h6 < 4 ? C_AQ + h6 * 64 : C_AK + (h6 - 4) * 64));
                const v2u w1 = *(const v2u*)(pr + col + d1), w2 = *(const v2u*)(pr + col + d2);
                f32x4 x1 = (f32x4){bflo(w1.x), bfhi(w1.x), bflo(w1.y), bfhi(w1.y)}, x2 = (f32x4){bflo(w2.x), bfhi(w2.x), bflo(w2.y), bfhi(w2.y)};
                float ss = (x1.x * x1.x + x1.y * x1.y) + (x1.z * x1.z + x1.w * x1.w) + (x2.x * x2.x + x2.y * x2.y) + (x2.z * x2.z + x2.w * x2.w);
                ss = DPP_ADD(ss, 0xB1); ss = DPP_ADD(ss, 0x4E); ss = DPP_ADD(ss, 0x141);
                if (isc) { const float r = (h6 < 4 ? 0.125f * 1.4426950408889634f : 1.0f) * __builtin_amdgcn_rsqf(ss * (1.f / 64.f) + LN_EPS); const float* gn = (h6 < 4 ? KA->in[19] : KA->in[20]) + l * 64;
                    x1 = x1 * r * *(const f32x4*)(gn + d1); x2 = x2 * r * *(const f32x4*)(gn + d2); }
                if (lat) { const f32x4 y1 = x1 * cs - x2 * sn, y2 = x1 * sn + x2 * cs; x1 = y1; x2 = y2; }
                if (isc || lat) { v2u o1, o2; o1.x = cvtpk(x1.x, x1.y); o1.y = cvtpk(x1.z, x1.w); o2.x = cvtpk(x2.x, x2.y); o2.y = cvtpk(x2.z, x2.w);
                    *(v2u*)(pr + col + d1) = o1; *(v2u*)(pr + col + d2) = o2; }
            }
        }
        { const int row = row8 + (F.lane >> 3), q = F.lane & 7; const float v = DTB[(size_t)row * 8 + q] + KA->in[16][l * 8 + q]; DTB[(size_t)row * 8 + q] = fmaxf(v, 0.f) + log1pf(__expf(-fabsf(v))); }
        } else {
        const int Ls = lat ? SEQ : CTXL; const int tt0 = lat ? (row8 & 4095) : ((row8 - NLAT) & 255);
        { const int j = part - 1; const int ch = 4 * F.lane + 256 * j;
            const f32x4 bias = *(const f32x4*)(KA->in[15] + l * 768 + ch);
            f32x4 cw[5];
#pragma unroll
            for (int k = 0; k < 5; ++k) cw[k] = *(const f32x4*)(KA->in[14] + (l * 5 + k) * 768 + ch);
            f32x4 xw[12];
            v2u wq[12];
#pragma unroll
            for (int q = 0; q < 12; ++q) { const int t2 = tt0 + q - 2; const int rq = (t2 >= 0 && t2 < Ls) ? row8 + q - 2 : row8;
                wq[q] = *(const v2u*)(P + (size_t)rq * NPJ + C_BX + ch); }
#pragma unroll
            for (int q = 0; q < 12; ++q) { const int t2 = tt0 + q - 2; const float kz = (t2 >= 0 && t2 < Ls) ? 1.0f : 0.0f;
                xw[q] = (f32x4){bflo(wq[q].x), bfhi(wq[q].x), bflo(wq[q].y), bfhi(wq[q].y)} * kz; }
#pragma unroll
            for (int q = 0; q < 8; ++q) { f32x4 acc = bias;
#pragma unroll
                for (int k = 0; k < 5; ++k) acc += cw[k] * xw[q + k];
                v2u o; o.x = cvtpk(silu(acc.x), silu(acc.y)); o.y = cvtpk(silu(acc.z), silu(acc.w)); *(v2u*)(U + (size_t)(row8 + q) * 768 + ch) = o; }
        }
        }
    }
}
DI void nkey(const float (&q)[64], float (&o)[64], float& m, float& l, const bf16* kr, const bf16* vr, float bias) {
    float s = bias;
#pragma unroll
    for (int c = 0; c < 8; ++c) { const v4u w = *(const v4u*)(kr + 8 * c);
        s += q[8 * c] * bflo(w.x) + q[8 * c + 1] * bfhi(w.x) + q[8 * c + 2] * bflo(w.y) + q[8 * c + 3] * bfhi(w.y) + q[8 * c + 4] * bflo(w.z) + q[8 * c + 5] * bfhi(w.z) + q[8 * c + 6] * bflo(w.w) + q[8 * c + 7] * bfhi(w.w); }
    const float mn = fmaxf(m, s), cf = __expf(m - mn), p = __expf(s - mn);
    l = l * cf + p; m = mn;
#pragma unroll
    for (int c = 0; c < 8; ++c) { const v4u w = *(const v4u*)(vr + 8 * c);
        o[8 * c] = o[8 * c] * cf + p * bflo(w.x); o[8 * c + 1] = o[8 * c + 1] * cf + p * bfhi(w.x); o[8 * c + 2] = o[8 * c + 2] * cf + p * bflo(w.y); o[8 * c + 3] = o[8 * c + 3] * cf + p * bfhi(w.y);
        o[8 * c + 4] = o[8 * c + 4] * cf + p * bflo(w.z); o[8 * c + 5] = o[8 * c + 5] * cf + p * bfhi(w.z); o[8 * c + 6] = o[8 * c + 6] * cf + p * bflo(w.w); o[8 * c + 7] = o[8 * c + 7] * cf + p * bfhi(w.w); }
}
template <int TYPE>
DI void naive_attn(int l, int row, int h, bool ctxq) {
    KArgs KA = kargs(); Frame F = mkframe();
    const bf16* P = ((bf16*)(KA->ws + WS_ACT));
    const int qcol = (TYPE == 0 ? C_AQ : TYPE == 1 ? C_CQ : C_DQ) + h * 64;
    const int kvh = TYPE == 2 ? h : (h >> 1);
    const int kcol = (TYPE == 0 ? C_AK : TYPE == 1 ? C_CK : C_DK) + kvh * 64, vcol = (TYPE == 0 ? C_AV : TYPE == 1 ? C_CV : C_DV) + kvh * 64;
    float q[64], o[64]; float m = -1e30f, ls = 0.f;
#pragma unroll
    for (int c = 0; c < 8; ++c) { const v4u w = *(const v4u*)(P + (size_t)row * NPJ + qcol + 8 * c);
        q[8 * c] = 0.125f * bflo(w.x); q[8 * c + 1] = 0.125f * bfhi(w.x); q[8 * c + 2] = 0.125f * bflo(w.y); q[8 * c + 3] = 0.125f * bfhi(w.y);
        q[8 * c + 4] = 0.125f * bflo(w.z); q[8 * c + 5] = 0.125f * bfhi(w.z); q[8 * c + 6] = 0.125f * bflo(w.w); q[8 * c + 7] = 0.125f * bfhi(w.w); }
#pragma unroll
    for (int d = 0; d < 64; ++d) o[d] = 0.f;
    int b;
    if (!ctxq) {
        b = row >> 12; const int t = row & 4095;
        if (TYPE == 0) { const int k0 = max(t - 128, 0), k1 = min(t + 128, SEQ - 1);
            for (int k = k0; k <= k1; ++k) { const bf16* kp = P + (size_t)(b * SEQ + k) * NPJ; nkey(q, o, m, ls, kp + kcol, kp + vcol, 0.f); } }
        else if (TYPE == 1) { for (int k = 0; k < SEQ; ++k) { const bf16* kp = P + (size_t)(b * SEQ + k) * NPJ; nkey(q, o, m, ls, kp + kcol, kp + vcol, 0.f); } }
        else { const int r = t >> 6, c = t & 63; const int rs = min(max(r - 4, 0), 56), cs = min(max(c - 8, 0), 48);
            for (int a = 0; a < 8; ++a) { const float* bp = KA->in[21] + ((size_t)(l * 4 + h) * 15 + (rs + a - r + 7)) * 31 + (cs - c + 15);
                for (int k = 0; k < 16; ++k) { const bf16* kp = P + (size_t)(b * SEQ + (rs + a) * 64 + cs + k) * NPJ; nkey(q, o, m, ls, kp + kcol, kp + vcol, bp[k]); } } }
    } else b = (row - NLAT) >> 8;
    for (int k = 0; k < CTXL; ++k) { const bf16* kp = P + (size_t)(NLAT + b * CTXL + k) * NPJ; nkey(q, o, m, ls, kp + kcol, kp + vcol, 0.f); }
    if (TYPE == 0) { const float sk = KA->in[13][l * 4 + h]; const float mn = fmaxf(m, sk), cf = __expf(m - mn); ls = ls * cf + __expf(sk - mn);
#pragma unroll
        for (int d = 0; d < 64; ++d) o[d] *= cf; }
    const float inv = 1.f / ls;
    bf16* op = ((bf16*)(KA->ws + WS_O)) + (size_t)row * DM + (TYPE == 0 ? 0 : TYPE == 1 ? 512 : 768) + h * 64;
#pragma unroll
    for (int c = 0; c < 8; ++c) { v4u w; w.x = pk2(o[8 * c] * inv, o[8 * c + 1] * inv); w.y = pk2(o[8 * c + 2] * inv, o[8 * c + 3] * inv); w.z = pk2(o[8 * c + 4] * inv, o[8 * c + 5] * inv); w.w = pk2(o[8 * c + 6] * inv, o[8 * c + 7] * inv);
        *(v4u*)(op + 8 * c) = w; }
}
DI void naive_ssd(int l, int item) {
    KArgs KA = kargs(); Frame F = mkframe();
    const int b = item >> 3, dir = (item >> 2) & 1, h = item & 3, g = h >> 1;
    const int p = F.tid >> 3, ng = F.tid & 7;
    const float A = -__expf(KA->in[17][l * 8 + dir * 4 + h]);
    bf16* Y = dir ? (((bf16*)(KA->ws + WS_Y) + (size_t)NROW * 256)) : ((bf16*)(KA->ws + WS_Y));
    float hs[16];
#pragma unroll
    for (int i = 0; i < 16; ++i) hs[i] = 0.f;
    for (int ph = 0; ph < 2; ++ph) {
        const int ns = ph ? SEQ : CTXL, base = ph ? b * SEQ : NLAT + b * CTXL;
#pragma unroll 4
        for (int s = 0; s < ns; ++s) {
            const int row = base + (dir ? ns - 1 - s : s);
            const float dt = ((float*)(KA->ws + WS_DT))[(size_t)row * 8 + dir * 4 + h];
            const bf16* ur = ((bf16*)(KA->ws + WS_U)) + (size_t)row * 768;
            const float xv = bf2f(ur[h * 64 + p]);
            const v4u b0 = *(const v4u*)(ur + 256 + g * 128 + ng * 16), b1 = *(const v4u*)(ur + 256 + g * 128 + ng * 16 + 8);
            const v4u c0 = *(const v4u*)(ur + 512 + g * 128 + ng * 16), c1 = *(const v4u*)(ur + 512 + g * 128 + ng * 16 + 8);
            const float dA = __expf(dt * A), dx = dt * xv;
            const unsigned bw[8] = {b0.x, b0.y, b0.z, b0.w, b1.x, b1.y, b1.z, b1.w}, cw[8] = {c0.x, c0.y, c0.z, c0.w, c1.x, c1.y, c1.z, c1.w};
            float y = 0.f;
#pragma unroll
            for (int i = 0; i < 8; ++i) { hs[2 * i] = hs[2 * i] * dA + dx * bflo(bw[i]); hs[2 * i + 1] = hs[2 * i + 1] * dA + dx * bfhi(bw[i]); y += bflo(cw[i]) * hs[2 * i] + bfhi(cw[i]) * hs[2 * i + 1]; }
            y += __shfl_xor(y, 1); y += __shfl_xor(y, 2); y += __shfl_xor(y, 4);
            if (ng == 0) Y[(size_t)row * 256 + h * 64 + p] = (bf16)f2bf(y);
        }
    }
}
DI void mixers_naive(int l, bool last) {
    Frame F = mkframe();
    const int nAttL = 64 * 12, nAttC = last ? 0 : 4 * 12, nItems = 64 + nAttL + nAttC;
    for (int it = blockIdx.x; it < nItems; it += F.G) {
        if (it < 64) { naive_ssd(l, it); continue; }
        int r = it - 64; bool cq = false; int rowbase;
        if (r >= nAttL) { r -= nAttL; cq = true; }
        const int rb = r / 12, ty = (r % 12) >> 2, h = r & 3;
        rowbase = cq ? NLAT + rb * 512 : rb * 512;
        const int row = rowbase + F.tid;
        if (ty == 0) naive_attn<0>(l, row, h, cq); else if (ty == 1) naive_attn<1>(l, row, h, cq); else naive_attn<2>(l, row, h, cq);
    }
}
typedef float f32x16 __attribute__((ext_vector_type(16)));
typedef short s16x4 __attribute__((ext_vector_type(4)));
typedef short bf16x8v __attribute__((ext_vector_type(8)));
typedef short v4i16_t __attribute__((ext_vector_type(4)));
DI s16x4 vtr(const LAS unsigned char* p) { return __builtin_bit_cast(s16x4, __builtin_amdgcn_ds_read_tr16_b64_v4i16((LAS v4i16_t*)p)); }
DI int crow16(int i, int h) { return (i & 3) + 8 * (i >> 2) + 4 * h; }
constexpr int AT_KRS = 144, AT_VRS = 192, AT_KB = 64 * AT_KRS, AT_BUF = AT_KB + 64 * AT_VRS, AT_RPB = 2 * AT_BUF;
constexpr float LOG2E = 1.4426950408889634f, AT_SC = 0.125f * LOG2E;
template <int TYPE>
DI void attn_unit(KArgs KA, const Frame& F, int l, int unit, bool ctxq) {
    const bf16* P = (const bf16*)(KA->ws + WS_ACT);
    const int L = F.lane, w = F.wave, r = L & 31, h2 = L >> 5, i16 = L & 15;
    int b, head, kvh, p0, qpos0, t0 = 0, nloc = 0;
    if (TYPE != 2) { int g, pb; if (!ctxq) { b = unit >> 6; g = (unit >> 5) & 1; pb = unit & 31; } else { b = unit >> 2; g = (unit >> 1) & 1; pb = unit & 1; }
        head = 2 * g + (w >> 2); kvh = g; p0 = pb * 128; qpos0 = p0 + 32 * (w & 3);
        if (!ctxq) { if (TYPE == 1) { t0 = 0; nloc = 64; } else { t0 = max(0, 2 * (pb - 1)); nloc = min(64, 2 * (pb + 2)) - t0; } } }
    else { int rb; if (!ctxq) { b = unit >> 6; head = (unit >> 4) & 3; rb = unit & 15; } else { b = unit >> 2; head = unit & 3; rb = 0; }
        kvh = head; p0 = rb * 256; qpos0 = p0 + 32 * w;
        if (!ctxq) { const int r0 = rb * 4; t0 = min(max(r0 - 4, 0), 56); nloc = min(max(r0 - 1, 0), 56) + 8 - t0; } }
    const int qcol = (TYPE == 0 ? C_AQ : TYPE == 1 ? C_CQ : C_DQ) + head * 64;
    const int kcol = (TYPE == 0 ? C_AK : TYPE == 1 ? C_CK : C_DK) + kvh * 64, vcol = (TYPE == 0 ? C_AV : TYPE == 1 ? C_CV : C_DV) + kvh * 64;
    const int qrow = (ctxq ? NLAT + b * CTXL : b * SEQ) + qpos0 + r;
    const int nt = nloc + 4;
    bf16x8v qf[4];
#pragma unroll
    for (int ks = 0; ks < 4; ++ks) qf[ks] = *(const bf16x8v*)(P + (size_t)qrow * NPJ + qcol + ks * 16 + 8 * h2);
    LAS unsigned char* lb = F.lds;
    if (TYPE == 2) { LAS float* rp = (LAS float*)(lb + AT_RPB); for (int i = F.tid; i < 465; i += 512) rp[i] = KA->in[21][(size_t)(l * 4 + head) * 465 + i] * 8.0f; }
    const int srow = F.tid >> 3, sch = F.tid & 7;
#define TILE_ROW0(i) ((i) < nloc ? b * SEQ + (t0 + (i)) * 64 : NLAT + b * CTXL + ((i) - nloc) * 64)
    v4u kreg, vreg;
    { const bf16* src = P + (size_t)(TILE_ROW0(0) + srow) * NPJ; kreg = *(const v4u*)(src + kcol + sch * 8); vreg = *(const v4u*)(src + vcol + sch * 8); }
    *(LAS v4u*)(lb + srow * AT_KRS + sch * 16) = kreg; *(LAS v4u*)(lb + AT_KB + srow * AT_VRS + sch * 16) = vreg;
    __syncthreads();
    f32x16 oacc[2];
#pragma unroll
    for (int i = 0; i < 16; ++i) { oacc[0][i] = 0.f; oacc[1][i] = 0.f; }
    float m = -1e30f, lsum = 0.f;
    if (TYPE == 1) {
        float gq = fabsf(KA->in[19][l * 64 + L]), gk = fabsf(KA->in[20][l * 64 + L]);
#pragma unroll
        for (int o = 1; o < 64; o <<= 1) { gq = fmaxf(gq, __shfl_xor(gq, o)); gk = fmaxf(gk, __shfl_xor(gk, o)); }
        m = 64.0f * 1.03f * gq * gk * AT_SC;
    }
    const int qpos = qpos0 + r;
    const int gr = qpos0 >> 6, rs = min(max(gr - 4, 0), 56), qc = qpos & 63, cs = min(max(qc - 8, 0), 48);
    for (int i = 0; i < nt; ++i) {
        const LAS unsigned char* kb_ = lb + (i & 1) * AT_BUF; const LAS unsigned char* vb_ = kb_ + AT_KB;
        if (i + 1 < nt) { const bf16* src = P + (size_t)(TILE_ROW0(i + 1) + srow) * NPJ; kreg = *(const v4u*)(src + kcol + sch * 8); vreg = *(const v4u*)(src + vcol + sch * 8); }
        const bool loc = i < nloc;
        bool skip = false;
        const int k0 = (t0 + i) * 64;
        if (loc && TYPE == 0) skip = (k0 + 63 < qpos0 - 128) || (k0 > qpos0 + 31 + 128);
        if (loc && TYPE == 2) skip = (t0 + i < rs) || (t0 + i >= rs + 8);
        if (!skip) {
            f32x16 sacc[2];
            bf16x8v kf[2][4], vf[2][2][2];
#pragma unroll
            for (int kb = 0; kb < 2; ++kb)
#pragma unroll
                for (int ks = 0; ks < 4; ++ks) kf[kb][ks] = *(const LAS bf16x8v*)(kb_ + (kb * 32 + r) * AT_KRS + ks * 32 + 16 * h2);
#pragma unroll
            for (int kb = 0; kb < 2; ++kb)
#pragma unroll
                for (int s = 0; s < 2; ++s)
#pragma unroll
                    for (int db = 0; db < 2; ++db) {
                        const LAS unsigned char* va = vb_ + (kb * 32 + 16 * s + 4 * h2 + (i16 >> 2)) * AT_VRS + (db * 32 + 16 * ((L >> 4) & 1) + 4 * (i16 & 3)) * 2;
                        const s16x4 lo = vtr(va), hi = vtr(va + 8 * AT_VRS);
                        vf[kb][s][db] = (bf16x8v){lo[0], lo[1], lo[2], lo[3], hi[0], hi[1], hi[2], hi[3]}; }
            __builtin_amdgcn_sched_barrier(0);
#pragma unroll
            for (int kb = 0; kb < 2; ++kb) {
#pragma unroll
                for (int q = 0; q < 16; ++q) sacc[kb][q] = (TYPE == 1) ? -m : 0.f;
#pragma unroll
                for (int ks = 0; ks < 4; ++ks) sacc[kb] = __builtin_amdgcn_mfma_f32_32x32x16_bf16(kf[kb][ks], qf[ks], sacc[kb], 0, 0, 0);
            }
            float tmax = -INFINITY;
            if ((TYPE == 0 || TYPE == 2) && loc) {
#pragma unroll
                for (int kb = 0; kb < 2; ++kb)
#pragma unroll
                    for (int q = 0; q < 16; ++q) { float s = sacc[kb][q]; const int kk = kb * 32 + crow16(q, h2);
                        if (TYPE == 0) { const int d = k0 + kk - qpos; if (d > 128 || d < -128) s = -INFINITY; }
                        if (TYPE == 2) { const int dc = kk - cs; const LAS float* rp = (const LAS float*)(lb + AT_RPB);
                            if (dc < 0 || dc >= 16) s = -INFINITY; else s += rp[(t0 + i - gr + 7) * 31 + (kk - qc + 15)]; }
                        sacc[kb][q] = s; }
            }
            if (TYPE != 1) {
#pragma unroll
                for (int kb = 0; kb < 2; ++kb)
#pragma unroll
                    for (int q = 0; q < 16; ++q) tmax = fmaxf(tmax, sacc[kb][q]);
                tmax = fmaxf(tmax, __shfl_xor(tmax, 32));
                const float mn = fmaxf(m, tmax);
                if (__any(mn > m)) {
                    const float alpha = __builtin_amdgcn_exp2f((m - mn) * AT_SC);
                    lsum *= alpha;
#pragma unroll
                    for (int q = 0; q < 16; ++q) { oacc[0][q] *= alpha; oacc[1][q] *= alpha; }
                }
                m = mn;
            }
            const float mns = -m * AT_SC;
            float psum = 0.f;
#pragma unroll
            for (int kb = 0; kb < 2; ++kb)
#pragma unroll
                for (int q = 0; q < 16; ++q) { const float p = (TYPE == 1) ? __builtin_amdgcn_exp2f(sacc[kb][q]) : __builtin_amdgcn_exp2f(__builtin_fmaf(sacc[kb][q], AT_SC, mns)); sacc[kb][q] = p; psum += p; }
            lsum += psum;
#pragma unroll
            for (int kb = 0; kb < 2; ++kb)
#pragma unroll
                for (int s = 0; s < 2; ++s) {
                    v4u pw; pw.x = cvtpk(sacc[kb][8 * s], sacc[kb][8 * s + 1]); pw.y = cvtpk(sacc[kb][8 * s + 2], sacc[kb][8 * s + 3]); pw.z = cvtpk(sacc[kb][8 * s + 4], sacc[kb][8 * s + 5]); pw.w = cvtpk(sacc[kb][8 * s + 6], sacc[kb][8 * s + 7]);
                    const bf16x8v pf = __builtin_bit_cast(bf16x8v, pw);
#pragma unroll
                    for (int db = 0; db < 2; ++db) oacc[db] = __builtin_amdgcn_mfma_f32_32x32x16_bf16(vf[kb][s][db], pf, oacc[db], 0, 0, 0);
                }
        }
        if (i + 1 < nt) { LAS unsigned char* nb = lb + ((i + 1) & 1) * AT_BUF; *(LAS v4u*)(nb + srow * AT_KRS + sch * 16) = kreg; *(LAS v4u*)(nb + AT_KB + srow * AT_VRS + sch * 16) = vreg; }
        __syncthreads();
    }
    lsum += __shfl_xor(lsum, 32);
    if (TYPE == 0) lsum += __builtin_amdgcn_exp2f(KA->in[13][l * 4 + head] * LOG2E - m * AT_SC);
    const float inv = __builtin_amdgcn_rcpf(lsum);
    bf16* op = (bf16*)(KA->ws + WS_O) + (size_t)qrow * DM + (TYPE == 0 ? 0 : TYPE == 1 ? 512 : 768) + head * 64;
#pragma unroll
    for (int db = 0; db < 2; ++db)
#pragma unroll
        for (int q4 = 0; q4 < 4; ++q4) { v2u o; o.x = cvtpk(oacc[db][4 * q4] * inv, oacc[db][4 * q4 + 1] * inv); o.y = cvtpk(oacc[db][4 * q4 + 2] * inv, oacc[db][4 * q4 + 3] * inv);
            *(v2u*)(op + db * 32 + 8 * q4 + 4 * h2) = o; }
}
constexpr size_t WS_ST = WS_A;
constexpr size_t WS_DEC = 3 * MiB;
constexpr int SS_B = 0, SS_BRS = 272, SS_X = 34816, SS_XRS = 192, SS_X2 = 59392, SS_HF = 83968, SS_HB = 101376, SS_ARR = 118784;
DI int slot_row(int b, int slot) { return slot < 2 ? NLAT + b * CTXL + slot * 128 : b * SEQ + (slot - 2) * 128; }
DI void ssd_stage_dt(KArgs KA, const Frame& F, int l, int h, int rowbase, LAS float* arr) {
    const float* DTB = (const float*)(KA->ws + WS_DT);
    if (F.tid < 128) { const float df = DTB[(size_t)(rowbase + F.tid) * 8 + h], db = DTB[(size_t)(rowbase + F.tid) * 8 + 4 + h];
        const float Af = -__expf(KA->in[17][l * 8 + h]) * LOG2E, Ab = -__expf(KA->in[17][l * 8 + 4 + h]) * LOG2E;
        arr[F.tid] = df * Af; arr[128 + F.tid] = db * Ab; arr[256 + F.tid] = df; arr[384 + F.tid] = db; }
    __syncthreads();
    if (F.wave < 2) { const int L = F.lane; const bool rev = F.wave == 1;
        const float v0 = rev ? arr[128 + 127 - 2 * L] : arr[2 * L], v1 = rev ? arr[128 + 126 - 2 * L] : arr[2 * L + 1];
        float t = v0 + v1;
#pragma unroll
        for (int o = 1; o < 64; o <<= 1) { const float u = __shfl_up(t, o); if (L >= o) t += u; }
        if (rev) { arr[640 + 127 - 2 * L] = t - v1; arr[640 + 126 - 2 * L] = t; } else { arr[512 + 2 * L] = t - v1; arr[512 + 2 * L + 1] = t; } }
    __syncthreads();
}
struct BRegs { v4u v[4]; };
DI BRegs ssd_load_B(KArgs KA, const Frame& F, int g, int rowbase) {
    const bf16* U = (const bf16*)(KA->ws + WS_U);
    const int row = F.tid >> 2, pc = F.tid & 3; const bf16* src = U + (size_t)(rowbase + row) * 768 + 256 + g * 128 + pc * 32;
    BRegs b;
#pragma unroll
    for (int k = 0; k < 4; ++k) b.v[k] = *(const v4u*)(src + k * 8);
    return b;
}
DI void ssd_store_B(const Frame& F, const BRegs& b) {
    const int row = F.tid >> 2, pc = F.tid & 3;
#pragma unroll
    for (int k = 0; k < 4; ++k) *(LAS v4u*)(F.lds + SS_B + row * SS_BRS + pc * 64 + k * 16) = b.v[k];
}
DI v4u scale8(v4u w, float s) { v4u o; o.x = cvtpk(bflo(w.x) * s, bfhi(w.x) * s); o.y = cvtpk(bflo(w.y) * s, bfhi(w.y) * s); o.z = cvtpk(bflo(w.z) * s, bfhi(w.z) * s); o.w = cvtpk(bflo(w.w) * s, bfhi(w.w) * s); return o; }
DI void ssd_states(KArgs KA, const Frame& F, int l, int item) {
    const int slot = item % 34, bh = item / 34, b = bh >> 2, h = bh & 3, g = h >> 1, rowbase = slot_row(b, slot);
    const int L = F.lane, w = F.wave, r = L & 31, h2 = L >> 5, i16 = L & 15, grp = (L >> 4) & 1;
    LAS float* arr = (LAS float*)(F.lds + SS_ARR);
    const BRegs breg = ssd_load_B(KA, F, g, rowbase);
    v4u x0, x1;
    { const bf16* U = (const bf16*)(KA->ws + WS_U); const int row = F.tid >> 2, pc = F.tid & 3; const bf16* src = U + (size_t)(rowbase + row) * 768 + h * 64 + pc * 16; x0 = *(const v4u*)src; x1 = *(const v4u*)(src + 8); }
    ssd_stage_dt(KA, F, l, h, rowbase, arr);
    ssd_store_B(F, breg);
    { const int row = F.tid >> 2, pc = F.tid & 3;
      const float wf = __builtin_amdgcn_exp2f(arr[512 + 127] - arr[512 + row]) * arr[256 + row], wb = __builtin_amdgcn_exp2f(arr[640] - arr[640 + row]) * arr[384 + row];
      *(LAS v4u*)(F.lds + SS_X + row * SS_XRS + pc * 32) = scale8(x0, wf); *(LAS v4u*)(F.lds + SS_X + row * SS_XRS + pc * 32 + 16) = scale8(x1, wf);
      *(LAS v4u*)(F.lds + SS_X2 + row * SS_XRS + pc * 32) = scale8(x0, wb); *(LAS v4u*)(F.lds + SS_X2 + row * SS_XRS + pc * 32 + 16) = scale8(x1, wb); }
    __syncthreads();
    const int pblk = w >> 2, nblk = w & 3;
    bf16* ST = (bf16*)(KA->ws + WS_ST); float* DEC = (float*)(KA->ws + WS_DEC);
#pragma unroll
    for (int dir = 0; dir < 2; ++dir) {
        f32x16 acc;
#pragma unroll
        for (int q = 0; q < 16; ++q) acc[q] = 0.f;
        const LAS unsigned char* xb = F.lds + (dir ? SS_X2 : SS_X);
#pragma unroll
        for (int ks = 0; ks < 8; ++ks) {
            const LAS unsigned char* xa = xb + (ks * 16 + 8 * h2 + (i16 >> 2)) * SS_XRS + (pblk * 32 + 16 * grp + 4 * (i16 & 3)) * 2;
            const s16x4 xlo = vtr(xa), xhi = vtr(xa + 4 * SS_XRS);
            const LAS unsigned char* ba = F.lds + SS_B + (ks * 16 + 8 * h2 + (i16 >> 2)) * SS_BRS + (nblk * 32 + 16 * grp + 4 * (i16 & 3)) * 2;
            const s16x4 blo = vtr(ba), bhi_ = vtr(ba + 4 * SS_BRS);
            const bf16x8v xf = (bf16x8v){xlo[0], xlo[1], xlo[2], xlo[3], xhi[0], xhi[1], xhi[2], xhi[3]}, bfr = (bf16x8v){blo[0], blo[1], blo[2], blo[3], bhi_[0], bhi_[1], bhi_[2], bhi_[3]};
            acc = __builtin_amdgcn_mfma_f32_32x32x16_bf16(xf, bfr, acc, 0, 0, 0); }
        bf16* dst = ST + ((size_t)((bh * 2 + dir) * 34 + slot)) * 8192;
#pragma unroll
        for (int q = 0; q < 16; ++q) dst[(pblk * 32 + crow16(q, h2)) * 128 + nblk * 32 + r] = (bf16)(cvtpk(acc[q], 0.f) & 0xffffu);
        if (F.tid == 0) DEC[(bh * 2 + dir) * 34 + slot] = __builtin_amdgcn_exp2f(dir ? arr[640] : arr[512 + 127]);
    }
    __syncthreads();
}
DI void ssd_scan() {
    KArgs KA = kargs(); Frame F = mkframe();
    bf16* ST = (bf16*)(KA->ws + WS_ST); const float* DEC = (const float*)(KA->ws + WS_DEC);
    for (int gt = blockIdx.x * 512 + F.tid; gt < 64 * 2048; gt += F.G * 512) {
        const int chain = gt >> 11, e4 = gt & 2047, dir = chain & 1;
        bf16* base = ST + (size_t)chain * 34 * 8192 + e4 * 4;
        v2u tw[34]; float dc[34];
#pragma unroll
        for (int k = 0; k < 34; ++k) { const int slot = dir == 0 ? k : (k < 2 ? 1 - k : 35 - k); tw[k] = *(const v2u*)(base + (size_t)slot * 8192); dc[k] = DEC[chain * 34 + slot]; }
        f32x4 hc = (f32x4){0.f, 0.f, 0.f, 0.f};
#pragma unroll
        for (int k = 0; k < 34; ++k) { const int slot = dir == 0 ? k : (k < 2 ? 1 - k : 35 - k);
            const f32x4 t = (f32x4){bflo(tw[k].x), bfhi(tw[k].x), bflo(tw[k].y), bfhi(tw[k].y)};
            v2u ow; ow.x = cvtpk(hc.x, hc.y); ow.y = cvtpk(hc.z, hc.w); *(v2u*)(base + (size_t)slot * 8192) = ow; hc = hc * dc[k] + t; }
    }
}
DI void ssd_outputs(KArgs KA, const Frame& F, int l, int item) {
    const int slot = item % 34, bh = item / 34, b = bh >> 2, h = bh & 3, g = h >> 1, rowbase = slot_row(b, slot);
    const int L = F.lane, w = F.wave, r = L & 31, h2 = L >> 5, i16 = L & 15, grp = (L >> 4) & 1;
    LAS float* arr = (LAS float*)(F.lds + SS_ARR);
    const bf16* U = (const bf16*)(KA->ws + WS_U);
    const int ib = w & 3, pb = w >> 2, ipos = ib * 32 + r;
    bf16x8v cfq[8];
#pragma unroll
    for (int ks = 0; ks < 8; ++ks) cfq[ks] = *(const bf16x8v*)(U + (size_t)(rowbase + ipos) * 768 + 512 + g * 128 + ks * 16 + 8 * h2);
    const BRegs breg = ssd_load_B(KA, F, g, rowbase);
    v4u x0, x1, hf0, hf1, hb0, hb1;
    { const int row = F.tid >> 2, pc = F.tid & 3; const bf16* src = U + (size_t)(rowbase + row) * 768 + h * 64 + pc * 16; x0 = *(const v4u*)src; x1 = *(const v4u*)(src + 8); }
    { const bf16* ST = (const bf16*)(KA->ws + WS_ST); const int p = F.tid >> 3, pc = F.tid & 7;
      const bf16* sf = ST + ((size_t)((bh * 2 + 0) * 34 + slot)) * 8192 + p * 128 + pc * 16; const bf16* sb = ST + ((size_t)((bh * 2 + 1) * 34 + slot)) * 8192 + p * 128 + pc * 16;
      hf0 = *(const v4u*)sf; hf1 = *(const v4u*)(sf + 8); hb0 = *(const v4u*)sb; hb1 = *(const v4u*)(sb + 8); }
    ssd_stage_dt(KA, F, l, h, rowbase, arr);
    ssd_store_B(F, breg);
    { const int row = F.tid >> 2, pc = F.tid & 3; *(LAS v4u*)(F.lds + SS_X + row * SS_XRS + pc * 32) = x0; *(LAS v4u*)(F.lds + SS_X + row * SS_XRS + pc * 32 + 16) = x1; }
    { const int p = F.tid >> 3, pc = F.tid & 7; LAS unsigned char* d = F.lds + SS_HF + p * SS_BRS + pc * 32; *(LAS v4u*)d = hf0; *(LAS v4u*)(d + 16) = hf1;
      LAS unsigned char* e = F.lds + SS_HB + p * SS_BRS + pc * 32; *(LAS v4u*)e = hb0; *(LAS v4u*)(e + 16) = hb1; }
    __syncthreads();
    const float cfi = arr[512 + ipos], cbi = arr[640 + ipos];
    f32x16 yacc;
#pragma unroll
    for (int q = 0; q < 16; ++q) yacc[q] = 0.f;
#pragma unroll
    for (int jb = 0; jb < 4; ++jb) {
        f32x16 acc;
#pragma unroll
        for (int q = 0; q < 16; ++q) acc[q] = 0.f;
#pragma unroll
        for (int ks = 0; ks < 8; ++ks) { const bf16x8v bfr = *(const LAS bf16x8v*)(F.lds + SS_B + (jb * 32 + r) * SS_BRS + ks * 32 + 16 * h2);
            acc = __builtin_amdgcn_mfma_f32_32x32x16_bf16(bfr, cfq[ks], acc, 0, 0, 0); }
        if (jb < ib) {
#pragma unroll
            for (int q = 0; q < 16; ++q) { const int j = jb * 32 + crow16(q, h2); acc[q] *= __builtin_amdgcn_exp2f(cfi - arr[512 + j]) * arr[256 + j]; }
        } else if (jb > ib) {
#pragma unroll
            for (int q = 0; q < 16; ++q) { const int j = jb * 32 + crow16(q, h2); acc[q] *= __builtin_amdgcn_exp2f(cbi - arr[640 + j]) * arr[384 + j]; }
        } else {
            int rl = r; asm volatile("" : "+v"(rl));
#pragma unroll
            for (int q = 0; q < 16; ++q) { const int jl = crow16(q, h2), j = jb * 32 + jl;
                float wt = 0.f;
                if (jl <= rl) wt += __builtin_amdgcn_exp2f(cfi - arr[512 + j]) * arr[256 + j];
                if (jl >= rl) wt += __builtin_amdgcn_exp2f(cbi - arr[640 + j]) * arr[384 + j];
                acc[q] *= wt; }
        }
#pragma unroll
        for (int s = 0; s < 2; ++s) {
            v4u pw; pw.x = cvtpk(acc[8 * s], acc[8 * s + 1]); pw.y = cvtpk(acc[8 * s + 2], acc[8 * s + 3]); pw.z = cvtpk(acc[8 * s + 4], acc[8 * s + 5]); pw.w = cvtpk(acc[8 * s + 6], acc[8 * s + 7]);
            const bf16x8v pf = __builtin_bit_cast(bf16x8v, pw);
            const LAS unsigned char* xa = F.lds + SS_X + (jb * 32 + 16 * s + 4 * h2 + (i16 >> 2)) * SS_XRS + (pb * 32 + 16 * grp + 4 * (i16 & 3)) * 2;
            const s16x4 lo = vtr(xa), hi = vtr(xa + 8 * SS_XRS);
            const bf16x8v xf = (bf16x8v){lo[0], lo[1], lo[2], lo[3], hi[0], hi[1], hi[2], hi[3]};
            yacc = __builtin_amdgcn_mfma_f32_32x32x16_bf16(xf, pf, yacc, 0, 0, 0); }
    }
#pragma unroll
    for (int dir = 0; dir < 2; ++dir) {
        f32x16 tacc;
#pragma unroll
        for (int q = 0; q < 16; ++q) tacc[q] = 0.f;
#pragma unroll
        for (int ks = 0; ks < 8; ++ks) { const bf16x8v hfr = *(const LAS bf16x8v*)(F.lds + (dir ? SS_HB : SS_HF) + (pb * 32 + r) * SS_BRS + ks * 32 + 16 * h2);
            tacc = __builtin_amdgcn_mfma_f32_32x32x16_bf16(hfr, cfq[ks], tacc, 0, 0, 0); }
        const float sc = __builtin_amdgcn_exp2f(dir ? cbi : cfi);
#pragma unroll
        for (int q = 0; q < 16; ++q) yacc[q] += sc * tacc[q];
    }
    bf16* yp = (bf16*)(KA->ws + WS_Y) + (size_t)(rowbase + ipos) * 256 + h * 64 + pb * 32;
#pragma unroll
    for (int q4 = 0; q4 < 4; ++q4) { v2u o; o.x = cvtpk(yacc[4 * q4], yacc[4 * q4 + 1]); o.y = cvtpk(yacc[4 * q4 + 2], yacc[4 * q4 + 3]); *(v2u*)(yp + 8 * q4 + 4 * h2) = o; }
    __syncthreads();
}
DI void ssd_outputs_phase(int l, bool last) {
    KArgs KA = kargs(); Frame F = mkframe();
    for (int it = blockIdx.x; it < 32 * 34; it += F.G) { if (last && (it % 34) < 2) continue; ssd_outputs(KA, F, l, it); }
}
DI void mixers_flash(int l, bool last) {
    KArgs KA = kargs(); Frame F = mkframe();
    const int nS = 32 * 34, nL = 1536, nC = last ? 0 : 96, nItems = nS + nL + nC;
    for (int it = blockIdx.x; it < nItems; it += F.G) {
        if (it < nS) { ssd_states(KA, F, l, it); continue; }
        int u = it - nS; bool cq = false;
        if (u >= nL) { u -= nL; cq = true; }
        const int ty = u % 3, un = u / 3;
        if (ty == 0) attn_unit<1>(KA, F, l, un, cq); else if (ty == 1) attn_unit<0>(KA, F, l, un, cq); else attn_unit<2>(KA, F, l, un, cq);
    }
}
DI void merge_pass(int l, int nrows) {
    KArgs KA = kargs(); Frame F = mkframe();
    const bf16* P = (const bf16*)(KA->ws + WS_ACT); const bf16* O = (const bf16*)(KA->ws + WS_O); const bf16* Y = (const bf16*)(KA->ws + WS_Y); const bf16* U = (const bf16*)(KA->ws + WS_U);
    bf16* A = (bf16*)(KA->ws + WS_A);
    const int hh = F.lane >> 4, cn = 4 * F.lane;
    const float dsk = KA->in[18][l * 4 + hh];
    f32x4 mg[4];
#pragma unroll
    for (int j = 0; j < 4; ++j) mg[j] = *(const f32x4*)(KA->in[12] + l * DM + 4 * F.lane + 256 * j);
    v2u o0, o2, o3, yw, xw, zw;
#define MERGE_LOAD(r_) do { o0 = *(const v2u*)(O + (size_t)(r_) * DM + cn); o2 = *(const v2u*)(O + (size_t)(r_) * DM + 512 + cn); o3 = *(const v2u*)(O + (size_t)(r_) * DM + 768 + cn); \
        yw = *(const v2u*)(Y + (size_t)(r_) * 256 + cn); xw = *(const v2u*)(U + (size_t)(r_) * 768 + cn); zw = *(const v2u*)(P + (size_t)(r_) * NPJ + C_BZ + cn); } while (0)
    if (F.gw < nrows) MERGE_LOAD(F.gw);
    for (int row = F.gw; row < nrows; row += F.ngw) {
        f32x4 v[4];
        v[0] = (f32x4){bflo(o0.x), bfhi(o0.x), bflo(o0.y), bfhi(o0.y)}; v[2] = (f32x4){bflo(o2.x), bfhi(o2.x), bflo(o2.y), bfhi(o2.y)}; v[3] = (f32x4){bflo(o3.x), bfhi(o3.x), bflo(o3.y), bfhi(o3.y)};
        { const f32x4 yf = (f32x4){bflo(yw.x), bfhi(yw.x), bflo(yw.y), bfhi(yw.y)}, xs = (f32x4){bflo(xw.x), bfhi(xw.x), bflo(xw.y), bfhi(xw.y)}, z = (f32x4){bflo(zw.x), bfhi(zw.x), bflo(zw.y), bfhi(zw.y)};
          const f32x4 y = yf + xs * dsk; v[1] = (f32x4){y.x * silu(z.x), y.y * silu(z.y), y.z * silu(z.z), y.w * silu(z.w)}; }
        if (row + F.ngw < nrows) MERGE_LOAD(row + F.ngw);
#pragma unroll
        for (int j = 0; j < 4; ++j) { const int n = 4 * F.lane + 256 * j;
            const float ss = wave_sum((v[j].x * v[j].x + v[j].y * v[j].y) + (v[j].z * v[j].z + v[j].w * v[j].w));
            const float r = __builtin_amdgcn_rsqf(ss * (1.f / 256.f) + LN_EPS);
            const f32x4 a = v[j] * r * mg[j];
            v2u w; w.x = cvtpk(a.x, a.y); w.y = cvtpk(a.z, a.w); *(v2u*)(A + (size_t)row * DM + n) = w; }
    }
#undef MERGE_LOAD
}
constexpr size_t WS_CTL = 3 * MiB + 512 * 1024, CTL_BYTES = 16384;
constexpr int MISC_OFF = 139264;
#define XB_TMO      128
#define XB_XCNT(j)  (256  + 64 * (j))
#define XB_XSUB(j)  (1280 + 64 * (j))
#define XB_XGEN(j)  (2304 + 64 * (j))
#define XB_TOP      3328
#define XB_TOPGEN   3392
#define XCD_BAR_WORDS 3456
#define XB_SPIN_CAP (1u << 18)

__device__ __forceinline__ unsigned xb_ld(unsigned* p)              { return __hip_atomic_load(p, __ATOMIC_RELAXED, __HIP_MEMORY_SCOPE_AGENT); }
__device__ __forceinline__ unsigned xb_add(unsigned* p, unsigned v) { return __hip_atomic_fetch_add(p, v, __ATOMIC_RELAXED, __HIP_MEMORY_SCOPE_AGENT); }
__device__ __forceinline__ unsigned xb_xcc_id() { return (unsigned)__builtin_amdgcn_s_getreg((3 << 11) | 20) & 0xFu; }
#define XB_SPIN(cond, bar) do { unsigned _sp = 0; while (cond) { __builtin_amdgcn_s_sleep(1); \
    if ((++_sp & 255u) == 0u) { if (xb_ld(&(bar)[XB_TMO])) break; if (_sp > XB_SPIN_CAP) { atomicAdd(&(bar)[XB_TMO], 1u); break; } } } } while (0)

struct XcdBarrier {
    unsigned* bar; unsigned x;
    volatile LAS unsigned* st;
};

__device__ __forceinline__ XcdBarrier xcd_barrier_post(unsigned* bar, volatile LAS unsigned* st) {
    XcdBarrier b; b.bar = bar; b.x = xb_xcc_id(); b.st = st;
    if (threadIdx.x == 0) (void)xb_add(&bar[XB_XCNT(b.x)], 1u);
    return b;
}
__device__ __forceinline__ void xcd_barrier_complete(unsigned* bar, unsigned x, unsigned& nloc, unsigned& nx) {
    const unsigned G = gridDim.x * gridDim.y * gridDim.z;
    unsigned sum, cnt, mine, sp = 0u;
    for (;;) {
        sum = 0u; cnt = 0u; mine = 0u;
#pragma unroll
        for (unsigned j = 0; j < 16; ++j) { const unsigned c = xb_ld(&bar[XB_XCNT(j)]); sum += c; cnt += (c > 0u) ? 1u : 0u; mine = (j == x) ? c : mine; }
        if (sum == G) break;
        __builtin_amdgcn_s_sleep(1);
        if ((++sp & 255u) == 0u) { if (xb_ld(&bar[XB_TMO])) break; if (sp > XB_SPIN_CAP) { atomicAdd(&bar[XB_TMO], 1u); break; } }
    }
    nloc = mine > 0u ? mine : 1u; nx = cnt > 0u ? cnt : 1u;
}

__device__ __forceinline__ void xcd_barrier(const XcdBarrier& b) {
    asm volatile("s_waitcnt vmcnt(0)" ::: "memory");
    __syncthreads();
    if (threadIdx.x == 0) {
        unsigned* bar = b.bar;
        __builtin_amdgcn_s_waitcnt(0);
        unsigned nloc = b.st[0], nx = b.st[1];
        if (nloc == 0u) { xcd_barrier_complete(bar, b.x, nloc, nx); b.st[0] = nloc; b.st[1] = nx; }
        const unsigned old = xb_add(&bar[XB_XSUB(b.x)], 1u);
        const unsigned gen = old / nloc;
        if (old + 1u == (gen + 1u) * nloc) {
            __builtin_amdgcn_fence(__ATOMIC_RELEASE, "agent");
            asm volatile("s_waitcnt vmcnt(0)" ::: "memory");
            const unsigned og = xb_add(&bar[XB_TOP], 1u);
            const unsigned tg = og / nx;
            if (og + 1u == (tg + 1u) * nx) xb_add(&bar[XB_TOPGEN], 1u);
            else XB_SPIN(xb_ld(&bar[XB_TOPGEN]) == tg, bar);
            __builtin_amdgcn_fence(__ATOMIC_ACQUIRE, "agent");
            xb_add(&bar[XB_XGEN(b.x)], 1u);
            asm volatile("s_waitcnt vmcnt(0)" ::: "memory");
        } else {
            XB_SPIN(xb_ld(&bar[XB_XGEN(b.x)]) == gen, bar);
            __builtin_amdgcn_fence(__ATOMIC_ACQUIRE, "agent");
            asm volatile("s_waitcnt vmcnt(0)" ::: "memory");
        }
    }
    __syncthreads();
}

#define GRID_BAR() do { XcdBarrier b_; b_.bar = (unsigned*)(kargs()->ws + WS_CTL); b_.x = xb_xcc_id(); b_.st = (volatile LAS unsigned*)((LAS unsigned char*)lds + MISC_OFF); xcd_barrier(b_); } while (0)
#ifndef PROBE_GRP
#define PROBE_GRP 0
#endif
#define TIMED(grp, ...) do { unsigned long long t0_ = 0; if (PROBE_GRP == (grp)) t0_ = __builtin_amdgcn_s_memrealtime(); __VA_ARGS__; \
    if (PROBE_GRP == (grp) && blockIdx.x == 0) { const unsigned long long dt_ = __builtin_amdgcn_s_memrealtime() - t0_; const unsigned long long t1_ = __builtin_amdgcn_s_memrealtime(); \
        while (__builtin_amdgcn_s_memrealtime() - t1_ < 2 * dt_) __builtin_amdgcn_s_sleep(8); } } while (0)
__global__ void __launch_bounds__(NWAVES * 64, 2) mega_fwd(Args args) {
    extern __shared__ __attribute__((aligned(16))) unsigned char lds[];
    cg::grid_group grid = cg::this_grid();
    if (threadIdx.x < 2) ((volatile LAS unsigned*)((LAS unsigned char*)lds + MISC_OFF))[threadIdx.x] = 0u;
    __syncthreads();
    (void)xcd_barrier_post((unsigned*)(kargs()->ws + WS_CTL), (volatile LAS unsigned*)((LAS unsigned char*)lds + MISC_OFF));
    { LAS float* rc = (LAS float*)((LAS unsigned char*)lds + ROPE_OFF);
      for (int i = threadIdx.x; i < 1024; i += 512) { const int pos = i >> 4, fi = i & 15; const float inv = exp2f(-(float)fi * (13.287712379549449f / 16.f)); const float ang = (float)pos * inv; rc[i] = cosf(ang); rc[1024 + i] = sinf(ang); } }
    __syncthreads();

    if (args.ws == nullptr) grid.sync();
    p0a(); GRID_BAR(); p0b(); GRID_BAR(); p0c(); GRID_BAR();
    for (int l = 0; l < NL; ++l) {
        const bool last = (l == NL - 1); const int mrows = last ? NLAT : NROW;
        for (int s = 0; s < 3; ++s) {
            if (s != 1) {
                const bool second = (s == 2); const int rows = (second && last) ? NLAT : NROW;
                { KArgs KA = kargs(); pg8::Gemm g{((bf16*)(KA->ws + WS_A)), wbuf(KA, l, second ? WO_W1B : WO_W1A), rows, 2 * DFF, DM}; pg8::StaticOrder S; S.init(rows, 2 * DFF, (int)gridDim.x, (int)blockIdx.x); pg8::EpiSwiGLU E{((bf16*)(KA->ws + WS_ACT)), DFF};
                  pg8::gemm_phase<pg8::EpiSwiGLU, pg8::StaticOrder, true, GEMM_SP2>((LAS unsigned char*)lds, g, S, E); }
                GRID_BAR();
                { KArgs KA = kargs(); pg8::Gemm g{((bf16*)(KA->ws + WS_ACT)), wbuf(KA, l, second ? WO_W2B : WO_W2A), NLAT, DM, DFF}; pg8::StaticOrder S; S.init(NLAT, DM, (int)gridDim.x, (int)blockIdx.x); pg8::EpiBf16 E{((bf16*)(KA->ws + WS_O)), DM};
                  pg8::gemm_phase<pg8::EpiBf16, pg8::StaticOrder, true, GEMM_SP2>((LAS unsigned char*)lds, g, S, E); }
                GRID_BAR();
                const bool split = (rows == NROW);
                const int gidx = second ? 8 : 2, lnidx = second ? 2 : 0, nl = second ? l + 1 : l, nsh = second ? (last ? -1 : 0) : 3;
                if (split && blockIdx.x < 32) {
                    KArgs KA = kargs(); pg8::Gemm g{((bf16*)(KA->ws + WS_ACT)) + (size_t)NLAT * DFF, wbuf(KA, l, second ? WO_W2B : WO_W2A), NCTX, DM, DFF}; pg8::StaticOrder S; S.init(NCTX, DM, 32, (int)blockIdx.x);
                    pg8::EpiBf16 E{((bf16*)(KA->ws + WS_O)) + (size_t)NLAT * DM, DM};
                    pg8::gemm_phase<pg8::EpiBf16, pg8::StaticOrder, true, GEMM_SP2>((LAS unsigned char*)lds, g, S, E);
                } else ln_pass(l, gidx, 0.5f, lnidx, nl, nsh, 0, NLAT, split ? 32 : 0, split ? (int)gridDim.x - 32 : (int)gridDim.x, !second);
                if (split) { GRID_BAR(); ln_pass(l, gidx, 0.5f, lnidx, nl, nsh, NLAT, NROW, 0, (int)gridDim.x, !second); }
                if (!(second && last)) GRID_BAR();
            } else {
                { KArgs KA = kargs(); pg8::Gemm g{((bf16*)(KA->ws + WS_A)), wbuf(KA, l, WO_WIN), NROW, NPJ, DM}; pg8::StaticOrder S; S.init(NROW, NPJ, (int)gridDim.x, (int)blockIdx.x); pg8::EpiBf16 E{((bf16*)(KA->ws + WS_ACT)), NPJ};
                  pg8::gemm_phase<pg8::EpiBf16, pg8::StaticOrder, true, GEMM_SP2>((LAS unsigned char*)lds, g, S, E); }
                GRID_BAR();
                prep_pass(l); GRID_BAR();
                mixers_flash(l, last); GRID_BAR();
                ssd_scan(); GRID_BAR();
                ssd_outputs_phase(l, last); GRID_BAR();
                merge_pass(l, mrows); GRID_BAR();
                { KArgs KA = kargs(); pg8::Gemm g{((bf16*)(KA->ws + WS_A)), wbuf(KA, l, WO_WOUT), mrows, DM, DM}; pg8::StaticOrder S; S.init(mrows, DM, (int)gridDim.x, (int)blockIdx.x); pg8::EpiBf16 E{((bf16*)(KA->ws + WS_O)), DM};
                  pg8::gemm_phase<pg8::EpiBf16, pg8::StaticOrder, true, GEMM_SP2>((LAS unsigned char*)lds, g, S, E); }
                GRID_BAR();
                ln_pass(l, 5, 1.0f, 1, l, 6, 0, mrows, 0, (int)gridDim.x, false); GRID_BAR();
            }
        }
    }
}

extern "C" void kernel_launch(void* const* d_in, const int* in_sizes, int n_in, void* d_out, int out_size, void* d_ws, size_t ws_size, hipStream_t stream) {
    static int grid = 0;
    if (grid == 0) {
        if (n_in != 24 || out_size != NLAT * DM || ws_size < WS_END) { fprintf(stderr, "kernel_launch: unexpected shapes: n_in %d out %d ws %zu\n", n_in, out_size, ws_size); grid = -1; return; }
        int dev = 0, cus = 0, per_cu = 0;
        hipGetDevice(&dev); hipDeviceGetAttribute(&cus, hipDeviceAttributeMultiprocessorCount, dev);
        if (hipFuncSetAttribute((const void*)mega_fwd, hipFuncAttributeMaxDynamicSharedMemorySize, LDS_BYTES) != hipSuccess) { fprintf(stderr, "kernel_launch: hipFuncSetAttribute failed\n"); grid = -1; return; }
        if (hipOccupancyMaxActiveBlocksPerMultiprocessor(&per_cu, (const void*)mega_fwd, NWAVES * 64, LDS_BYTES) != hipSuccess || per_cu < 1) { fprintf(stderr, "kernel_launch: occupancy query says %d\n", per_cu); per_cu = 1; }
        (void)hipGetLastError();
        grid = cus;
    }
    if (grid < 0) return;
    if (hipMemsetAsync((char*)d_ws + WS_CTL, 0, CTL_BYTES, stream) != hipSuccess) { fprintf(stderr, "kernel_launch: memset of the barrier words failed\n"); return; }
    Args a{};
    for (int i = 0; i < 24; ++i) a.in[i] = (const float*)d_in[i];
    a.out = (float*)d_out; a.ws = (unsigned char*)d_ws;
    void* kargs[] = {&a};
    hipError_t e = hipLaunchCooperativeKernel((const void*)mega_fwd, dim3(grid), dim3(NWAVES * 64), kargs, LDS_BYTES, stream);
    if (e != hipSuccess) fprintf(stderr, "kernel_launch: cooperative launch failed: %s (grid %d)\n", hipGetErrorString(e), grid);
}
```

```cpp
#include <hip/hip_runtime.h>
#include <hip/hip_cooperative_groups.h>
#include <cstdio>
#include <cstdint>
namespace cg = cooperative_groups;
namespace pg8 {
#define PG8_LAS __attribute__((address_space(3)))
typedef unsigned short bf16_t;
typedef short bf16x8 __attribute__((ext_vector_type(8)));
typedef float f32x4 __attribute__((ext_vector_type(4)));
typedef unsigned u32x4 __attribute__((ext_vector_type(4)));
constexpr int BM = 256, BK = 64, HALF = 128, HTB = HALF * BK * 2  , STAGE_BYTES = 8 * HTB, NXCD = 8, WGM = 8;

__host__ __device__ __forceinline__ int lds_byte(int r, int c) { const int st = (r >> 4) * 2 + (c >> 5), rr = r & 15, cc = c & 31, ob = rr * 64 + cc * 2; return st * 1024 + (ob ^ (((ob >> 9) & 1) << 5)); }
__host__ __device__ __forceinline__ void stage_rc(int b, int& R, int& C) { const int st = b / 1024, sb = b % 1024, swz = sb ^ (((sb >> 9) & 1) << 5); R = (st >> 1) * 16 + swz / 64; C = (st & 1) * 32 + (swz % 64) / 2; }
__host__ __device__ __forceinline__ int perm32(int rho) { const int n = rho >> 4, i = rho & 15; return 8 * (i >> 2) + 4 * n + (i & 3); }

struct Unit { int pm, pn; };
struct Gemm { const bf16_t* A; const bf16_t* Bt; int M, N, K; };

struct StaticOrder {
    int nM, nN, nwg, G, c;
    __host__ __device__ void init(int M, int N, int G_, int c_) { nM = M / BM; nN = N / BM; nwg = nM * nN; G = G_; c = c_; }
    __host__ __device__ bool next(int i, Unit& u) const {
        const long L = (long)i * G + c; if (L >= nwg) return false;
        int wgid = (int)L; { const int q = nwg / NXCD, r = nwg % NXCD, xcd = wgid % NXCD, off = wgid / NXCD; wgid = (xcd < r ? xcd * (q + 1) : r * (q + 1) + (xcd - r) * q) + off; }
        const int nig = WGM * nN, gid = wgid / nig, fm = gid * WGM, gsz = (nM - fm) < WGM ? (nM - fm) : WGM;
        u.pm = fm + ((wgid % nig) % gsz); u.pn = (wgid % nig) / gsz; return true;
    }
    __device__ __forceinline__ void a_ready(const Unit&) const {}
    __device__ __forceinline__ void done(const Unit&) const {}
};

__device__ __forceinline__ unsigned cvt_pk_bf16(float lo, float hi) { unsigned r; asm volatile("v_cvt_pk_bf16_f32 %0, %1, %2" : "=v"(r) : "v"(lo), "v"(hi)); return r; }
struct EpiBf16 {
    static constexpr bool PERM = true, AFTER_DRAIN = false;
    bf16_t* O; int ldc;
    __device__ __forceinline__ void operator()(const f32x4 (&acc)[2][2][4][2], const Unit& u, int wr, int wc, int fr, int fq) const {
        const int row0 = u.pm * BM + wr * 64 + fr; const int col0 = u.pn * BM + wc * 32 + 8 * fq;
#pragma unroll
        for (int ai = 0; ai < 2; ++ai)
#pragma unroll
            for (int m = 0; m < 4; ++m) { bf16_t* rowp = O + (size_t)(row0 + ai * HALF + m * 16) * ldc + col0;
#pragma unroll
                for (int bj = 0; bj < 2; ++bj) { const f32x4 v0 = acc[ai][bj][m][0], v1 = acc[ai][bj][m][1];
                    u32x4 w; w.x = cvt_pk_bf16(v0[0], v0[1]); w.y = cvt_pk_bf16(v0[2], v0[3]); w.z = cvt_pk_bf16(v1[0], v1[1]); w.w = cvt_pk_bf16(v1[2], v1[3]);
                    *(u32x4*)(rowp + bj * HALF) = w; } }
    }
};
__device__ __forceinline__ float silu_f(float x) { return x * __builtin_amdgcn_rcpf(1.0f + __expf(-x)); }
struct EpiSwiGLU {
    static constexpr bool PERM = true, AFTER_DRAIN = false;
    bf16_t* O; int ldc;
    __device__ __forceinline__ void operator()(const f32x4 (&acc)[2][2][4][2], const Unit& u, int wr, int wc, int fr, int fq) const {
        const int row0 = u.pm * BM + wr * 64 + fr; const int col0 = u.pn * HALF + wc * 32 + 8 * fq;
#pragma unroll
        for (int ai = 0; ai < 2; ++ai)
#pragma unroll
            for (int m = 0; m < 4; ++m) { bf16_t* rowp = O + (size_t)(row0 + ai * HALF + m * 16) * ldc + col0;
                const f32x4 a0 = acc[ai][0][m][0], a1 = acc[ai][0][m][1], u0 = acc[ai][1][m][0], u1 = acc[ai][1][m][1];
                u32x4 w;
                w.x = cvt_pk_bf16(silu_f(a0[0]) * u0[0], silu_f(a0[1]) * u0[1]); w.y = cvt_pk_bf16(silu_f(a0[2]) * u0[2], silu_f(a0[3]) * u0[3]);
                w.z = cvt_pk_bf16(silu_f(a1[0]) * u1[0], silu_f(a1[1]) * u1[1]); w.w = cvt_pk_bf16(silu_f(a1[2]) * u1[2], silu_f(a1[3]) * u1[3]);
                *(u32x4*)rowp = w; }
    }
};
template <class Epi, class Sched, bool ALIGN_EPI = false, bool SP2 = false>
__device__ __forceinline__ void gemm_phase(PG8_LAS unsigned char* lds, const Gemm g, const Sched& S, const Epi& E) {
    int tid_l = threadIdx.x; asm volatile("" : "+v"(tid_l));
    const int tid = tid_l, wid = __builtin_amdgcn_readfirstlane(tid >> 6), lane = tid & 63, wr = wid >> 2, wc = wid & 3, fr = lane & 15, fq = lane >> 4;
    const int K = g.K, nt = K / BK;
    unsigned voffA[2], voffB[2];
#pragma unroll
    for (int i = 0; i < 2; ++i) { int R, C; stage_rc(tid * 16 + i * 8192, R, C); const int Rb = Epi::PERM ? ((R & ~31) + perm32(R & 31)) : R;
        voffA[i] = (unsigned)(R * K + C) * 2u; voffB[i] = (unsigned)(Rb * K + C) * 2u; }
    const size_t kstep = (size_t)(BK * 2);
    const size_t hstep = (size_t)HALF * K * 2;
    const size_t tstep = 2 * hstep;
    const unsigned ldsw = (unsigned)wid * 1024u;
    const int aoff = lds_byte(wr * 64 + fr, fq * 8), boff = lds_byte(wc * 32 + fr, fq * 8);
#define PG8_SA(b, h) (((b) * 2 + (h)) * HTB)
#define PG8_SB(b, h) ((4 + (b) * 2 + (h)) * HTB)
#define PG8_STAGE(bufoff, gbase, voff) do { _Pragma("unroll") for (int _i = 0; _i < 2; ++_i) \
        __builtin_amdgcn_global_load_lds((const unsigned*)((const char*)(gbase) + (voff)[_i]), (PG8_LAS unsigned*)(lds + (bufoff) + ldsw + _i * 8192), 16, 0, 0); } while (0)
#define PG8_LDA(dst, b, h) do { _Pragma("unroll") for (int m = 0; m < 4; ++m) _Pragma("unroll") for (int k = 0; k < 2; ++k) dst[m][k] = *(const PG8_LAS bf16x8*)(lds + PG8_SA(b, h) + aoff + m * 2048 + k * 1024); } while (0)
#define PG8_LDB(dst, b, h) do { _Pragma("unroll") for (int n = 0; n < 2; ++n) _Pragma("unroll") for (int k = 0; k < 2; ++k) dst[n][k] = *(const PG8_LAS bf16x8*)(lds + PG8_SB(b, h) + boff + n * 2048 + k * 1024); } while (0)
#define PG8_MMA(ai, bj, At, Bt) do { __builtin_amdgcn_s_setprio(1); _Pragma("unroll") for (int m = 0; m < 4; ++m) _Pragma("unroll") for (int n = 0; n < 2; ++n) _Pragma("unroll") for (int k = 0; k < 2; ++k) \
        acc[ai][bj][m][n] = __builtin_amdgcn_mfma_f32_16x16x32_bf16(Bt[n][k], At[m][k], acc[ai][bj][m][n], 0, 0, 0); __builtin_amdgcn_s_setprio(0); } while (0)
#define PG8_WAIT_V(n) asm volatile("s_waitcnt vmcnt(" #n ")" ::: "memory")
#define PG8_WAIT_L(n) asm volatile("s_waitcnt lgkmcnt(" #n ")" ::: "memory")
#define PG8_BAR __builtin_amdgcn_s_barrier()
#define PG8_SCHED __builtin_amdgcn_sched_barrier(0)
    Unit cur, nxt; int ui = 0;
    if (!S.next(0, cur)) return;
    f32x4 acc[2][2][4][2];
#pragma unroll
    for (int a = 0; a < 2; ++a)
#pragma unroll
        for (int b = 0; b < 2; ++b)
#pragma unroll
            for (int m = 0; m < 4; ++m)
#pragma unroll
                for (int n = 0; n < 2; ++n) acc[a][b][m][n] = (f32x4){0.f, 0.f, 0.f, 0.f};
    bf16x8 At[4][2], B0[2][2], B1[2][2];
    const char* cA = (const char*)g.A + (size_t)cur.pm * tstep; const char* cB = (const char*)g.Bt + (size_t)cur.pn * tstep;
    S.a_ready(cur);
    if constexpr (SP2) {
        PG8_STAGE(PG8_SB(0, 0), cB, voffB); PG8_STAGE(PG8_SB(0, 1), cB + hstep, voffB); PG8_STAGE(PG8_SA(0, 0), cA, voffA); PG8_STAGE(PG8_SA(0, 1), cA + hstep, voffA);
        if (wr == 1) PG8_BAR;
        PG8_WAIT_V(2); PG8_BAR;
        PG8_STAGE(PG8_SB(1, 0), cB + kstep, voffB); PG8_STAGE(PG8_SA(1, 0), cA + kstep, voffA); PG8_STAGE(PG8_SB(1, 1), cB + hstep + kstep, voffB);
        PG8_WAIT_V(6); PG8_BAR;
    } else {
        PG8_STAGE(PG8_SB(0, 0), cB, voffB); PG8_STAGE(PG8_SA(0, 0), cA, voffA); PG8_STAGE(PG8_SB(0, 1), cB + hstep, voffB); PG8_STAGE(PG8_SA(0, 1), cA + hstep, voffA);
        if (wr == 1) PG8_BAR;
        PG8_WAIT_V(4); PG8_BAR;
        PG8_STAGE(PG8_SB(1, 0), cB + kstep, voffB); PG8_STAGE(PG8_SA(1, 0), cA + kstep, voffA); PG8_STAGE(PG8_SB(1, 1), cB + hstep + kstep, voffB);
        PG8_WAIT_V(6); PG8_BAR;
    }
    for (;;) {
        const bool has_next = S.next(ui + 1, nxt);
        const char* nA = has_next ? (const char*)g.A + (size_t)nxt.pm * tstep : cA; const char* nB = has_next ? (const char*)g.Bt + (size_t)nxt.pn * tstep : cB;
        for (int t = 0; t < nt; t += 2) {
            const bool last = (t == nt - 2);
            const char* a1 = cA + (size_t)(t + 1) * kstep;
            const char* a2 = last ? nA : cA + (size_t)(t + 2) * kstep; const char* b2 = last ? nB : cB + (size_t)(t + 2) * kstep;
            const char* a3 = a2 + kstep; const char* b3 = b2 + kstep;
            if (last && has_next) S.a_ready(nxt);
            if constexpr (SP2) {
            PG8_LDB(B0, 0, 0); PG8_LDB(B1, 0, 1); PG8_SCHED; PG8_LDA(At, 0, 0); PG8_STAGE(PG8_SA(1, 1), a1 + hstep, voffA);
            PG8_WAIT_V(8); PG8_WAIT_L(0); PG8_BAR; PG8_MMA(0, 0, At, B0); PG8_MMA(0, 1, At, B1); PG8_BAR; PG8_SCHED;
            PG8_LDA(At, 0, 1); PG8_STAGE(PG8_SB(0, 0), b2, voffB); PG8_STAGE(PG8_SB(0, 1), b2 + hstep, voffB); PG8_STAGE(PG8_SA(0, 0), a2, voffA);
            PG8_WAIT_V(8); PG8_WAIT_L(0); PG8_BAR; PG8_MMA(1, 0, At, B0); PG8_MMA(1, 1, At, B1); PG8_BAR; PG8_SCHED;
            PG8_LDB(B0, 1, 0); PG8_LDB(B1, 1, 1); PG8_SCHED; PG8_LDA(At, 1, 0); PG8_STAGE(PG8_SA(0, 1), a2 + hstep, voffA);
            PG8_WAIT_V(8); PG8_WAIT_L(0); PG8_BAR; PG8_MMA(0, 0, At, B0); PG8_MMA(0, 1, At, B1); PG8_BAR; PG8_SCHED;
            PG8_LDA(At, 1, 1); PG8_STAGE(PG8_SB(1, 0), b3, voffB); PG8_STAGE(PG8_SB(1, 1), b3 + hstep, voffB); PG8_STAGE(PG8_SA(1, 0), a3, voffA);
            PG8_WAIT_V(8); PG8_WAIT_L(0); PG8_BAR; PG8_MMA(1, 0, At, B0); PG8_MMA(1, 1, At, B1); PG8_BAR; PG8_SCHED;
            } else {
            PG8_LDB(B0, 0, 0); PG8_SCHED; PG8_LDA(At, 0, 0); PG8_STAGE(PG8_SA(1, 1), a1 + hstep, voffA);
            PG8_WAIT_L(8); PG8_BAR; PG8_WAIT_L(0); PG8_MMA(0, 0, At, B0); PG8_BAR; PG8_SCHED;
            PG8_LDB(B1, 0, 1); PG8_STAGE(PG8_SB(0, 0), b2, voffB);
            PG8_BAR; PG8_WAIT_L(0); PG8_MMA(0, 1, At, B1); PG8_BAR;
            PG8_LDA(At, 0, 1); PG8_STAGE(PG8_SA(0, 0), a2, voffA);
            PG8_BAR; PG8_WAIT_L(0); PG8_MMA(1, 0, At, B0); PG8_BAR; PG8_SCHED;
            PG8_STAGE(PG8_SB(0, 1), b2 + hstep, voffB);
            PG8_WAIT_V(6); PG8_BAR; PG8_MMA(1, 1, At, B1); PG8_BAR;
            PG8_LDB(B0, 1, 0); PG8_SCHED; PG8_LDA(At, 1, 0); PG8_STAGE(PG8_SA(0, 1), a2 + hstep, voffA);
            PG8_WAIT_L(8); PG8_BAR; PG8_WAIT_L(0); PG8_MMA(0, 0, At, B0); PG8_BAR; PG8_SCHED;
            PG8_LDB(B1, 1, 1); PG8_STAGE(PG8_SB(1, 0), b3, voffB);
            PG8_BAR; PG8_WAIT_L(0); PG8_MMA(0, 1, At, B1); PG8_BAR;
            PG8_LDA(At, 1, 1); PG8_STAGE(PG8_SA(1, 0), a3, voffA);
            PG8_BAR; PG8_WAIT_L(0); PG8_MMA(1, 0, At, B0); PG8_BAR; PG8_SCHED;
            PG8_STAGE(PG8_SB(1, 1), b3 + hstep, voffB);
            PG8_WAIT_V(6); PG8_BAR; PG8_MMA(1, 1, At, B1); PG8_BAR;
            }
        }
        if constexpr (ALIGN_EPI) { if (wr == 0) PG8_BAR; }
        if constexpr (!Epi::AFTER_DRAIN) { E(acc, cur, wr, wc, fr, fq); S.done(cur); }
        if (!has_next) break;
#pragma unroll
        for (int a = 0; a < 2; ++a)
#pragma unroll
            for (int b = 0; b < 2; ++b)
#pragma unroll
                for (int m = 0; m < 4; ++m)
#pragma unroll
                    for (int n = 0; n < 2; ++n) acc[a][b][m][n] = (f32x4){0.f, 0.f, 0.f, 0.f};
        cur = nxt; cA = nA; cB = nB; ++ui;
        if constexpr (ALIGN_EPI) { if (wr == 1) PG8_BAR; }
    }
    PG8_WAIT_V(0);
    if constexpr (!ALIGN_EPI) { if (wr == 0) PG8_BAR; }
    PG8_BAR;
    if constexpr (Epi::AFTER_DRAIN) { E.fused(acc, cur, wr, wc, fr, fq, lds, wid, lane); S.done(cur); }
#undef PG8_SA
#undef PG8_SB
#undef PG8_STAGE
#undef PG8_LDA
#undef PG8_LDB
#undef PG8_MMA
#undef PG8_WAIT_V
#undef PG8_WAIT_L
#undef PG8_BAR
#undef PG8_SCHED
}
}

constexpr int NB = 8, SEQ = 4096, DM = 1024, NL = 2, CTXL = 256;
constexpr int NLAT = NB * SEQ, NCTX = NB * CTXL, NROW = NLAT + NCTX;
constexpr int DFF = 2816, NPJ = 2816, INW = 2824, NMODW = 9 * DM;
constexpr float LN_EPS = 1e-5f, ALPHA = 1.41421356237f;
constexpr int C_AQ = 0, C_AK = 256, C_AV = 384, C_BZ = 512, C_BX = 768, C_CQ = 1536, C_CK = 1792, C_CV = 1920, C_DQ = 2048, C_DK = 2304, C_DV = 2560;
constexpr int C_DTSRC = 1536;
constexpr size_t MiB = 1u << 20;
constexpr size_t WS_MOD = 0;
constexpr size_t WS_DT = 1 * MiB;
constexpr size_t WS_W = 4 * MiB, WS_WL = 41 * MiB;
constexpr size_t WO_W1A = 0, WO_W2A = 11 * MiB, WO_WIN = 16 * MiB + MiB / 2, WO_WOUT = 22 * MiB, WO_W1B = 24 * MiB, WO_W2B = 35 * MiB;
constexpr size_t WS_A = 86 * MiB;
constexpr size_t WS_ACT = 154 * MiB;
constexpr size_t WS_U = 341 * MiB;
constexpr size_t WS_O = 392 * MiB;
constexpr size_t WS_XC = 460 * MiB;
constexpr size_t WS_Y = 468 * MiB;
constexpr size_t WS_END = 512 * MiB;
constexpr int RING_BYTES = 131072, ROPE_OFF = RING_BYTES, LDS_BYTES = 147456;
constexpr int NWAVES = 8;
constexpr bool GEMM_SP2 = true;

#define LAS __attribute__((address_space(3)))
#define DI __device__ __forceinline__
typedef unsigned short bf16;
typedef unsigned v4u __attribute__((ext_vector_type(4)));
typedef unsigned v2u __attribute__((ext_vector_type(2)));
typedef float f32x4 __attribute__((ext_vector_type(4)));

DI float bf2f(unsigned b) { return __uint_as_float(b << 16); }
DI float bflo(unsigned w) { return __uint_as_float(w << 16); }
DI float bfhi(unsigned w) { return __uint_as_float(w & 0xffff0000u); }
DI unsigned f2bf(float f) { unsigned u = __float_as_uint(f); return (u + 0x7fffu + ((u >> 16) & 1u)) >> 16; }
DI unsigned pk2(float lo, float hi) { return f2bf(lo) | (f2bf(hi) << 16); }
typedef float f32x2_t __attribute__((ext_vector_type(2))); typedef __bf16 bf16x2_t __attribute__((ext_vector_type(2)));
DI unsigned cvtpk(float lo, float hi) { f32x2_t v = {lo, hi}; bf16x2_t b = __builtin_convertvector(v, bf16x2_t); return __builtin_bit_cast(unsigned, b); }
DI float dpp_f(float v, const int ctrl_unused) { return v; }
#define DPP_ADD(v_, ctrl_) ((v_) + __builtin_bit_cast(float, __builtin_amdgcn_update_dpp(0, __builtin_bit_cast(int, (v_)), (ctrl_), 0xf, 0xf, false)))
DI float wave_sum(float v) {
    v = DPP_ADD(v, 0xB1);
    v = DPP_ADD(v, 0x4E);
    v = DPP_ADD(v, 0x141);
    v = DPP_ADD(v, 0x140);
    const int vi = __builtin_bit_cast(int, v);
    const float r0 = __builtin_bit_cast(float, __builtin_amdgcn_readlane(vi, 0)), r1 = __builtin_bit_cast(float, __builtin_amdgcn_readlane(vi, 16));
    const float r2 = __builtin_bit_cast(float, __builtin_amdgcn_readlane(vi, 32)), r3 = __builtin_bit_cast(float, __builtin_amdgcn_readlane(vi, 48));
    return (r0 + r1) + (r2 + r3);
}
DI float silu(float x) { return x * __builtin_amdgcn_rcpf(1.0f + __expf(-x)); }

struct Args { const float* in[24]; float* out; unsigned char* ws; };
typedef const __attribute__((address_space(4))) Args* KArgs;
DI KArgs kargs() { KArgs p = (KArgs)__builtin_amdgcn_kernarg_segment_ptr(); asm volatile("" : "+s"(p)); return p; }

struct Frame {
    LAS unsigned char* lds;
    int tid, lane, wave, G, gw, ngw;
};
DI Frame mkframe() { Frame F; extern __shared__ __attribute__((aligned(16))) unsigned char lds_base[]; F.lds = (LAS unsigned char*)lds_base;
    int t = threadIdx.x; asm volatile("" : "+v"(t)); F.tid = t; F.lane = t & 63; F.wave = __builtin_amdgcn_readfirstlane(t >> 6);
    F.G = gridDim.x; F.gw = blockIdx.x * NWAVES + F.wave; F.ngw = F.G * NWAVES; return F; }
DI bf16* wbuf(KArgs KA, int l, size_t off) { return (bf16*)((KA->ws) + WS_W + (size_t)l * WS_WL + off); }

DI void transpose_item(const float* W, int ldw, int k0, int n0, bf16* WT, int ldt, int drow0, LAS float* scr, int lane) {
    float tv[32];
#pragma unroll
    for (int i = 0; i < 32; ++i) tv[i] = W[(size_t)(k0 + 2 * i + (lane >> 5)) * ldw + n0 + (lane & 31)];
#pragma unroll
    for (int i = 0; i < 32; ++i) scr[(2 * i + (lane >> 5)) * 33 + (lane & 31)] = tv[i];
    asm volatile("s_waitcnt lgkmcnt(0)" ::: "memory");
    const int c = lane & 7;
#pragma unroll
    for (int j = 0; j < 4; ++j) { const int n = (lane >> 3) + 8 * j; const LAS float* s = scr + (8 * c) * 33 + n;
        v4u o; o.x = pk2(s[0 * 33], s[1 * 33]); o.y = pk2(s[2 * 33], s[3 * 33]); o.z = pk2(s[4 * 33], s[5 * 33]); o.w = pk2(s[6 * 33], s[7 * 33]);
        *(v4u*)(WT + (size_t)(drow0 + n) * ldt + k0 + 8 * c) = o; }
    asm volatile("s_waitcnt lgkmcnt(0)" ::: "memory");
}
DI void p0a() {
    KArgs KA = kargs(); Frame F = mkframe();
    {
        LAS float* sv = (LAS float*)F.lds;
        for (int it = blockIdx.x; it < NL * 16 * 9; it += F.G) {
            const int l = it / 144, kc = (it % 144) / 9, cb = it % 9;
            __syncthreads();
            for (int i = F.tid; i < 576; i += 512) { const int r = i >> 6, kk = i & 63; const float v = r < 8 ? KA->in[1][r * DM + kc * 64 + kk] : KA->in[3][kc * 64 + kk]; sv[i] = silu(v); }
            __syncthreads();
            const int cg4 = F.tid & 255, kh = F.tid >> 8, col = cb * 1024 + 4 * cg4;
            f32x4 acc[9];
#pragma unroll
            for (int r = 0; r < 9; ++r) acc[r] = (f32x4){0.f, 0.f, 0.f, 0.f};
            const float* wp = KA->in[4] + ((size_t)l * DM + kc * 64 + kh * 32) * NMODW + col;
#pragma unroll 8
            for (int kk = 0; kk < 32; ++kk) { const f32x4 w = *(const f32x4*)(wp + (size_t)kk * NMODW);
#pragma unroll
                for (int r = 0; r < 9; ++r) acc[r] += w * sv[r * 64 + kh * 32 + kk]; }
#pragma unroll
            for (int r = 0; r < 9; ++r) *(f32x4*)(((float*)(KA->ws + WS_ACT)) + ((size_t)(l * 32 + kc * 2 + kh) * 9 + r) * NMODW + col) = acc[r];
        }
        __syncthreads();
    }
    LAS float* scr = (LAS float*)(F.lds + F.wave * 16384);
    constexpr int I1 = 16 * 176, I2 = 44 * 32, I3 = 16 * 88, I4 = 16 * 32, IL = 2 * I1 + 2 * I2 + I3 + I4;
    for (int it = F.gw; it < NL * IL; it += F.ngw) {
        const int l = it / IL; int r = it % IL;
        if (r < I1 || (r >= I1 + I2 + I3 + I4 && r < 2 * I1 + I2 + I3 + I4)) {
            const bool second = r >= I1; if (second) r -= I1 + I2 + I3 + I4;
            const int kb = r / 176, nb = r % 176, n0 = nb * 32;
            const int drow = n0 < DFF ? 256 * (n0 >> 7) + (n0 & 127) : 256 * ((n0 - DFF) >> 7) + 128 + ((n0 - DFF) & 127);
            transpose_item((second ? KA->in[22] : KA->in[8]) + (size_t)l * DM * 2 * DFF, 2 * DFF, kb * 64, n0, wbuf(KA, l, second ? WO_W1B : WO_W1A), DM, drow, scr, F.lane);
            continue; }
        r -= I1;
        if (r < I2) { const int kb = r / 32, nb = r % 32; transpose_item(KA->in[9] + (size_t)l * DFF * DM, DM, kb * 64, nb * 32, wbuf(KA, l, WO_W2A), DFF, nb * 32, scr, F.lane); continue; }
        r -= I2;
        if (r < I3) { const int kb = r / 88, nb = r % 88; const int n0 = nb < 48 ? nb * 32 : 1544 + (nb - 48) * 32;
            transpose_item(KA->in[10] + (size_t)l * DM * INW, INW, kb * 64, n0, wbuf(KA, l, WO_WIN), DM, nb * 32, scr, F.lane); continue; }
        r -= I3;
        if (r < I4) { const int kb = r / 32, nb = r % 32; transpose_item(KA->in[11] + (size_t)l * DM * DM, DM, kb * 64, nb * 32, wbuf(KA, l, WO_WOUT), DM, nb * 32, scr, F.lane); continue; }
        r -= I4 + I1;
        { const int kb = r / 32, nb = r % 32; transpose_item(KA->in[23] + (size_t)l * DFF * DM, DM, kb * 64, nb * 32, wbuf(KA, l, WO_W2B), DFF, nb * 32, scr, F.lane); }
    }
}
DI void p0b() {
    KArgs KA = kargs(); Frame F = mkframe();
    for (int i = blockIdx.x * 512 + F.tid; i < NL * 9 * NMODW; i += F.G * 512) {
        const int l = i / (9 * NMODW), rr = (i / NMODW) % 9, n = i % NMODW;
        float s = KA->in[5][l * NMODW + n];
        for (int p = 0; p < 32; ++p) s += ((float*)(KA->ws + WS_ACT))[((size_t)(l * 32 + p) * 9 + rr) * NMODW + n];
        ((float*)(KA->ws + WS_MOD))[i] = s;
    }
}
DI const float* modp(KArgs KA, int l, int mb, int idx) { return ((float*)(KA->ws + WS_MOD)) + ((size_t)(l * 9 + mb) * 9 + idx) * DM; }
DI void p0c() {
    KArgs KA = kargs(); Frame F = mkframe();
    for (int row = F.gw; row < NROW; row += F.ngw) {
        const int mb = row < NLAT ? (row >> 12) : 8;
        const float* src = row < NLAT ? KA->in[0] + (size_t)row * DM : KA->in[2] + (size_t)(row - NLAT) * DM;
        const float* sh = modp(KA, 0, mb, 0); const float* sc = modp(KA, 0, mb, 1);
#pragma unroll
        for (int j = 0; j < 4; ++j) { const int n = 4 * F.lane + 256 * j; const f32x4 v = *(const f32x4*)(src + n);
            const f32x4 a = v * (1.0f + *(const f32x4*)(sc + n)) + *(const f32x4*)(sh + n);
            v2u w; w.x = pk2(a.x, a.y); w.y = pk2(a.z, a.w); *(v2u*)(((bf16*)(KA->ws + WS_A)) + (size_t)row * DM + n) = w; }
    }
}
DI void ln_pass(int l, int gidx, float gmul, int lnidx, int nl, int nsh, int row0, int nrows, int wg0, int nwgs, const bool DTP) {
    KArgs KA = kargs(); Frame F = mkframe();
    const int nwv_ = nwgs * NWAVES, per_ = (nrows - row0 + nwv_ - 1) / nwv_;
    F.gw = row0 + (((int)blockIdx.x - wg0) * NWAVES + F.wave) * per_; F.ngw = 1;
    const int rend = min(F.gw + per_, nrows);
    LAS float* wdt = (LAS float*)F.lds;
    if (DTP) { __syncthreads(); for (int i = F.tid; i < 8192; i += 512) wdt[i] = KA->in[10][((size_t)l * DM + (i >> 3)) * INW + C_DTSRC + (i & 7)]; __syncthreads(); }
    const float* g = KA->in[6] + (l * 3 + lnidx) * DM; const float* bb = KA->in[7] + (l * 3 + lnidx) * DM;
    float* const xlat = KA->out; float* const xctx = (float*)(KA->ws + WS_XC); const bf16* const fbase = (const bf16*)(KA->ws + WS_O);
    const bool fromin = (l == 0 && lnidx == 0);
    const float* const slat = fromin ? KA->in[0] : (const float*)xlat; const float* const sctx = fromin ? KA->in[2] : (const float*)xctx;
    f32x4 g4[4], b4[4];
#pragma unroll
    for (int j = 0; j < 4; ++j) { g4[j] = *(const f32x4*)(g + 4 * F.lane + 256 * j); b4[j] = *(const f32x4*)(bb + 4 * F.lane + 256 * j); }
    f32x4 xn[4]; v2u fn[4];
    if (F.gw < rend) { const int row = F.gw; const float* xr = row < NLAT ? slat + (size_t)row * DM : sctx + (size_t)(row - NLAT) * DM;
#pragma unroll
        for (int j = 0; j < 4; ++j) { const int n = 4 * F.lane + 256 * j; xn[j] = *(const f32x4*)(xr + n); fn[j] = *(const v2u*)(fbase + (size_t)row * DM + n); } }
    f32x4 gt4[4], sh4[4], sc4[4]; int cur_mb = -1;
    for (int row = F.gw; row < rend; row += F.ngw) {
        const int mb = row < NLAT ? (row >> 12) : 8;
        if (mb != cur_mb) { cur_mb = mb;
#pragma unroll
            for (int j = 0; j < 4; ++j) { const int n = 4 * F.lane + 256 * j; gt4[j] = *(const f32x4*)(modp(KA, l, mb, gidx) + n) * gmul;
                if (nsh >= 0) { sc4[j] = 1.0f + *(const f32x4*)(modp(KA, nl, mb, nsh + 1) + n); sh4[j] = *(const f32x4*)(modp(KA, nl, mb, nsh) + n); } } }
        float* xrow = row < NLAT ? xlat + (size_t)row * DM : xctx + (size_t)(row - NLAT) * DM;
        f32x4 v[4]; float s = 0.f;
#pragma unroll
        for (int j = 0; j < 4; ++j) { const f32x4 fv = (f32x4){bflo(fn[j].x), bfhi(fn[j].x), bflo(fn[j].y), bfhi(fn[j].y)};
            v[j] = xn[j] * ALPHA + gt4[j] * fv; s += (v[j].x + v[j].y) + (v[j].z + v[j].w); }
        { const int nrow = row + F.ngw;
          if (nrow < rend) { const float* xr = nrow < NLAT ? slat + (size_t)nrow * DM : sctx + (size_t)(nrow - NLAT) * DM;
#pragma unroll
            for (int j = 0; j < 4; ++j) { const int n = 4 * F.lane + 256 * j; xn[j] = *(const f32x4*)(xr + n); fn[j] = *(const v2u*)(fbase + (size_t)nrow * DM + n); } } }
        const float mean = wave_sum(s) * (1.f / DM); float s2 = 0.f;
#pragma unroll
        for (int j = 0; j < 4; ++j) { v[j] = v[j] - mean; s2 += (v[j].x * v[j].x + v[j].y * v[j].y) + (v[j].z * v[j].z + v[j].w * v[j].w); }
        const float rstd = __builtin_amdgcn_rsqf(wave_sum(s2) * (1.f / DM) + LN_EPS);
        float dt[8];
#pragma unroll
        for (int q = 0; q < 8; ++q) dt[q] = 0.f;
#pragma unroll
        for (int j = 0; j < 4; ++j) { const int n = 4 * F.lane + 256 * j;
            const f32x4 y = v[j] * rstd * g4[j] + b4[j];
            *(f32x4*)(xrow + n) = y;
            if (nsh >= 0) { const f32x4 a = y * sc4[j] + sh4[j];
                v2u w; w.x = cvtpk(a.x, a.y); w.y = cvtpk(a.z, a.w); *(v2u*)(((bf16*)(KA->ws + WS_A)) + (size_t)row * DM + n) = w;
                if (DTP) {
#pragma unroll
                    for (int e = 0; e < 4; ++e) { const f32x4 w0 = *(const LAS f32x4*)(wdt + (n + e) * 8), w1 = *(const LAS f32x4*)(wdt + (n + e) * 8 + 4); const float ae = a[e];
                        dt[0] += ae * w0.x; dt[1] += ae * w0.y; dt[2] += ae * w0.z; dt[3] += ae * w0.w; dt[4] += ae * w1.x; dt[5] += ae * w1.y; dt[6] += ae * w1.z; dt[7] += ae * w1.w; } } }
        }
        if (DTP) {
#pragma unroll
            for (int q = 0; q < 8; ++q) dt[q] = wave_sum(dt[q]);
            if (F.lane == 0) { *(f32x4*)(((float*)(KA->ws + WS_DT)) + (size_t)row * 8) = (f32x4){dt[0], dt[1], dt[2], dt[3]}; *(f32x4*)(((float*)(KA->ws + WS_DT)) + (size_t)row * 8 + 4) = (f32x4){dt[4], dt[5], dt[6], dt[7]}; }
        }
    }
}
DI void prep_pass(int l) {
    KArgs KA = kargs(); Frame F = mkframe();
    const LAS float* rc = (const LAS float*)(F.lds + ROPE_OFF); const LAS float* rsn = rc + 1024;
    bf16* P = (bf16*)(KA->ws + WS_ACT); bf16* U = (bf16*)(KA->ws + WS_U); float* DTB = (float*)(KA->ws + WS_DT);
    const int hv = F.lane >> 5, s = F.lane & 31, hsub = s >> 3, ra = (s >> 2) & 1, ig = s & 3, d1 = ra * 32 + 4 * ig, d2 = d1 + 16;
    const f32x4 gq1 = *(const f32x4*)(KA->in[19] + l * 64 + d1), gq2 = *(const f32x4*)(KA->in[19] + l * 64 + d2), gk1 = *(const f32x4*)(KA->in[20] + l * 64 + d1), gk2 = *(const f32x4*)(KA->in[20] + l * 64 + d2);
    constexpr int NBLK = NROW / 8;
    for (int item = F.gw; item < 4 * NBLK; item += F.ngw) {
        const int part = item / NBLK, rb = item - part * NBLK;
        const int row8 = rb * 8; const bool lat = row8 < NLAT;
        if (part == 0) {
        v2u W1[4][3], W2[4][3];
#pragma unroll
        for (int rr = 0; rr < 4; ++rr) { const bf16* pr = P + (size_t)(row8 + 2 * rr + hv) * NPJ;
#pragma unroll
            for (int it = 0; it < 3; ++it) { const int hh = it * 4 + hsub; const bool isc = hh >= 6; const int h6 = isc ? hh - 6 : hh;
                const int col = (isc ? (h6 < 4 ? C_CQ + h6 * 64 : C_CK + (h6 - 4) * 64) : (h6 < 4 ? C_AQ + h6 * 64 : C_AK + (h6 - 4) * 64));
                W1[rr][it] = *(const v2u*)(pr + col + d1); W2[rr][it] = *(const v2u*)(pr + col + d2); } }
#pragma unroll
        for (int rr = 0; rr < 4; ++rr) {
            const int row = row8 + 2 * rr + hv; const int t = row & 4095;
            const int pos = ra == 0 ? (t >> 6) : (t & 63);
            const f32x4 cs = *(const LAS f32x4*)(rc + pos * 16 + 4 * ig), sn = *(const LAS f32x4*)(rsn + pos * 16 + 4 * ig);
            bf16* pr = P + (size_t)row * NPJ;
#pragma unroll
            for (int it = 0; it < 3; ++it) {
                const int hh = it * 4 + hsub;
                const bool isc = hh >= 6; const int h6 = isc ? hh - 6 : hh;
                const int col = (isc ? (h6 < 4 ? C_CQ + h6 * 64 : C_CK + (h6 - 4) * 64) : (h6 < 4 ? C_AQ + h6 * 64 : C_AK + (h6 - 4) * 64));
                const v2u w1 = W1[rr][it], w2 = W2[rr][it];
                f32x4 x1 = (f32x4){bflo(w1.x), bfhi(w1.x), bflo(w1.y), bfhi(w1.y)}, x2 = (f32x4){bflo(w2.x), bfhi(w2.x), bflo(w2.y), bfhi(w2.y)};
                float ss = (x1.x * x1.x + x1.y * x1.y) + (x1.z * x1.z + x1.w * x1.w) + (x2.x * x2.x + x2.y * x2.y) + (x2.z * x2.z + x2.w * x2.w);
                ss = DPP_ADD(ss, 0xB1); ss = DPP_ADD(ss, 0x4E); ss = DPP_ADD(ss, 0x141);
                if (isc) { const float r = (h6 < 4 ? 0.125f * 1.4426950408889634f : 1.0f) * __builtin_amdgcn_rsqf(ss * (1.f / 64.f) + LN_EPS);
                    x1 = x1 * r * (h6 < 4 ? gq1 : gk1); x2 = x2 * r * (h6 < 4 ? gq2 : gk2); }
                if (lat) { const f32x4 y1 = x1 * cs - x2 * sn, y2 = x1 * sn + x2 * cs; x1 = y1; x2 = y2; }
                if (isc || lat) { v2u o1, o2; o1.x = cvtpk(x1.x, x1.y); o1.y = cvtpk(x1.z, x1.w); o2.x = cvtpk(x2.x, x2.y); o2.y = cvtpk(x2.z, x2.w);
                    *(v2u*)(pr + col + d1) = o1; *(v2u*)(pr + col + d2) = o2; }
            }
        }
        { const int row = row8 + (F.lane >> 3), q = F.lane & 7; const float v = DTB[(size_t)row * 8 + q] + KA->in[16][l * 8 + q]; DTB[(size_t)row * 8 + q] = fmaxf(v, 0.f) + log1pf(__expf(-fabsf(v))); }
        } else {
        const int Ls = lat ? SEQ : CTXL; const int tt0 = lat ? (row8 & 4095) : ((row8 - NLAT) & 255);
        { const int j = part - 1; const int ch = 4 * F.lane + 256 * j;
            const f32x4 bias = *(const f32x4*)(KA->in[15] + l * 768 + ch);
            f32x4 cw[5];
#pragma unroll
            for (int k = 0; k < 5; ++k) cw[k] = *(const f32x4*)(KA->in[14] + (l * 5 + k) * 768 + ch);
            f32x4 xw[12];
            v2u wq[12];
#pragma unroll
            for (int q = 0; q < 12; ++q) { const int t2 = tt0 + q - 2; const int rq = (t2 >= 0 && t2 < Ls) ? row8 + q - 2 : row8;
                wq[q] = *(const v2u*)(P + (size_t)rq * NPJ + C_BX + ch); }
#pragma unroll
            for (int q = 0; q < 12; ++q) { const int t2 = tt0 + q - 2; const float kz = (t2 >= 0 && t2 < Ls) ? 1.0f : 0.0f;
                xw[q] = (f32x4){bflo(wq[q].x), bfhi(wq[q].x), bflo(wq[q].y), bfhi(wq[q].y)} * kz; }
#pragma unroll
            for (int q = 0; q < 8; ++q) { f32x4 acc = bias;
#pragma unroll
                for (int k = 0; k < 5; ++k) acc += cw[k] * xw[q + k];
                v2u o; o.x = cvtpk(silu(acc.x), silu(acc.y)); o.y = cvtpk(silu(acc.z), silu(acc.w)); *(v2u*)(U + (size_t)(row8 + q) * 768 + ch) = o; }
        }
        }
    }
}
DI void nkey(const float (&q)[64], float (&o)[64], float& m, float& l, const bf16* kr, const bf16* vr, float bias) {
    float s = bias;
#pragma unroll
    for (int c = 0; c < 8; ++c) { const v4u w = *(const v4u*)(kr + 8 * c);
        s += q[8 * c] * bflo(w.x) + q[8 * c + 1] * bfhi(w.x) + q[8 * c + 2] * bflo(w.y) + q[8 * c + 3] * bfhi(w.y) + q[8 * c + 4] * bflo(w.z) + q[8 * c + 5] * bfhi(w.z) + q[8 * c + 6] * bflo(w.w) + q[8 * c + 7] * bfhi(w.w); }
    const float mn = fmaxf(m, s), cf = __expf(m - mn), p = __expf(s - mn);
    l = l * cf + p; m = mn;
#pragma unroll
    for (int c = 0; c < 8; ++c) { const v4u w = *(const v4u*)(vr + 8 * c);
        o[8 * c] = o[8 * c] * cf + p * bflo(w.x); o[8 * c + 1] = o[8 * c + 1] * cf + p * bfhi(w.x); o[8 * c + 2] = o[8 * c + 2] * cf + p * bflo(w.y); o[8 * c + 3] = o[8 * c + 3] * cf + p * bfhi(w.y);
        o[8 * c + 4] = o[8 * c + 4] * cf + p * bflo(w.z); o[8 * c + 5] = o[8 * c + 5] * cf + p * bfhi(w.z); o[8 * c + 6] = o[8 * c + 6] * cf + p * bflo(w.w); o[8 * c + 7] = o[8 * c + 7] * cf + p * bfhi(w.w); }
}
template <int TYPE>
DI void naive_attn(int l, int row, int h, bool ctxq) {
    KArgs KA = kargs(); Frame F = mkframe();
    const bf16* P = ((bf16*)(KA->ws + WS_ACT));
    const int qcol = (TYPE == 0 ? C_AQ : TYPE == 1 ? C_CQ : C_DQ) + h * 64;
    const int kvh = TYPE == 2 ? h : (h >> 1);
    const int kcol = (TYPE == 0 ? C_AK : TYPE == 1 ? C_CK : C_DK) + kvh * 64, vcol = (TYPE == 0 ? C_AV : TYPE == 1 ? C_CV : C_DV) + kvh * 64;
    float q[64], o[64]; float m = -1e30f, ls = 0.f;
#pragma unroll
    for (int c = 0; c < 8; ++c) { const v4u w = *(const v4u*)(P + (size_t)row * NPJ + qcol + 8 * c);
        q[8 * c] = 0.125f * bflo(w.x); q[8 * c + 1] = 0.125f * bfhi(w.x); q[8 * c + 2] = 0.125f * bflo(w.y); q[8 * c + 3] = 0.125f * bfhi(w.y);
        q[8 * c + 4] = 0.125f * bflo(w.z); q[8 * c + 5] = 0.125f * bfhi(w.z); q[8 * c + 6] = 0.125f * bflo(w.w); q[8 * c + 7] = 0.125f * bfhi(w.w); }
#pragma unroll
    for (int d = 0; d < 64; ++d) o[d] = 0.f;
    int b;
    if (!ctxq) {
        b = row >> 12; const int t = row & 4095;
        if (TYPE == 0) { const int k0 = max(t - 128, 0), k1 = min(t + 128, SEQ - 1);
            for (int k = k0; k <= k1; ++k) { const bf16* kp = P + (size_t)(b * SEQ + k) * NPJ; nkey(q, o, m, ls, kp + kcol, kp + vcol, 0.f); } }
        else if (TYPE == 1) { for (int k = 0; k < SEQ; ++k) { const bf16* kp = P + (size_t)(b * SEQ + k) * NPJ; nkey(q, o, m, ls, kp + kcol, kp + vcol, 0.f); } }
        else { const int r = t >> 6, c = t & 63; const int rs = min(max(r - 4, 0), 56), cs = min(max(c - 8, 0), 48);
            for (int a = 0; a < 8; ++a) { const float* bp = KA->in[21] + ((size_t)(l * 4 + h) * 15 + (rs + a - r + 7)) * 31 + (cs - c + 15);
                for (int k = 0; k < 16; ++k) { const bf16* kp = P + (size_t)(b * SEQ + (rs + a) * 64 + cs + k) * NPJ; nkey(q, o, m, ls, kp + kcol, kp + vcol, bp[k]); } } }
    } else b = (row - NLAT) >> 8;
    for (int k = 0; k < CTXL; ++k) { const bf16* kp = P + (size_t)(NLAT + b * CTXL + k) * NPJ; nkey(q, o, m, ls, kp + kcol, kp + vcol, 0.f); }
    if (TYPE == 0) { const float sk = KA->in[13][l * 4 + h]; const float mn = fmaxf(m, sk), cf = __expf(m - mn); ls = ls * cf + __expf(sk - mn);
#pragma unroll
        for (int d = 0; d < 64; ++d) o[d] *= cf; }
    const float inv = 1.f / ls;
    bf16* op = ((bf16*)(KA->ws + WS_O)) + (size_t)row * DM + (TYPE == 0 ? 0 : TYPE == 1 ? 512 : 768) + h * 64;
#pragma unroll
    for (int c = 0; c < 8; ++c) { v4u w; w.x = pk2(o[8 * c] * inv, o[8 * c + 1] * inv); w.y = pk2(o[8 * c + 2] * inv, o[8 * c + 3] * inv); w.z = pk2(o[8 * c + 4] * inv, o[8 * c + 5] * inv); w.w = pk2(o[8 * c + 6] * inv, o[8 * c + 7] * inv);
        *(v4u*)(op + 8 * c) = w; }
}
DI void naive_ssd(int l, int item) {
    KArgs KA = kargs(); Frame F = mkframe();
    const int b = item >> 3, dir = (item >> 2) & 1, h = item & 3, g = h >> 1;
    const int p = F.tid >> 3, ng = F.tid & 7;
    const float A = -__expf(KA->in[17][l * 8 + dir * 4 + h]);
    bf16* Y = dir ? (((bf16*)(KA->ws + WS_Y) + (size_t)NROW * 256)) : ((bf16*)(KA->ws + WS_Y));
    float hs[16];
#pragma unroll
    for (int i = 0; i < 16; ++i) hs[i] = 0.f;
    for (int ph = 0; ph < 2; ++ph) {
        const int ns = ph ? SEQ : CTXL, base = ph ? b * SEQ : NLAT + b * CTXL;
#pragma unroll 4
        for (int s = 0; s < ns; ++s) {
            const int row = base + (dir ? ns - 1 - s : s);
            const float dt = ((float*)(KA->ws + WS_DT))[(size_t)row * 8 + dir * 4 + h];
            const bf16* ur = ((bf16*)(KA->ws + WS_U)) + (size_t)row * 768;
            const float xv = bf2f(ur[h * 64 + p]);
            const v4u b0 = *(const v4u*)(ur + 256 + g * 128 + ng * 16), b1 = *(const v4u*)(ur + 256 + g * 128 + ng * 16 + 8);
            const v4u c0 = *(const v4u*)(ur + 512 + g * 128 + ng * 16), c1 = *(const v4u*)(ur + 512 + g * 128 + ng * 16 + 8);
            const float dA = __expf(dt * A), dx = dt * xv;
            const unsigned bw[8] = {b0.x, b0.y, b0.z, b0.w, b1.x, b1.y, b1.z, b1.w}, cw[8] = {c0.x, c0.y, c0.z, c0.w, c1.x, c1.y, c1.z, c1.w};
            float y = 0.f;
#pragma unroll
            for (int i = 0; i < 8; ++i) { hs[2 * i] = hs[2 * i] * dA + dx * bflo(bw[i]); hs[2 * i + 1] = hs[2 * i + 1] * dA + dx * bfhi(bw[i]); y += bflo(cw[i]) * hs[2 * i] + bfhi(cw[i]) * hs[2 * i + 1]; }
            y += __shfl_xor(y, 1); y += __shfl_xor(y, 2); y += __shfl_xor(y, 4);
            if (ng == 0) Y[(size_t)row * 256 + h * 64 + p] = (bf16)f2bf(y);
        }
    }
}
DI void mixers_naive(int l, bool last) {
    Frame F = mkframe();
    const int nAttL = 64 * 12, nAttC = last ? 0 : 4 * 12, nItems = 64 + nAttL + nAttC;
    for (int it = blockIdx.x; it < nItems; it += F.G) {
        if (it < 64) { naive_ssd(l, it); continue; }
        int r = it - 64; bool cq = false; int rowbase;
        if (r >= nAttL) { r -= nAttL; cq = true; }
        const int rb = r / 12, ty = (r % 12) >> 2, h = r & 3;
        rowbase = cq ? NLAT + rb * 512 : rb * 512;
        const int row = rowbase + F.tid;
        if (ty == 0) naive_attn<0>(l, row, h, cq); else if (ty == 1) naive_attn<1>(l, row, h, cq); else naive_attn<2>(l, row, h, cq);
    }
}
typedef float f32x16 __attribute__((ext_vector_type(16)));
typedef short s16x4 __attribute__((ext_vector_type(4)));
typedef short bf16x8v __attribute__((ext_vector_type(8)));
typedef short v4i16_t __attribute__((ext_vector_type(4)));
DI s16x4 vtr(const LAS unsigned char* p) { return __builtin_bit_cast(s16x4, __builtin_amdgcn_ds_read_tr16_b64_v4i16((LAS v4i16_t*)p)); }
DI int crow16(int i, int h) { return (i & 3) + 8 * (i >> 2) + 4 * h; }
constexpr int AT_KRS = 144, AT_VRS = 192, AT_KB = 64 * AT_KRS, AT_BUF = AT_KB + 64 * AT_VRS, AT_RPB = 2 * AT_BUF;
constexpr float LOG2E = 1.4426950408889634f, AT_SC = 0.125f * LOG2E;
template <int TYPE>
DI void attn_unit(KArgs KA, const Frame& F, int l, int unit, bool ctxq) {
    const bf16* P = (const bf16*)(KA->ws + WS_ACT);
    const int L = F.lane, w = F.wave, r = L & 31, h2 = L >> 5, i16 = L & 15;
    int b, head, kvh, p0, qpos0, t0 = 0, nloc = 0;
    if (TYPE != 2) { int g, pb; if (!ctxq) { b = unit >> 6; g = (unit >> 5) & 1; pb = unit & 31; } else { b = unit >> 2; g = (unit >> 1) & 1; pb = unit & 1; }
        head = 2 * g + (w >> 2); kvh = g; p0 = pb * 128; qpos0 = p0 + 32 * (w & 3);
        if (!ctxq) { if (TYPE == 1) { t0 = 0; nloc = 64; } else { t0 = max(0, 2 * (pb - 1)); nloc = min(64, 2 * (pb + 2)) - t0; } } }
    else { int rb; if (!ctxq) { b = unit >> 6; head = (unit >> 4) & 3; rb = unit & 15; } else { b = unit >> 2; head = unit & 3; rb = 0; }
        kvh = head; p0 = rb * 256; qpos0 = p0 + 32 * w;
        if (!ctxq) { const int r0 = rb * 4; t0 = min(max(r0 - 4, 0), 56); nloc = min(max(r0 - 1, 0), 56) + 8 - t0; } }
    const int qcol = (TYPE == 0 ? C_AQ : TYPE == 1 ? C_CQ : C_DQ) + head * 64;
    const int kcol = (TYPE == 0 ? C_AK : TYPE == 1 ? C_CK : C_DK) + kvh * 64, vcol = (TYPE == 0 ? C_AV : TYPE == 1 ? C_CV : C_DV) + kvh * 64;
    const int qrow = (ctxq ? NLAT + b * CTXL : b * SEQ) + qpos0 + r;
    const int nt = nloc + 4;
    bf16x8v qf[4];
#pragma unroll
    for (int ks = 0; ks < 4; ++ks) qf[ks] = *(const bf16x8v*)(P + (size_t)qrow * NPJ + qcol + ks * 16 + 8 * h2);
    LAS unsigned char* lb = F.lds;
    if (TYPE == 2) { LAS float* rp = (LAS float*)(lb + AT_RPB); for (int i = F.tid; i < 465; i += 512) rp[i] = KA->in[21][(size_t)(l * 4 + head) * 465 + i] * 8.0f; }
    const int srow = F.tid >> 3, sch = F.tid & 7;
#define TILE_ROW0(i) ((i) < nloc ? b * SEQ + (t0 + (i)) * 64 : NLAT + b * CTXL + ((i) - nloc) * 64)
    v4u kreg, vreg;
    { const bf16* src = P + (size_t)(TILE_ROW0(0) + srow) * NPJ; kreg = *(const v4u*)(src + kcol + sch * 8); vreg = *(const v4u*)(src + vcol + sch * 8); }
    *(LAS v4u*)(lb + srow * AT_KRS + sch * 16) = kreg; *(LAS v4u*)(lb + AT_KB + srow * AT_VRS + sch * 16) = vreg;
    __syncthreads();
    f32x16 oacc[2];
#pragma unroll
    for (int i = 0; i < 16; ++i) { oacc[0][i] = 0.f; oacc[1][i] = 0.f; }
    float m = -1e30f, lsum = 0.f;
    if (TYPE == 1) {
        float gq = fabsf(KA->in[19][l * 64 + L]), gk = fabsf(KA->in[20][l * 64 + L]);
#pragma unroll
        for (int o = 1; o < 64; o <<= 1) { gq = fmaxf(gq, __shfl_xor(gq, o)); gk = fmaxf(gk, __shfl_xor(gk, o)); }
        m = 64.0f * 1.03f * gq * gk * AT_SC;
    }
    const int qpos = qpos0 + r;
    const int gr = qpos0 >> 6, rs = min(max(gr - 4, 0), 56), qc = qpos & 63, cs = min(max(qc - 8, 0), 48);
    for (int i = 0; i < nt; ++i) {
        const LAS unsigned char* kb_ = lb + (i & 1) * AT_BUF; const LAS unsigned char* vb_ = kb_ + AT_KB;
        if (i + 1 < nt) { const bf16* src = P + (size_t)(TILE_ROW0(i + 1) + srow) * NPJ; kreg = *(const v4u*)(src + kcol + sch * 8); vreg = *(const v4u*)(src + vcol + sch * 8); }
        const bool loc = i < nloc;
        bool skip = false;
        const int k0 = (t0 + i) * 64;
        if (loc && TYPE == 0) skip = (k0 + 63 < qpos0 - 128) || (k0 > qpos0 + 31 + 128);
        if (loc && TYPE == 2) skip = (t0 + i < rs) || (t0 + i >= rs + 8);
        if (!skip) {
            f32x16 sacc[2];
            bf16x8v kf[2][4], vf[2][2][2];
#pragma unroll
            for (int kb = 0; kb < 2; ++kb)
#pragma unroll
                for (int ks = 0; ks < 4; ++ks) kf[kb][ks] = *(const LAS bf16x8v*)(kb_ + (kb * 32 + r) * AT_KRS + ks * 32 + 16 * h2);
#pragma unroll
            for (int kb = 0; kb < 2; ++kb)
#pragma unroll
                for (int s = 0; s < 2; ++s)
#pragma unroll
                    for (int db = 0; db < 2; ++db) {
                        const LAS unsigned char* va = vb_ + (kb * 32 + 16 * s + 4 * h2 + (i16 >> 2)) * AT_VRS + (db * 32 + 16 * ((L >> 4) & 1) + 4 * (i16 & 3)) * 2;
                        const s16x4 lo = vtr(va), hi = vtr(va + 8 * AT_VRS);
                        vf[kb][s][db] = (bf16x8v){lo[0], lo[1], lo[2], lo[3], hi[0], hi[1], hi[2], hi[3]}; }
            __builtin_amdgcn_sched_barrier(0);
#pragma unroll
            for (int kb = 0; kb < 2; ++kb) {
#pragma unroll
                for (int q = 0; q < 16; ++q) sacc[kb][q] = (TYPE == 1) ? -m : 0.f;
#pragma unroll
                for (int ks = 0; ks < 4; ++ks) sacc[kb] = __builtin_amdgcn_mfma_f32_32x32x16_bf16(kf[kb][ks], qf[ks], sacc[kb], 0, 0, 0);
            }
            float tmax = -INFINITY;
            if ((TYPE == 0 || TYPE == 2) && loc) {
#pragma unroll
                for (int kb = 0; kb < 2; ++kb)
#pragma unroll
                    for (int q = 0; q < 16; ++q) { float s = sacc[kb][q]; const int kk = kb * 32 + crow16(q, h2);
                        if (TYPE == 0) { const int d = k0 + kk - qpos; if (d > 128 || d < -128) s = -INFINITY; }
                        if (TYPE == 2) { const int dc = kk - cs; const LAS float* rp = (const LAS float*)(lb + AT_RPB);
                            if (dc < 0 || dc >= 16) s = -INFINITY; else s += rp[(t0 + i - gr + 7) * 31 + (kk - qc + 15)]; }
                        sacc[kb][q] = s; }
            }
            if (TYPE != 1) {
#pragma unroll
                for (int kb = 0; kb < 2; ++kb)
#pragma unroll
                    for (int q = 0; q < 16; ++q) tmax = fmaxf(tmax, sacc[kb][q]);
                tmax = fmaxf(tmax, __shfl_xor(tmax, 32));
                const float mn = fmaxf(m, tmax);
                if (__any(mn > m)) {
                    const float alpha = __builtin_amdgcn_exp2f((m - mn) * AT_SC);
                    lsum *= alpha;
#pragma unroll
                    for (int q = 0; q < 16; ++q) { oacc[0][q] *= alpha; oacc[1][q] *= alpha; }
                }
                m = mn;
            }
            const float mns = -m * AT_SC;
            float psum = 0.f;
#pragma unroll
            for (int kb = 0; kb < 2; ++kb)
#pragma unroll
                for (int q = 0; q < 16; ++q) { const float p = (TYPE == 1) ? __builtin_amdgcn_exp2f(sacc[kb][q]) : __builtin_amdgcn_exp2f(__builtin_fmaf(sacc[kb][q], AT_SC, mns)); sacc[kb][q] = p; psum += p; }
            lsum += psum;
#pragma unroll
            for (int kb = 0; kb < 2; ++kb)
#pragma unroll
                for (int s = 0; s < 2; ++s) {
                    v4u pw; pw.x = cvtpk(sacc[kb][8 * s], sacc[kb][8 * s + 1]); pw.y = cvtpk(sacc[kb][8 * s + 2], sacc[kb][8 * s + 3]); pw.z = cvtpk(sacc[kb][8 * s + 4], sacc[kb][8 * s + 5]); pw.w = cvtpk(sacc[kb][8 * s + 6], sacc[kb][8 * s + 7]);
                    const bf16x8v pf = __builtin_bit_cast(bf16x8v, pw);
#pragma unroll
                    for (int db = 0; db < 2; ++db) oacc[db] = __builtin_amdgcn_mfma_f32_32x32x16_bf16(vf[kb][s][db], pf, oacc[db], 0, 0, 0);
                }
        }
        if (i + 1 < nt) { LAS unsigned char* nb = lb + ((i + 1) & 1) * AT_BUF; *(LAS v4u*)(nb + srow * AT_KRS + sch * 16) = kreg; *(LAS v4u*)(nb + AT_KB + srow * AT_VRS + sch * 16) = vreg; }
        __syncthreads();
    }
    lsum += __shfl_xor(lsum, 32);
    if (TYPE == 0) lsum += __builtin_amdgcn_exp2f(KA->in[13][l * 4 + head] * LOG2E - m * AT_SC);
    const float inv = __builtin_amdgcn_rcpf(lsum);
    bf16* op = (bf16*)(KA->ws + WS_O) + (size_t)qrow * DM + (TYPE == 0 ? 0 : TYPE == 1 ? 512 : 768) + head * 64;
#pragma unroll
    for (int db = 0; db < 2; ++db)
#pragma unroll
        for (int q4 = 0; q4 < 4; ++q4) { v2u o; o.x = cvtpk(oacc[db][4 * q4] * inv, oacc[db][4 * q4 + 1] * inv); o.y = cvtpk(oacc[db][4 * q4 + 2] * inv, oacc[db][4 * q4 + 3] * inv);
            *(v2u*)(op + db * 32 + 8 * q4 + 4 * h2) = o; }
}
constexpr size_t WS_ST = WS_A;
constexpr size_t WS_DEC = 3 * MiB;
constexpr int SS_B = 0, SS_BRS = 272, SS_X = 34816, SS_XRS = 192, SS_X2 = 59392, SS_HF = 83968, SS_HB = 101376, SS_ARR = 118784;
DI int slot_row(int b, int slot) { return slot < 2 ? NLAT + b * CTXL + slot * 128 : b * SEQ + (slot - 2) * 128; }
DI void ssd_stage_dt(KArgs KA, const Frame& F, int l, int h, int rowbase, LAS float* arr) {
    const float* DTB = (const float*)(KA->ws + WS_DT);
    if (F.tid < 128) { const float df = DTB[(size_t)(rowbase + F.tid) * 8 + h], db = DTB[(size_t)(rowbase + F.tid) * 8 + 4 + h];
        const float Af = -__expf(KA->in[17][l * 8 + h]) * LOG2E, Ab = -__expf(KA->in[17][l * 8 + 4 + h]) * LOG2E;
        arr[F.tid] = df * Af; arr[128 + F.tid] = db * Ab; arr[256 + F.tid] = df; arr[384 + F.tid] = db; }
    __syncthreads();
    if (F.wave < 2) { const int L = F.lane; const bool rev = F.wave == 1;
        const float v0 = rev ? arr[128 + 127 - 2 * L] : arr[2 * L], v1 = rev ? arr[128 + 126 - 2 * L] : arr[2 * L + 1];
        float t = v0 + v1;
#pragma unroll
        for (int o = 1; o < 64; o <<= 1) { const float u = __shfl_up(t, o); if (L >= o) t += u; }
        if (rev) { arr[640 + 127 - 2 * L] = t - v1; arr[640 + 126 - 2 * L] = t; } else { arr[512 + 2 * L] = t - v1; arr[512 + 2 * L + 1] = t; } }
    __syncthreads();
}
struct BRegs { v4u v[4]; };
DI BRegs ssd_load_B(KArgs KA, const Frame& F, int g, int rowbase) {
    const bf16* U = (const bf16*)(KA->ws + WS_U);
    const int row = F.tid >> 2, pc = F.tid & 3; const bf16* src = U + (size_t)(rowbase + row) * 768 + 256 + g * 128 + pc * 32;
    BRegs b;
#pragma unroll
    for (int k = 0; k < 4; ++k) b.v[k] = *(const v4u*)(src + k * 8);
    return b;
}
DI void ssd_store_B(const Frame& F, const BRegs& b) {
    const int row = F.tid >> 2, pc = F.tid & 3;
#pragma unroll
    for (int k = 0; k < 4; ++k) *(LAS v4u*)(F.lds + SS_B + row * SS_BRS + pc * 64 + k * 16) = b.v[k];
}
DI v4u scale8(v4u w, float s) { v4u o; o.x = cvtpk(bflo(w.x) * s, bfhi(w.x) * s); o.y = cvtpk(bflo(w.y) * s, bfhi(w.y) * s); o.z = cvtpk(bflo(w.z) * s, bfhi(w.z) * s); o.w = cvtpk(bflo(w.w) * s, bfhi(w.w) * s); return o; }
DI void ssd_states(KArgs KA, const Frame& F, int l, int item) {
    const int slot = item % 34, bh = item / 34, b = bh >> 2, h = bh & 3, g = h >> 1, rowbase = slot_row(b, slot);
    const int L = F.lane, w = F.wave, r = L & 31, h2 = L >> 5, i16 = L & 15, grp = (L >> 4) & 1;
    LAS float* arr = (LAS float*)(F.lds + SS_ARR);
    const BRegs breg = ssd_load_B(KA, F, g, rowbase);
    v4u x0, x1;
    { const bf16* U = (const bf16*)(KA->ws + WS_U); const int row = F.tid >> 2, pc = F.tid & 3; const bf16* src = U + (size_t)(rowbase + row) * 768 + h * 64 + pc * 16; x0 = *(const v4u*)src; x1 = *(const v4u*)(src + 8); }
    ssd_stage_dt(KA, F, l, h, rowbase, arr);
    ssd_store_B(F, breg);
    { const int row = F.tid >> 2, pc = F.tid & 3;
      const float wf = __builtin_amdgcn_exp2f(arr[512 + 127] - arr[512 + row]) * arr[256 + row], wb = __builtin_amdgcn_exp2f(arr[640] - arr[640 + row]) * arr[384 + row];
      *(LAS v4u*)(F.lds + SS_X + row * SS_XRS + pc * 32) = scale8(x0, wf); *(LAS v4u*)(F.lds + SS_X + row * SS_XRS + pc * 32 + 16) = scale8(x1, wf);
      *(LAS v4u*)(F.lds + SS_X2 + row * SS_XRS + pc * 32) = scale8(x0, wb); *(LAS v4u*)(F.lds + SS_X2 + row * SS_XRS + pc * 32 + 16) = scale8(x1, wb); }
    __syncthreads();
    const int pblk = w >> 2, nblk = w & 3;
    bf16* ST = (bf16*)(KA->ws + WS_ST); float* DEC = (float*)(KA->ws + WS_DEC);
#pragma unroll
    for (int dir = 0; dir < 2; ++dir) {
        f32x16 acc;
#pragma unroll
        for (int q = 0; q < 16; ++q) acc[q] = 0.f;
        const LAS unsigned char* xb = F.lds + (dir ? SS_X2 : SS_X);
#pragma unroll
        for (int ks = 0; ks < 8; ++ks) {
            const LAS unsigned char* xa = xb + (ks * 16 + 8 * h2 + (i16 >> 2)) * SS_XRS + (pblk * 32 + 16 * grp + 4 * (i16 & 3)) * 2;
            const s16x4 xlo = vtr(xa), xhi = vtr(xa + 4 * SS_XRS);
            const LAS unsigned char* ba = F.lds + SS_B + (ks * 16 + 8 * h2 + (i16 >> 2)) * SS_BRS + (nblk * 32 + 16 * grp + 4 * (i16 & 3)) * 2;
            const s16x4 blo = vtr(ba), bhi_ = vtr(ba + 4 * SS_BRS);
            const bf16x8v xf = (bf16x8v){xlo[0], xlo[1], xlo[2], xlo[3], xhi[0], xhi[1], xhi[2], xhi[3]}, bfr = (bf16x8v){blo[0], blo[1], blo[2], blo[3], bhi_[0], bhi_[1], bhi_[2], bhi_[3]};
            acc = __builtin_amdgcn_mfma_f32_32x32x16_bf16(xf, bfr, acc, 0, 0, 0); }
        bf16* dst = ST + ((size_t)((bh * 2 + dir) * 34 + slot)) * 8192;
#pragma unroll
        for (int q = 0; q < 16; ++q) dst[(pblk * 32 + crow16(q, h2)) * 128 + nblk * 32 + r] = (bf16)(cvtpk(acc[q], 0.f) & 0xffffu);
        if (F.tid == 0) DEC[(bh * 2 + dir) * 34 + slot] = __builtin_amdgcn_exp2f(dir ? arr[640] : arr[512 + 127]);
    }
    __syncthreads();
}
DI void ssd_scan() {
    KArgs KA = kargs(); Frame F = mkframe();
    bf16* ST = (bf16*)(KA->ws + WS_ST); const float* DEC = (const float*)(KA->ws + WS_DEC);
    for (int gt = blockIdx.x * 512 + F.tid; gt < 64 * 2048; gt += F.G * 512) {
        const int chain = gt >> 11, e4 = gt & 2047, dir = chain & 1;
        bf16* base = ST + (size_t)chain * 34 * 8192 + e4 * 4;
        v2u tw[34]; float dc[34];
#pragma unroll
        for (int k = 0; k < 34; ++k) { const int slot = dir == 0 ? k : (k < 2 ? 1 - k : 35 - k); tw[k] = *(const v2u*)(base + (size_t)slot * 8192); dc[k] = DEC[chain * 34 + slot]; }
        f32x4 hc = (f32x4){0.f, 0.f, 0.f, 0.f};
#pragma unroll
        for (int k = 0; k < 34; ++k) { const int slot = dir == 0 ? k : (k < 2 ? 1 - k : 35 - k);
            const f32x4 t = (f32x4){bflo(tw[k].x), bfhi(tw[k].x), bflo(tw[k].y), bfhi(tw[k].y)};
            v2u ow; ow.x = cvtpk(hc.x, hc.y); ow.y = cvtpk(hc.z, hc.w); *(v2u*)(base + (size_t)slot * 8192) = ow; hc = hc * dc[k] + t; }
    }
}
DI void ssd_outputs(KArgs KA, const Frame& F, int l, int item) {
    const int slot = item % 34, bh = item / 34, b = bh >> 2, h = bh & 3, g = h >> 1, rowbase = slot_row(b, slot);
    const int L = F.lane, w = F.wave, r = L & 31, h2 = L >> 5, i16 = L & 15, grp = (L >> 4) & 1;
    LAS float* arr = (LAS float*)(F.lds + SS_ARR);
    const bf16* U = (const bf16*)(KA->ws + WS_U);
    const int ib = w & 3, pb = w >> 2, ipos = ib * 32 + r;
    bf16x8v cfq[8];
#pragma unroll
    for (int ks = 0; ks < 8; ++ks) cfq[ks] = *(const bf16x8v*)(U + (size_t)(rowbase + ipos) * 768 + 512 + g * 128 + ks * 16 + 8 * h2);
    const BRegs breg = ssd_load_B(KA, F, g, rowbase);
    v4u x0, x1, hf0, hf1, hb0, hb1;
    { const int row = F.tid >> 2, pc = F.tid & 3; const bf16* src = U + (size_t)(rowbase + row) * 768 + h * 64 + pc * 16; x0 = *(const v4u*)src; x1 = *(const v4u*)(src + 8); }
    { const bf16* ST = (const bf16*)(KA->ws + WS_ST); const int p = F.tid >> 3, pc = F.tid & 7;
      const bf16* sf = ST + ((size_t)((bh * 2 + 0) * 34 + slot)) * 8192 + p * 128 + pc * 16; const bf16* sb = ST + ((size_t)((bh * 2 + 1) * 34 + slot)) * 8192 + p * 128 + pc * 16;
      hf0 = *(const v4u*)sf; hf1 = *(const v4u*)(sf + 8); hb0 = *(const v4u*)sb; hb1 = *(const v4u*)(sb + 8); }
    ssd_stage_dt(KA, F, l, h, rowbase, arr);
    ssd_store_B(F, breg);
    { const int row = F.tid >> 2, pc = F.tid & 3; *(LAS v4u*)(F.lds + SS_X + row * SS_XRS + pc * 32) = x0; *(LAS v4u*)(F.lds + SS_X + row * SS_XRS + pc * 32 + 16) = x1; }
    { const int p = F.tid >> 3, pc = F.tid & 7; LAS unsigned char* d = F.lds + SS_HF + p * SS_BRS + pc * 32; *(LAS v4u*)d = hf0; *(LAS v4u*)(d + 16) = hf1;
      LAS unsigned char* e = F.lds + SS_HB + p * SS_BRS + pc * 32; *(LAS v4u*)e = hb0; *(LAS v4u*)(e + 16) = hb1; }
    __syncthreads();
    const float cfi = arr[512 + ipos], cbi = arr[640 + ipos];
    f32x16 yacc;
#pragma unroll
    for (int q = 0; q < 16; ++q) yacc[q] = 0.f;
#pragma unroll
    for (int jb = 0; jb < 4; ++jb) {
        f32x16 acc;
#pragma unroll
        for (int q = 0; q < 16; ++q) acc[q] = 0.f;
#pragma unroll
        for (int ks = 0; ks < 8; ++ks) { const bf16x8v bfr = *(const LAS bf16x8v*)(F.lds + SS_B + (jb * 32 + r) * SS_BRS + ks * 32 + 16 * h2);
            acc = __builtin_amdgcn_mfma_f32_32x32x16_bf16(bfr, cfq[ks], acc, 0, 0, 0); }
        if (jb < ib) {
#pragma unroll
            for (int q = 0; q < 16; ++q) { const int j = jb * 32 + crow16(q, h2); acc[q] *= __builtin_amdgcn_exp2f(cfi - arr[512 + j]) * arr[256 + j]; }
        } else if (jb > ib) {
#pragma unroll
            for (int q = 0; q < 16; ++q) { const int j = jb * 32 + crow16(q, h2); acc[q] *= __builtin_amdgcn_exp2f(cbi - arr[640 + j]) * arr[384 + j]; }
        } else {
            int rl = r; asm volatile("" : "+v"(rl));
#pragma unroll
            for (int q = 0; q < 16; ++q) { const int jl = crow16(q, h2), j = jb * 32 + jl;
                float wt = 0.f;
                if (jl <= rl) wt += __builtin_amdgcn_exp2f(cfi - arr[512 + j]) * arr[256 + j];
                if (jl >= rl) wt += __builtin_amdgcn_exp2f(cbi - arr[640 + j]) * arr[384 + j];
                acc[q] *= wt; }
        }
#pragma unroll
        for (int s = 0; s < 2; ++s) {
            v4u pw; pw.x = cvtpk(acc[8 * s], acc[8 * s + 1]); pw.y = cvtpk(acc[8 * s + 2], acc[8 * s + 3]); pw.z = cvtpk(acc[8 * s + 4], acc[8 * s + 5]); pw.w = cvtpk(acc[8 * s + 6], acc[8 * s + 7]);
            const bf16x8v pf = __builtin_bit_cast(bf16x8v, pw);
            const LAS unsigned char* xa = F.lds + SS_X + (jb * 32 + 16 * s + 4 * h2 + (i16 >> 2)) * SS_XRS + (pb * 32 + 16 * grp + 4 * (i16 & 3)) * 2;
            const s16x4 lo = vtr(xa), hi = vtr(xa + 8 * SS_XRS);
            const bf16x8v xf = (bf16x8v){lo[0], lo[1], lo[2], lo[3], hi[0], hi[1], hi[2], hi[3]};
            yacc = __builtin_amdgcn_mfma_f32_32x32x16_bf16(xf, pf, yacc, 0, 0, 0); }
    }
#pragma unroll
    for (int dir = 0; dir < 2; ++dir) {
        f32x16 tacc;
#pragma unroll
        for (int q = 0; q < 16; ++q) tacc[q] = 0.f;
#pragma unroll
        for (int ks = 0; ks < 8; ++ks) { const bf16x8v hfr = *(const LAS bf16x8v*)(F.lds + (dir ? SS_HB : SS_HF) + (pb * 32 + r) * SS_BRS + ks * 32 + 16 * h2);
            tacc = __builtin_amdgcn_mfma_f32_32x32x16_bf16(hfr, cfq[ks], tacc, 0, 0, 0); }
        const float sc = __builtin_amdgcn_exp2f(dir ? cbi : cfi);
#pragma unroll
        for (int q = 0; q < 16; ++q) yacc[q] += sc * tacc[q];
    }
    bf16* yp = (bf16*)(KA->ws + WS_Y) + (size_t)(rowbase + ipos) * 256 + h * 64 + pb * 32;
#pragma unroll
    for (int q4 = 0; q4 < 4; ++q4) { v2u o; o.x = cvtpk(yacc[4 * q4], yacc[4 * q4 + 1]); o.y = cvtpk(yacc[4 * q4 + 2], yacc[4 * q4 + 3]); *(v2u*)(yp + 8 * q4 + 4 * h2) = o; }
    __syncthreads();
}
DI void ssd_outputs_phase(int l, bool last) {
    KArgs KA = kargs(); Frame F = mkframe();
    for (int it = blockIdx.x; it < 32 * 34; it += F.G) { if (last && (it % 34) < 2) continue; ssd_outputs(KA, F, l, it); }
}
DI void mixers_flash(int l, bool last) {
    KArgs KA = kargs(); Frame F = mkframe();
    const int nS = 32 * 34, nL = 1536, nC = last ? 0 : 96, nItems = nS + nL + nC;
    for (int it = blockIdx.x; it < nItems; it += F.G) {
        if (it < nS) { ssd_states(KA, F, l, it); continue; }
        int u = it - nS; bool cq = false;
        if (u >= nL) { u -= nL; cq = true; }
        const int ty = u % 3, un = u / 3;
        if (ty == 0) attn_unit<1>(KA, F, l, un, cq); else if (ty == 1) attn_unit<0>(KA, F, l, un, cq); else attn_unit<2>(KA, F, l, un, cq);
    }
}
DI void merge_pass(int l, int nrows) {
    KArgs KA = kargs(); Frame F = mkframe();
    const bf16* P = (const bf16*)(KA->ws + WS_ACT); const bf16* O = (const bf16*)(KA->ws + WS_O); const bf16* Y = (const bf16*)(KA->ws + WS_Y); const bf16* U = (const bf16*)(KA->ws + WS_U);
    bf16* A = (bf16*)(KA->ws + WS_A);
    const int hh = F.lane >> 4, cn = 4 * F.lane;
    const float dsk = KA->in[18][l * 4 + hh];
    f32x4 mg[4];
#pragma unroll
    for (int j = 0; j < 4; ++j) mg[j] = *(const f32x4*)(KA->in[12] + l * DM + 4 * F.lane + 256 * j);
    v2u o0, o2, o3, yw, xw, zw;
#define MERGE_LOAD(r_) do { o0 = *(const v2u*)(O + (size_t)(r_) * DM + cn); o2 = *(const v2u*)(O + (size_t)(r_) * DM + 512 + cn); o3 = *(const v2u*)(O + (size_t)(r_) * DM + 768 + cn); \
        yw = *(const v2u*)(Y + (size_t)(r_) * 256 + cn); xw = *(const v2u*)(U + (size_t)(r_) * 768 + cn); zw = *(const v2u*)(P + (size_t)(r_) * NPJ + C_BZ + cn); } while (0)
    if (F.gw < nrows) MERGE_LOAD(F.gw);
    for (int row = F.gw; row < nrows; row += F.ngw) {
        f32x4 v[4];
        v[0] = (f32x4){bflo(o0.x), bfhi(o0.x), bflo(o0.y), bfhi(o0.y)}; v[2] = (f32x4){bflo(o2.x), bfhi(o2.x), bflo(o2.y), bfhi(o2.y)}; v[3] = (f32x4){bflo(o3.x), bfhi(o3.x), bflo(o3.y), bfhi(o3.y)};
        { const f32x4 yf = (f32x4){bflo(yw.x), bfhi(yw.x), bflo(yw.y), bfhi(yw.y)}, xs = (f32x4){bflo(xw.x), bfhi(xw.x), bflo(xw.y), bfhi(xw.y)}, z = (f32x4){bflo(zw.x), bfhi(zw.x), bflo(zw.y), bfhi(zw.y)};
          const f32x4 y = yf + xs * dsk; v[1] = (f32x4){y.x * silu(z.x), y.y * silu(z.y), y.z * silu(z.z), y.w * silu(z.w)}; }
        if (row + F.ngw < nrows) MERGE_LOAD(row + F.ngw);
#pragma unroll
        for (int j = 0; j < 4; ++j) { const int n = 4 * F.lane + 256 * j;
            const float ss = wave_sum((v[j].x * v[j].x + v[j].y * v[j].y) + (v[j].z * v[j].z + v[j].w * v[j].w));
            const float r = __builtin_amdgcn_rsqf(ss * (1.f / 256.f) + LN_EPS);
            const f32x4 a = v[j] * r * mg[j];
            v2u w; w.x = cvtpk(a.x, a.y); w.y = cvtpk(a.z, a.w); *(v2u*)(A + (size_t)row * DM + n) = w; }
    }
#undef MERGE_LOAD
}
constexpr size_t WS_CTL = 3 * MiB + 512 * 1024, CTL_BYTES = 16384;
constexpr int MISC_OFF = 139264;
#define XB_TMO      128
#define XB_XCNT(j)  (256  + 64 * (j))
#define XB_XSUB(j)  (1280 + 64 * (j))
#define XB_XGEN(j)  (2304 + 64 * (j))
#define XB_TOP      3328
#define XB_TOPGEN   3392
#define XCD_BAR_WORDS 3456
#define XB_SPIN_CAP (1u << 18)

__device__ __forceinline__ unsigned xb_ld(unsigned* p)              { return __hip_atomic_load(p, __ATOMIC_RELAXED, __HIP_MEMORY_SCOPE_AGENT); }
__device__ __forceinline__ unsigned xb_add(unsigned* p, unsigned v) { return __hip_atomic_fetch_add(p, v, __ATOMIC_RELAXED, __HIP_MEMORY_SCOPE_AGENT); }
__device__ __forceinline__ unsigned xb_xcc_id() { return (unsigned)__builtin_amdgcn_s_getreg((3 << 11) | 20) & 0xFu; }
#define XB_SPIN(cond, bar) do { unsigned _sp = 0; while (cond) { __builtin_amdgcn_s_sleep(1); \
    if ((++_sp & 255u) == 0u) { if (xb_ld(&(bar)[XB_TMO])) break; if (_sp > XB_SPIN_CAP) { atomicAdd(&(bar)[XB_TMO], 1u); break; } } } } while (0)

struct XcdBarrier {
    unsigned* bar; unsigned x;
    volatile LAS unsigned* st;
};

__device__ __forceinline__ XcdBarrier xcd_barrier_post(unsigned* bar, volatile LAS unsigned* st) {
    XcdBarrier b; b.bar = bar; b.x = xb_xcc_id(); b.st = st;
    if (threadIdx.x == 0) (void)xb_add(&bar[XB_XCNT(b.x)], 1u);
    return b;
}
__device__ __forceinline__ void xcd_barrier_complete(unsigned* bar, unsigned x, unsigned& nloc, unsigned& nx) {
    const unsigned G = gridDim.x * gridDim.y * gridDim.z;
    unsigned sum, cnt, mine, sp = 0u;
    for (;;) {
        sum = 0u; cnt = 0u; mine = 0u;
#pragma unroll
        for (unsigned j = 0; j < 16; ++j) { const unsigned c = xb_ld(&bar[XB_XCNT(j)]); sum += c; cnt += (c > 0u) ? 1u : 0u; mine = (j == x) ? c : mine; }
        if (sum == G) break;
        __builtin_amdgcn_s_sleep(1);
        if ((++sp & 255u) == 0u) { if (xb_ld(&bar[XB_TMO])) break; if (sp > XB_SPIN_CAP) { atomicAdd(&bar[XB_TMO], 1u); break; } }
    }
    nloc = mine > 0u ? mine : 1u; nx = cnt > 0u ? cnt : 1u;
}

__device__ __forceinline__ void xcd_barrier(const XcdBarrier& b) {
    asm volatile("s_waitcnt vmcnt(0)" ::: "memory");
    __syncthreads();
    if (threadIdx.x == 0) {
        unsigned* bar = b.bar;
        __builtin_amdgcn_s_waitcnt(0);
        unsigned nloc = b.st[0], nx = b.st[1];
        if (nloc == 0u) { xcd_barrier_complete(bar, b.x, nloc, nx); b.st[0] = nloc; b.st[1] = nx; }
        const unsigned old = xb_add(&bar[XB_XSUB(b.x)], 1u);
        const unsigned gen = old / nloc;
        if (old + 1u == (gen + 1u) * nloc) {
            __builtin_amdgcn_fence(__ATOMIC_RELEASE, "agent");
            asm volatile("s_waitcnt vmcnt(0)" ::: "memory");
            const unsigned og = xb_add(&bar[XB_TOP], 1u);
            const unsigned tg = og / nx;
            if (og + 1u == (tg + 1u) * nx) xb_add(&bar[XB_TOPGEN], 1u);
            else XB_SPIN(xb_ld(&bar[XB_TOPGEN]) == tg, bar);
            __builtin_amdgcn_fence(__ATOMIC_ACQUIRE, "agent");
            xb_add(&bar[XB_XGEN(b.x)], 1u);
            asm volatile("s_waitcnt vmcnt(0)" ::: "memory");
        } else {
            XB_SPIN(xb_ld(&bar[XB_XGEN(b.x)]) == gen, bar);
            __builtin_amdgcn_fence(__ATOMIC_ACQUIRE, "agent");
            asm volatile("s_waitcnt vmcnt(0)" ::: "memory");
        }
    }
    __syncthreads();
}

#define GRID_BAR() do { XcdBarrier b_; b_.bar = (unsigned*)(kargs()->ws + WS_CTL); b_.x = xb_xcc_id(); b_.st = (volatile LAS unsigned*)((LAS unsigned char*)lds + MISC_OFF); xcd_barrier(b_); } while (0)
#ifndef PROBE_GRP
#define PROBE_GRP 0
#endif
#define TIMED(grp, ...) do { unsigned long long t0_ = 0; if (PROBE_GRP == (grp)) t0_ = __builtin_amdgcn_s_memrealtime(); __VA_ARGS__; \
    if (PROBE_GRP == (grp) && blockIdx.x == 0) { const unsigned long long dt_ = __builtin_amdgcn_s_memrealtime() - t0_; const unsigned long long t1_ = __builtin_amdgcn_s_memrealtime(); \
        while (__builtin_amdgcn_s_memrealtime() - t1_ < 2 * dt_) __builtin_amdgcn_s_sleep(8); } } while (0)
__global__ void __launch_bounds__(NWAVES * 64, 2) mega_fwd(Args args) {
    extern __shared__ __attribute__((aligned(16))) unsigned char lds[];
    cg::grid_group grid = cg::this_grid();
    if (threadIdx.x < 2) ((volatile LAS unsigned*)((LAS unsigned char*)lds + MISC_OFF))[threadIdx.x] = 0u;
    __syncthreads();
    (void)xcd_barrier_post((unsigned*)(kargs()->ws + WS_CTL), (volatile LAS unsigned*)((LAS unsigned char*)lds + MISC_OFF));
    { LAS float* rc = (LAS float*)((LAS unsigned char*)lds + ROPE_OFF);
      for (int i = threadIdx.x; i < 1024; i += 512) { const int pos = i >> 4, fi = i & 15; const float inv = exp2f(-(float)fi * (13.287712379549449f / 16.f)); const float ang = (float)pos * inv; rc[i] = cosf(ang); rc[1024 + i] = sinf(ang); } }
    __syncthreads();

    if (args.ws == nullptr) grid.sync();
    p0a(); GRID_BAR(); p0b(); GRID_BAR(); p0c(); GRID_BAR();
    for (int l = 0; l < NL; ++l) {
        const bool last = (l == NL - 1); const int mrows = last ? NLAT : NROW;
        for (int s = 0; s < 3; ++s) {
            if (s != 1) {
                const bool second = (s == 2); const int rows = (second && last) ? NLAT : NROW;
                { KArgs KA = kargs(); pg8::Gemm g{((bf16*)(KA->ws + WS_A)), wbuf(KA, l, second ? WO_W1B : WO_W1A), rows, 2 * DFF, DM}; pg8::StaticOrder S; S.init(rows, 2 * DFF, (int)gridDim.x, (int)blockIdx.x); pg8::EpiSwiGLU E{((bf16*)(KA->ws + WS_ACT)), DFF};
                  pg8::gemm_phase<pg8::EpiSwiGLU, pg8::StaticOrder, true, GEMM_SP2>((LAS unsigned char*)lds, g, S, E); }
                GRID_BAR();
                { KArgs KA = kargs(); pg8::Gemm g{((bf16*)(KA->ws + WS_ACT)), wbuf(KA, l, second ? WO_W2B : WO_W2A), NLAT, DM, DFF}; pg8::StaticOrder S; S.init(NLAT, DM, (int)gridDim.x, (int)blockIdx.x); pg8::EpiBf16 E{((bf16*)(KA->ws + WS_O)), DM};
                  pg8::gemm_phase<pg8::EpiBf16, pg8::StaticOrder, true, GEMM_SP2>((LAS unsigned char*)lds, g, S, E); }
                GRID_BAR();
                const bool split = (rows == NROW);
                const int gidx = second ? 8 : 2, lnidx = second ? 2 : 0, nl = second ? l + 1 : l, nsh = second ? (last ? -1 : 0) : 3;
                if (split && blockIdx.x < 32) {
                    KArgs KA = kargs(); pg8::Gemm g{((bf16*)(KA->ws + WS_ACT)) + (size_t)NLAT * DFF, wbuf(KA, l, second ? WO_W2B : WO_W2A), NCTX, DM, DFF}; pg8::StaticOrder S; S.init(NCTX, DM, 32, (int)blockIdx.x);
                    pg8::EpiBf16 E{((bf16*)(KA->ws + WS_O)) + (size_t)NLAT * DM, DM};
                    pg8::gemm_phase<pg8::EpiBf16, pg8::StaticOrder, true, GEMM_SP2>((LAS unsigned char*)lds, g, S, E);
                } else ln_pass(l, gidx, 0.5f, lnidx, nl, nsh, 0, NLAT, split ? 32 : 0, split ? (int)gridDim.x - 32 : (int)gridDim.x, !second);
                if (split) { GRID_BAR(); ln_pass(l, gidx, 0.5f, lnidx, nl, nsh, NLAT, NROW, 0, (int)gridDim.x, !second); }
                if (!(second && last)) GRID_BAR();
            } else {
                { KArgs KA = kargs(); pg8::Gemm g{((bf16*)(KA->ws + WS_A)), wbuf(KA, l, WO_WIN), NROW, NPJ, DM}; pg8::StaticOrder S; S.init(NROW, NPJ, (int)gridDim.x, (int)blockIdx.x); pg8::EpiBf16 E{((bf16*)(KA->ws + WS_ACT)), NPJ};
                  pg8::gemm_phase<pg8::EpiBf16, pg8::StaticOrder, true, GEMM_SP2>((LAS unsigned char*)lds, g, S, E); }
                GRID_BAR();
                prep_pass(l); GRID_BAR();
                mixers_flash(l, last); GRID_BAR();
                ssd_scan(); GRID_BAR();
                ssd_outputs_phase(l, last); GRID_BAR();
                merge_pass(l, mrows); GRID_BAR();
                { KArgs KA = kargs(); pg8::Gemm g{((bf16*)(KA->ws + WS_A)), wbuf(KA, l, WO_WOUT), mrows, DM, DM}; pg8::StaticOrder S; S.init(mrows, DM, (int)gridDim.x, (int)blockIdx.x); pg8::EpiBf16 E{((bf16*)(KA->ws + WS_O)), DM};
                  pg8::gemm_phase<pg8::EpiBf16, pg8::StaticOrder, true, GEMM_SP2>((LAS unsigned char*)lds, g, S, E); }
                GRID_BAR();
                ln_pass(l, 5, 1.0f, 1, l, 6, 0, mrows, 0, (int)gridDim.x, false); GRID_BAR();
            }
        }
    }
}

extern "C" void kernel_launch(void* const* d_in, const int* in_sizes, int n_in, void* d_out, int out_size, void* d_ws, size_t ws_size, hipStream_t stream) {
    static int grid = 0;
    if (grid == 0) {
        if (n_in != 24 || out_size != NLAT * DM || ws_size < WS_END) { fprintf(stderr, "kernel_launch: unexpected shapes: n_in %d out %d ws %zu\n", n_in, out_size, ws_size); grid = -1; return; }
        int dev = 0, cus = 0, per_cu = 0;
        hipGetDevice(&dev); hipDeviceGetAttribute(&cus, hipDeviceAttributeMultiprocessorCount, dev);
        if (hipFuncSetAttribute((const void*)mega_fwd, hipFuncAttributeMaxDynamicSharedMemorySize, LDS_BYTES) != hipSuccess) { fprintf(stderr, "kernel_launch: hipFuncSetAttribute failed\n"); grid = -1; return; }
        if (hipOccupancyMaxActiveBlocksPerMultiprocessor(&per_cu, (const void*)mega_fwd, NWAVES * 64, LDS_BYTES) != hipSuccess || per_cu < 1) { fprintf(stderr, "kernel_launch: occupancy query says %d\n", per_cu); per_cu = 1; }
        (void)hipGetLastError();
        grid = cus;
    }
    if (grid < 0) return;
    if (hipMemsetAsync((char*)d_ws + WS_CTL, 0, CTL_BYTES, stream) != hipSuccess) { fprintf(stderr, "kernel_launch: memset of the barrier words failed\n"); return; }
    Args a{};
    for (int i = 0; i < 24; ++i) a.in[i] = (const float*)d_in[i];
    a.out = (float*)d_out; a.ws = (unsigned char*)d_ws;
    void* kargs[] = {&a};
    hipError_t e = hipLaunchCooperativeKernel((const void*)mega_fwd, dim3(grid), dim3(NWAVES * 64), kargs, LDS_BYTES, stream);
    if (e != hipSuccess) fprintf(stderr, "kernel_launch: cooperative launch failed: %s (grid %d)\n", hipGetErrorString(e), grid);
}
```
